# Optimizing an MI355X kernel written in HIP

```python
import math
import jax, jax.numpy as jnp
from jax import lax
import numpy as np

D_MODEL = 1024
BATCH = 16
SEQ = 256
DEPTH = 4
DEC_BATCH = 2
DEC_SEQ = 2048
PAST_LEN = 256

GRID_W = 64
Q_BLOCK = 128
ROPE_THETA = 10000.0
EPS = 1e-6
N_EVEN = (DEPTH + 1) // 2
N_ODD = DEPTH // 2

MLA_HEADS = 8
MLA_NOPE = 64
MLA_ROPE = 32
MLA_V = 64
MLA_QK = MLA_NOPE + MLA_ROPE
Q_LORA = 256
KV_LORA = 128
MLA_WIDTH = MLA_HEADS * MLA_V
DIFF_HEADS = 4
DIFF_HD = 64
DIFF_WIDTH = DIFF_HEADS * 2 * DIFF_HD
NA_HEADS = 8
NA_HD = 64
NA_ROWS = 8
NA_COLS = 16
NA_QCOLS = 16
NA_BAND = 2 * NA_COLS
NA_WIDTH = NA_HEADS * NA_HD
GQA_HEADS = 8
GQA_KV = 2
GQA_GROUP = GQA_HEADS // GQA_KV
GQA_HD = 64
GQA_WIDTH = GQA_HEADS * GQA_HD

EVEN_SPLITS = (Q_LORA, KV_LORA + MLA_ROPE, MLA_WIDTH, DIFF_WIDTH, DIFF_WIDTH, DIFF_WIDTH, DIFF_WIDTH)
EVEN_IN = sum(EVEN_SPLITS)
EVEN_OUT = MLA_WIDTH + DIFF_WIDTH
ODD_SPLITS = (3 * NA_WIDTH, NA_WIDTH, GQA_WIDTH, 2 * GQA_KV * GQA_HD, GQA_WIDTH)
ODD_IN = sum(ODD_SPLITS)
ODD_OUT = NA_WIDTH + GQA_WIDTH

kernel_name = 'hybrid_mla_diff_natten_gqa_prefix_dit_step'


def _split(u, sizes):
    idx = [int(v) for v in np.cumsum(sizes)[:-1]]
    return jnp.split(u, idx, axis=-1)


def rmsnorm(x, g):
    x32 = x.astype(jnp.float32)
    y = x32 * lax.rsqrt(jnp.mean(x32 * x32, axis=-1, keepdims=True) + EPS)
    return (y * g.astype(jnp.float32)).astype(x.dtype)


def axial_rope(T, rot_dim):
    pos = jnp.arange(T, dtype=jnp.int32)
    row = (pos // GRID_W).astype(jnp.float32)
    col = (pos % GRID_W).astype(jnp.float32)
    n = rot_dim // 2
    inv = ROPE_THETA ** (-jnp.arange(0, n, 2, dtype=jnp.float32) / n)
    ang = jnp.concatenate([row[:, None] * inv, col[:, None] * inv], axis=-1)
    return jnp.cos(ang), jnp.sin(ang)


def apply_rope(x, cs):
    cos, sin = cs
    shp = (1, cos.shape[0]) + (1,) * (x.ndim - 3) + (cos.shape[-1],)
    cos = cos.reshape(shp)
    sin = sin.reshape(shp)
    x32 = x.astype(jnp.float32)
    half = x.shape[-1] // 2
    x1, x2 = x32[..., :half], x32[..., half:]
    return jnp.concatenate([x1 * cos - x2 * sin, x2 * cos + x1 * sin], axis=-1).astype(x.dtype)


def attend(q, k, v, scale):
    B, Tq, Hk, G, d = q.shape
    nb = Tq // Q_BLOCK
    qb = q.reshape(B, nb, Q_BLOCK, Hk, G, d).swapaxes(0, 1)
    k32 = k.astype(jnp.float32)
    v32 = v.astype(jnp.float32)

    def one(qblk):
        s = jnp.einsum('bqhgd,bkhd->bhgqk', qblk.astype(jnp.float32), k32) * scale
        p = jax.nn.softmax(s, axis=-1)
        return jnp.einsum('bhgqk,bkhe->bqhge', p, v32)

    o = lax.map(one, qb)
    return o.swapaxes(0, 1).reshape(B, Tq, Hk, G, v.shape[-1]).astype(q.dtype)


def na_attend(q, k, v, ck, cv, rpb):
    B, T, H, d = q.shape
    rows = T // GRID_W
    kr = min(NA_ROWS, rows)
    ncb = GRID_W // NA_QCOLS
    scale = d ** -0.5
    qg = q.reshape(B, rows, GRID_W, H, d)
    kg = k.reshape(B, rows, GRID_W, H, d)
    vg = v.reshape(B, rows, GRID_W, H, d)
    row_start = jnp.clip(jnp.arange(rows) - kr // 2, 0, rows - kr)
    qc0 = np.arange(ncb) * NA_QCOLS
    band_start = np.clip(qc0 - NA_COLS // 2, 0, GRID_W - NA_BAND)
    band_idx = band_start[:, None] + np.arange(NA_BAND)
    qcols = qc0[:, None] + np.arange(NA_QCOLS)
    col_start = np.clip(qcols - NA_COLS // 2, 0, GRID_W - NA_COLS)
    kcol = band_idx[:, None, :]
    col_valid = (kcol >= col_start[:, :, None]) & (kcol < col_start[:, :, None] + NA_COLS)
    dc_idx = np.clip(kcol - qcols[:, :, None] + NA_COLS - 1, 0, 2 * NA_COLS - 2)
    mask = jnp.asarray(np.broadcast_to(col_valid[:, :, None, :], (ncb, NA_QCOLS, kr, NA_BAND)).reshape(ncb, NA_QCOLS, kr * NA_BAND))
    rpb_c = rpb.astype(jnp.float32)[:, :, dc_idx]
    ck32 = ck.astype(jnp.float32)
    cv32 = cv.astype(jnp.float32)
    nloc = kr * NA_BAND

    def one_row(args):
        q_row, r = args
        rs = row_start[r]
        kw = lax.dynamic_slice_in_dim(kg, rs, kr, axis=1)
        vw = lax.dynamic_slice_in_dim(vg, rs, kr, axis=1)
        kb = kw[:, :, band_idx].transpose(0, 2, 1, 3, 4, 5).reshape(B, ncb, nloc, H, d).astype(jnp.float32)
        vb = vw[:, :, band_idx].transpose(0, 2, 1, 3, 4, 5).reshape(B, ncb, nloc, H, d).astype(jnp.float32)
        dr_idx = rs + jnp.arange(kr) - r + NA_ROWS - 1
        bias = rpb_c[:, dr_idx].transpose(0, 2, 3, 1, 4).reshape(H, ncb, NA_QCOLS, nloc)
        qr = q_row.reshape(B, ncb, NA_QCOLS, H, d).astype(jnp.float32)
        s_loc = jnp.einsum('bnqhd,bnkhd->bhnqk', qr, kb) * scale + bias[None]
        s_loc = jnp.where(mask[None, None], s_loc, -1e30)
        s_ctx = jnp.einsum('bnqhd,bkhd->bhnqk', qr, ck32) * scale
        p = jax.nn.softmax(jnp.concatenate([s_loc, s_ctx], axis=-1), axis=-1)
        o = jnp.einsum('bhnqk,bnkhd->bnqhd', p[..., :nloc], vb) + jnp.einsum('bhnqk,bkhd->bnqhd', p[..., nloc:], cv32)
        return o.reshape(B, GRID_W, H, d)

    out = lax.map(one_row, (qg.swapaxes(0, 1), jnp.arange(rows)))
    return out.swapaxes(0, 1).reshape(B, T, H, d).astype(q.dtype)


def even_mixers(h, i, lam_init, P, rope, cache):
    B, T, _ = h.shape
    u = h @ P['w_in_even'][i]
    qa, kva, mgate, dq, dk, dv, dgate = _split(u, EVEN_SPLITS)
    q = (rmsnorm(qa, P['mla_qa_norm'][i]) @ P['mla_wqb'][i]).reshape(B, T, MLA_HEADS, MLA_QK)
    q_nope = rmsnorm(q[..., :MLA_NOPE], P['mla_qn_nope'][i])
    q_pe = rmsnorm(q[..., MLA_NOPE:], P['mla_qn_rope'][i])
    c_kv = rmsnorm(kva[..., :KV_LORA], P['mla_kva_norm'][i])
    k_pe = rmsnorm(kva[..., KV_LORA:], P['mla_kn_rope'][i])
    state = [c_kv, k_pe]
    k_pe_use = k_pe
    if rope is not None:
        q_pe = apply_rope(q_pe, rope['mla'])
        k_pe_use = apply_rope(k_pe[:, :, None, :], rope['mla'])[:, :, 0]
    c_all, kpe_all = c_kv, k_pe_use
    if cache is not None:
        c_all = jnp.concatenate([c_kv, cache[0]], axis=1)
        kpe_all = jnp.concatenate([k_pe_use, cache[1]], axis=1)
    Tk = c_all.shape[1]
    kv = (c_all @ P['mla_wkvb'][i]).reshape(B, Tk, MLA_HEADS, MLA_NOPE + MLA_V)
    k_nope = rmsnorm(kv[..., :MLA_NOPE], P['mla_kn_nope'][i])
    v_m = kv[..., MLA_NOPE:]
    k_m = jnp.concatenate([k_nope, jnp.broadcast_to(kpe_all[:, :, None, :], (B, Tk, MLA_HEADS, MLA_ROPE))], axis=-1)
    q_m = jnp.concatenate([q_nope, q_pe], axis=-1)[:, :, :, None, :]
    o_mla = attend(q_m, k_m, v_m, MLA_QK ** -0.5).reshape(B, T, MLA_WIDTH) * jax.nn.silu(mgate)
    dq = rmsnorm(dq.reshape(B, T, DIFF_HEADS, 2, DIFF_HD), P['diff_qn'][i])
    dk = rmsnorm(dk.reshape(B, T, DIFF_HEADS, 2, DIFF_HD), P['diff_kn'][i])
    dv = dv.reshape(B, T, DIFF_HEADS, 2 * DIFF_HD)
    state += [dk, dv]
    dk_use = dk
    if rope is not None:
        dq = apply_rope(dq, rope['diff'])
        dk_use = apply_rope(dk, rope['diff'])
    dk_all, dv_all = dk_use, dv
    if cache is not None:
        dk_all = jnp.concatenate([dk_use, cache[2]], axis=1)
        dv_all = jnp.concatenate([dv, cache[3]], axis=1)
    f32 = jnp.float32
    lam = (jnp.exp(jnp.sum(P['diff_lq1'][i].astype(f32) * P['diff_lk1'][i].astype(f32)))
           - jnp.exp(jnp.sum(P['diff_lq2'][i].astype(f32) * P['diff_lk2'][i].astype(f32))) + lam_init)
    sc = DIFF_HD ** -0.5
    a1 = attend(dq[:, :, :, 0:1], dk_all[:, :, :, 0], dv_all, sc)
    a2 = attend(dq[:, :, :, 1:2], dk_all[:, :, :, 1], dv_all, sc)
    o_d = rmsnorm((a1 - lam.astype(a1.dtype) * a2)[:, :, :, 0], P['diff_subln'][i]) * (1.0 - lam_init)
    o_diff = o_d.reshape(B, T, DIFF_WIDTH) * jax.nn.silu(dgate)
    out = jnp.concatenate([o_mla, o_diff], axis=-1) @ P['w_out_even'][i]
    return out, state


def odd_mixers(h, i, P, rope, cache):
    B, T, _ = h.shape
    u = h @ P['w_in_odd'][i]
    naqkv, nagate, gq, gkv, ggate = _split(u, ODD_SPLITS)
    naqkv = naqkv.reshape(B, T, 3, NA_HEADS, NA_HD)
    nq = rmsnorm(naqkv[:, :, 0], P['na_qn'][i])
    nk = rmsnorm(naqkv[:, :, 1], P['na_kn'][i])
    nv = naqkv[:, :, 2]
    state = [nk, nv]
    if cache is None:
        o_na = attend(nq[:, :, :, None], nk, nv, NA_HD ** -0.5)[:, :, :, 0]
    else:
        o_na = na_attend(nq, nk, nv, cache[0], cache[1], P['na_rpb'][i])
    o_na = o_na.reshape(B, T, NA_WIDTH) * jax.nn.silu(nagate)
    gq = rmsnorm(gq.reshape(B, T, GQA_KV, GQA_GROUP, GQA_HD), P['gqa_qn'][i])
    gkv = gkv.reshape(B, T, 2, GQA_KV, GQA_HD)
    gk = rmsnorm(gkv[:, :, 0], P['gqa_kn'][i])
    gv = gkv[:, :, 1]
    state += [gk, gv]
    gk_use = gk
    if rope is not None:
        gq = apply_rope(gq, rope['gqa'])
        gk_use = apply_rope(gk, rope['gqa'])
    gk_all, gv_all = gk_use, gv
    if cache is not None:
        gk_all = jnp.concatenate([gk_use, cache[2]], axis=1)
        gv_all = jnp.concatenate([gv, cache[3]], axis=1)
    o_g = attend(gq, gk_all, gv_all, GQA_HD ** -0.5).reshape(B, T, GQA_WIDTH) * jax.nn.silu(ggate)
    out = jnp.concatenate([o_na, o_g], axis=-1) @ P['w_out_odd'][i]
    return out, state


def block(x, cvec, l, P, rope, cache):
    mod = jax.nn.silu(cvec) @ P['w_mod'][l] + P['b_mod'][l]
    shift, scale, gate = jnp.split(mod[:, None, :], 3, axis=-1)
    h = rmsnorm(x, P['norm_w'][l]) * (1.0 + scale) + shift
    if l % 2 == 0:
        lam_init = 0.8 - 0.6 * math.exp(-0.3 * l)
        o, st = even_mixers(h, l // 2, lam_init, P, rope, cache)
    else:
        o, st = odd_mixers(h, l // 2, P, rope, cache)
    return x + gate * o, st


def setup_inputs(seed: int = 0) -> dict:
    key = jax.random.key(seed)
    ks = iter(jax.random.split(key, 48))
    f32 = jnp.float32

    def nrm(shape, scale=1.0):
        return jax.random.normal(next(ks), shape, f32) * scale

    def gain(shape):
        return 1.0 + nrm(shape, 0.05)

    return {
        'x_prompt': nrm((BATCH, SEQ, D_MODEL)),
        'x_sample': nrm((DEC_BATCH, DEC_SEQ, D_MODEL)),
        'cache_mla_ckv': nrm((DEC_BATCH, N_EVEN, PAST_LEN, KV_LORA)),
        'cache_mla_kpe': nrm((DEC_BATCH, N_EVEN, PAST_LEN, MLA_ROPE)),
        'cache_diff_k': nrm((DEC_BATCH, N_EVEN, PAST_LEN, DIFF_HEADS, 2, DIFF_HD)),
        'cache_diff_v': nrm((DEC_BATCH, N_EVEN, PAST_LEN, DIFF_HEADS, 2 * DIFF_HD)),
        'cache_na_k': nrm((DEC_BATCH, N_ODD, PAST_LEN, NA_HEADS, NA_HD)),
        'cache_na_v': nrm((DEC_BATCH, N_ODD, PAST_LEN, NA_HEADS, NA_HD)),
        'cache_gqa_k': nrm((DEC_BATCH, N_ODD, PAST_LEN, GQA_KV, GQA_HD)),
        'cache_gqa_v': nrm((DEC_BATCH, N_ODD, PAST_LEN, GQA_KV, GQA_HD)),
        'c': nrm((DEC_BATCH, D_MODEL)),
        'c_ctx': nrm((D_MODEL,)),
        'norm_w': gain((DEPTH, D_MODEL)),
        'w_mod': nrm((DEPTH, D_MODEL, 3 * D_MODEL), 0.5 * D_MODEL ** -0.5),
        'b_mod': nrm((DEPTH, 3 * D_MODEL), 0.01),
        'w_in_even': nrm((N_EVEN, D_MODEL, EVEN_IN), D_MODEL ** -0.5),
        'w_out_even': nrm((N_EVEN, EVEN_OUT, D_MODEL), EVEN_OUT ** -0.5),
        'mla_qa_norm': gain((N_EVEN, Q_LORA)),
        'mla_wqb': nrm((N_EVEN, Q_LORA, MLA_HEADS * MLA_QK), Q_LORA ** -0.5),
        'mla_kva_norm': gain((N_EVEN, KV_LORA)),
        'mla_wkvb': nrm((N_EVEN, KV_LORA, MLA_HEADS * (MLA_NOPE + MLA_V)), KV_LORA ** -0.5),
        'mla_qn_nope': gain((N_EVEN, MLA_NOPE)),
        'mla_qn_rope': gain((N_EVEN, MLA_ROPE)),
        'mla_kn_nope': gain((N_EVEN, MLA_NOPE)),
        'mla_kn_rope': gain((N_EVEN, MLA_ROPE)),
        'diff_qn': gain((N_EVEN, DIFF_HD)),
        'diff_kn': gain((N_EVEN, DIFF_HD)),
        'diff_lq1': nrm((N_EVEN, DIFF_HD), 0.1),
        'diff_lk1': nrm((N_EVEN, DIFF_HD), 0.1),
        'diff_lq2': nrm((N_EVEN, DIFF_HD), 0.1),
        'diff_lk2': nrm((N_EVEN, DIFF_HD), 0.1),
        'diff_subln': gain((N_EVEN, 2 * DIFF_HD)),
        'w_in_odd': nrm((N_ODD, D_MODEL, ODD_IN), D_MODEL ** -0.5),
        'w_out_odd': nrm((N_ODD, ODD_OUT, D_MODEL), ODD_OUT ** -0.5),
        'na_qn': gain((N_ODD, NA_HD)),
        'na_kn': gain((N_ODD, NA_HD)),
        'na_rpb': nrm((N_ODD, NA_HEADS, 2 * NA_ROWS - 1, 2 * NA_COLS - 1), 0.1),
        'gqa_qn': gain((N_ODD, GQA_HD)),
        'gqa_kn': gain((N_ODD, GQA_HD)),
    }


def reference(x_prompt, x_sample, cache_mla_ckv, cache_mla_kpe, cache_diff_k, cache_diff_v,
              cache_na_k, cache_na_v, cache_gqa_k, cache_gqa_v, c, c_ctx,
              norm_w, w_mod, b_mod, w_in_even, w_out_even, mla_qa_norm, mla_wqb, mla_kva_norm, mla_wkvb,
              mla_qn_nope, mla_qn_rope, mla_kn_nope, mla_kn_rope, diff_qn, diff_kn,
              diff_lq1, diff_lk1, diff_lq2, diff_lk2, diff_subln, w_in_odd, w_out_odd,
              na_qn, na_kn, na_rpb, gqa_qn, gqa_kn):
    P = dict(norm_w=norm_w, w_mod=w_mod, b_mod=b_mod, w_in_even=w_in_even, w_out_even=w_out_even,
             mla_qa_norm=mla_qa_norm, mla_wqb=mla_wqb, mla_kva_norm=mla_kva_norm, mla_wkvb=mla_wkvb,
             mla_qn_nope=mla_qn_nope, mla_qn_rope=mla_qn_rope, mla_kn_nope=mla_kn_nope, mla_kn_rope=mla_kn_rope,
             diff_qn=diff_qn, diff_kn=diff_kn, diff_lq1=diff_lq1, diff_lk1=diff_lk1, diff_lq2=diff_lq2,
             diff_lk2=diff_lk2, diff_subln=diff_subln, w_in_odd=w_in_odd, w_out_odd=w_out_odd,
             na_qn=na_qn, na_kn=na_kn, na_rpb=na_rpb, gqa_qn=gqa_qn, gqa_kn=gqa_kn)

    ev_states = [[], [], [], []]
    od_states = [[], [], [], []]
    x = x_prompt
    c_prompt = c_ctx[None, :]
    for l in range(DEPTH):
        x, st = block(x, c_prompt, l, P, None, None)
        target = ev_states if l % 2 == 0 else od_states
        for j in range(4):
            target[j].append(st[j])
    y_prompt = x

    T = x_sample.shape[1]
    rope = {'mla': axial_rope(T, MLA_ROPE), 'diff': axial_rope(T, DIFF_HD), 'gqa': axial_rope(T, GQA_HD)}
    x = x_sample
    for l in range(DEPTH):
        i = l // 2
        if l % 2 == 0:
            cache = (cache_mla_ckv[:, i], cache_mla_kpe[:, i], cache_diff_k[:, i], cache_diff_v[:, i])
        else:
            cache = (cache_na_k[:, i], cache_na_v[:, i], cache_gqa_k[:, i], cache_gqa_v[:, i])
        x, _ = block(x, c, l, P, rope, cache)
    y_sample = x

    new_mla_ckv = jnp.stack(ev_states[0], axis=1)
    new_mla_kpe = jnp.stack(ev_states[1], axis=1)
    new_diff_k = jnp.stack(ev_states[2], axis=1)
    new_diff_v = jnp.stack(ev_states[3], axis=1)
    new_na_k = jnp.stack(od_states[0], axis=1)
    new_na_v = jnp.stack(od_states[1], axis=1)
    new_gqa_k = jnp.stack(od_states[2], axis=1)
    new_gqa_v = jnp.stack(od_states[3], axis=1)
    return (y_prompt, y_sample, new_mla_ckv, new_mla_kpe, new_diff_k, new_diff_v, new_na_k, new_na_v, new_gqa_k, new_gqa_v)
```

```cpp
#ifndef CPU_EMU
#include <hip/hip_runtime.h>
#endif
#include <stdint.h>
#include <math.h>

#ifndef CFG_BATCH
#define CFG_BATCH 16
#endif
#ifndef CFG_DB
#define CFG_DB 2
#endif
#ifndef CFG_DS
#define CFG_DS 2048
#endif
constexpr int D = 1024, BATCH = CFG_BATCH, SEQ = 256, DB = CFG_DB, DS = CFG_DS, PAST = 256;
constexpr int MP = BATCH * SEQ, MS = DB * DS, M = MP + MS;
constexpr int TKS = DS + PAST;
constexpr int KM = MP + DB * TKS;
constexpr int NCV = 1 + DB;
constexpr int GW = 64, GROWS = DS / GW;
constexpr int EVEN_IN = 2976, ODD_IN = 3328;
constexpr float EPSN = 1e-6f;
constexpr float LOG2E = 1.4426950408889634f;

typedef _Float16 h16;

struct Params {
  const float *x_prompt, *x_sample, *cache_mla_ckv, *cache_mla_kpe, *cache_diff_k, *cache_diff_v, *cache_na_k, *cache_na_v,
      *cache_gqa_k, *cache_gqa_v, *c, *c_ctx, *norm_w, *w_mod, *b_mod, *w_in_even, *w_out_even, *mla_qa_norm, *mla_wqb,
      *mla_kva_norm, *mla_wkvb, *mla_qn_nope, *mla_qn_rope, *mla_kn_nope, *mla_kn_rope, *diff_qn, *diff_kn, *diff_lq1,
      *diff_lk1, *diff_lq2, *diff_lk2, *diff_subln, *w_in_odd, *w_out_odd, *na_qn, *na_kn, *na_rpb, *gqa_qn, *gqa_kn;
  float *Y;
  float *o_ckv, *o_kpe, *o_dk, *o_dv, *o_nk, *o_nv, *o_gk, *o_gv;
  float *modv;
  float *ropeC64, *ropeS64;
  float *ropeC32, *ropeS32;
  float *lamv;
  float *rstdx;
  h16 *ubuf;
  float *abuf;
  float *ckvbuf;
  float *kpebuf;
  h16 *QA, *QB, *KA, *KB, *VA, *VB, *gates16, *O16;
};

#ifdef CPU_EMU
#include <stdio.h>
#include <stdlib.h>
#include <string.h>
typedef void* hipStream_t;
#define KERNEL static void
#define DEVFN static inline
static thread_local long emu_gtid;
#define GTID emu_gtid
template <class... A, class... B>
static void launch1d(void (*f)(A...), long n, hipStream_t, B... a) {
#pragma omp parallel for schedule(dynamic, 64)
  for (long i = 0; i < n; i++) { emu_gtid = i; f(a...); }
}
static inline float exp2f_(float x) { return exp2f(x); }
#else
#define KERNEL __global__ void __launch_bounds__(256)
#define DEVFN __device__ __forceinline__
#define GTID ((long)blockIdx.x * 256 + threadIdx.x)
template <class... A, class... B>
static void launch1d(void (*f)(A...), long n, hipStream_t s, B... a) {
  hipLaunchKernelGGL(f, dim3((unsigned)((n + 255) / 256)), dim3(256), 0, s, a...);
}
DEVFN float exp2f_(float x) { return exp2f(x); }
#endif

DEVFN int tok_cv(int m) { return m < MP ? 0 : 1 + (m - MP) / DS; }
DEVFN int tok_keyrow(int m) { return m < MP ? m : MP + ((m - MP) / DS) * TKS + (m - MP) % DS; }
DEVFN int tok_pos(int m) { return m < MP ? (m % SEQ) : ((m - MP) % DS); }
DEVFN const float* xrow(const Params& p, int l, int m) {
  if (l > 0) return p.Y + (size_t)m * D;
  return m < MP ? p.x_prompt + (size_t)m * D : p.x_sample + (size_t)(m - MP) * D;
}
DEVFN float siluf(float x) { return x / (1.f + expf(-x)); }

KERNEL nk_mod(Params p, long n) {
  long g = GTID; if (g >= n) return;
  int col = g % 3072; int cv = (g / 3072) % NCV; int l = g / (3072 * NCV);
  const float* cvec = cv == 0 ? p.c_ctx : p.c + (size_t)(cv - 1) * D;
  const float* w = p.w_mod + (size_t)l * D * 3072 + col;
  float acc = p.b_mod[l * 3072 + col];
  for (int k = 0; k < D; k++) acc += siluf(cvec[k]) * w[(size_t)k * 3072];
  p.modv[((size_t)l * NCV + cv) * 3072 + col] = acc;
}
KERNEL nk_tab(Params p, long n) {
  long g = GTID; if (g >= n) return;
  if (g < 2) {
    int i = g; int l = 2 * i;
    float s1 = 0, s2 = 0;
    for (int k = 0; k < 64; k++) { s1 += p.diff_lq1[i * 64 + k] * p.diff_lk1[i * 64 + k]; s2 += p.diff_lq2[i * 64 + k] * p.diff_lk2[i * 64 + k]; }
    float lam_init = 0.8f - 0.6f * expf(-0.3f * l);
    p.lamv[i] = expf(s1) - expf(s2) + lam_init;
  }
  int t = g / 48, j = g % 48;
  if (t >= DS) return;
  float row = (float)(t / GW), col = (float)(t % GW);
  if (j < 32) {
    int f = j & 15; float inv = powf(10000.f, -(float)(2 * f) / 32.f);
    float ang = (j < 16 ? row : col) * inv;
    p.ropeC64[t * 32 + j] = cosf(ang); p.ropeS64[t * 32 + j] = sinf(ang);
  } else {
    int jj = j - 32; int f = jj & 7; float inv = powf(10000.f, -(float)(2 * f) / 16.f);
    float ang = (jj < 8 ? row : col) * inv;
    p.ropeC32[t * 16 + jj] = cosf(ang); p.ropeS32[t * 16 + jj] = sinf(ang);
  }
}
KERNEL nk_rstd(Params p, int l, long n) {
  long g = GTID; if (g >= n) return;
  const float* x = xrow(p, l, (int)g);
  float s = 0; for (int k = 0; k < D; k++) s += x[k] * x[k];
  p.rstdx[g] = 1.f / sqrtf(s / D + EPSN);
}
KERNEL nk_inproj(Params p, int l, long n) {
  long g = GTID; if (g >= n) return;
  const int N = (l & 1) ? ODD_IN : EVEN_IN;
  int m = g / N, col = g % N;
  const float* W = ((l & 1) ? p.w_in_odd : p.w_in_even) + (size_t)(l >> 1) * D * N + col;
  const float* x = xrow(p, l, m);
  const float* md = p.modv + ((size_t)l * NCV + tok_cv(m)) * 3072;
  const float* nw = p.norm_w + l * D;
  float r = p.rstdx[m], acc = 0;
  for (int k = 0; k < D; k++) { float h = x[k] * r * nw[k] * (1.f + md[1024 + k]) + md[k]; acc += h * W[(size_t)k * N]; }
  p.ubuf[(size_t)m * 3328 + col] = (h16)acc;
}
DEVFN size_t st_row(int m, int i) { int b = m / SEQ, t = m % SEQ; return ((size_t)(b * 2 + i) * SEQ + t); }

KERNEL nk_epi_even(Params p, int l, long n) {
  long g = GTID; if (g >= n) return;
  const int i = l >> 1;
  int m = g / 50, u = g % 50;
  const h16* ur = p.ubuf + (size_t)m * 3328;
  const bool smp = m >= MP; const int t = tok_pos(m); const int kr = tok_keyrow(m);
  if (u < 8) {
    float ss = 0; for (int k = 0; k < 256; k++) { float v = (float)ur[k]; ss += v * v; }
    float r = 1.f / sqrtf(ss / 256 + EPSN);
    float q[96];
#pragma unroll
    for (int j = 0; j < 96; j++) q[j] = 0;
    const float* W = p.mla_wqb + (size_t)i * 256 * 768 + u * 96;
    for (int k = 0; k < 256; k++) {
      float a = (float)ur[k] * r * p.mla_qa_norm[i * 256 + k];
#pragma unroll
      for (int j = 0; j < 96; j++) q[j] += a * W[(size_t)k * 768 + j];
    }
    float s1 = 0, s2 = 0;
#pragma unroll
    for (int j = 0; j < 64; j++) s1 += q[j] * q[j];
#pragma unroll
    for (int j = 64; j < 96; j++) s2 += q[j] * q[j];
    float r1 = 1.f / sqrtf(s1 / 64 + EPSN), r2 = 1.f / sqrtf(s2 / 32 + EPSN);
#pragma unroll
    for (int j = 0; j < 64; j++) q[j] = q[j] * r1 * p.mla_qn_nope[i * 64 + j];
#pragma unroll
    for (int j = 0; j < 32; j++) q[64 + j] = q[64 + j] * r2 * p.mla_qn_rope[i * 32 + j];
    if (smp) {
#pragma unroll
      for (int j = 0; j < 16; j++) {
        float c = p.ropeC32[t * 16 + j], s = p.ropeS32[t * 16 + j];
        float x1 = q[64 + j], x2 = q[80 + j];
        q[64 + j] = x1 * c - x2 * s; q[80 + j] = x2 * c + x1 * s;
      }
    }
    const float sc = LOG2E / sqrtf(96.f);
    h16* dst = p.QA + ((size_t)m * 8 + u) * 96;
#pragma unroll
    for (int j = 0; j < 96; j++) dst[j] = (h16)(q[j] * sc);
  } else if (u == 8) {
    float ss = 0; for (int k = 0; k < 128; k++) { float v = (float)ur[256 + k]; ss += v * v; }
    float r = 1.f / sqrtf(ss / 128 + EPSN);
    for (int k = 0; k < 128; k++) {
      float v = (float)ur[256 + k] * r * p.mla_kva_norm[i * 128 + k];
      if (!smp) p.o_ckv[st_row(m, i) * 128 + k] = v;
      p.ckvbuf[(size_t)kr * 128 + k] = v;
    }
  } else if (u == 9) {
    float v[32]; float ss = 0;
#pragma unroll
    for (int k = 0; k < 32; k++) { v[k] = (float)ur[384 + k]; ss += v[k] * v[k]; }
    float r = 1.f / sqrtf(ss / 32 + EPSN);
#pragma unroll
    for (int k = 0; k < 32; k++) { v[k] = v[k] * r * p.mla_kn_rope[i * 32 + k]; if (!smp) p.o_kpe[st_row(m, i) * 32 + k] = v[k]; }
    if (smp) {
#pragma unroll
      for (int j = 0; j < 16; j++) {
        float c = p.ropeC32[t * 16 + j], s = p.ropeS32[t * 16 + j];
        float x1 = v[j], x2 = v[16 + j];
        v[j] = x1 * c - x2 * s; v[16 + j] = x2 * c + x1 * s;
      }
    }
#pragma unroll
    for (int k = 0; k < 32; k++) p.kpebuf[(size_t)kr * 32 + k] = v[k];
  } else if (u < 18) {
    int cb = (u - 10) * 64;
    for (int j = 0; j < 64; j++) p.gates16[(size_t)m * 1024 + cb + j] = (h16)siluf((float)ur[416 + cb + j]);
  } else if (u < 34) {
    const bool isq = u < 26; int hc = isq ? u - 18 : u - 26;
    const h16* src = ur + (isq ? 928 : 1440) + hc * 64;
    const float* gn = (isq ? p.diff_qn : p.diff_kn) + i * 64;
    float v[64]; float ss = 0;
#pragma unroll
    for (int k = 0; k < 64; k++) { v[k] = (float)src[k]; ss += v[k] * v[k]; }
    float r = 1.f / sqrtf(ss / 64 + EPSN);
#pragma unroll
    for (int k = 0; k < 64; k++) { v[k] = v[k] * r * gn[k]; if (!isq && !smp) p.o_dk[st_row(m, i) * 512 + hc * 64 + k] = v[k]; }
    if (smp) {
#pragma unroll
      for (int j = 0; j < 32; j++) {
        float c = p.ropeC64[t * 32 + j], s = p.ropeS64[t * 32 + j];
        float x1 = v[j], x2 = v[32 + j];
        v[j] = x1 * c - x2 * s; v[32 + j] = x2 * c + x1 * s;
      }
    }
    if (isq) {
      const float sc = LOG2E / 8.f; h16* dst = p.QB + ((size_t)m * 8 + hc) * 64;
#pragma unroll
      for (int k = 0; k < 64; k++) dst[k] = (h16)(v[k] * sc);
    } else {
      h16* dst = p.KB + ((size_t)hc * KM + kr) * 64;
#pragma unroll
      for (int k = 0; k < 64; k++) dst[k] = (h16)v[k];
    }
  } else if (u < 42) {
    int ch = u - 34; int h = ch >> 1, half = ch & 1;
    for (int j = 0; j < 64; j++) {
      float v = (float)ur[1952 + ch * 64 + j];
      if (!smp) p.o_dv[st_row(m, i) * 512 + ch * 64 + j] = v;
      p.VB[((size_t)h * 128 + half * 64 + j) * KM + kr] = (h16)v;
    }
  } else {
    int cb = (u - 42) * 64;
    for (int j = 0; j < 64; j++) p.gates16[(size_t)m * 1024 + 512 + cb + j] = (h16)siluf((float)ur[2464 + cb + j]);
  }
}
KERNEL nk_cache_even(Params p, int l, long n) {
  long g = GTID; if (g >= n) return;
  const int i = l >> 1;
  int u = g % 17; int pos = (g / 17) % PAST; int b = g / (17 * PAST);
  const int kr = MP + b * TKS + DS + pos;
  const size_t crow = ((size_t)(b * 2 + i) * PAST + pos);
  if (u == 0) {
    for (int k = 0; k < 128; k++) p.ckvbuf[(size_t)kr * 128 + k] = p.cache_mla_ckv[crow * 128 + k];
    for (int k = 0; k < 32; k++) p.kpebuf[(size_t)kr * 32 + k] = p.cache_mla_kpe[crow * 32 + k];
  } else if (u < 9) {
    int hc = u - 1;
    for (int k = 0; k < 64; k++) p.KB[((size_t)hc * KM + kr) * 64 + k] = (h16)p.cache_diff_k[crow * 512 + hc * 64 + k];
  } else {
    int ch = u - 9; int h = ch >> 1, half = ch & 1;
    for (int j = 0; j < 64; j++) p.VB[((size_t)h * 128 + half * 64 + j) * KM + kr] = (h16)p.cache_diff_v[crow * 512 + ch * 64 + j];
  }
}
KERNEL nk_kv(Params p, int l, long n) {
  long g = GTID; if (g >= n) return;
  const int i = l >> 1;
  int part = g & 1; int h = (g >> 1) & 7; int kr = g >> 4;
  const float* cr = p.ckvbuf + (size_t)kr * 128;
  const float* W = p.mla_wkvb + (size_t)i * 128 * 1024 + h * 128 + part * 64;
  float a[64];
#pragma unroll
  for (int j = 0; j < 64; j++) a[j] = 0;
  for (int k = 0; k < 128; k++) {
    float c = (float)(h16)cr[k];
#pragma unroll
    for (int j = 0; j < 64; j++) a[j] += c * W[(size_t)k * 1024 + j];
  }
  if (part == 0) {
    float ss = 0;
#pragma unroll
    for (int j = 0; j < 64; j++) ss += a[j] * a[j];
    float r = 1.f / sqrtf(ss / 64 + EPSN);
    h16* dst = p.KA + ((size_t)h * KM + kr) * 96;
#pragma unroll
    for (int j = 0; j < 64; j++) dst[j] = (h16)(a[j] * r * p.mla_kn_nope[i * 64 + j]);
    for (int j = 0; j < 32; j++) dst[64 + j] = (h16)p.kpebuf[(size_t)kr * 32 + j];
  } else {
#pragma unroll
    for (int j = 0; j < 64; j++) p.VA[((size_t)h * 64 + j) * KM + kr] = (h16)a[j];
  }
}
KERNEL nk_epi_odd(Params p, int l, long n) {
  long g = GTID; if (g >= n) return;
  const int i = l >> 1;
  int m = g / 52, u = g % 52;
  const h16* ur = p.ubuf + (size_t)m * 3328;
  const bool smp = m >= MP; const int t = tok_pos(m); const int kr = tok_keyrow(m);
  if (u < 16 || (u >= 32 && u < 42)) {
    int colbase, head; const float* gn; int kind;
    if (u < 8) { kind = 0; head = u; colbase = head * 64; gn = p.na_qn + i * 64; }
    else if (u < 16) { kind = 1; head = u - 8; colbase = 512 + head * 64; gn = p.na_kn + i * 64; }
    else if (u < 40) { kind = 2; head = u - 32; colbase = 2048 + head * 64; gn = p.gqa_qn + i * 64; }
    else { kind = 3; head = u - 40; colbase = 2560 + head * 64; gn = p.gqa_kn + i * 64; }
    float v[64]; float ss = 0;
#pragma unroll
    for (int k = 0; k < 64; k++) { v[k] = (float)ur[colbase + k]; ss += v[k] * v[k]; }
    float r = 1.f / sqrtf(ss / 64 + EPSN);
#pragma unroll
    for (int k = 0; k < 64; k++) v[k] = v[k] * r * gn[k];
    if (!smp) {
      if (kind == 1) { for (int k = 0; k < 64; k++) p.o_nk[st_row(m, i) * 512 + head * 64 + k] = v[k]; }
      if (kind == 3) { for (int k = 0; k < 64; k++) p.o_gk[st_row(m, i) * 128 + head * 64 + k] = v[k]; }
    }
    if (smp && kind >= 2) {
#pragma unroll
      for (int j = 0; j < 32; j++) {
        float c = p.ropeC64[t * 32 + j], s = p.ropeS64[t * 32 + j];
        float x1 = v[j], x2 = v[32 + j];
        v[j] = x1 * c - x2 * s; v[32 + j] = x2 * c + x1 * s;
      }
    }
    const float sc = LOG2E / 8.f;
    h16* dst;
    if (kind == 0) dst = p.QA + ((size_t)m * 8 + head) * 64;
    else if (kind == 1) dst = p.KA + ((size_t)head * KM + kr) * 64;
    else if (kind == 2) dst = p.QB + ((size_t)m * 8 + head) * 64;
    else dst = p.KB + ((size_t)head * KM + kr) * 64;
    const float mul = (kind == 0 || kind == 2) ? sc : 1.f;
#pragma unroll
    for (int k = 0; k < 64; k++) dst[k] = (h16)(v[k] * mul);
  } else if (u < 24) {
    int head = u - 16;
    for (int j = 0; j < 64; j++) {
      float v = (float)ur[1024 + head * 64 + j];
      if (!smp) p.o_nv[st_row(m, i) * 512 + head * 64 + j] = v;
      p.VA[((size_t)head * 64 + j) * KM + kr] = (h16)v;
    }
  } else if (u < 32) {
    int cb = (u - 24) * 64;
    for (int j = 0; j < 64; j++) p.gates16[(size_t)m * 1024 + cb + j] = (h16)siluf((float)ur[1536 + cb + j]);
  } else if (u < 44) {
    int head = u - 42;
    for (int j = 0; j < 64; j++) {
      float v = (float)ur[2688 + head * 64 + j];
      if (!smp) p.o_gv[st_row(m, i) * 128 + head * 64 + j] = v;
      p.VB[((size_t)head * 64 + j) * KM + kr] = (h16)v;
    }
  } else {
    int cb = (u - 44) * 64;
    for (int j = 0; j < 64; j++) p.gates16[(size_t)m * 1024 + 512 + cb + j] = (h16)siluf((float)ur[2816 + cb + j]);
  }
}
KERNEL nk_cache_odd(Params p, int l, long n) {
  long g = GTID; if (g >= n) return;
  const int i = l >> 1;
  int u = g % 20; int pos = (g / 20) % PAST; int b = g / (20 * PAST);
  const int kr = MP + b * TKS + DS + pos;
  const size_t crow = ((size_t)(b * 2 + i) * PAST + pos);
  if (u < 8) { for (int k = 0; k < 64; k++) p.KA[((size_t)u * KM + kr) * 64 + k] = (h16)p.cache_na_k[crow * 512 + u * 64 + k]; }
  else if (u < 16) { int h = u - 8; for (int j = 0; j < 64; j++) p.VA[((size_t)h * 64 + j) * KM + kr] = (h16)p.cache_na_v[crow * 512 + h * 64 + j]; }
  else if (u < 18) { int h = u - 16; for (int k = 0; k < 64; k++) p.KB[((size_t)h * KM + kr) * 64 + k] = (h16)p.cache_gqa_k[crow * 128 + h * 64 + k]; }
  else { int h = u - 18; for (int j = 0; j < 64; j++) p.VB[((size_t)h * 64 + j) * KM + kr] = (h16)p.cache_gqa_v[crow * 128 + h * 64 + j]; }
}
template <int DQK>
DEVFN void attn_dense_thread(const h16* q, const h16* K, const h16* VT, int kr0, int nk, float* out) {
  float qf[DQK];
#pragma unroll
  for (int j = 0; j < DQK; j++) qf[j] = (float)q[j];
  float o[64];
#pragma unroll
  for (int j = 0; j < 64; j++) o[j] = 0;
  float mx = -1e30f, sum = 0;
  for (int kk = 0; kk < nk; kk++) {
    const h16* kp = K + (size_t)(kr0 + kk) * DQK;
    float s = 0;
#pragma unroll
    for (int j = 0; j < DQK; j++) s += qf[j] * (float)kp[j];
    float mn = fmaxf(mx, s); float al = exp2f_(mx - mn); float pe = exp2f_(s - mn);
    sum = sum * al + pe; mx = mn;
#pragma unroll
    for (int j = 0; j < 64; j++) o[j] = o[j] * al + pe * (float)VT[(size_t)j * KM + kr0 + kk];
  }
  float inv = 1.f / sum;
#pragma unroll
  for (int j = 0; j < 64; j++) out[j] = o[j] * inv;
}
KERNEL nk_attn_dense(Params p, int kind, int mlo, int mhi, long n) {
  long g = GTID; if (g >= n) return;
  const int nch = kind == 1 ? 2 : 1;
  int ch = g % nch; int head = (g / nch) % 8; int m = mlo + g / (nch * 8);
  if (m >= mhi) return;
  int kr0, nk;
  if (m < MP) { kr0 = (m / SEQ) * SEQ; nk = SEQ; } else { kr0 = MP + ((m - MP) / DS) * TKS; nk = TKS; }
  if (kind == 0) {
    attn_dense_thread<96>(p.QA + ((size_t)m * 8 + head) * 96, p.KA + (size_t)head * KM * 96, p.VA + (size_t)head * 64 * KM, kr0, nk,
                          p.abuf + (size_t)m * 1536 + head * 64);
  } else if (kind == 1) {
    attn_dense_thread<64>(p.QB + ((size_t)m * 8 + head) * 64, p.KB + (size_t)head * KM * 64,
                          p.VB + ((size_t)(head >> 1) * 128 + ch * 64) * KM, kr0, nk, p.abuf + (size_t)m * 1536 + 512 + head * 128 + ch * 64);
  } else if (kind == 2) {
    attn_dense_thread<64>(p.QA + ((size_t)m * 8 + head) * 64, p.KA + (size_t)head * KM * 64, p.VA + (size_t)head * 64 * KM, kr0, nk,
                          p.abuf + (size_t)m * 1536 + head * 64);
  } else {
    attn_dense_thread<64>(p.QB + ((size_t)m * 8 + head) * 64, p.KB + (size_t)(head >> 2) * KM * 64, p.VB + (size_t)(head >> 2) * 64 * KM,
                          kr0, nk, p.abuf + (size_t)m * 1536 + 512 + head * 64);
  }
}
KERNEL nk_attn_na(Params p, int l, long n) {
  long g = GTID; if (g >= n) return;
  const int i = l >> 1;
  int head = g & 7; int ms = g >> 3; int m = MP + ms;
  int b = ms / DS, t = ms % DS; int r = t / GW, c = t % GW;
  int rs = r - 4; rs = rs < 0 ? 0 : (rs > GROWS - 8 ? GROWS - 8 : rs);
  int cs = c - 8; cs = cs < 0 ? 0 : (cs > GW - 16 ? GW - 16 : cs);
  const h16* q = p.QA + ((size_t)m * 8 + head) * 64;
  const h16* K = p.KA + (size_t)head * KM * 64; const h16* VT = p.VA + (size_t)head * 64 * KM;
  const int kbase = MP + b * TKS;
  const float* rpb = p.na_rpb + ((size_t)i * 8 + head) * 15 * 31;
  float qf[64], o[64];
#pragma unroll
  for (int j = 0; j < 64; j++) { qf[j] = (float)q[j]; o[j] = 0; }
  float mx = -1e30f, sum = 0;
  for (int kk = 0; kk < 128 + PAST; kk++) {
    int kr; float bias = 0;
    if (kk < 128) { int ri = kk >> 4, cj = kk & 15; kr = kbase + (rs + ri) * GW + cs + cj; bias = rpb[(rs + ri - r + 7) * 31 + (cs + cj - c + 15)] * LOG2E; }
    else kr = kbase + DS + (kk - 128);
    const h16* kp = K + (size_t)kr * 64;
    float s = bias;
#pragma unroll
    for (int j = 0; j < 64; j++) s += qf[j] * (float)kp[j];
    float mn = fmaxf(mx, s); float al = exp2f_(mx - mn); float pe = exp2f_(s - mn);
    sum = sum * al + pe; mx = mn;
#pragma unroll
    for (int j = 0; j < 64; j++) o[j] = o[j] * al + pe * (float)VT[(size_t)j * KM + kr];
  }
  float inv = 1.f / sum; float* out = p.abuf + (size_t)m * 1536 + head * 64;
#pragma unroll
  for (int j = 0; j < 64; j++) out[j] = o[j] * inv;
}
KERNEL nk_fin(Params p, int l, long n) {
  long g = GTID; if (g >= n) return;
  const int i = l >> 1;
  if (l & 1) {
    int ch = g & 15; int m = g >> 4;
    for (int j = 0; j < 64; j++) {
      int col = ch * 64 + j;
      p.O16[(size_t)m * 1024 + col] = (h16)(p.abuf[(size_t)m * 1536 + col] * (float)p.gates16[(size_t)m * 1024 + col]);
    }
  } else {
    int u = g % 12; int m = g / 12;
    if (u < 8) {
      for (int j = 0; j < 64; j++) {
        int col = u * 64 + j;
        p.O16[(size_t)m * 1024 + col] = (h16)(p.abuf[(size_t)m * 1536 + col] * (float)p.gates16[(size_t)m * 1024 + col]);
      }
    } else {
      int h = u - 8; float lam = p.lamv[i]; float lam_init = 0.8f - 0.6f * expf(-0.3f * l);
      const float* a1 = p.abuf + (size_t)m * 1536 + 512 + (h * 2) * 128; const float* a2 = a1 + 128;
      float ss = 0;
      for (int j = 0; j < 128; j++) { float d = a1[j] - lam * a2[j]; ss += d * d; }
      float r = 1.f / sqrtf(ss / 128 + EPSN);
      for (int j = 0; j < 128; j++) {
        float d = (a1[j] - lam * a2[j]) * r * p.diff_subln[i * 128 + j] * (1.f - lam_init);
        int col = 512 + h * 128 + j;
        p.O16[(size_t)m * 1024 + col] = (h16)(d * (float)p.gates16[(size_t)m * 1024 + col]);
      }
    }
  }
}
KERNEL nk_outproj(Params p, int l, long n) {
  long g = GTID; if (g >= n) return;
  int m = g >> 10, col = g & 1023;
  const float* W = ((l & 1) ? p.w_out_odd : p.w_out_even) + (size_t)(l >> 1) * 1024 * 1024 + col;
  const h16* o = p.O16 + (size_t)m * 1024;
  float acc = 0;
  for (int k = 0; k < 1024; k++) acc += (float)o[k] * W[(size_t)k * 1024];
  float gate = p.modv[((size_t)l * NCV + tok_cv(m)) * 3072 + 2048 + col];
  p.Y[(size_t)m * 1024 + col] = xrow(p, l, m)[col] + gate * acc;
}

static inline size_t al256(size_t x) { return (x + 255) & ~(size_t)255; }

extern "C" void kernel_launch(void* const* d_in, const int* in_sizes, int n_in, void* d_out, int out_size, void* d_ws, size_t ws_size,
                              hipStream_t stream) {
  Params p{};
  const float** ip = (const float**)&p.x_prompt;
  for (int k = 0; k < 39; k++) ip[k] = (const float*)d_in[k];
  float* o = (float*)d_out;
  p.Y = o; o += (size_t)M * 1024;
  p.o_ckv = o; o += (size_t)BATCH * 2 * SEQ * 128;
  p.o_kpe = o; o += (size_t)BATCH * 2 * SEQ * 32;
  p.o_dk = o; o += (size_t)BATCH * 2 * SEQ * 512;
  p.o_dv = o; o += (size_t)BATCH * 2 * SEQ * 512;
  p.o_nk = o; o += (size_t)BATCH * 2 * SEQ * 512;
  p.o_nv = o; o += (size_t)BATCH * 2 * SEQ * 512;
  p.o_gk = o; o += (size_t)BATCH * 2 * SEQ * 128;
  p.o_gv = o; o += (size_t)BATCH * 2 * SEQ * 128;
  char* w = (char*)d_ws; size_t off = 0;
  auto take = [&](size_t bytes) { char* r = w + off; off += al256(bytes); return r; };
  p.modv = (float*)take((size_t)4 * NCV * 3072 * 4);
  p.ropeC64 = (float*)take((size_t)DS * 32 * 4); p.ropeS64 = (float*)take((size_t)DS * 32 * 4);
  p.ropeC32 = (float*)take((size_t)DS * 16 * 4); p.ropeS32 = (float*)take((size_t)DS * 16 * 4);
  p.lamv = (float*)take(256);
  p.rstdx = (float*)take((size_t)M * 4);
  p.QA = (h16*)take((size_t)M * 8 * 96 * 2); p.QB = (h16*)take((size_t)M * 8 * 64 * 2);
  p.KA = (h16*)take((size_t)8 * KM * 96 * 2); p.KB = (h16*)take((size_t)8 * KM * 64 * 2);
  p.VA = (h16*)take((size_t)8 * 64 * KM * 2); p.VB = (h16*)take((size_t)8 * 64 * KM * 2);
  p.gates16 = (h16*)take((size_t)M * 1024 * 2); p.O16 = (h16*)take((size_t)M * 1024 * 2);
  p.ckvbuf = (float*)take((size_t)KM * 128 * 4); p.kpebuf = (float*)take((size_t)KM * 32 * 4);
  size_t ub = (size_t)M * 3328 * 2, ab = (size_t)M * 1536 * 4;
  char* big = take(ub > ab ? ub : ab);
  p.ubuf = (h16*)big; p.abuf = (float*)big;
  (void)ws_size; (void)n_in; (void)in_sizes; (void)out_size;

  launch1d(nk_mod, (long)4 * NCV * 3072, stream, p, (long)4 * NCV * 3072);
  launch1d(nk_tab, (long)DS * 48, stream, p, (long)DS * 48);
  for (int l = 0; l < 4; l++) {
    launch1d(nk_rstd, (long)M, stream, p, l, (long)M);
    const int N = (l & 1) ? ODD_IN : EVEN_IN;
    launch1d(nk_inproj, (long)M * N, stream, p, l, (long)M * N);
    if ((l & 1) == 0) {
      launch1d(nk_epi_even, (long)M * 50, stream, p, l, (long)M * 50);
      launch1d(nk_cache_even, (long)DB * PAST * 17, stream, p, l, (long)DB * PAST * 17);
      launch1d(nk_kv, (long)KM * 16, stream, p, l, (long)KM * 16);
      launch1d(nk_attn_dense, (long)M * 8, stream, p, 0, 0, M, (long)M * 8);
      launch1d(nk_attn_dense, (long)M * 16, stream, p, 1, 0, M, (long)M * 16);
      launch1d(nk_fin, (long)M * 12, stream, p, l, (long)M * 12);
    } else {
      launch1d(nk_epi_odd, (long)M * 52, stream, p, l, (long)M * 52);
      launch1d(nk_cache_odd, (long)DB * PAST * 20, stream, p, l, (long)DB * PAST * 20);
      launch1d(nk_attn_dense, (long)MP * 8, stream, p, 2, 0, MP, (long)MP * 8);
      launch1d(nk_attn_na, (long)MS * 8, stream, p, l, (long)MS * 8);
      launch1d(nk_attn_dense, (long)M * 8, stream, p, 3, 0, M, (long)M * 8);
      launch1d(nk_fin, (long)M * 16, stream, p, l, (long)M * 16);
    }
    launch1d(nk_outproj, (long)M * 1024, stream, p, l, (long)M * 1024);
  }
}
```

```cpp
#ifndef CPU_EMU
#include <hip/hip_runtime.h>
#endif
#include <stdint.h>
#include <math.h>

#define FAST_INPROJ 2
#define DUAL_WRITE 0
#define FAST_A2 1
#define FAST_OUTPROJ 1
#define FAST_ATTN 1
#ifndef CFG_BATCH
#define CFG_BATCH 16
#endif
#ifndef CFG_DB
#define CFG_DB 2
#endif
#ifndef CFG_DS
#define CFG_DS 2048
#endif
constexpr int D = 1024, BATCH = CFG_BATCH, SEQ = 256, DB = CFG_DB, DS = CFG_DS, PAST = 256;
constexpr int MP = BATCH * SEQ, MS = DB * DS, M = MP + MS;
constexpr int TKS = DS + PAST;
constexpr int KM = MP + DB * TKS;
constexpr int NCV = 1 + DB;
constexpr int GW = 64, GROWS = DS / GW;
constexpr int EVEN_IN = 2976, ODD_IN = 3328;
constexpr int NPE = 3072, NPO = 3328;
constexpr float EPSN = 1e-6f;
constexpr float LOG2E = 1.4426950408889634f;

typedef _Float16 h16;

struct Params {
  const float *x_prompt, *x_sample, *cache_mla_ckv, *cache_mla_kpe, *cache_diff_k, *cache_diff_v, *cache_na_k, *cache_na_v,
      *cache_gqa_k, *cache_gqa_v, *c, *c_ctx, *norm_w, *w_mod, *b_mod, *w_in_even, *w_out_even, *mla_qa_norm, *mla_wqb,
      *mla_kva_norm, *mla_wkvb, *mla_qn_nope, *mla_qn_rope, *mla_kn_nope, *mla_kn_rope, *diff_qn, *diff_kn, *diff_lq1,
      *diff_lk1, *diff_lq2, *diff_lk2, *diff_subln, *w_in_odd, *w_out_odd, *na_qn, *na_kn, *na_rpb, *gqa_qn, *gqa_kn;
  float *Y;
  float *o_ckv, *o_kpe, *o_dk, *o_dv, *o_nk, *o_nv, *o_gk, *o_gv;
  float *modv;
  float *ropeC64, *ropeS64;
  float *ropeC32, *ropeS32;
  float *lamv;
  float *rstdx;
  h16 *ubuf;
  float *abuf;
  float *ckvbuf;
  float *kpebuf;
  h16 *QA, *QB, *KA, *KB, *VA, *VB, *gates16, *O16;
  h16 *xs16;
  float *biasv;
  h16 *win16[4];
  h16 *wout16[4];
  h16 *wqb16[2];
  h16 *wkvb16[2];
  h16 *qa16;
  float *rowss_qa;
  h16 *ckv16;
  h16 *kpe16;
  float *rowss_l;
};

#ifdef CPU_EMU
#include <stdio.h>
#include <stdlib.h>
#include <string.h>
typedef void* hipStream_t;
#define KERNEL static void
#define DEVFN static inline
static thread_local long emu_gtid;
#define GTID emu_gtid
template <class... A, class... B>
static void launch1d(void (*f)(A...), long n, hipStream_t, B... a) {
#pragma omp parallel for schedule(dynamic, 64)
  for (long i = 0; i < n; i++) { emu_gtid = i; f(a...); }
}
static inline float exp2f_(float x) { return exp2f(x); }
#else
#define KERNEL __global__ void __launch_bounds__(256)
#define DEVFN __device__ __forceinline__
#define GTID ((long)blockIdx.x * 256 + threadIdx.x)
template <class... A, class... B>
static void launch1d(void (*f)(A...), long n, hipStream_t s, B... a) {
  hipLaunchKernelGGL(f, dim3((unsigned)((n + 255) / 256)), dim3(256), 0, s, a...);
}
DEVFN float exp2f_(float x) { return exp2f(x); }
#endif

DEVFN int tok_cv(int m) { return m < MP ? 0 : 1 + (m - MP) / DS; }
DEVFN int tok_keyrow(int m) { return m < MP ? m : MP + ((m - MP) / DS) * TKS + (m - MP) % DS; }
DEVFN int tok_pos(int m) { return m < MP ? (m % SEQ) : ((m - MP) % DS); }
DEVFN const float* xrow(const Params& p, int l, int m) {
  if (l > 0) return p.Y + (size_t)m * D;
  return m < MP ? p.x_prompt + (size_t)m * D : p.x_sample + (size_t)(m - MP) * D;
}
DEVFN float siluf(float x) { return x / (1.f + expf(-x)); }

KERNEL nk_mod(Params p, long n) {
  long g = GTID; if (g >= n) return;
  int col = g % 3072; int cv = (g / 3072) % NCV; int l = g / (3072 * NCV);
  const float* cvec = cv == 0 ? p.c_ctx : p.c + (size_t)(cv - 1) * D;
  const float* w = p.w_mod + (size_t)l * D * 3072 + col;
  float acc = p.b_mod[l * 3072 + col];
  for (int k = 0; k < D; k++) acc += siluf(cvec[k]) * w[(size_t)k * 3072];
  p.modv[((size_t)l * NCV + cv) * 3072 + col] = acc;
}
KERNEL nk_tab(Params p, long n) {
  long g = GTID; if (g >= n) return;
  if (g < 2) {
    int i = g; int l = 2 * i;
    float s1 = 0, s2 = 0;
    for (int k = 0; k < 64; k++) { s1 += p.diff_lq1[i * 64 + k] * p.diff_lk1[i * 64 + k]; s2 += p.diff_lq2[i * 64 + k] * p.diff_lk2[i * 64 + k]; }
    float lam_init = 0.8f - 0.6f * expf(-0.3f * l);
    p.lamv[i] = expf(s1) - expf(s2) + lam_init;
  }
  int t = g / 48, j = g % 48;
  if (t >= DS) return;
  float row = (float)(t / GW), col = (float)(t % GW);
  if (j < 32) {
    int f = j & 15; float inv = powf(10000.f, -(float)(2 * f) / 32.f);
    float ang = (j < 16 ? row : col) * inv;
    p.ropeC64[t * 32 + j] = cosf(ang); p.ropeS64[t * 32 + j] = sinf(ang);
  } else {
    int jj = j - 32; int f = jj & 7; float inv = powf(10000.f, -(float)(2 * f) / 16.f);
    float ang = (jj < 8 ? row : col) * inv;
    p.ropeC32[t * 16 + jj] = cosf(ang); p.ropeS32[t * 16 + jj] = sinf(ang);
  }
}
KERNEL nk_rstd(Params p, int l, long n) {
  long g = GTID; if (g >= n) return;
  const float* x = xrow(p, l, (int)g);
  float s = 0; for (int k = 0; k < D; k++) s += x[k] * x[k];
  p.rstdx[g] = 1.f / sqrtf(s / D + EPSN);
}
KERNEL nk_inproj(Params p, int l, long n) {
  long g = GTID; if (g >= n) return;
  const int N = (l & 1) ? ODD_IN : EVEN_IN;
  int m = g / N, col = g % N;
  const float* W = ((l & 1) ? p.w_in_odd : p.w_in_even) + (size_t)(l >> 1) * D * N + col;
  const float* x = xrow(p, l, m);
  const float* md = p.modv + ((size_t)l * NCV + tok_cv(m)) * 3072;
  const float* nw = p.norm_w + l * D;
  float r = p.rstdx[m], acc = 0;
  for (int k = 0; k < D; k++) { float h = x[k] * r * nw[k] * (1.f + md[1024 + k]) + md[k]; acc += h * W[(size_t)k * N]; }
  p.ubuf[(size_t)m * 3328 + col] = (h16)acc;
}
DEVFN size_t st_row(int m, int i) { int b = m / SEQ, t = m % SEQ; return ((size_t)(b * 2 + i) * SEQ + t); }

KERNEL nk_epi_even(Params p, int l, int qa_only, long n) {
  long g = GTID; if (g >= n) return;
  const int i = l >> 1;
  int m = g / 50, u = g % 50;
  if (qa_only && u >= 8) return;
  const h16* ur = qa_only ? p.qa16 + (size_t)m * 256 : p.ubuf + (size_t)m * 3328;
  const bool smp = m >= MP; const int t = tok_pos(m); const int kr = tok_keyrow(m);
  if (u < 8) {
    float ss = 0; for (int k = 0; k < 256; k++) { float v = (float)ur[k]; ss += v * v; }
    float r = 1.f / sqrtf(ss / 256 + EPSN);
    float q[96];
#pragma unroll
    for (int j = 0; j < 96; j++) q[j] = 0;
    const float* W = p.mla_wqb + (size_t)i * 256 * 768 + u * 96;
    for (int k = 0; k < 256; k++) {
      float a = (float)ur[k] * r * p.mla_qa_norm[i * 256 + k];
#pragma unroll
      for (int j = 0; j < 96; j++) q[j] += a * W[(size_t)k * 768 + j];
    }
    float s1 = 0, s2 = 0;
#pragma unroll
    for (int j = 0; j < 64; j++) s1 += q[j] * q[j];
#pragma unroll
    for (int j = 64; j < 96; j++) s2 += q[j] * q[j];
    float r1 = 1.f / sqrtf(s1 / 64 + EPSN), r2 = 1.f / sqrtf(s2 / 32 + EPSN);
#pragma unroll
    for (int j = 0; j < 64; j++) q[j] = q[j] * r1 * p.mla_qn_nope[i * 64 + j];
#pragma unroll
    for (int j = 0; j < 32; j++) q[64 + j] = q[64 + j] * r2 * p.mla_qn_rope[i * 32 + j];
    if (smp) {
#pragma unroll
      for (int j = 0; j < 16; j++) {
        float c = p.ropeC32[t * 16 + j], s = p.ropeS32[t * 16 + j];
        float x1 = q[64 + j], x2 = q[80 + j];
        q[64 + j] = x1 * c - x2 * s; q[80 + j] = x2 * c + x1 * s;
      }
    }
    const float sc = LOG2E / sqrtf(96.f);
    h16* dst = p.QA + ((size_t)m * 8 + u) * 96;
#pragma unroll
    for (int j = 0; j < 96; j++) dst[j] = (h16)(q[j] * sc);
  } else if (u == 8) {
    float ss = 0; for (int k = 0; k < 128; k++) { float v = (float)ur[256 + k]; ss += v * v; }
    float r = 1.f / sqrtf(ss / 128 + EPSN);
    for (int k = 0; k < 128; k++) {
      float v = (float)ur[256 + k] * r * p.mla_kva_norm[i * 128 + k];
      if (!smp) p.o_ckv[st_row(m, i) * 128 + k] = v;
      p.ckvbuf[(size_t)kr * 128 + k] = v;
    }
  } else if (u == 9) {
    float v[32]; float ss = 0;
#pragma unroll
    for (int k = 0; k < 32; k++) { v[k] = (float)ur[384 + k]; ss += v[k] * v[k]; }
    float r = 1.f / sqrtf(ss / 32 + EPSN);
#pragma unroll
    for (int k = 0; k < 32; k++) { v[k] = v[k] * r * p.mla_kn_rope[i * 32 + k]; if (!smp) p.o_kpe[st_row(m, i) * 32 + k] = v[k]; }
    if (smp) {
#pragma unroll
      for (int j = 0; j < 16; j++) {
        float c = p.ropeC32[t * 16 + j], s = p.ropeS32[t * 16 + j];
        float x1 = v[j], x2 = v[16 + j];
        v[j] = x1 * c - x2 * s; v[16 + j] = x2 * c + x1 * s;
      }
    }
#pragma unroll
    for (int k = 0; k < 32; k++) p.kpebuf[(size_t)kr * 32 + k] = v[k];
  } else if (u < 18) {
    int cb = (u - 10) * 64;
    for (int j = 0; j < 64; j++) p.gates16[(size_t)m * 1024 + cb + j] = (h16)siluf((float)ur[416 + cb + j]);
  } else if (u < 34) {
    const bool isq = u < 26; int hc = isq ? u - 18 : u - 26;
    const h16* src = ur + (isq ? 928 : 1440) + hc * 64;
    const float* gn = (isq ? p.diff_qn : p.diff_kn) + i * 64;
    float v[64]; float ss = 0;
#pragma unroll
    for (int k = 0; k < 64; k++) { v[k] = (float)src[k]; ss += v[k] * v[k]; }
    float r = 1.f / sqrtf(ss / 64 + EPSN);
#pragma unroll
    for (int k = 0; k < 64; k++) { v[k] = v[k] * r * gn[k]; if (!isq && !smp) p.o_dk[st_row(m, i) * 512 + hc * 64 + k] = v[k]; }
    if (smp) {
#pragma unroll
      for (int j = 0; j < 32; j++) {
        float c = p.ropeC64[t * 32 + j], s = p.ropeS64[t * 32 + j];
        float x1 = v[j], x2 = v[32 + j];
        v[j] = x1 * c - x2 * s; v[32 + j] = x2 * c + x1 * s;
      }
    }
    if (isq) {
      const float sc = LOG2E / 8.f; h16* dst = p.QB + ((size_t)m * 8 + hc) * 64;
#pragma unroll
      for (int k = 0; k < 64; k++) dst[k] = (h16)(v[k] * sc);
    } else {
      h16* dst = p.KB + ((size_t)hc * KM + kr) * 64;
#pragma unroll
      for (int k = 0; k < 64; k++) dst[k] = (h16)v[k];
    }
  } else if (u < 42) {
    int ch = u - 34; int h = ch >> 1, half = ch & 1;
    for (int j = 0; j < 64; j++) {
      float v = (float)ur[1952 + ch * 64 + j];
      if (!smp) p.o_dv[st_row(m, i) * 512 + ch * 64 + j] = v;
      p.VB[((size_t)h * 128 + half * 64 + j) * KM + kr] = (h16)v;
    }
  } else {
    int cb = (u - 42) * 64;
    for (int j = 0; j < 64; j++) p.gates16[(size_t)m * 1024 + 512 + cb + j] = (h16)siluf((float)ur[2464 + cb + j]);
  }
}
KERNEL nk_cache_even(Params p, int l, long n) {
  long g = GTID; if (g >= n) return;
  const int i = l >> 1;
  int u = g % 17; int pos = (g / 17) % PAST; int b = g / (17 * PAST);
  const int kr = MP + b * TKS + DS + pos;
  const size_t crow = ((size_t)(b * 2 + i) * PAST + pos);
  if (u == 0) {
    for (int k = 0; k < 128; k++) { float v = p.cache_mla_ckv[crow * 128 + k]; p.ckvbuf[(size_t)kr * 128 + k] = v; p.ckv16[(size_t)kr * 128 + k] = (h16)v; }
    for (int k = 0; k < 32; k++) { float v = p.cache_mla_kpe[crow * 32 + k]; p.kpebuf[(size_t)kr * 32 + k] = v; p.kpe16[(size_t)kr * 32 + k] = (h16)v; }
  } else if (u < 9) {
    int hc = u - 1;
    for (int k = 0; k < 64; k++) p.KB[((size_t)hc * KM + kr) * 64 + k] = (h16)p.cache_diff_k[crow * 512 + hc * 64 + k];
  } else {
    int ch = u - 9; int h = ch >> 1, half = ch & 1;
    for (int j = 0; j < 64; j++) p.VB[((size_t)h * 128 + half * 64 + j) * KM + kr] = (h16)p.cache_diff_v[crow * 512 + ch * 64 + j];
  }
}
KERNEL nk_kv(Params p, int l, long n) {
  long g = GTID; if (g >= n) return;
  const int i = l >> 1;
  int part = g & 1; int h = (g >> 1) & 7; int kr = g >> 4;
  const float* cr = p.ckvbuf + (size_t)kr * 128;
  const float* W = p.mla_wkvb + (size_t)i * 128 * 1024 + h * 128 + part * 64;
  float a[64];
#pragma unroll
  for (int j = 0; j < 64; j++) a[j] = 0;
  for (int k = 0; k < 128; k++) {
    float c = (float)(h16)cr[k];
#pragma unroll
    for (int j = 0; j < 64; j++) a[j] += c * W[(size_t)k * 1024 + j];
  }
  if (part == 0) {
    float ss = 0;
#pragma unroll
    for (int j = 0; j < 64; j++) ss += a[j] * a[j];
    float r = 1.f / sqrtf(ss / 64 + EPSN);
    h16* dst = p.KA + ((size_t)h * KM + kr) * 128;
#pragma unroll
    for (int j = 0; j < 64; j++) dst[j] = (h16)(a[j] * r * p.mla_kn_nope[i * 64 + j]);
    for (int j = 0; j < 32; j++) dst[64 + j] = (h16)p.kpebuf[(size_t)kr * 32 + j];
  } else {
#pragma unroll
    for (int j = 0; j < 64; j++) p.VA[((size_t)h * 64 + j) * KM + kr] = (h16)a[j];
  }
}
KERNEL nk_epi_odd(Params p, int l, long n) {
  long g = GTID; if (g >= n) return;
  const int i = l >> 1;
  int m = g / 52, u = g % 52;
  const h16* ur = p.ubuf + (size_t)m * 3328;
  const bool smp = m >= MP; const int t = tok_pos(m); const int kr = tok_keyrow(m);
  if (u < 16 || (u >= 32 && u < 42)) {
    int colbase, head; const float* gn; int kind;
    if (u < 8) { kind = 0; head = u; colbase = head * 64; gn = p.na_qn + i * 64; }
    else if (u < 16) { kind = 1; head = u - 8; colbase = 512 + head * 64; gn = p.na_kn + i * 64; }
    else if (u < 40) { kind = 2; head = u - 32; colbase = 2048 + head * 64; gn = p.gqa_qn + i * 64; }
    else { kind = 3; head = u - 40; colbase = 2560 + head * 64; gn = p.gqa_kn + i * 64; }
    float v[64]; float ss = 0;
#pragma unroll
    for (int k = 0; k < 64; k++) { v[k] = (float)ur[colbase + k]; ss += v[k] * v[k]; }
    float r = 1.f / sqrtf(ss / 64 + EPSN);
#pragma unroll
    for (int k = 0; k < 64; k++) v[k] = v[k] * r * gn[k];
    if (!smp) {
      if (kind == 1) { for (int k = 0; k < 64; k++) p.o_nk[st_row(m, i) * 512 + head * 64 + k] = v[k]; }
      if (kind == 3) { for (int k = 0; k < 64; k++) p.o_gk[st_row(m, i) * 128 + head * 64 + k] = v[k]; }
    }
    if (smp && kind >= 2) {
#pragma unroll
      for (int j = 0; j < 32; j++) {
        float c = p.ropeC64[t * 32 + j], s = p.ropeS64[t * 32 + j];
        float x1 = v[j], x2 = v[32 + j];
        v[j] = x1 * c - x2 * s; v[32 + j] = x2 * c + x1 * s;
      }
    }
    const float sc = LOG2E / 8.f;
    h16* dst;
    if (kind == 0) dst = p.QA + ((size_t)m * 8 + head) * 64;
    else if (kind == 1) dst = p.KA + ((size_t)head * KM + kr) * 64;
    else if (kind == 2) dst = p.QB + ((size_t)m * 8 + head) * 64;
    else dst = p.KB + ((size_t)head * KM + kr) * 64;
    const float mul = (kind == 0 || kind == 2) ? sc : 1.f;
#pragma unroll
    for (int k = 0; k < 64; k++) dst[k] = (h16)(v[k] * mul);
  } else if (u < 24) {
    int head = u - 16;
    for (int j = 0; j < 64; j++) {
      float v = (float)ur[1024 + head * 64 + j];
      if (!smp) p.o_nv[st_row(m, i) * 512 + head * 64 + j] = v;
      p.VA[((size_t)head * 64 + j) * KM + kr] = (h16)v;
    }
  } else if (u < 32) {
    int cb = (u - 24) * 64;
    for (int j = 0; j < 64; j++) p.gates16[(size_t)m * 1024 + cb + j] = (h16)siluf((float)ur[1536 + cb + j]);
  } else if (u < 44) {
    int head = u - 42;
    for (int j = 0; j < 64; j++) {
      float v = (float)ur[2688 + head * 64 + j];
      if (!smp) p.o_gv[st_row(m, i) * 128 + head * 64 + j] = v;
      p.VB[((size_t)head * 64 + j) * KM + kr] = (h16)v;
    }
  } else {
    int cb = (u - 44) * 64;
    for (int j = 0; j < 64; j++) p.gates16[(size_t)m * 1024 + 512 + cb + j] = (h16)siluf((float)ur[2816 + cb + j]);
  }
}
KERNEL nk_cache_odd(Params p, int l, long n) {
  long g = GTID; if (g >= n) return;
  const int i = l >> 1;
  int u = g % 20; int pos = (g / 20) % PAST; int b = g / (20 * PAST);
  const int kr = MP + b * TKS + DS + pos;
  const size_t crow = ((size_t)(b * 2 + i) * PAST + pos);
  if (u < 8) { for (int k = 0; k < 64; k++) p.KA[((size_t)u * KM + kr) * 64 + k] = (h16)p.cache_na_k[crow * 512 + u * 64 + k]; }
  else if (u < 16) { int h = u - 8; for (int j = 0; j < 64; j++) p.VA[((size_t)h * 64 + j) * KM + kr] = (h16)p.cache_na_v[crow * 512 + h * 64 + j]; }
  else if (u < 18) { int h = u - 16; for (int k = 0; k < 64; k++) p.KB[((size_t)h * KM + kr) * 64 + k] = (h16)p.cache_gqa_k[crow * 128 + h * 64 + k]; }
  else { int h = u - 18; for (int j = 0; j < 64; j++) p.VB[((size_t)h * 64 + j) * KM + kr] = (h16)p.cache_gqa_v[crow * 128 + h * 64 + j]; }
}
template <int DQK, int KP>
DEVFN void attn_dense_thread(const h16* q, const h16* K, const h16* VT, int kr0, int nk, float* out) {
  float qf[DQK];
#pragma unroll
  for (int j = 0; j < DQK; j++) qf[j] = (float)q[j];
  float o[64];
#pragma unroll
  for (int j = 0; j < 64; j++) o[j] = 0;
  float mx = -1e30f, sum = 0;
  for (int kk = 0; kk < nk; kk++) {
    const h16* kp = K + (size_t)(kr0 + kk) * KP;
    float s = 0;
#pragma unroll
    for (int j = 0; j < DQK; j++) s += qf[j] * (float)kp[j];
    float mn = fmaxf(mx, s); float al = exp2f_(mx - mn); float pe = exp2f_(s - mn);
    sum = sum * al + pe; mx = mn;
#pragma unroll
    for (int j = 0; j < 64; j++) o[j] = o[j] * al + pe * (float)VT[(size_t)j * KM + kr0 + kk];
  }
  float inv = 1.f / sum;
#pragma unroll
  for (int j = 0; j < 64; j++) out[j] = o[j] * inv;
}
KERNEL nk_attn_dense(Params p, int kind, int mlo, int mhi, long n) {
  long g = GTID; if (g >= n) return;
  const int nch = kind == 1 ? 2 : 1;
  int ch = g % nch; int head = (g / nch) % 8; int m = mlo + g / (nch * 8);
  if (m >= mhi) return;
  int kr0, nk;
  if (m < MP) { kr0 = (m / SEQ) * SEQ; nk = SEQ; } else { kr0 = MP + ((m - MP) / DS) * TKS; nk = TKS; }
  if (kind == 0) {
    attn_dense_thread<96, 128>(p.QA + ((size_t)m * 8 + head) * 96, p.KA + (size_t)head * KM * 128, p.VA + (size_t)head * 64 * KM, kr0, nk,
                          p.abuf + (size_t)m * 1536 + head * 64);
  } else if (kind == 1) {
    attn_dense_thread<64, 64>(p.QB + ((size_t)m * 8 + head) * 64, p.KB + (size_t)head * KM * 64,
                          p.VB + ((size_t)(head >> 1) * 128 + ch * 64) * KM, kr0, nk, p.abuf + (size_t)m * 1536 + 512 + head * 128 + ch * 64);
  } else if (kind == 2) {
    attn_dense_thread<64, 64>(p.QA + ((size_t)m * 8 + head) * 64, p.KA + (size_t)head * KM * 64, p.VA + (size_t)head * 64 * KM, kr0, nk,
                          p.abuf + (size_t)m * 1536 + head * 64);
  } else {
    attn_dense_thread<64, 64>(p.QB + ((size_t)m * 8 + head) * 64, p.KB + (size_t)(head >> 2) * KM * 64, p.VB + (size_t)(head >> 2) * 64 * KM,
                          kr0, nk, p.abuf + (size_t)m * 1536 + 512 + head * 64);
  }
}
KERNEL nk_attn_na(Params p, int l, long n) {
  long g = GTID; if (g >= n) return;
  const int i = l >> 1;
  int head = g & 7; int ms = g >> 3; int m = MP + ms;
  int b = ms / DS, t = ms % DS; int r = t / GW, c = t % GW;
  int rs = r - 4; rs = rs < 0 ? 0 : (rs > GROWS - 8 ? GROWS - 8 : rs);
  int cs = c - 8; cs = cs < 0 ? 0 : (cs > GW - 16 ? GW - 16 : cs);
  const h16* q = p.QA + ((size_t)m * 8 + head) * 64;
  const h16* K = p.KA + (size_t)head * KM * 64; const h16* VT = p.VA + (size_t)head * 64 * KM;
  const int kbase = MP + b * TKS;
  const float* rpb = p.na_rpb + ((size_t)i * 8 + head) * 15 * 31;
  float qf[64], o[64];
#pragma unroll
  for (int j = 0; j < 64; j++) { qf[j] = (float)q[j]; o[j] = 0; }
  float mx = -1e30f, sum = 0;
  for (int kk = 0; kk < 128 + PAST; kk++) {
    int kr; float bias = 0;
    if (kk < 128) { int ri = kk >> 4, cj = kk & 15; kr = kbase + (rs + ri) * GW + cs + cj; bias = rpb[(rs + ri - r + 7) * 31 + (cs + cj - c + 15)] * LOG2E; }
    else kr = kbase + DS + (kk - 128);
    const h16* kp = K + (size_t)kr * 64;
    float s = bias;
#pragma unroll
    for (int j = 0; j < 64; j++) s += qf[j] * (float)kp[j];
    float mn = fmaxf(mx, s); float al = exp2f_(mx - mn); float pe = exp2f_(s - mn);
    sum = sum * al + pe; mx = mn;
#pragma unroll
    for (int j = 0; j < 64; j++) o[j] = o[j] * al + pe * (float)VT[(size_t)j * KM + kr];
  }
  float inv = 1.f / sum; float* out = p.abuf + (size_t)m * 1536 + head * 64;
#pragma unroll
  for (int j = 0; j < 64; j++) out[j] = o[j] * inv;
}
KERNEL nk_fin(Params p, int l, long n) {
  long g = GTID; if (g >= n) return;
  const int i = l >> 1;
  if (l & 1) {
    int ch = g & 15; int m = g >> 4;
    for (int j = 0; j < 64; j++) {
      int col = ch * 64 + j;
      p.O16[(size_t)m * 1024 + col] = (h16)(p.abuf[(size_t)m * 1536 + col] * (float)p.gates16[(size_t)m * 1024 + col]);
    }
  } else {
    int u = g % 12; int m = g / 12;
    if (u < 8) {
      for (int j = 0; j < 64; j++) {
        int col = u * 64 + j;
        p.O16[(size_t)m * 1024 + col] = (h16)(p.abuf[(size_t)m * 1536 + col] * (float)p.gates16[(size_t)m * 1024 + col]);
      }
    } else {
      int h = u - 8; float lam = p.lamv[i]; float lam_init = 0.8f - 0.6f * expf(-0.3f * l);
      const float* a1 = p.abuf + (size_t)m * 1536 + 512 + (h * 2) * 128; const float* a2 = a1 + 128;
      float ss = 0;
      for (int j = 0; j < 128; j++) { float d = a1[j] - lam * a2[j]; ss += d * d; }
      float r = 1.f / sqrtf(ss / 128 + EPSN);
      for (int j = 0; j < 128; j++) {
        float d = (a1[j] - lam * a2[j]) * r * p.diff_subln[i * 128 + j] * (1.f - lam_init);
        int col = 512 + h * 128 + j;
        p.O16[(size_t)m * 1024 + col] = (h16)(d * (float)p.gates16[(size_t)m * 1024 + col]);
      }
    }
  }
}
KERNEL nk_outproj(Params p, int l, long n) {
  long g = GTID; if (g >= n) return;
  int m = g >> 10, col = g & 1023;
  const float* W = ((l & 1) ? p.w_out_odd : p.w_out_even) + (size_t)(l >> 1) * 1024 * 1024 + col;
  const h16* o = p.O16 + (size_t)m * 1024;
  float acc = 0;
  for (int k = 0; k < 1024; k++) acc += (float)o[k] * W[(size_t)k * 1024];
  float gate = p.modv[((size_t)l * NCV + tok_cv(m)) * 3072 + 2048 + col];
  p.Y[(size_t)m * 1024 + col] = xrow(p, l, m)[col] + gate * acc;
}


#ifndef CPU_EMU
typedef _Float16 h16x8 __attribute__((ext_vector_type(8)));
typedef _Float16 h16x4 __attribute__((ext_vector_type(4)));
typedef float f32x16 __attribute__((ext_vector_type(16)));
typedef float f32x4 __attribute__((ext_vector_type(4)));

DEVFN int even_col(int np) { return np < 416 ? np : (np < 512 ? -1 : np - 96); }

__global__ void __launch_bounds__(256) fk_convw(const float* src, h16* dst, int K, int Nsrc, int Ndst, int mode, const float* kscale) {
  __shared__ float t[64][65];
  const int nb = blockIdx.x * 64, kb = blockIdx.y * 64, tid = threadIdx.x;
  {
    int j = tid & 63; int np = nb + j; int col;
    if (mode == 0) col = np; else if (mode == 1) col = even_col(np); else if (mode == 3) { int hh = (np & 511) >> 6; col = hh * 128 + (np >> 9) * 64 + (np & 63); } else { int h = np >> 7, jj = np & 127; col = jj < 96 ? h * 96 + jj : -1; }
    for (int i = 0; i < 16; i++) {
      int kk = (tid >> 6) + 4 * i;
      float v = 0.f;
      if (col >= 0 && np < Ndst) { v = src[(size_t)(kb + kk) * Nsrc + col]; if (kscale) v *= kscale[kb + kk]; }
      t[kk][j] = v;
    }
  }
  __syncthreads();
  {
    int kk = tid & 63;
    for (int i = 0; i < 16; i++) { int j = (tid >> 6) + 4 * i; if (nb + j < Ndst) dst[(size_t)(nb + j) * K + kb + kk] = (h16)t[kk][j]; }
  }
}
__global__ void __launch_bounds__(256) fk_prep_x(Params p, int l) {
  const int lane = threadIdx.x & 63; const int m = blockIdx.x * 4 + (threadIdx.x >> 6);
  const float* x = xrow(p, l, m); const float* md = p.modv + ((size_t)l * NCV + tok_cv(m)) * 3072 + 1024; const float* nw = p.norm_w + l * D;
  float ss = 0;
  for (int i = 0; i < 4; i++) {
    int k = (i * 64 + lane) * 4;
    f32x4 v = *(const f32x4*)(x + k); f32x4 s = *(const f32x4*)(md + k); f32x4 w = *(const f32x4*)(nw + k);
    h16x4 o;
    for (int e = 0; e < 4; e++) { ss += v[e] * v[e]; o[e] = (h16)(v[e] * w[e] * (1.f + s[e])); }
    *(h16x4*)(p.xs16 + (size_t)m * D + k) = o;
  }
  for (int o = 32; o; o >>= 1) ss += __shfl_xor(ss, o);
  if (lane == 0) p.rowss_l[(size_t)l * M + m] = ss;
}
__global__ void __launch_bounds__(256) fk_bias(Params p, int l) {
  const int lane = threadIdx.x & 63; const int np = blockIdx.x * 4 + (threadIdx.x >> 6);
  const int NP = (l & 1) ? NPO : NPE; if (np >= NP) return;
  const h16* w = p.win16[l] + (size_t)np * D;
  float a[NCV];
  for (int c = 0; c < NCV; c++) a[c] = 0;
  for (int i = 0; i < 2; i++) {
    int k = (i * 64 + lane) * 8; h16x8 wv = *(const h16x8*)(w + k);
    for (int c = 0; c < NCV; c++) { const float* sh = p.modv + ((size_t)l * NCV + c) * 3072 + k; for (int e = 0; e < 8; e++) a[c] += sh[e] * (float)wv[e]; }
  }
  for (int c = 0; c < NCV; c++) { float v = a[c]; for (int o = 32; o; o >>= 1) v += __shfl_xor(v, o); if (lane == 0) p.biasv[((size_t)l * NCV + c) * NPO + np] = v; }
}

constexpr int G_STAGE = 49152, G_NSTAGE = 3, G_LDS = G_STAGE * G_NSTAGE;
DEVFN int img_off(int r, int c) { return r * 128 + ((c ^ ((r >> 1) & 7)) << 4); }
template <int R>
DEVFN void stage_rows(const h16* g, int ld, char* lds, int tid) {
#pragma unroll
  for (int i = 0; i < R / 64; i++) {
    int r = (tid >> 3) + 64 * i; int c = (tid & 7) ^ ((r >> 1) & 7);
    __builtin_amdgcn_global_load_lds((const unsigned*)(g + (size_t)r * ld + c * 8), (unsigned*)(lds + i * 8192 + tid * 16), 16, 0, 0);
  }
}
#define WAITV(n) asm volatile("s_waitcnt vmcnt(" #n ")" ::: "memory")
#define RAWBAR() do { asm volatile("s_waitcnt lgkmcnt(0)" ::: "memory"); __builtin_amdgcn_s_barrier(); } while (0)
template <bool TR>
DEVFN void gemm_tile(const h16* A, int lda, const h16* Bt, int ldb, int K, int m0, int n0, char* lds, f32x16 (&acc)[2][2]) {
  const int tid = threadIdx.x, lane = tid & 63, w = tid >> 6, wm = w >> 1, wn = w & 1;
  const int nt = K / 64;
  const h16* Ag = A + (size_t)m0 * lda; const h16* Bg = Bt + (size_t)n0 * ldb;
#pragma unroll
  for (int a = 0; a < 2; a++)
#pragma unroll
    for (int b = 0; b < 2; b++)
#pragma unroll
      for (int r = 0; r < 16; r++) acc[a][b][r] = 0.f;
  stage_rows<256>(Ag, lda, lds, tid); stage_rows<128>(Bg, ldb, lds + 32768, tid);
  if (nt > 1) { stage_rows<256>(Ag + 64, lda, lds + G_STAGE, tid); stage_rows<128>(Bg + 64, ldb, lds + G_STAGE + 32768, tid); }
  const int ra = wm * 64 + (lane & 31), rb = wn * 64 + (lane & 31), ch = lane >> 5;
  for (int t = 0; t < nt; t++) {
    if (t + 1 < nt) WAITV(6); else WAITV(0);
    RAWBAR();
    if (t + 2 < nt) { char* s = lds + ((t + 2) % 3) * G_STAGE; stage_rows<256>(Ag + (t + 2) * 64, lda, s, tid); stage_rows<128>(Bg + (t + 2) * 64, ldb, s + 32768, tid); }
    const char* sa = lds + (t % 3) * G_STAGE; const char* sb = sa + 32768;
#pragma unroll
    for (int ks = 0; ks < 4; ks++) {
      h16x8 af[2], bf[2];
#pragma unroll
      for (int mb = 0; mb < 2; mb++) af[mb] = *(const h16x8*)(sa + img_off(ra + mb * 32, 2 * ks + ch));
#pragma unroll
      for (int nb = 0; nb < 2; nb++) bf[nb] = *(const h16x8*)(sb + img_off(rb + nb * 32, 2 * ks + ch));
#pragma unroll
      for (int mb = 0; mb < 2; mb++)
#pragma unroll
        for (int nb = 0; nb < 2; nb++) {
          if (TR) acc[mb][nb] = __builtin_amdgcn_mfma_f32_32x32x16_f16(bf[nb], af[mb], acc[mb][nb], 0, 0, 0);
          else acc[mb][nb] = __builtin_amdgcn_mfma_f32_32x32x16_f16(af[mb], bf[nb], acc[mb][nb], 0, 0, 0);
        }
    }
  }
  RAWBAR();
}

DEVFN float wsum32(float v) { return v + __shfl_xor(v, 32); }

template <class RsF, class DstF>
DEVFN void epi_head64(const Params& p, const f32x16 (&acc)[2][2], int mbase, RsF rsf, const float* bias, const float* gain, bool rope, float oscale,
                      float* state, int spitch, int scol, int ilayer, DstF dstf) {
  const int lane = threadIdx.x & 63, h = lane >> 5;
#pragma unroll
  for (int mb = 0; mb < 2; mb++) {
    const int m = mbase + mb * 32 + (lane & 31);
    const float rs = rsf(m);
    float v[2][16]; float ss = 0;
#pragma unroll
    for (int nb = 0; nb < 2; nb++)
#pragma unroll
      for (int q = 0; q < 4; q++) {
        const int j = nb * 32 + 8 * q + 4 * h;
        f32x4 b = bias ? *(const f32x4*)(bias + j) : (f32x4){0.f, 0.f, 0.f, 0.f};
#pragma unroll
        for (int e = 0; e < 4; e++) { float x = acc[mb][nb][q * 4 + e] * rs + b[e]; v[nb][q * 4 + e] = x; ss += x * x; }
      }
    ss = wsum32(ss);
    const float rr = 1.f / sqrtf(ss * (1.f / 64.f) + EPSN);
#pragma unroll
    for (int nb = 0; nb < 2; nb++)
#pragma unroll
      for (int q = 0; q < 4; q++) {
        const int j = nb * 32 + 8 * q + 4 * h;
        f32x4 g = *(const f32x4*)(gain + j);
#pragma unroll
        for (int e = 0; e < 4; e++) v[nb][q * 4 + e] *= rr * g[e];
      }
    const bool smp = m >= MP;
    if (state && !smp) {
      float* sp = state + st_row(m, ilayer) * spitch + scol;
#pragma unroll
      for (int nb = 0; nb < 2; nb++)
#pragma unroll
        for (int q = 0; q < 4; q++) { f32x4 o = {v[nb][q * 4], v[nb][q * 4 + 1], v[nb][q * 4 + 2], v[nb][q * 4 + 3]}; *(f32x4*)(sp + nb * 32 + 8 * q + 4 * h) = o; }
    }
    if (rope && smp) {
      const int t = tok_pos(m);
#pragma unroll
      for (int q = 0; q < 4; q++) {
        f32x4 c = *(const f32x4*)(p.ropeC64 + t * 32 + 8 * q + 4 * h), s = *(const f32x4*)(p.ropeS64 + t * 32 + 8 * q + 4 * h);
#pragma unroll
        for (int e = 0; e < 4; e++) { float x1 = v[0][q * 4 + e], x2 = v[1][q * 4 + e]; v[0][q * 4 + e] = x1 * c[e] - x2 * s[e]; v[1][q * 4 + e] = x2 * c[e] + x1 * s[e]; }
      }
    }
    h16* dst = dstf(m);
#pragma unroll
    for (int nb = 0; nb < 2; nb++)
#pragma unroll
      for (int q = 0; q < 4; q++) {
        h16x4 o;
#pragma unroll
        for (int e = 0; e < 4; e++) o[e] = (h16)(v[nb][q * 4 + e] * oscale);
        *(h16x4*)(dst + nb * 32 + 8 * q + 4 * h) = o;
      }
  }
}
template <class RsF, class DstF>
DEVFN void epi_head32(const Params& p, const f32x16 (&acc)[2][2], int mbase, RsF rsf, const float* bias, const float* gain, bool rope, float oscale,
                      float* state, int ilayer, DstF dstf, float* dual = nullptr) {
  const int lane = threadIdx.x & 63, h = lane >> 5;
#pragma unroll
  for (int mb = 0; mb < 2; mb++) {
    const int m = mbase + mb * 32 + (lane & 31);
    const float rs = rsf(m);
    float v[16]; float ss = 0;
#pragma unroll
    for (int q = 0; q < 4; q++) {
      const int j = 8 * q + 4 * h;
      f32x4 b = bias ? *(const f32x4*)(bias + j) : (f32x4){0.f, 0.f, 0.f, 0.f};
#pragma unroll
      for (int e = 0; e < 4; e++) { float x = acc[mb][0][q * 4 + e] * rs + b[e]; v[q * 4 + e] = x; ss += x * x; }
    }
    ss = wsum32(ss);
    const float rr = 1.f / sqrtf(ss * (1.f / 32.f) + EPSN);
#pragma unroll
    for (int q = 0; q < 4; q++) {
      f32x4 g = *(const f32x4*)(gain + 8 * q + 4 * h);
#pragma unroll
      for (int e = 0; e < 4; e++) v[q * 4 + e] *= rr * g[e];
    }
    const bool smp = m >= MP;
    if (state && !smp) {
      float* sp = state + st_row(m, ilayer) * 32;
#pragma unroll
      for (int q = 0; q < 4; q++) { f32x4 o = {v[q * 4], v[q * 4 + 1], v[q * 4 + 2], v[q * 4 + 3]}; *(f32x4*)(sp + 8 * q + 4 * h) = o; }
    }
    if (rope && smp) {
      const int t = tok_pos(m);
#pragma unroll
      for (int q = 0; q < 2; q++) {
        f32x4 c = *(const f32x4*)(p.ropeC32 + t * 16 + 8 * q + 4 * h), s = *(const f32x4*)(p.ropeS32 + t * 16 + 8 * q + 4 * h);
#pragma unroll
        for (int e = 0; e < 4; e++) { float x1 = v[q * 4 + e], x2 = v[(q + 2) * 4 + e]; v[q * 4 + e] = x1 * c[e] - x2 * s[e]; v[(q + 2) * 4 + e] = x2 * c[e] + x1 * s[e]; }
      }
    }
    h16* dst = dstf(m);
#pragma unroll
    for (int q = 0; q < 4; q++) {
      h16x4 o;
#pragma unroll
      for (int e = 0; e < 4; e++) o[e] = (h16)(v[q * 4 + e] * oscale);
      *(h16x4*)(dst + 8 * q + 4 * h) = o;
      if (dual) { for (int e = 0; e < 4; e++) dual[(size_t)tok_keyrow(m) * 32 + 8 * q + 4 * h + e] = v[q * 4 + e]; }
    }
  }
}
template <class RsF, class KrF>
DEVFN void epi_vt(const f32x16 (&acc)[2][2], int mbase, RsF rsf, const float* bias  , float* state, int spitch, int scol, int ilayer,
                  h16* vt  , KrF krf) {
  const int lane = threadIdx.x & 63, h = lane >> 5, e0 = lane & 31;
#pragma unroll
  for (int mb = 0; mb < 2; mb++)
#pragma unroll
    for (int q = 0; q < 4; q++) {
      const int mq = mbase + mb * 32 + 8 * q + 4 * h;
      float rs[4];
#pragma unroll
      for (int e = 0; e < 4; e++) rs[e] = rsf(mq + e);
      const int kr = krf(mq);
#pragma unroll
      for (int nb = 0; nb < 2; nb++) {
        const int col = nb * 32 + e0; const float b = bias ? bias[col] : 0.f;
        h16x4 o;
#pragma unroll
        for (int e = 0; e < 4; e++) {
          float x = acc[mb][nb][q * 4 + e] * rs[e] + b; o[e] = (h16)x;
          if (state && mq < MP) state[st_row(mq + e, ilayer) * spitch + scol + col] = x;
        }
        *(h16x4*)(vt + (size_t)col * KM + kr) = o;
      }
    }
}

DEVFN void inproj_tile(const Params& p, int l, int mt, int ntile, char* lds) {
  const int i = l >> 1; const bool odd = l & 1;
  const int m0 = mt * 256, n0 = ntile * 128;
  const int lane = threadIdx.x & 63, w = threadIdx.x >> 6, wm = w >> 1, wn = w & 1, h = lane >> 5;
  const bool isV = odd ? ((ntile >= 8 && ntile < 12) || ntile == 21) : (ntile >= 16 && ntile < 20);
  f32x16 acc[2][2];
  if (isV) gemm_tile<false>(p.xs16, D, p.win16[l], D, D, m0, n0, lds, acc);
  else gemm_tile<true>(p.xs16, D, p.win16[l], D, D, m0, n0, lds, acc);
  const int mbase = m0 + wm * 64, npw = n0 + wn * 64;
  const int cv = tok_cv(m0);
  const float* bias = p.biasv + ((size_t)l * NCV + cv) * NPO + npw;
  const float* rowss = p.rowss_l + (size_t)l * M;
  auto rsf = [&](int m) { return 1.f / sqrtf(rowss[m] * (1.f / D) + EPSN); };
  auto krf = [&](int m) { return tok_keyrow(m); };
  const float QS = LOG2E / 8.f;
  int gcol = -1;
  if (!odd) { if (ntile >= 4 && ntile < 8) gcol = npw - 512; else if (ntile >= 20) gcol = npw - 2560 + 512; }
  else { if (ntile >= 12 && ntile < 16) gcol = npw - 1536; else if (ntile >= 22) gcol = npw - 2816 + 512; }
  if (gcol >= 0) {
#pragma unroll
    for (int mb = 0; mb < 2; mb++) {
      const int m = mbase + mb * 32 + (lane & 31); const float rs = rsf(m);
#pragma unroll
      for (int nb = 0; nb < 2; nb++)
#pragma unroll
        for (int q = 0; q < 4; q++) {
          const int j = nb * 32 + 8 * q + 4 * h; f32x4 b = *(const f32x4*)(bias + j); h16x4 o;
#pragma unroll
          for (int e = 0; e < 4; e++) o[e] = (h16)siluf(acc[mb][nb][q * 4 + e] * rs + b[e]);
          *(h16x4*)(p.gates16 + (size_t)m * 1024 + gcol + j) = o;
        }
    }
    return;
  }
  if (!odd) {
    if (ntile < 2) {
#pragma unroll
      for (int mb = 0; mb < 2; mb++) {
        const int m = mbase + mb * 32 + (lane & 31); const float rs = rsf(m); float ss = 0;
#pragma unroll
        for (int nb = 0; nb < 2; nb++)
#pragma unroll
          for (int q = 0; q < 4; q++) {
            const int j = nb * 32 + 8 * q + 4 * h; f32x4 b = *(const f32x4*)(bias + j); h16x4 o;
#pragma unroll
            for (int e = 0; e < 4; e++) { float x = acc[mb][nb][q * 4 + e] * rs + b[e]; o[e] = (h16)x; float xr = (float)o[e]; ss += xr * xr; }
            *(h16x4*)(p.qa16 + (size_t)m * 256 + npw + j) = o;
          }
        ss = wsum32(ss);
        if (h == 0) atomicAdd(p.rowss_qa + (size_t)i * M + m, ss);
      }
    } else if (ntile == 2) {
      float* red = (float*)lds;
      float v[2][2][16];
#pragma unroll
      for (int mb = 0; mb < 2; mb++) {
        const int m = mbase + mb * 32 + (lane & 31); const float rs = rsf(m); float ss = 0;
#pragma unroll
        for (int nb = 0; nb < 2; nb++)
#pragma unroll
          for (int q = 0; q < 4; q++) {
            const int j = nb * 32 + 8 * q + 4 * h; f32x4 b = *(const f32x4*)(bias + j);
#pragma unroll
            for (int e = 0; e < 4; e++) { float x = acc[mb][nb][q * 4 + e] * rs + b[e]; v[mb][nb][q * 4 + e] = x; ss += x * x; }
          }
        ss = wsum32(ss);
        if (h == 0) red[wn * 256 + wm * 64 + mb * 32 + lane] = ss;
      }
      __syncthreads();
#pragma unroll
      for (int mb = 0; mb < 2; mb++) {
        const int rl = wm * 64 + mb * 32 + (lane & 31); const int m = m0 + rl;
        const float rr = 1.f / sqrtf((red[rl] + red[256 + rl]) * (1.f / 128.f) + EPSN);
        const int kr = tok_keyrow(m);
#pragma unroll
        for (int nb = 0; nb < 2; nb++)
#pragma unroll
          for (int q = 0; q < 4; q++) {
            const int j = wn * 64 + nb * 32 + 8 * q + 4 * h; f32x4 g = *(const f32x4*)(p.mla_kva_norm + i * 128 + j); f32x4 o; h16x4 oh;
#pragma unroll
            for (int e = 0; e < 4; e++) { o[e] = v[mb][nb][q * 4 + e] * rr * g[e]; oh[e] = (h16)o[e]; }
            if (m < MP) *(f32x4*)(p.o_ckv + st_row(m, i) * 128 + j) = o;
            *(h16x4*)(p.ckv16 + (size_t)kr * 128 + j) = oh;
#if DUAL_WRITE
            *(f32x4*)(p.ckvbuf + (size_t)kr * 128 + j) = o;
#endif
          }
      }
      __syncthreads();
    } else if (ntile == 3) {
      if (wn == 0) {
        epi_head32(p, acc, mbase, rsf, bias, p.mla_kn_rope + i * 32, true, 1.f, p.o_kpe, i, [&](int m) { return p.kpe16 + (size_t)tok_keyrow(m) * 32; },
                   DUAL_WRITE ? p.kpebuf : nullptr);
      }
    } else if (ntile < 12) {
      const int hc = (ntile - 8) * 2 + wn;
      epi_head64(p, acc, mbase, rsf, bias, p.diff_qn + i * 64, true, QS, nullptr, 0, 0, i, [&](int m) { return p.QB + ((size_t)m * 8 + hc) * 64; });
    } else if (ntile < 16) {
      const int hc = (ntile - 12) * 2 + wn;
      epi_head64(p, acc, mbase, rsf, bias, p.diff_kn + i * 64, true, 1.f, p.o_dk, 512, hc * 64, i, [&](int m) { return p.KB + ((size_t)hc * KM + tok_keyrow(m)) * 64; });
    } else {
      const int vcol = (ntile - 16) * 128 + wn * 64;
      epi_vt(acc, mbase, rsf, bias, p.o_dv, 512, vcol, i, p.VB + (size_t)vcol * KM, krf);
    }
  } else {
    if (ntile < 4) {
      const int hd = ntile * 2 + wn;
      epi_head64(p, acc, mbase, rsf, bias, p.na_qn + i * 64, false, QS, nullptr, 0, 0, i, [&](int m) { return p.QA + ((size_t)m * 8 + hd) * 64; });
    } else if (ntile < 8) {
      const int hd = (ntile - 4) * 2 + wn;
      epi_head64(p, acc, mbase, rsf, bias, p.na_kn + i * 64, false, 1.f, p.o_nk, 512, hd * 64, i, [&](int m) { return p.KA + ((size_t)hd * KM + tok_keyrow(m)) * 64; });
    } else if (ntile < 12) {
      const int vcol = (ntile - 8) * 128 + wn * 64;
      epi_vt(acc, mbase, rsf, bias, p.o_nv, 512, vcol, i, p.VA + (size_t)vcol * KM, krf);
    } else if (ntile < 20) {
      const int hd = (ntile - 16) * 2 + wn;
      epi_head64(p, acc, mbase, rsf, bias, p.gqa_qn + i * 64, true, QS, nullptr, 0, 0, i, [&](int m) { return p.QB + ((size_t)m * 8 + hd) * 64; });
    } else if (ntile == 20) {
      epi_head64(p, acc, mbase, rsf, bias, p.gqa_kn + i * 64, true, 1.f, p.o_gk, 128, wn * 64, i, [&](int m) { return p.KB + ((size_t)wn * KM + tok_keyrow(m)) * 64; });
    } else {
      const int vcol = wn * 64;
      epi_vt(acc, mbase, rsf, bias, p.o_gv, 128, vcol, i, p.VB + (size_t)vcol * KM, krf);
    }
  }
}
__global__ void __launch_bounds__(512) fk_inproj(Params p, int l) {
  __shared__ __attribute__((aligned(16))) char lds[G_LDS];
  const int NP = (l & 1) ? NPO : NPE; const int ntn = NP / 128;
  inproj_tile(p, l, blockIdx.x / ntn, blockIdx.x % ntn, lds);
}
DEVFN void qgemm_tile(const Params& p, int l, int mt, int head, char* lds) {
  const int i = l >> 1; const int m0 = mt * 256;
  const int w = threadIdx.x >> 6, wm = w >> 1, wn = w & 1;
  f32x16 acc[2][2];
  gemm_tile<true>(p.qa16, 256, p.wqb16[i], 256, 256, m0, head * 128, lds, acc);
  const float* rq = p.rowss_qa + (size_t)i * M;
  auto rsf = [&](int m) { return 1.f / sqrtf(rq[m] * (1.f / 256.f) + EPSN); };
  const float sc = LOG2E / sqrtf(96.f);
  if (wn == 0) epi_head64(p, acc, m0 + wm * 64, rsf, nullptr, p.mla_qn_nope + i * 64, false, sc, nullptr, 0, 0, i, [&](int m) { return p.QA + ((size_t)m * 8 + head) * 96; });
  else epi_head32(p, acc, m0 + wm * 64, rsf, nullptr, p.mla_qn_rope + i * 32, true, sc, nullptr, i, [&](int m) { return p.QA + ((size_t)m * 8 + head) * 96 + 64; });
}
DEVFN void kvgemm_tile(const Params& p, int l, int mt, int ntile, char* lds) {
  const int i = l >> 1; const int m0 = mt * 256;
  const int lane = threadIdx.x & 63, w = threadIdx.x >> 6, wm = w >> 1, wn = w & 1, h = lane >> 5;
  f32x16 acc[2][2];
  auto one = [](int) { return 1.f; };
  if (ntile < 4) {
    gemm_tile<true>(p.ckv16, 128, p.wkvb16[i], 128, 128, m0, ntile * 128, lds, acc);
    const int head = ntile * 2 + wn;
    epi_head64(p, acc, m0 + wm * 64, one, nullptr, p.mla_kn_nope + i * 64, false, 1.f, nullptr, 0, 0, i, [&](int m) { return p.KA + ((size_t)head * KM + m) * 128; });
#pragma unroll
    for (int mb = 0; mb < 2; mb++) {
      const int kr = m0 + wm * 64 + mb * 32 + (lane & 31);
      const h16x8* s = (const h16x8*)(p.kpe16 + (size_t)kr * 32 + h * 16);
      h16x8* d = (h16x8*)(p.KA + ((size_t)head * KM + kr) * 128 + 64 + h * 16);
      d[0] = s[0]; d[1] = s[1];
    }
  } else {
    gemm_tile<false>(p.ckv16, 128, p.wkvb16[i], 128, 128, m0, ntile * 128, lds, acc);
    const int head = (ntile - 4) * 2 + wn;
    epi_vt(acc, m0 + wm * 64, one, nullptr, nullptr, 0, 0, i, p.VA + (size_t)head * 64 * KM, [](int m) { return m; });
  }
}
DEVFN void outproj_tile(const Params& p, int l, int mt, int ntile, char* lds) {
  const int m0 = mt * 256, n0 = ntile * 128;
  const int lane = threadIdx.x & 63, w = threadIdx.x >> 6, wm = w >> 1, wn = w & 1, h = lane >> 5;
  f32x16 acc[2][2];
  gemm_tile<true>(p.O16, D, p.wout16[l], D, D, m0, n0, lds, acc);
  const int cv = tok_cv(m0); const int nw0 = n0 + wn * 64;
  const float* gate = p.modv + ((size_t)l * NCV + cv) * 3072 + 2048 + nw0;
  const float* nsc = p.modv + ((size_t)(l + 1) * NCV + cv) * 3072 + 1024 + nw0;
  const float* nnw = p.norm_w + (l + 1) * D + nw0;
#pragma unroll
  for (int mb = 0; mb < 2; mb++) {
    const int m = m0 + wm * 64 + mb * 32 + (lane & 31);
    const float* xr = xrow(p, l, m) + nw0; float* yr = p.Y + (size_t)m * D + nw0;
    float ss = 0;
#pragma unroll
    for (int nb = 0; nb < 2; nb++)
#pragma unroll
      for (int q = 0; q < 4; q++) {
        const int j = nb * 32 + 8 * q + 4 * h;
        f32x4 x = *(const f32x4*)(xr + j), g = *(const f32x4*)(gate + j), o;
#pragma unroll
        for (int e = 0; e < 4; e++) { o[e] = x[e] + g[e] * acc[mb][nb][q * 4 + e]; ss += o[e] * o[e]; }
        *(f32x4*)(yr + j) = o;
        if (l < 3) {
          f32x4 s = *(const f32x4*)(nsc + j), nw = *(const f32x4*)(nnw + j); h16x4 oh;
#pragma unroll
          for (int e = 0; e < 4; e++) oh[e] = (h16)(o[e] * nw[e] * (1.f + s[e]));
          *(h16x4*)(p.xs16 + (size_t)m * D + nw0 + j) = oh;
        }
      }
    if (l < 3) { ss = wsum32(ss); if (h == 0) atomicAdd(p.rowss_l + (size_t)(l + 1) * M + m, ss); }
  }
}
__global__ void __launch_bounds__(512) fk_a2(Params p, int l) {
  __shared__ __attribute__((aligned(16))) char lds[G_LDS];
  const int nq = (M / 256) * 8;
  if ((int)blockIdx.x < nq) qgemm_tile(p, l, blockIdx.x / 8, blockIdx.x % 8, lds);
  else { int b = blockIdx.x - nq; kvgemm_tile(p, l, b / 8, b % 8, lds); }
}
__global__ void __launch_bounds__(512) fk_outproj(Params p, int l) {
  __shared__ __attribute__((aligned(16))) char lds[G_LDS];
  outproj_tile(p, l, blockIdx.x / 8, blockIdx.x % 8, lds);
}
struct AttnItem {
  const h16 *k0, *k1; int kld;
  const h16 *v0, *v1;
  int kr0, nt0, kr1, nt1;
};
constexpr int A_RING = 3 * 32768;

template <int DQK, int NKI, int NVI, int NDB, bool NAMASK>
DEVFN void attn_core(const AttnItem& it, const h16* qptr, int qpitch, int ksel, int ta, int tb, const float* rpbl, int na_dr0  , int na_c,
                     char* lds, f32x16 (&o)[NDB], float& lsum_out) {
  constexpr int NIMG = NKI + NVI; constexpr int STG = NIMG * 8192;
  const int tid = threadIdx.x, lane = tid & 63, h = lane >> 5;
  h16x8 qf[DQK / 16];
#pragma unroll
  for (int ks = 0; ks < DQK / 16; ks++) qf[ks] = *(const h16x8*)(qptr + (size_t)(lane & 31) * qpitch + ks * 16 + 8 * h);
#pragma unroll
  for (int db = 0; db < NDB; db++)
#pragma unroll
    for (int r = 0; r < 16; r++) o[db][r] = 0.f;
  float m_run = -1e30f, lsum = 0.f;
  const int nt = it.nt0 + it.nt1;
  auto stage = [&](int t) {
    char* s = lds + (t % 3) * STG; const int kr = t < it.nt0 ? it.kr0 + 64 * t : it.kr1 + 64 * (t - it.nt0);
    stage_rows<64>(it.k0 + (size_t)kr * it.kld, it.kld, s, tid);
    if (NKI == 2) stage_rows<64>(it.k1 + (size_t)kr * it.kld, it.kld, s + 8192, tid);
    stage_rows<64>(it.v0 + kr, KM, s + NKI * 8192, tid);
    if (NVI == 2) stage_rows<64>(it.v1 + kr, KM, s + NKI * 8192 + 8192, tid);
  };
  stage(0); if (nt > 1) stage(1);
  const int l5 = lane & 31;
  const int prow = (l5 & 19) | ((l5 & 4) << 1) | ((l5 & 8) >> 1);
  int na_cs = na_c - 8; na_cs = na_cs < 0 ? 0 : (na_cs > GW - 16 ? GW - 16 : na_cs);
  for (int t = 0; t < nt; t++) {
    if (t + 1 < nt) { if (NIMG == 2) WAITV(2); else if (NIMG == 3) WAITV(3); else WAITV(4); } else WAITV(0);
    RAWBAR();
    if (t + 2 < nt) stage(t + 2);
    const bool active = (t >= it.nt0) || (t >= ta && t < tb);
    if (active) {
      const char* s = lds + (t % 3) * STG;
      f32x16 st[2];
#pragma unroll
      for (int kb = 0; kb < 2; kb++) {
#pragma unroll
        for (int r = 0; r < 16; r++) st[kb][r] = 0.f;
#pragma unroll
        for (int ks = 0; ks < DQK / 16; ks++) {
          const int img = (DQK == 96) ? (ks >> 2) : ksel;
          h16x8 kf = *(const h16x8*)(s + img * 8192 + img_off(32 * kb + prow, 2 * (ks & 3) + h));
          st[kb] = __builtin_amdgcn_mfma_f32_32x32x16_f16(kf, qf[ks], st[kb], 0, 0, 0);
        }
      }
      if (NAMASK && t < it.nt0) {
        const int drow = (na_dr0 + t) * 31 + 15 - na_c;
#pragma unroll
        for (int kb = 0; kb < 2; kb++)
#pragma unroll
          for (int r = 0; r < 16; r++) {
            const int kcol = 32 * kb + (r & 7) + 8 * h + 16 * (r >> 3);
            const bool valid = (unsigned)(kcol - na_cs) < 16u;
            const float bv = rpbl[valid ? drow + kcol : 0];
            st[kb][r] = valid ? st[kb][r] + bv : -1e30f;
          }
      }
      float mx = st[0][0];
#pragma unroll
      for (int r = 1; r < 16; r++) mx = fmaxf(mx, st[0][r]);
#pragma unroll
      for (int r = 0; r < 16; r++) mx = fmaxf(mx, st[1][r]);
      mx = fmaxf(mx, __shfl_xor(mx, 32));
      const float mn = fmaxf(m_run, mx); const float al = __builtin_amdgcn_exp2f(m_run - mn); m_run = mn;
      float sum = 0.f;
#pragma unroll
      for (int kb = 0; kb < 2; kb++)
#pragma unroll
        for (int r = 0; r < 16; r++) { float pe = __builtin_amdgcn_exp2f(st[kb][r] - mn); st[kb][r] = pe; sum += pe; }
      lsum = lsum * al + sum;
#pragma unroll
      for (int db = 0; db < NDB; db++)
#pragma unroll
        for (int r = 0; r < 16; r++) o[db][r] *= al;
      h16x8 pf[4];
#pragma unroll
      for (int sI = 0; sI < 4; sI++)
#pragma unroll
        for (int j = 0; j < 8; j++) pf[sI][j] = (h16)st[sI >> 1][8 * (sI & 1) + j];
      const char* sv = s + NKI * 8192;
#pragma unroll
      for (int db = 0; db < NDB; db++)
#pragma unroll
        for (int sI = 0; sI < 4; sI++) {
          h16x8 vf = *(const h16x8*)(sv + (db >> 1) * 8192 + img_off((db & 1) * 32 + l5, 2 * sI + h));
          o[db] = __builtin_amdgcn_mfma_f32_32x32x16_f16(vf, pf[sI], o[db], 0, 0, 0);
        }
    }
  }
  RAWBAR();
  lsum_out = lsum + __shfl_xor(lsum, 32);
}
template <int NDB>
DEVFN void attn_store_gated(const Params& p, const f32x16 (&o)[NDB], float inv, int m, int col0) {
  const int h = (threadIdx.x & 63) >> 5;
#pragma unroll
  for (int db = 0; db < NDB; db++)
#pragma unroll
    for (int q = 0; q < 4; q++) {
      const int c = col0 + 32 * db + 8 * q + 4 * h;
      h16x4 g = *(const h16x4*)(p.gates16 + (size_t)m * 1024 + c), ov;
#pragma unroll
      for (int e = 0; e < 4; e++) ov[e] = (h16)(o[db][q * 4 + e] * inv * (float)g[e]);
      *(h16x4*)(p.O16 + (size_t)m * 1024 + c) = ov;
    }
}
DEVFN void attn_even_item(const Params& p, int l, int item, char* lds) {
  const int i = l >> 1; const int lane = threadIdx.x & 63, w = threadIdx.x >> 6, h = lane >> 5;
  const int grp = item >> 7, j = item & 127; const bool smp = grp < 2; const bool isdiff = (grp & 1) == 0;
  AttnItem it{}; it.nt1 = 0; it.kr1 = 0;
  if (isdiff) {
    int b, hh, t0;
    if (smp) { b = j >> 6; hh = (j >> 4) & 3; t0 = (j & 15) * 128; it.kr0 = MP + b * TKS; it.nt0 = TKS / 64; }
    else { b = j >> 3; hh = (j >> 1) & 3; t0 = (j & 1) * 128; it.kr0 = b * SEQ; it.nt0 = SEQ / 64; }
    const int comp = w >> 2;
    const int m0w = (smp ? MP + b * DS : b * SEQ) + t0 + (w & 3) * 32;
    it.k0 = p.KB + (size_t)(2 * hh) * KM * 64; it.k1 = p.KB + (size_t)(2 * hh + 1) * KM * 64; it.kld = 64;
    it.v0 = p.VB + (size_t)(hh * 128) * KM; it.v1 = p.VB + (size_t)(hh * 128 + 64) * KM;
    f32x16 o[4]; float lsum;
    attn_core<64, 2, 2, 4, false>(it, p.QB + ((size_t)m0w * 8 + 2 * hh + comp) * 64, 512, comp, 0, 1 << 30, nullptr, 0, 0, lds, o, lsum);
    const float inv = 1.f / lsum;
    float* a2 = (float*)lds + (size_t)(w & 3) * 32 * 132 + (size_t)(lane & 31) * 132;
    if (comp == 1) {
#pragma unroll
      for (int db = 0; db < 4; db++)
#pragma unroll
        for (int q = 0; q < 4; q++) { f32x4 v = {o[db][q * 4] * inv, o[db][q * 4 + 1] * inv, o[db][q * 4 + 2] * inv, o[db][q * 4 + 3] * inv}; *(f32x4*)(a2 + 32 * db + 8 * q + 4 * h) = v; }
    }
    __syncthreads();
    if (comp == 0) {
      const float lam = p.lamv[i]; const float lam_init = 0.8f - 0.6f * expf(-0.3f * l);
      float ss = 0;
#pragma unroll
      for (int db = 0; db < 4; db++)
#pragma unroll
        for (int q = 0; q < 4; q++) {
          f32x4 v2 = *(const f32x4*)(a2 + 32 * db + 8 * q + 4 * h);
#pragma unroll
          for (int e = 0; e < 4; e++) { float d = o[db][q * 4 + e] * inv - lam * v2[e]; o[db][q * 4 + e] = d; ss += d * d; }
        }
      ss = wsum32(ss);
      const float rr = (1.f - lam_init) / sqrtf(ss * (1.f / 128.f) + EPSN);
      const int m = m0w + (lane & 31);
#pragma unroll
      for (int db = 0; db < 4; db++)
#pragma unroll
        for (int q = 0; q < 4; q++) {
          const int dv = 32 * db + 8 * q + 4 * h; const int c = 512 + hh * 128 + dv;
          f32x4 sg = *(const f32x4*)(p.diff_subln + i * 128 + dv);
          h16x4 g = *(const h16x4*)(p.gates16 + (size_t)m * 1024 + c), ov;
#pragma unroll
          for (int e = 0; e < 4; e++) ov[e] = (h16)(o[db][q * 4 + e] * rr * sg[e] * (float)g[e]);
          *(h16x4*)(p.O16 + (size_t)m * 1024 + c) = ov;
        }
    }
    __syncthreads();
  } else {
    int b, head, t0;
    if (smp) { b = j >> 6; head = (j >> 3) & 7; t0 = (j & 7) * 256; it.kr0 = MP + b * TKS; it.nt0 = TKS / 64; }
    else { b = j >> 3; head = j & 7; t0 = 0; it.kr0 = b * SEQ; it.nt0 = SEQ / 64; }
    const int m0w = (smp ? MP + b * DS : b * SEQ) + t0 + w * 32;
    it.k0 = p.KA + (size_t)head * KM * 128; it.k1 = it.k0 + 64; it.kld = 128;
    it.v0 = p.VA + (size_t)(head * 64) * KM; it.v1 = it.v0;
    f32x16 o[2]; float lsum;
    attn_core<96, 2, 1, 2, false>(it, p.QA + ((size_t)m0w * 8 + head) * 96, 768, 0, 0, 1 << 30, nullptr, 0, 0, lds, o, lsum);
    attn_store_gated<2>(p, o, 1.f / lsum, m0w + (lane & 31), head * 64);
  }
}
DEVFN void attn_odd_item(const Params& p, int l, int item, char* lds) {
  const int i = l >> 1; const int lane = threadIdx.x & 63, w = threadIdx.x >> 6;
  const int grp = item >> 7, j = item & 127; const bool smp = grp < 2; const bool isgqa = (grp & 1) == 0;
  AttnItem it{}; it.nt1 = 0; it.kr1 = 0; it.kld = 64;
  f32x16 o[2]; float lsum;
  if (isgqa) {
    int b, kvh, t0;
    if (smp) { b = j >> 6; kvh = (j >> 5) & 1; t0 = (j & 31) * 64; it.kr0 = MP + b * TKS; it.nt0 = TKS / 64; }
    else { b = j >> 3; kvh = (j >> 2) & 1; t0 = (j & 3) * 64; it.kr0 = b * SEQ; it.nt0 = SEQ / 64; }
    const int head = kvh * 4 + (w >> 1);
    const int m0w = (smp ? MP + b * DS : b * SEQ) + t0 + (w & 1) * 32;
    it.k0 = p.KB + (size_t)kvh * KM * 64; it.k1 = it.k0; it.v0 = p.VB + (size_t)(kvh * 64) * KM; it.v1 = it.v0;
    attn_core<64, 1, 1, 2, false>(it, p.QB + ((size_t)m0w * 8 + head) * 64, 512, 0, 0, 1 << 30, nullptr, 0, 0, lds, o, lsum);
    attn_store_gated<2>(p, o, 1.f / lsum, m0w + (lane & 31), 512 + head * 64);
  } else if (!smp) {
    const int b = j >> 3, head = j & 7; it.kr0 = b * SEQ; it.nt0 = SEQ / 64;
    const int m0w = b * SEQ + w * 32;
    it.k0 = p.KA + (size_t)head * KM * 64; it.k1 = it.k0; it.v0 = p.VA + (size_t)(head * 64) * KM; it.v1 = it.v0;
    attn_core<64, 1, 1, 2, false>(it, p.QA + ((size_t)m0w * 8 + head) * 64, 512, 0, 0, 1 << 30, nullptr, 0, 0, lds, o, lsum);
    attn_store_gated<2>(p, o, 1.f / lsum, m0w + (lane & 31), head * 64);
  } else {
    const int b = j >> 6, head = (j >> 3) & 7, r0 = (j & 7) * 4;
    const int r = r0 + (w >> 1), c0 = (w & 1) * 32;
    auto rsf = [](int rr) { int s = rr - 4; return s < 0 ? 0 : (s > GROWS - 8 ? GROWS - 8 : s); };
    const int rlo = rsf(r0), rhi = rsf(r0 + 3) + 8;
    const int kbase = MP + b * TKS;
    it.kr0 = kbase + rlo * 64; it.nt0 = rhi - rlo; it.kr1 = kbase + DS; it.nt1 = PAST / 64;
    it.k0 = p.KA + (size_t)head * KM * 64; it.k1 = it.k0; it.v0 = p.VA + (size_t)(head * 64) * KM; it.v1 = it.v0;
    float* rpbl = (float*)(lds + A_RING);
    { const float* src = p.na_rpb + ((size_t)i * 8 + head) * 465; for (int k = threadIdx.x; k < 465; k += 512) rpbl[k] = src[k] * LOG2E; }
    const int m0w = MP + b * DS + r * 64 + c0;
    const int ta = rsf(r) - rlo;
    attn_core<64, 1, 1, 2, true>(it, p.QA + ((size_t)m0w * 8 + head) * 64, 512, 0, ta, ta + 8, rpbl, rlo - r + 7, c0 + (lane & 31), lds, o, lsum);
    attn_store_gated<2>(p, o, 1.f / lsum, m0w + (lane & 31), head * 64);
  }
}
__global__ void __launch_bounds__(512) fk_attn(Params p, int l) {
  __shared__ __attribute__((aligned(16))) char lds[G_LDS];
  if (l & 1) attn_odd_item(p, l, blockIdx.x, lds); else attn_even_item(p, l, blockIdx.x, lds);
}
__global__ void __launch_bounds__(512) fk_inproj_plain(Params p, int l) {
  __shared__ __attribute__((aligned(16))) char lds[G_LDS];
  const int NP = (l & 1) ? NPO : NPE; const int ntn = NP / 128;
  const int mt = blockIdx.x / ntn, ntile = blockIdx.x % ntn;
  const int m0 = mt * 256, n0 = ntile * 128;
  f32x16 acc[2][2];
  gemm_tile<true>(p.xs16, D, p.win16[l], D, D, m0, n0, lds, acc);
  const int lane = threadIdx.x & 63, w = threadIdx.x >> 6, wm = w >> 1, wn = w & 1;
  for (int mb = 0; mb < 2; mb++) {
    int m = m0 + wm * 64 + mb * 32 + (lane & 31);
    float rstd = 1.f / sqrtf(p.rowss_l[(size_t)l * M + m] / D + EPSN);
    const float* bias = p.biasv + ((size_t)l * NCV + tok_cv(m)) * NPO;
    for (int nb = 0; nb < 2; nb++)
      for (int r = 0; r < 16; r++) {
        int np = n0 + wn * 64 + nb * 32 + (r & 3) + 8 * (r >> 2) + 4 * (lane >> 5);
        int col = (l & 1) ? np : even_col(np);
        if (col >= 0) p.ubuf[(size_t)m * 3328 + col] = (h16)(acc[mb][nb][r] * rstd + bias[np]);
      }
  }
}
#endif

static inline size_t al256(size_t x) { return (x + 255) & ~(size_t)255; }

extern "C" void kernel_launch(void* const* d_in, const int* in_sizes, int n_in, void* d_out, int out_size, void* d_ws, size_t ws_size,
                              hipStream_t stream) {
  Params p{};
  const float** ip = (const float**)&p.x_prompt;
  for (int k = 0; k < 39; k++) ip[k] = (const float*)d_in[k];
  float* o = (float*)d_out;
  p.Y = o; o += (size_t)M * 1024;
  p.o_ckv = o; o += (size_t)BATCH * 2 * SEQ * 128;
  p.o_kpe = o; o += (size_t)BATCH * 2 * SEQ * 32;
  p.o_dk = o; o += (size_t)BATCH * 2 * SEQ * 512;
  p.o_dv = o; o += (size_t)BATCH * 2 * SEQ * 512;
  p.o_nk = o; o += (size_t)BATCH * 2 * SEQ * 512;
  p.o_nv = o; o += (size_t)BATCH * 2 * SEQ * 512;
  p.o_gk = o; o += (size_t)BATCH * 2 * SEQ * 128;
  p.o_gv = o; o += (size_t)BATCH * 2 * SEQ * 128;
  char* w = (char*)d_ws; size_t off = 0;
  auto take = [&](size_t bytes) { char* r = w + off; off += al256(bytes); return r; };
  p.modv = (float*)take((size_t)4 * NCV * 3072 * 4);
  p.ropeC64 = (float*)take((size_t)DS * 32 * 4); p.ropeS64 = (float*)take((size_t)DS * 32 * 4);
  p.ropeC32 = (float*)take((size_t)DS * 16 * 4); p.ropeS32 = (float*)take((size_t)DS * 16 * 4);
  p.lamv = (float*)take(256);
  p.rstdx = (float*)take((size_t)M * 4);
  p.QA = (h16*)take((size_t)M * 8 * 96 * 2); p.QB = (h16*)take((size_t)M * 8 * 64 * 2);
  p.KA = (h16*)take((size_t)8 * KM * 128 * 2); p.KB = (h16*)take((size_t)8 * KM * 64 * 2);
  p.VA = (h16*)take((size_t)8 * 64 * KM * 2); p.VB = (h16*)take((size_t)8 * 64 * KM * 2);
  p.gates16 = (h16*)take((size_t)M * 1024 * 2); p.O16 = (h16*)take((size_t)M * 1024 * 2);
  p.ckvbuf = (float*)take((size_t)KM * 128 * 4); p.kpebuf = (float*)take((size_t)KM * 32 * 4);
  p.xs16 = (h16*)take((size_t)M * D * 2); p.rowss_l = (float*)take((size_t)4 * M * 4); p.rowss_qa = (float*)take((size_t)2 * M * 4); p.qa16 = (h16*)take((size_t)M * 256 * 2); p.ckv16 = (h16*)take((size_t)KM * 128 * 2); p.kpe16 = (h16*)take((size_t)KM * 32 * 2); p.biasv = (float*)take((size_t)4 * NCV * NPO * 4);
  for (int l = 0; l < 4; l++) { p.win16[l] = (h16*)take((size_t)((l & 1) ? NPO : NPE) * D * 2); p.wout16[l] = (h16*)take((size_t)D * D * 2); }
  for (int i = 0; i < 2; i++) { p.wqb16[i] = (h16*)take((size_t)1024 * 256 * 2); p.wkvb16[i] = (h16*)take((size_t)1024 * 128 * 2); }
  size_t ub = (size_t)M * 3328 * 2, ab = (size_t)M * 1536 * 4;
  char* big = take(ub > ab ? ub : ab);
  p.ubuf = (h16*)big; p.abuf = (float*)big;
  (void)ws_size; (void)n_in; (void)in_sizes; (void)out_size;

#ifndef CPU_EMU
  hipMemsetAsync(p.rowss_qa, 0, (size_t)2 * M * 4, stream);
  hipMemsetAsync(p.rowss_l, 0, (size_t)4 * M * 4, stream);
#endif
  launch1d(nk_mod, (long)4 * NCV * 3072, stream, p, (long)4 * NCV * 3072);
  launch1d(nk_tab, (long)DS * 48, stream, p, (long)DS * 48);
#ifndef CPU_EMU
  for (int l = 0; l < 4; l++) {
    const int i = l >> 1;
    if (l & 1) hipLaunchKernelGGL(fk_convw, dim3(NPO / 64, D / 64), dim3(256), 0, stream, p.w_in_odd + (size_t)i * D * ODD_IN, p.win16[l], D, ODD_IN, NPO, 0, (const float*)nullptr);
    else hipLaunchKernelGGL(fk_convw, dim3(NPE / 64, D / 64), dim3(256), 0, stream, p.w_in_even + (size_t)i * D * EVEN_IN, p.win16[l], D, EVEN_IN, NPE, 1, (const float*)nullptr);
    hipLaunchKernelGGL(fk_convw, dim3(D / 64, D / 64), dim3(256), 0, stream, ((l & 1) ? p.w_out_odd : p.w_out_even) + (size_t)i * D * D, p.wout16[l], D, D, D, 0, (const float*)nullptr);
  }
  for (int i = 0; i < 2; i++) {
    hipLaunchKernelGGL(fk_convw, dim3(1024 / 64, 256 / 64), dim3(256), 0, stream, p.mla_wqb + (size_t)i * 256 * 768, p.wqb16[i], 256, 768, 1024, 2, p.mla_qa_norm + i * 256);
    hipLaunchKernelGGL(fk_convw, dim3(1024 / 64, 128 / 64), dim3(256), 0, stream, p.mla_wkvb + (size_t)i * 128 * 1024, p.wkvb16[i], 128, 1024, 1024, 3, (const float*)nullptr);
  }
#endif
  for (int l = 0; l < 4; l++) {
    const int N = (l & 1) ? ODD_IN : EVEN_IN;
#if defined(CPU_EMU) || !FAST_INPROJ
    launch1d(nk_rstd, (long)M, stream, p, l, (long)M);
    launch1d(nk_inproj, (long)M * N, stream, p, l, (long)M * N);
#else
    {
      const int NP = (l & 1) ? NPO : NPE;
      if (l == 0 || !FAST_OUTPROJ) hipLaunchKernelGGL(fk_prep_x, dim3(M / 4), dim3(256), 0, stream, p, l);
      hipLaunchKernelGGL(fk_bias, dim3(NP / 4), dim3(256), 0, stream, p, l);
#if FAST_INPROJ == 1
      hipLaunchKernelGGL(fk_inproj_plain, dim3((M / 256) * (NP / 128)), dim3(512), 0, stream, p, l);
#else
      hipLaunchKernelGGL(fk_inproj, dim3((M / 256) * (NP / 128)), dim3(512), 0, stream, p, l);
#endif
    }
#endif
    if ((l & 1) == 0) {
#if !defined(CPU_EMU) && FAST_INPROJ == 2 && FAST_A2
      launch1d(nk_cache_even, (long)DB * PAST * 17, stream, p, l, (long)DB * PAST * 17);
      hipLaunchKernelGGL(fk_a2, dim3((M / 256) * 8 + (KM / 256) * 8), dim3(512), 0, stream, p, l);
#else
#if !defined(CPU_EMU) && FAST_INPROJ == 2
      launch1d(nk_epi_even, (long)M * 50, stream, p, l, 1, (long)M * 50);
#else
      launch1d(nk_epi_even, (long)M * 50, stream, p, l, 0, (long)M * 50);
#endif
      launch1d(nk_cache_even, (long)DB * PAST * 17, stream, p, l, (long)DB * PAST * 17);
      launch1d(nk_kv, (long)KM * 16, stream, p, l, (long)KM * 16);
#endif
#if !defined(CPU_EMU) && FAST_ATTN
      hipLaunchKernelGGL(fk_attn, dim3(512), dim3(512), 0, stream, p, l);
#else
      launch1d(nk_attn_dense, (long)M * 8, stream, p, 0, 0, M, (long)M * 8);
      launch1d(nk_attn_dense, (long)M * 16, stream, p, 1, 0, M, (long)M * 16);
      launch1d(nk_fin, (long)M * 12, stream, p, l, (long)M * 12);
#endif
    } else {
#if defined(CPU_EMU) || FAST_INPROJ != 2
      launch1d(nk_epi_odd, (long)M * 52, stream, p, l, (long)M * 52);
#endif
      launch1d(nk_cache_odd, (long)DB * PAST * 20, stream, p, l, (long)DB * PAST * 20);
#if !defined(CPU_EMU) && FAST_ATTN
      hipLaunchKernelGGL(fk_attn, dim3(512), dim3(512), 0, stream, p, l);
#else
      launch1d(nk_attn_dense, (long)MP * 8, stream, p, 2, 0, MP, (long)MP * 8);
      launch1d(nk_attn_na, (long)MS * 8, stream, p, l, (long)MS * 8);
      launch1d(nk_attn_dense, (long)M * 8, stream, p, 3, 0, M, (long)M * 8);
      launch1d(nk_fin, (long)M * 16, stream, p, l, (long)M * 16);
#endif
    }
#if !defined(CPU_EMU) && FAST_OUTPROJ
    hipLaunchKernelGGL(fk_outproj, dim3((M / 256) * 8), dim3(512), 0, stream, p, l);
#else
    launch1d(nk_outproj, (long)M * 1024, stream, p, l, (long)M * 1024);
#endif
  }
}
```

```cpp
#ifndef CPU_EMU
#include <hip/hip_runtime.h>
#endif
#include <stdint.h>
#include <math.h>

#define FAST_INPROJ 2
#define DUAL_WRITE 0
#define FAST_A2 1
#define FAST_OUTPROJ 1
#define FAST_ATTN 1
#define MEGA 1
#ifndef CFG_BATCH
#define CFG_BATCH 16
#endif
#ifndef CFG_DB
#define CFG_DB 2
#endif
#ifndef CFG_DS
#define CFG_DS 2048
#endif
constexpr int D = 1024, BATCH = CFG_BATCH, SEQ = 256, DB = CFG_DB, DS = CFG_DS, PAST = 256;
constexpr int MP = BATCH * SEQ, MS = DB * DS, M = MP + MS;
constexpr int TKS = DS + PAST;
constexpr int KM = MP + DB * TKS;
constexpr int NCV = 1 + DB;
constexpr int GW = 64, GROWS = DS / GW;
constexpr int EVEN_IN = 2976, ODD_IN = 3328;
constexpr int NPE = 3072, NPO = 3328;
constexpr float EPSN = 1e-6f;
constexpr float LOG2E = 1.4426950408889634f;

typedef _Float16 h16;

struct Params {
  const float *x_prompt, *x_sample, *cache_mla_ckv, *cache_mla_kpe, *cache_diff_k, *cache_diff_v, *cache_na_k, *cache_na_v,
      *cache_gqa_k, *cache_gqa_v, *c, *c_ctx, *norm_w, *w_mod, *b_mod, *w_in_even, *w_out_even, *mla_qa_norm, *mla_wqb,
      *mla_kva_norm, *mla_wkvb, *mla_qn_nope, *mla_qn_rope, *mla_kn_nope, *mla_kn_rope, *diff_qn, *diff_kn, *diff_lq1,
      *diff_lk1, *diff_lq2, *diff_lk2, *diff_subln, *w_in_odd, *w_out_odd, *na_qn, *na_kn, *na_rpb, *gqa_qn, *gqa_kn;
  float *Y;
  float *o_ckv, *o_kpe, *o_dk, *o_dv, *o_nk, *o_nv, *o_gk, *o_gv;
  float *modv;
  float *ropeC64, *ropeS64;
  float *ropeC32, *ropeS32;
  float *lamv;
  float *rstdx;
  h16 *ubuf;
  float *abuf;
  float *ckvbuf;
  float *kpebuf;
  h16 *QA, *QB, *KA, *KB, *VA, *VB, *gates16, *O16;
  h16 *xs16;
  float *biasv;
  h16 *win16;
  h16 *wout16;
  h16 *wqb16;
  h16 *wkvb16;
  h16 *qa16;
  float *rowss_qa;
  h16 *ckv16;
  h16 *kpe16;
  float *rowss_l;
  unsigned *bar;
};

#ifdef CPU_EMU
#include <stdio.h>
#include <stdlib.h>
#include <string.h>
typedef void* hipStream_t;
#define KERNEL static void
#define DEVFN static inline
static thread_local long emu_gtid;
#define GTID emu_gtid
template <class... A, class... B>
static void launch1d(void (*f)(A...), long n, hipStream_t, B... a) {
#pragma omp parallel for schedule(dynamic, 64)
  for (long i = 0; i < n; i++) { emu_gtid = i; f(a...); }
}
static inline float exp2f_(float x) { return exp2f(x); }
#else
#define KERNEL __global__ void __launch_bounds__(256)
#define DEVFN __device__ __forceinline__
#define GTID ((long)blockIdx.x * 256 + threadIdx.x)
template <class... A, class... B>
static void launch1d(void (*f)(A...), long n, hipStream_t s, B... a) {
  hipLaunchKernelGGL(f, dim3((unsigned)((n + 255) / 256)), dim3(256), 0, s, a...);
}
DEVFN float exp2f_(float x) { return exp2f(x); }
#endif

DEVFN int tok_cv(int m) { return m < MP ? 0 : 1 + (m - MP) / DS; }
DEVFN int tok_keyrow(int m) { return m < MP ? m : MP + ((m - MP) / DS) * TKS + (m - MP) % DS; }
DEVFN int tok_pos(int m) { return m < MP ? (m % SEQ) : ((m - MP) % DS); }
DEVFN const float* xrow(const Params& p, int l, int m) {
  if (l > 0) return p.Y + (size_t)m * D;
  return m < MP ? p.x_prompt + (size_t)m * D : p.x_sample + (size_t)(m - MP) * D;
}
DEVFN float siluf(float x) { return x / (1.f + expf(-x)); }

KERNEL nk_mod(Params p, long n) {
  long g = GTID; if (g >= n) return;
  int col = g % 3072; int cv = (g / 3072) % NCV; int l = g / (3072 * NCV);
  const float* cvec = cv == 0 ? p.c_ctx : p.c + (size_t)(cv - 1) * D;
  const float* w = p.w_mod + (size_t)l * D * 3072 + col;
  float acc = p.b_mod[l * 3072 + col];
  for (int k = 0; k < D; k++) acc += siluf(cvec[k]) * w[(size_t)k * 3072];
  p.modv[((size_t)l * NCV + cv) * 3072 + col] = acc;
}
KERNEL nk_tab(Params p, long n) {
  long g = GTID; if (g >= n) return;
  if (g < 2) {
    int i = g; int l = 2 * i;
    float s1 = 0, s2 = 0;
    for (int k = 0; k < 64; k++) { s1 += p.diff_lq1[i * 64 + k] * p.diff_lk1[i * 64 + k]; s2 += p.diff_lq2[i * 64 + k] * p.diff_lk2[i * 64 + k]; }
    float lam_init = 0.8f - 0.6f * expf(-0.3f * l);
    p.lamv[i] = expf(s1) - expf(s2) + lam_init;
  }
  int t = g / 48, j = g % 48;
  if (t >= DS) return;
  float row = (float)(t / GW), col = (float)(t % GW);
  if (j < 32) {
    int f = j & 15; float inv = powf(10000.f, -(float)(2 * f) / 32.f);
    float ang = (j < 16 ? row : col) * inv;
    p.ropeC64[t * 32 + j] = cosf(ang); p.ropeS64[t * 32 + j] = sinf(ang);
  } else {
    int jj = j - 32; int f = jj & 7; float inv = powf(10000.f, -(float)(2 * f) / 16.f);
    float ang = (jj < 8 ? row : col) * inv;
    p.ropeC32[t * 16 + jj] = cosf(ang); p.ropeS32[t * 16 + jj] = sinf(ang);
  }
}
KERNEL nk_rstd(Params p, int l, long n) {
  long g = GTID; if (g >= n) return;
  const float* x = xrow(p, l, (int)g);
  float s = 0; for (int k = 0; k < D; k++) s += x[k] * x[k];
  p.rstdx[g] = 1.f / sqrtf(s / D + EPSN);
}
KERNEL nk_inproj(Params p, int l, long n) {
  long g = GTID; if (g >= n) return;
  const int N = (l & 1) ? ODD_IN : EVEN_IN;
  int m = g / N, col = g % N;
  const float* W = ((l & 1) ? p.w_in_odd : p.w_in_even) + (size_t)(l >> 1) * D * N + col;
  const float* x = xrow(p, l, m);
  const float* md = p.modv + ((size_t)l * NCV + tok_cv(m)) * 3072;
  const float* nw = p.norm_w + l * D;
  float r = p.rstdx[m], acc = 0;
  for (int k = 0; k < D; k++) { float h = x[k] * r * nw[k] * (1.f + md[1024 + k]) + md[k]; acc += h * W[(size_t)k * N]; }
  p.ubuf[(size_t)m * 3328 + col] = (h16)acc;
}
DEVFN size_t st_row(int m, int i) { int b = m / SEQ, t = m % SEQ; return ((size_t)(b * 2 + i) * SEQ + t); }

KERNEL nk_epi_even(Params p, int l, int qa_only, long n) {
  long g = GTID; if (g >= n) return;
  const int i = l >> 1;
  int m = g / 50, u = g % 50;
  if (qa_only && u >= 8) return;
  const h16* ur = qa_only ? p.qa16 + (size_t)m * 256 : p.ubuf + (size_t)m * 3328;
  const bool smp = m >= MP; const int t = tok_pos(m); const int kr = tok_keyrow(m);
  if (u < 8) {
    float ss = 0; for (int k = 0; k < 256; k++) { float v = (float)ur[k]; ss += v * v; }
    float r = 1.f / sqrtf(ss / 256 + EPSN);
    float q[96];
#pragma unroll
    for (int j = 0; j < 96; j++) q[j] = 0;
    const float* W = p.mla_wqb + (size_t)i * 256 * 768 + u * 96;
    for (int k = 0; k < 256; k++) {
      float a = (float)ur[k] * r * p.mla_qa_norm[i * 256 + k];
#pragma unroll
      for (int j = 0; j < 96; j++) q[j] += a * W[(size_t)k * 768 + j];
    }
    float s1 = 0, s2 = 0;
#pragma unroll
    for (int j = 0; j < 64; j++) s1 += q[j] * q[j];
#pragma unroll
    for (int j = 64; j < 96; j++) s2 += q[j] * q[j];
    float r1 = 1.f / sqrtf(s1 / 64 + EPSN), r2 = 1.f / sqrtf(s2 / 32 + EPSN);
#pragma unroll
    for (int j = 0; j < 64; j++) q[j] = q[j] * r1 * p.mla_qn_nope[i * 64 + j];
#pragma unroll
    for (int j = 0; j < 32; j++) q[64 + j] = q[64 + j] * r2 * p.mla_qn_rope[i * 32 + j];
    if (smp) {
#pragma unroll
      for (int j = 0; j < 16; j++) {
        float c = p.ropeC32[t * 16 + j], s = p.ropeS32[t * 16 + j];
        float x1 = q[64 + j], x2 = q[80 + j];
        q[64 + j] = x1 * c - x2 * s; q[80 + j] = x2 * c + x1 * s;
      }
    }
    const float sc = LOG2E / sqrtf(96.f);
    h16* dst = p.QA + ((size_t)m * 8 + u) * 96;
#pragma unroll
    for (int j = 0; j < 96; j++) dst[j] = (h16)(q[j] * sc);
  } else if (u == 8) {
    float ss = 0; for (int k = 0; k < 128; k++) { float v = (float)ur[256 + k]; ss += v * v; }
    float r = 1.f / sqrtf(ss / 128 + EPSN);
    for (int k = 0; k < 128; k++) {
      float v = (float)ur[256 + k] * r * p.mla_kva_norm[i * 128 + k];
      if (!smp) p.o_ckv[st_row(m, i) * 128 + k] = v;
      p.ckvbuf[(size_t)kr * 128 + k] = v;
    }
  } else if (u == 9) {
    float v[32]; float ss = 0;
#pragma unroll
    for (int k = 0; k < 32; k++) { v[k] = (float)ur[384 + k]; ss += v[k] * v[k]; }
    float r = 1.f / sqrtf(ss / 32 + EPSN);
#pragma unroll
    for (int k = 0; k < 32; k++) { v[k] = v[k] * r * p.mla_kn_rope[i * 32 + k]; if (!smp) p.o_kpe[st_row(m, i) * 32 + k] = v[k]; }
    if (smp) {
#pragma unroll
      for (int j = 0; j < 16; j++) {
        float c = p.ropeC32[t * 16 + j], s = p.ropeS32[t * 16 + j];
        float x1 = v[j], x2 = v[16 + j];
        v[j] = x1 * c - x2 * s; v[16 + j] = x2 * c + x1 * s;
      }
    }
#pragma unroll
    for (int k = 0; k < 32; k++) p.kpebuf[(size_t)kr * 32 + k] = v[k];
  } else if (u < 18) {
    int cb = (u - 10) * 64;
    for (int j = 0; j < 64; j++) p.gates16[(size_t)m * 1024 + cb + j] = (h16)siluf((float)ur[416 + cb + j]);
  } else if (u < 34) {
    const bool isq = u < 26; int hc = isq ? u - 18 : u - 26;
    const h16* src = ur + (isq ? 928 : 1440) + hc * 64;
    const float* gn = (isq ? p.diff_qn : p.diff_kn) + i * 64;
    float v[64]; float ss = 0;
#pragma unroll
    for (int k = 0; k < 64; k++) { v[k] = (float)src[k]; ss += v[k] * v[k]; }
    float r = 1.f / sqrtf(ss / 64 + EPSN);
#pragma unroll
    for (int k = 0; k < 64; k++) { v[k] = v[k] * r * gn[k]; if (!isq && !smp) p.o_dk[st_row(m, i) * 512 + hc * 64 + k] = v[k]; }
    if (smp) {
#pragma unroll
      for (int j = 0; j < 32; j++) {
        float c = p.ropeC64[t * 32 + j], s = p.ropeS64[t * 32 + j];
        float x1 = v[j], x2 = v[32 + j];
        v[j] = x1 * c - x2 * s; v[32 + j] = x2 * c + x1 * s;
      }
    }
    if (isq) {
      const float sc = LOG2E / 8.f; h16* dst = p.QB + ((size_t)m * 8 + hc) * 64;
#pragma unroll
      for (int k = 0; k < 64; k++) dst[k] = (h16)(v[k] * sc);
    } else {
      h16* dst = p.KB + ((size_t)hc * KM + kr) * 64;
#pragma unroll
      for (int k = 0; k < 64; k++) dst[k] = (h16)v[k];
    }
  } else if (u < 42) {
    int ch = u - 34; int h = ch >> 1, half = ch & 1;
    for (int j = 0; j < 64; j++) {
      float v = (float)ur[1952 + ch * 64 + j];
      if (!smp) p.o_dv[st_row(m, i) * 512 + ch * 64 + j] = v;
      p.VB[((size_t)h * 128 + half * 64 + j) * KM + kr] = (h16)v;
    }
  } else {
    int cb = (u - 42) * 64;
    for (int j = 0; j < 64; j++) p.gates16[(size_t)m * 1024 + 512 + cb + j] = (h16)siluf((float)ur[2464 + cb + j]);
  }
}
KERNEL nk_cache_even(Params p, int l, long n) {
  long g = GTID; if (g >= n) return;
  const int i = l >> 1;
  int u = g % 17; int pos = (g / 17) % PAST; int b = g / (17 * PAST);
  const int kr = MP + b * TKS + DS + pos;
  const size_t crow = ((size_t)(b * 2 + i) * PAST + pos);
  if (u == 0) {
    for (int k = 0; k < 128; k++) { float v = p.cache_mla_ckv[crow * 128 + k]; p.ckvbuf[(size_t)kr * 128 + k] = v; p.ckv16[(size_t)kr * 128 + k] = (h16)v; }
    for (int k = 0; k < 32; k++) { float v = p.cache_mla_kpe[crow * 32 + k]; p.kpebuf[(size_t)kr * 32 + k] = v; p.kpe16[(size_t)kr * 32 + k] = (h16)v; }
  } else if (u < 9) {
    int hc = u - 1;
    for (int k = 0; k < 64; k++) p.KB[((size_t)hc * KM + kr) * 64 + k] = (h16)p.cache_diff_k[crow * 512 + hc * 64 + k];
  } else {
    int ch = u - 9; int h = ch >> 1, half = ch & 1;
    for (int j = 0; j < 64; j++) p.VB[((size_t)h * 128 + half * 64 + j) * KM + kr] = (h16)p.cache_diff_v[crow * 512 + ch * 64 + j];
  }
}
KERNEL nk_kv(Params p, int l, long n) {
  long g = GTID; if (g >= n) return;
  const int i = l >> 1;
  int part = g & 1; int h = (g >> 1) & 7; int kr = g >> 4;
  const float* cr = p.ckvbuf + (size_t)kr * 128;
  const float* W = p.mla_wkvb + (size_t)i * 128 * 1024 + h * 128 + part * 64;
  float a[64];
#pragma unroll
  for (int j = 0; j < 64; j++) a[j] = 0;
  for (int k = 0; k < 128; k++) {
    float c = (float)(h16)cr[k];
#pragma unroll
    for (int j = 0; j < 64; j++) a[j] += c * W[(size_t)k * 1024 + j];
  }
  if (part == 0) {
    float ss = 0;
#pragma unroll
    for (int j = 0; j < 64; j++) ss += a[j] * a[j];
    float r = 1.f / sqrtf(ss / 64 + EPSN);
    h16* dst = p.KA + ((size_t)h * KM + kr) * 128;
#pragma unroll
    for (int j = 0; j < 64; j++) dst[j] = (h16)(a[j] * r * p.mla_kn_nope[i * 64 + j]);
    for (int j = 0; j < 32; j++) dst[64 + j] = (h16)p.kpebuf[(size_t)kr * 32 + j];
  } else {
#pragma unroll
    for (int j = 0; j < 64; j++) p.VA[((size_t)h * 64 + j) * KM + kr] = (h16)a[j];
  }
}
KERNEL nk_epi_odd(Params p, int l, long n) {
  long g = GTID; if (g >= n) return;
  const int i = l >> 1;
  int m = g / 52, u = g % 52;
  const h16* ur = p.ubuf + (size_t)m * 3328;
  const bool smp = m >= MP; const int t = tok_pos(m); const int kr = tok_keyrow(m);
  if (u < 16 || (u >= 32 && u < 42)) {
    int colbase, head; const float* gn; int kind;
    if (u < 8) { kind = 0; head = u; colbase = head * 64; gn = p.na_qn + i * 64; }
    else if (u < 16) { kind = 1; head = u - 8; colbase = 512 + head * 64; gn = p.na_kn + i * 64; }
    else if (u < 40) { kind = 2; head = u - 32; colbase = 2048 + head * 64; gn = p.gqa_qn + i * 64; }
    else { kind = 3; head = u - 40; colbase = 2560 + head * 64; gn = p.gqa_kn + i * 64; }
    float v[64]; float ss = 0;
#pragma unroll
    for (int k = 0; k < 64; k++) { v[k] = (float)ur[colbase + k]; ss += v[k] * v[k]; }
    float r = 1.f / sqrtf(ss / 64 + EPSN);
#pragma unroll
    for (int k = 0; k < 64; k++) v[k] = v[k] * r * gn[k];
    if (!smp) {
      if (kind == 1) { for (int k = 0; k < 64; k++) p.o_nk[st_row(m, i) * 512 + head * 64 + k] = v[k]; }
      if (kind == 3) { for (int k = 0; k < 64; k++) p.o_gk[st_row(m, i) * 128 + head * 64 + k] = v[k]; }
    }
    if (smp && kind >= 2) {
#pragma unroll
      for (int j = 0; j < 32; j++) {
        float c = p.ropeC64[t * 32 + j], s = p.ropeS64[t * 32 + j];
        float x1 = v[j], x2 = v[32 + j];
        v[j] = x1 * c - x2 * s; v[32 + j] = x2 * c + x1 * s;
      }
    }
    const float sc = LOG2E / 8.f;
    h16* dst;
    if (kind == 0) dst = p.QA + ((size_t)m * 8 + head) * 64;
    else if (kind == 1) dst = p.KA + ((size_t)head * KM + kr) * 64;
    else if (kind == 2) dst = p.QB + ((size_t)m * 8 + head) * 64;
    else dst = p.KB + ((size_t)head * KM + kr) * 64;
    const float mul = (kind == 0 || kind == 2) ? sc : 1.f;
#pragma unroll
    for (int k = 0; k < 64; k++) dst[k] = (h16)(v[k] * mul);
  } else if (u < 24) {
    int head = u - 16;
    for (int j = 0; j < 64; j++) {
      float v = (float)ur[1024 + head * 64 + j];
      if (!smp) p.o_nv[st_row(m, i) * 512 + head * 64 + j] = v;
      p.VA[((size_t)head * 64 + j) * KM + kr] = (h16)v;
    }
  } else if (u < 32) {
    int cb = (u - 24) * 64;
    for (int j = 0; j < 64; j++) p.gates16[(size_t)m * 1024 + cb + j] = (h16)siluf((float)ur[1536 + cb + j]);
  } else if (u < 44) {
    int head = u - 42;
    for (int j = 0; j < 64; j++) {
      float v = (float)ur[2688 + head * 64 + j];
      if (!smp) p.o_gv[st_row(m, i) * 128 + head * 64 + j] = v;
      p.VB[((size_t)head * 64 + j) * KM + kr] = (h16)v;
    }
  } else {
    int cb = (u - 44) * 64;
    for (int j = 0; j < 64; j++) p.gates16[(size_t)m * 1024 + 512 + cb + j] = (h16)siluf((float)ur[2816 + cb + j]);
  }
}
KERNEL nk_cache_odd(Params p, int l, long n) {
  long g = GTID; if (g >= n) return;
  const int i = l >> 1;
  int u = g % 20; int pos = (g / 20) % PAST; int b = g / (20 * PAST);
  const int kr = MP + b * TKS + DS + pos;
  const size_t crow = ((size_t)(b * 2 + i) * PAST + pos);
  if (u < 8) { for (int k = 0; k < 64; k++) p.KA[((size_t)u * KM + kr) * 64 + k] = (h16)p.cache_na_k[crow * 512 + u * 64 + k]; }
  else if (u < 16) { int h = u - 8; for (int j = 0; j < 64; j++) p.VA[((size_t)h * 64 + j) * KM + kr] = (h16)p.cache_na_v[crow * 512 + h * 64 + j]; }
  else if (u < 18) { int h = u - 16; for (int k = 0; k < 64; k++) p.KB[((size_t)h * KM + kr) * 64 + k] = (h16)p.cache_gqa_k[crow * 128 + h * 64 + k]; }
  else { int h = u - 18; for (int j = 0; j < 64; j++) p.VB[((size_t)h * 64 + j) * KM + kr] = (h16)p.cache_gqa_v[crow * 128 + h * 64 + j]; }
}
template <int DQK, int KP>
DEVFN void attn_dense_thread(const h16* q, const h16* K, const h16* VT, int kr0, int nk, float* out) {
  float qf[DQK];
#pragma unroll
  for (int j = 0; j < DQK; j++) qf[j] = (float)q[j];
  float o[64];
#pragma unroll
  for (int j = 0; j < 64; j++) o[j] = 0;
  float mx = -1e30f, sum = 0;
  for (int kk = 0; kk < nk; kk++) {
    const h16* kp = K + (size_t)(kr0 + kk) * KP;
    float s = 0;
#pragma unroll
    for (int j = 0; j < DQK; j++) s += qf[j] * (float)kp[j];
    float mn = fmaxf(mx, s); float al = exp2f_(mx - mn); float pe = exp2f_(s - mn);
    sum = sum * al + pe; mx = mn;
#pragma unroll
    for (int j = 0; j < 64; j++) o[j] = o[j] * al + pe * (float)VT[(size_t)j * KM + kr0 + kk];
  }
  float inv = 1.f / sum;
#pragma unroll
  for (int j = 0; j < 64; j++) out[j] = o[j] * inv;
}
KERNEL nk_attn_dense(Params p, int kind, int mlo, int mhi, long n) {
  long g = GTID; if (g >= n) return;
  const int nch = kind == 1 ? 2 : 1;
  int ch = g % nch; int head = (g / nch) % 8; int m = mlo + g / (nch * 8);
  if (m >= mhi) return;
  int kr0, nk;
  if (m < MP) { kr0 = (m / SEQ) * SEQ; nk = SEQ; } else { kr0 = MP + ((m - MP) / DS) * TKS; nk = TKS; }
  if (kind == 0) {
    attn_dense_thread<96, 128>(p.QA + ((size_t)m * 8 + head) * 96, p.KA + (size_t)head * KM * 128, p.VA + (size_t)head * 64 * KM, kr0, nk,
                          p.abuf + (size_t)m * 1536 + head * 64);
  } else if (kind == 1) {
    attn_dense_thread<64, 64>(p.QB + ((size_t)m * 8 + head) * 64, p.KB + (size_t)head * KM * 64,
                          p.VB + ((size_t)(head >> 1) * 128 + ch * 64) * KM, kr0, nk, p.abuf + (size_t)m * 1536 + 512 + head * 128 + ch * 64);
  } else if (kind == 2) {
    attn_dense_thread<64, 64>(p.QA + ((size_t)m * 8 + head) * 64, p.KA + (size_t)head * KM * 64, p.VA + (size_t)head * 64 * KM, kr0, nk,
                          p.abuf + (size_t)m * 1536 + head * 64);
  } else {
    attn_dense_thread<64, 64>(p.QB + ((size_t)m * 8 + head) * 64, p.KB + (size_t)(head >> 2) * KM * 64, p.VB + (size_t)(head >> 2) * 64 * KM,
                          kr0, nk, p.abuf + (size_t)m * 1536 + 512 + head * 64);
  }
}
KERNEL nk_attn_na(Params p, int l, long n) {
  long g = GTID; if (g >= n) return;
  const int i = l >> 1;
  int head = g & 7; int ms = g >> 3; int m = MP + ms;
  int b = ms / DS, t = ms % DS; int r = t / GW, c = t % GW;
  int rs = r - 4; rs = rs < 0 ? 0 : (rs > GROWS - 8 ? GROWS - 8 : rs);
  int cs = c - 8; cs = cs < 0 ? 0 : (cs > GW - 16 ? GW - 16 : cs);
  const h16* q = p.QA + ((size_t)m * 8 + head) * 64;
  const h16* K = p.KA + (size_t)head * KM * 64; const h16* VT = p.VA + (size_t)head * 64 * KM;
  const int kbase = MP + b * TKS;
  const float* rpb = p.na_rpb + ((size_t)i * 8 + head) * 15 * 31;
  float qf[64], o[64];
#pragma unroll
  for (int j = 0; j < 64; j++) { qf[j] = (float)q[j]; o[j] = 0; }
  float mx = -1e30f, sum = 0;
  for (int kk = 0; kk < 128 + PAST; kk++) {
    int kr; float bias = 0;
    if (kk < 128) { int ri = kk >> 4, cj = kk & 15; kr = kbase + (rs + ri) * GW + cs + cj; bias = rpb[(rs + ri - r + 7) * 31 + (cs + cj - c + 15)] * LOG2E; }
    else kr = kbase + DS + (kk - 128);
    const h16* kp = K + (size_t)kr * 64;
    float s = bias;
#pragma unroll
    for (int j = 0; j < 64; j++) s += qf[j] * (float)kp[j];
    float mn = fmaxf(mx, s); float al = exp2f_(mx - mn); float pe = exp2f_(s - mn);
    sum = sum * al + pe; mx = mn;
#pragma unroll
    for (int j = 0; j < 64; j++) o[j] = o[j] * al + pe * (float)VT[(size_t)j * KM + kr];
  }
  float inv = 1.f / sum; float* out = p.abuf + (size_t)m * 1536 + head * 64;
#pragma unroll
  for (int j = 0; j < 64; j++) out[j] = o[j] * inv;
}
KERNEL nk_fin(Params p, int l, long n) {
  long g = GTID; if (g >= n) return;
  const int i = l >> 1;
  if (l & 1) {
    int ch = g & 15; int m = g >> 4;
    for (int j = 0; j < 64; j++) {
      int col = ch * 64 + j;
      p.O16[(size_t)m * 1024 + col] = (h16)(p.abuf[(size_t)m * 1536 + col] * (float)p.gates16[(size_t)m * 1024 + col]);
    }
  } else {
    int u = g % 12; int m = g / 12;
    if (u < 8) {
      for (int j = 0; j < 64; j++) {
        int col = u * 64 + j;
        p.O16[(size_t)m * 1024 + col] = (h16)(p.abuf[(size_t)m * 1536 + col] * (float)p.gates16[(size_t)m * 1024 + col]);
      }
    } else {
      int h = u - 8; float lam = p.lamv[i]; float lam_init = 0.8f - 0.6f * expf(-0.3f * l);
      const float* a1 = p.abuf + (size_t)m * 1536 + 512 + (h * 2) * 128; const float* a2 = a1 + 128;
      float ss = 0;
      for (int j = 0; j < 128; j++) { float d = a1[j] - lam * a2[j]; ss += d * d; }
      float r = 1.f / sqrtf(ss / 128 + EPSN);
      for (int j = 0; j < 128; j++) {
        float d = (a1[j] - lam * a2[j]) * r * p.diff_subln[i * 128 + j] * (1.f - lam_init);
        int col = 512 + h * 128 + j;
        p.O16[(size_t)m * 1024 + col] = (h16)(d * (float)p.gates16[(size_t)m * 1024 + col]);
      }
    }
  }
}
KERNEL nk_outproj(Params p, int l, long n) {
  long g = GTID; if (g >= n) return;
  int m = g >> 10, col = g & 1023;
  const float* W = ((l & 1) ? p.w_out_odd : p.w_out_even) + (size_t)(l >> 1) * 1024 * 1024 + col;
  const h16* o = p.O16 + (size_t)m * 1024;
  float acc = 0;
  for (int k = 0; k < 1024; k++) acc += (float)o[k] * W[(size_t)k * 1024];
  float gate = p.modv[((size_t)l * NCV + tok_cv(m)) * 3072 + 2048 + col];
  p.Y[(size_t)m * 1024 + col] = xrow(p, l, m)[col] + gate * acc;
}


#ifndef CPU_EMU
typedef _Float16 h16x8 __attribute__((ext_vector_type(8)));
typedef _Float16 h16x4 __attribute__((ext_vector_type(4)));
typedef float f32x16 __attribute__((ext_vector_type(16)));
typedef float f32x4 __attribute__((ext_vector_type(4)));
DEVFN int tid_op() { int t = threadIdx.x; asm volatile("" : "+v"(t)); return t; }

DEVFN int even_col(int np) { return np < 416 ? np : (np < 512 ? -1 : np - 96); }

__global__ void __launch_bounds__(256) fk_convw(const float* src, h16* dst, int K, int Nsrc, int Ndst, int mode, const float* kscale) {
  __shared__ float t[64][65];
  const int nb = blockIdx.x * 64, kb = blockIdx.y * 64, tid = threadIdx.x;
  {
    int j = tid & 63; int np = nb + j; int col;
    if (mode == 0) col = np; else if (mode == 1) col = even_col(np); else if (mode == 3) { int hh = (np & 511) >> 6; col = hh * 128 + (np >> 9) * 64 + (np & 63); } else { int h = np >> 7, jj = np & 127; col = jj < 96 ? h * 96 + jj : -1; }
    for (int i = 0; i < 16; i++) {
      int kk = (tid >> 6) + 4 * i;
      float v = 0.f;
      if (col >= 0 && np < Ndst) { v = src[(size_t)(kb + kk) * Nsrc + col]; if (kscale) v *= kscale[kb + kk]; }
      t[kk][j] = v;
    }
  }
  __syncthreads();
  {
    int kk = tid & 63;
    for (int i = 0; i < 16; i++) { int j = (tid >> 6) + 4 * i; if (nb + j < Ndst) dst[(size_t)(nb + j) * K + kb + kk] = (h16)t[kk][j]; }
  }
}
__global__ void __launch_bounds__(256) fk_prep_x(Params p, int l) {
  const int lane = threadIdx.x & 63; const int m = blockIdx.x * 4 + (threadIdx.x >> 6);
  const float* x = xrow(p, l, m); const float* md = p.modv + ((size_t)l * NCV + tok_cv(m)) * 3072 + 1024; const float* nw = p.norm_w + l * D;
  float ss = 0;
  for (int i = 0; i < 4; i++) {
    int k = (i * 64 + lane) * 4;
    f32x4 v = *(const f32x4*)(x + k); f32x4 s = *(const f32x4*)(md + k); f32x4 w = *(const f32x4*)(nw + k);
    h16x4 o;
    for (int e = 0; e < 4; e++) { ss += v[e] * v[e]; o[e] = (h16)(v[e] * w[e] * (1.f + s[e])); }
    *(h16x4*)(p.xs16 + (size_t)m * D + k) = o;
  }
  for (int o = 32; o; o >>= 1) ss += __shfl_xor(ss, o);
  if (lane == 0) p.rowss_l[(size_t)l * M + m] = ss;
}
__global__ void __launch_bounds__(256) fk_bias(Params p, int l) {
  const int lane = threadIdx.x & 63; const int np = blockIdx.x * 4 + (threadIdx.x >> 6);
  const int NP = (l & 1) ? NPO : NPE; if (np >= NP) return;
  const h16* w = (p.win16 + (size_t)l * NPO * D) + (size_t)np * D;
  float a[NCV];
  for (int c = 0; c < NCV; c++) a[c] = 0;
  for (int i = 0; i < 2; i++) {
    int k = (i * 64 + lane) * 8; h16x8 wv = *(const h16x8*)(w + k);
    for (int c = 0; c < NCV; c++) { const float* sh = p.modv + ((size_t)l * NCV + c) * 3072 + k; for (int e = 0; e < 8; e++) a[c] += sh[e] * (float)wv[e]; }
  }
  for (int c = 0; c < NCV; c++) { float v = a[c]; for (int o = 32; o; o >>= 1) v += __shfl_xor(v, o); if (lane == 0) p.biasv[((size_t)l * NCV + c) * NPO + np] = v; }
}

constexpr int G_STAGE = 49152, G_NSTAGE = 3, G_LDS = G_STAGE * G_NSTAGE;
DEVFN int img_off(int r, int c) { return r * 128 + ((c ^ ((r >> 1) & 7)) << 4); }
template <int R>
DEVFN void stage_rows(const h16* g, int ld, char* lds, int tid) {
#pragma unroll
  for (int i = 0; i < R / 64; i++) {
    int r = (tid >> 3) + 64 * i; int c = (tid & 7) ^ ((r >> 1) & 7);
    __builtin_amdgcn_global_load_lds((const unsigned*)(g + (size_t)r * ld + c * 8), (unsigned*)(lds + i * 8192 + tid * 16), 16, 0, 0);
  }
}
#define WAITV(n) asm volatile("s_waitcnt vmcnt(" #n ")" ::: "memory")
#define RAWBAR() do { asm volatile("s_waitcnt lgkmcnt(0)" ::: "memory"); __builtin_amdgcn_s_barrier(); } while (0)
template <bool TR>
DEVFN void gemm_tile(const h16* A, int lda, const h16* Bt, int ldb, int K, int m0, int n0, char* lds, f32x16 (&acc)[2][2]) {
  const int TIDX = tid_op();
  const int tid = TIDX, lane = tid & 63, w = tid >> 6, wm = w >> 1, wn = w & 1;
  const int nt = K / 64;
  const h16* Ag = A + (size_t)m0 * lda; const h16* Bg = Bt + (size_t)n0 * ldb;
#pragma unroll
  for (int a = 0; a < 2; a++)
#pragma unroll
    for (int b = 0; b < 2; b++)
#pragma unroll
      for (int r = 0; r < 16; r++) acc[a][b][r] = 0.f;
  stage_rows<256>(Ag, lda, lds, tid); stage_rows<128>(Bg, ldb, lds + 32768, tid);
  if (nt > 1) { stage_rows<256>(Ag + 64, lda, lds + G_STAGE, tid); stage_rows<128>(Bg + 64, ldb, lds + G_STAGE + 32768, tid); }
  const int ra = wm * 64 + (lane & 31), rb = wn * 64 + (lane & 31), ch = lane >> 5;
  for (int t = 0; t < nt; t++) {
    if (t + 1 < nt) WAITV(6); else WAITV(0);
    RAWBAR();
    if (t + 2 < nt) { char* s = lds + ((t + 2) % 3) * G_STAGE; stage_rows<256>(Ag + (t + 2) * 64, lda, s, tid); stage_rows<128>(Bg + (t + 2) * 64, ldb, s + 32768, tid); }
    const char* sa = lds + (t % 3) * G_STAGE; const char* sb = sa + 32768;
#pragma unroll
    for (int ks = 0; ks < 4; ks++) {
      h16x8 af[2], bf[2];
#pragma unroll
      for (int mb = 0; mb < 2; mb++) af[mb] = *(const h16x8*)(sa + img_off(ra + mb * 32, 2 * ks + ch));
#pragma unroll
      for (int nb = 0; nb < 2; nb++) bf[nb] = *(const h16x8*)(sb + img_off(rb + nb * 32, 2 * ks + ch));
#pragma unroll
      for (int mb = 0; mb < 2; mb++)
#pragma unroll
        for (int nb = 0; nb < 2; nb++) {
          if (TR) acc[mb][nb] = __builtin_amdgcn_mfma_f32_32x32x16_f16(bf[nb], af[mb], acc[mb][nb], 0, 0, 0);
          else acc[mb][nb] = __builtin_amdgcn_mfma_f32_32x32x16_f16(af[mb], bf[nb], acc[mb][nb], 0, 0, 0);
        }
    }
  }
  RAWBAR();
}

DEVFN float wsum32(float v) { return v + __shfl_xor(v, 32); }

template <class RsF, class DstF>
DEVFN void epi_head64(const Params& p, const f32x16 (&acc)[2][2], int mbase, RsF rsf, const float* bias, const float* gain, bool rope, float oscale,
                      float* state, int spitch, int scol, int ilayer, DstF dstf) {
  const int TIDX = tid_op();
  const int lane = TIDX & 63, h = lane >> 5;
#pragma unroll
  for (int mb = 0; mb < 2; mb++) {
    const int m = mbase + mb * 32 + (lane & 31);
    const float rs = rsf(m);
    float v[2][16]; float ss = 0;
#pragma unroll
    for (int nb = 0; nb < 2; nb++)
#pragma unroll
      for (int q = 0; q < 4; q++) {
        const int j = nb * 32 + 8 * q + 4 * h;
        f32x4 b = bias ? *(const f32x4*)(bias + j) : (f32x4){0.f, 0.f, 0.f, 0.f};
#pragma unroll
        for (int e = 0; e < 4; e++) { float x = acc[mb][nb][q * 4 + e] * rs + b[e]; v[nb][q * 4 + e] = x; ss += x * x; }
      }
    ss = wsum32(ss);
    const float rr = 1.f / sqrtf(ss * (1.f / 64.f) + EPSN);
#pragma unroll
    for (int nb = 0; nb < 2; nb++)
#pragma unroll
      for (int q = 0; q < 4; q++) {
        const int j = nb * 32 + 8 * q + 4 * h;
        f32x4 g = *(const f32x4*)(gain + j);
#pragma unroll
        for (int e = 0; e < 4; e++) v[nb][q * 4 + e] *= rr * g[e];
      }
    const bool smp = m >= MP;
    if (state && !smp) {
      float* sp = state + st_row(m, ilayer) * spitch + scol;
#pragma unroll
      for (int nb = 0; nb < 2; nb++)
#pragma unroll
        for (int q = 0; q < 4; q++) { f32x4 o = {v[nb][q * 4], v[nb][q * 4 + 1], v[nb][q * 4 + 2], v[nb][q * 4 + 3]}; *(f32x4*)(sp + nb * 32 + 8 * q + 4 * h) = o; }
    }
    if (rope && smp) {
      const int t = tok_pos(m);
#pragma unroll
      for (int q = 0; q < 4; q++) {
        f32x4 c = *(const f32x4*)(p.ropeC64 + t * 32 + 8 * q + 4 * h), s = *(const f32x4*)(p.ropeS64 + t * 32 + 8 * q + 4 * h);
#pragma unroll
        for (int e = 0; e < 4; e++) { float x1 = v[0][q * 4 + e], x2 = v[1][q * 4 + e]; v[0][q * 4 + e] = x1 * c[e] - x2 * s[e]; v[1][q * 4 + e] = x2 * c[e] + x1 * s[e]; }
      }
    }
    h16* dst = dstf(m);
#pragma unroll
    for (int nb = 0; nb < 2; nb++)
#pragma unroll
      for (int q = 0; q < 4; q++) {
        h16x4 o;
#pragma unroll
        for (int e = 0; e < 4; e++) o[e] = (h16)(v[nb][q * 4 + e] * oscale);
        *(h16x4*)(dst + nb * 32 + 8 * q + 4 * h) = o;
      }
  }
}
template <class RsF, class DstF>
DEVFN void epi_head32(const Params& p, const f32x16 (&acc)[2][2], int mbase, RsF rsf, const float* bias, const float* gain, bool rope, float oscale,
                      float* state, int ilayer, DstF dstf, float* dual = nullptr) {
  const int TIDX = tid_op();
  const int lane = TIDX & 63, h = lane >> 5;
#pragma unroll
  for (int mb = 0; mb < 2; mb++) {
    const int m = mbase + mb * 32 + (lane & 31);
    const float rs = rsf(m);
    float v[16]; float ss = 0;
#pragma unroll
    for (int q = 0; q < 4; q++) {
      const int j = 8 * q + 4 * h;
      f32x4 b = bias ? *(const f32x4*)(bias + j) : (f32x4){0.f, 0.f, 0.f, 0.f};
#pragma unroll
      for (int e = 0; e < 4; e++) { float x = acc[mb][0][q * 4 + e] * rs + b[e]; v[q * 4 + e] = x; ss += x * x; }
    }
    ss = wsum32(ss);
    const float rr = 1.f / sqrtf(ss * (1.f / 32.f) + EPSN);
#pragma unroll
    for (int q = 0; q < 4; q++) {
      f32x4 g = *(const f32x4*)(gain + 8 * q + 4 * h);
#pragma unroll
      for (int e = 0; e < 4; e++) v[q * 4 + e] *= rr * g[e];
    }
    const bool smp = m >= MP;
    if (state && !smp) {
      float* sp = state + st_row(m, ilayer) * 32;
#pragma unroll
      for (int q = 0; q < 4; q++) { f32x4 o = {v[q * 4], v[q * 4 + 1], v[q * 4 + 2], v[q * 4 + 3]}; *(f32x4*)(sp + 8 * q + 4 * h) = o; }
    }
    if (rope && smp) {
      const int t = tok_pos(m);
#pragma unroll
      for (int q = 0; q < 2; q++) {
        f32x4 c = *(const f32x4*)(p.ropeC32 + t * 16 + 8 * q + 4 * h), s = *(const f32x4*)(p.ropeS32 + t * 16 + 8 * q + 4 * h);
#pragma unroll
        for (int e = 0; e < 4; e++) { float x1 = v[q * 4 + e], x2 = v[(q + 2) * 4 + e]; v[q * 4 + e] = x1 * c[e] - x2 * s[e]; v[(q + 2) * 4 + e] = x2 * c[e] + x1 * s[e]; }
      }
    }
    h16* dst = dstf(m);
#pragma unroll
    for (int q = 0; q < 4; q++) {
      h16x4 o;
#pragma unroll
      for (int e = 0; e < 4; e++) o[e] = (h16)(v[q * 4 + e] * oscale);
      *(h16x4*)(dst + 8 * q + 4 * h) = o;
      if (dual) { for (int e = 0; e < 4; e++) dual[(size_t)tok_keyrow(m) * 32 + 8 * q + 4 * h + e] = v[q * 4 + e]; }
    }
  }
}
template <class RsF, class KrF>
DEVFN void epi_vt(const f32x16 (&acc)[2][2], int mbase, RsF rsf, const float* bias  , float* state, int spitch, int scol, int ilayer,
                  h16* vt  , KrF krf) {
  const int TIDX = tid_op();
  const int lane = TIDX & 63, h = lane >> 5, e0 = lane & 31;
#pragma unroll
  for (int mb = 0; mb < 2; mb++)
#pragma unroll
    for (int q = 0; q < 4; q++) {
      const int mq = mbase + mb * 32 + 8 * q + 4 * h;
      float rs[4];
#pragma unroll
      for (int e = 0; e < 4; e++) rs[e] = rsf(mq + e);
      const int kr = krf(mq);
#pragma unroll
      for (int nb = 0; nb < 2; nb++) {
        const int col = nb * 32 + e0; const float b = bias ? bias[col] : 0.f;
        h16x4 o;
#pragma unroll
        for (int e = 0; e < 4; e++) {
          float x = acc[mb][nb][q * 4 + e] * rs[e] + b; o[e] = (h16)x;
          if (state && mq < MP) state[st_row(mq + e, ilayer) * spitch + scol + col] = x;
        }
        *(h16x4*)(vt + (size_t)col * KM + kr) = o;
      }
    }
}

DEVFN void inproj_tile(const Params& p, int l, int mt, int ntile, char* lds) {
  const int TIDX = tid_op();
  const int i = l >> 1; const bool odd = l & 1;
  const int m0 = mt * 256, n0 = ntile * 128;
  const int lane = TIDX & 63, w = TIDX >> 6, wm = w >> 1, wn = w & 1, h = lane >> 5;
  const bool isV = odd ? ((ntile >= 8 && ntile < 12) || ntile == 21) : (ntile >= 16 && ntile < 20);
  f32x16 acc[2][2];
  if (isV) gemm_tile<false>(p.xs16, D, (p.win16 + (size_t)l * NPO * D), D, D, m0, n0, lds, acc);
  else gemm_tile<true>(p.xs16, D, (p.win16 + (size_t)l * NPO * D), D, D, m0, n0, lds, acc);
  const int mbase = m0 + wm * 64, npw = n0 + wn * 64;
  const int cv = tok_cv(m0);
  const float* bias = p.biasv + ((size_t)l * NCV + cv) * NPO + npw;
  const float* rowss = p.rowss_l + (size_t)l * M;
  auto rsf = [&](int m) { return 1.f / sqrtf(rowss[m] * (1.f / D) + EPSN); };
  auto krf = [&](int m) { return tok_keyrow(m); };
  const float QS = LOG2E / 8.f;
  int gcol = -1;
  if (!odd) { if (ntile >= 4 && ntile < 8) gcol = npw - 512; else if (ntile >= 20) gcol = npw - 2560 + 512; }
  else { if (ntile >= 12 && ntile < 16) gcol = npw - 1536; else if (ntile >= 22) gcol = npw - 2816 + 512; }
  if (gcol >= 0) {
#pragma unroll
    for (int mb = 0; mb < 2; mb++) {
      const int m = mbase + mb * 32 + (lane & 31); const float rs = rsf(m);
#pragma unroll
      for (int nb = 0; nb < 2; nb++)
#pragma unroll
        for (int q = 0; q < 4; q++) {
          const int j = nb * 32 + 8 * q + 4 * h; f32x4 b = *(const f32x4*)(bias + j); h16x4 o;
#pragma unroll
          for (int e = 0; e < 4; e++) o[e] = (h16)siluf(acc[mb][nb][q * 4 + e] * rs + b[e]);
          *(h16x4*)(p.gates16 + (size_t)m * 1024 + gcol + j) = o;
        }
    }
    return;
  }
  if (!odd) {
    if (ntile < 2) {
#pragma unroll
      for (int mb = 0; mb < 2; mb++) {
        const int m = mbase + mb * 32 + (lane & 31); const float rs = rsf(m); float ss = 0;
#pragma unroll
        for (int nb = 0; nb < 2; nb++)
#pragma unroll
          for (int q = 0; q < 4; q++) {
            const int j = nb * 32 + 8 * q + 4 * h; f32x4 b = *(const f32x4*)(bias + j); h16x4 o;
#pragma unroll
            for (int e = 0; e < 4; e++) { float x = acc[mb][nb][q * 4 + e] * rs + b[e]; o[e] = (h16)x; float xr = (float)o[e]; ss += xr * xr; }
            *(h16x4*)(p.qa16 + (size_t)m * 256 + npw + j) = o;
          }
        ss = wsum32(ss);
        if (h == 0) atomicAdd(p.rowss_qa + (size_t)i * M + m, ss);
      }
    } else if (ntile == 2) {
      float* red = (float*)lds;
      float v[2][2][16];
#pragma unroll
      for (int mb = 0; mb < 2; mb++) {
        const int m = mbase + mb * 32 + (lane & 31); const float rs = rsf(m); float ss = 0;
#pragma unroll
        for (int nb = 0; nb < 2; nb++)
#pragma unroll
          for (int q = 0; q < 4; q++) {
            const int j = nb * 32 + 8 * q + 4 * h; f32x4 b = *(const f32x4*)(bias + j);
#pragma unroll
            for (int e = 0; e < 4; e++) { float x = acc[mb][nb][q * 4 + e] * rs + b[e]; v[mb][nb][q * 4 + e] = x; ss += x * x; }
          }
        ss = wsum32(ss);
        if (h == 0) red[wn * 256 + wm * 64 + mb * 32 + lane] = ss;
      }
      __syncthreads();
#pragma unroll
      for (int mb = 0; mb < 2; mb++) {
        const int rl = wm * 64 + mb * 32 + (lane & 31); const int m = m0 + rl;
        const float rr = 1.f / sqrtf((red[rl] + red[256 + rl]) * (1.f / 128.f) + EPSN);
        const int kr = tok_keyrow(m);
#pragma unroll
        for (int nb = 0; nb < 2; nb++)
#pragma unroll
          for (int q = 0; q < 4; q++) {
            const int j = wn * 64 + nb * 32 + 8 * q + 4 * h; f32x4 g = *(const f32x4*)(p.mla_kva_norm + i * 128 + j); f32x4 o; h16x4 oh;
#pragma unroll
            for (int e = 0; e < 4; e++) { o[e] = v[mb][nb][q * 4 + e] * rr * g[e]; oh[e] = (h16)o[e]; }
            if (m < MP) *(f32x4*)(p.o_ckv + st_row(m, i) * 128 + j) = o;
            *(h16x4*)(p.ckv16 + (size_t)kr * 128 + j) = oh;
#if DUAL_WRITE
            *(f32x4*)(p.ckvbuf + (size_t)kr * 128 + j) = o;
#endif
          }
      }
      __syncthreads();
    } else if (ntile == 3) {
      if (wn == 0) {
        epi_head32(p, acc, mbase, rsf, bias, p.mla_kn_rope + i * 32, true, 1.f, p.o_kpe, i, [&](int m) { return p.kpe16 + (size_t)tok_keyrow(m) * 32; },
                   DUAL_WRITE ? p.kpebuf : nullptr);
      }
    } else if (ntile < 12) {
      const int hc = (ntile - 8) * 2 + wn;
      epi_head64(p, acc, mbase, rsf, bias, p.diff_qn + i * 64, true, QS, nullptr, 0, 0, i, [&](int m) { return p.QB + ((size_t)m * 8 + hc) * 64; });
    } else if (ntile < 16) {
      const int hc = (ntile - 12) * 2 + wn;
      epi_head64(p, acc, mbase, rsf, bias, p.diff_kn + i * 64, true, 1.f, p.o_dk, 512, hc * 64, i, [&](int m) { return p.KB + ((size_t)hc * KM + tok_keyrow(m)) * 64; });
    } else {
      const int vcol = (ntile - 16) * 128 + wn * 64;
      epi_vt(acc, mbase, rsf, bias, p.o_dv, 512, vcol, i, p.VB + (size_t)vcol * KM, krf);
    }
  } else {
    if (ntile < 4) {
      const int hd = ntile * 2 + wn;
      epi_head64(p, acc, mbase, rsf, bias, p.na_qn + i * 64, false, QS, nullptr, 0, 0, i, [&](int m) { return p.QA + ((size_t)m * 8 + hd) * 64; });
    } else if (ntile < 8) {
      const int hd = (ntile - 4) * 2 + wn;
      epi_head64(p, acc, mbase, rsf, bias, p.na_kn + i * 64, false, 1.f, p.o_nk, 512, hd * 64, i, [&](int m) { return p.KA + ((size_t)hd * KM + tok_keyrow(m)) * 64; });
    } else if (ntile < 12) {
      const int vcol = (ntile - 8) * 128 + wn * 64;
      epi_vt(acc, mbase, rsf, bias, p.o_nv, 512, vcol, i, p.VA + (size_t)vcol * KM, krf);
    } else if (ntile < 20) {
      const int hd = (ntile - 16) * 2 + wn;
      epi_head64(p, acc, mbase, rsf, bias, p.gqa_qn + i * 64, true, QS, nullptr, 0, 0, i, [&](int m) { return p.QB + ((size_t)m * 8 + hd) * 64; });
    } else if (ntile == 20) {
      epi_head64(p, acc, mbase, rsf, bias, p.gqa_kn + i * 64, true, 1.f, p.o_gk, 128, wn * 64, i, [&](int m) { return p.KB + ((size_t)wn * KM + tok_keyrow(m)) * 64; });
    } else {
      const int vcol = wn * 64;
      epi_vt(acc, mbase, rsf, bias, p.o_gv, 128, vcol, i, p.VB + (size_t)vcol * KM, krf);
    }
  }
}
__global__ void __launch_bounds__(512) fk_inproj(Params p, int l) {
  __shared__ __attribute__((aligned(16))) char lds[G_LDS];
  const int NP = (l & 1) ? NPO : NPE; const int ntn = NP / 128;
  inproj_tile(p, l, blockIdx.x / ntn, blockIdx.x % ntn, lds);
}
DEVFN void qgemm_tile(const Params& p, int l, int mt, int head, char* lds) {
  const int TIDX = tid_op();
  const int i = l >> 1; const int m0 = mt * 256;
  const int w = TIDX >> 6, wm = w >> 1, wn = w & 1;
  f32x16 acc[2][2];
  gemm_tile<true>(p.qa16, 256, (p.wqb16 + (size_t)i * 1024 * 256), 256, 256, m0, head * 128, lds, acc);
  const float* rq = p.rowss_qa + (size_t)i * M;
  auto rsf = [&](int m) { return 1.f / sqrtf(rq[m] * (1.f / 256.f) + EPSN); };
  const float sc = LOG2E / sqrtf(96.f);
  if (wn == 0) epi_head64(p, acc, m0 + wm * 64, rsf, nullptr, p.mla_qn_nope + i * 64, false, sc, nullptr, 0, 0, i, [&](int m) { return p.QA + ((size_t)m * 8 + head) * 96; });
  else epi_head32(p, acc, m0 + wm * 64, rsf, nullptr, p.mla_qn_rope + i * 32, true, sc, nullptr, i, [&](int m) { return p.QA + ((size_t)m * 8 + head) * 96 + 64; });
}
DEVFN void kvgemm_tile(const Params& p, int l, int mt, int ntile, char* lds) {
  const int TIDX = tid_op();
  const int i = l >> 1; const int m0 = mt * 256;
  const int lane = TIDX & 63, w = TIDX >> 6, wm = w >> 1, wn = w & 1, h = lane >> 5;
  f32x16 acc[2][2];
  auto one = [](int) { return 1.f; };
  if (ntile < 4) {
    gemm_tile<true>(p.ckv16, 128, (p.wkvb16 + (size_t)i * 1024 * 128), 128, 128, m0, ntile * 128, lds, acc);
    const int head = ntile * 2 + wn;
    epi_head64(p, acc, m0 + wm * 64, one, nullptr, p.mla_kn_nope + i * 64, false, 1.f, nullptr, 0, 0, i, [&](int m) { return p.KA + ((size_t)head * KM + m) * 128; });
#pragma unroll
    for (int mb = 0; mb < 2; mb++) {
      const int kr = m0 + wm * 64 + mb * 32 + (lane & 31);
      const h16x8* s = (const h16x8*)(p.kpe16 + (size_t)kr * 32 + h * 16);
      h16x8* d = (h16x8*)(p.KA + ((size_t)head * KM + kr) * 128 + 64 + h * 16);
      d[0] = s[0]; d[1] = s[1];
    }
  } else {
    gemm_tile<false>(p.ckv16, 128, (p.wkvb16 + (size_t)i * 1024 * 128), 128, 128, m0, ntile * 128, lds, acc);
    const int head = (ntile - 4) * 2 + wn;
    epi_vt(acc, m0 + wm * 64, one, nullptr, nullptr, 0, 0, i, p.VA + (size_t)head * 64 * KM, [](int m) { return m; });
  }
}
DEVFN void outproj_tile(const Params& p, int l, int mt, int ntile, char* lds) {
  const int TIDX = tid_op();
  const int m0 = mt * 256, n0 = ntile * 128;
  const int lane = TIDX & 63, w = TIDX >> 6, wm = w >> 1, wn = w & 1, h = lane >> 5;
  f32x16 acc[2][2];
  gemm_tile<true>(p.O16, D, (p.wout16 + (size_t)l * D * D), D, D, m0, n0, lds, acc);
  const int cv = tok_cv(m0); const int nw0 = n0 + wn * 64;
  const float* gate = p.modv + ((size_t)l * NCV + cv) * 3072 + 2048 + nw0;
  const float* nsc = p.modv + ((size_t)(l + 1) * NCV + cv) * 3072 + 1024 + nw0;
  const float* nnw = p.norm_w + (l + 1) * D + nw0;
#pragma unroll
  for (int mb = 0; mb < 2; mb++) {
    const int m = m0 + wm * 64 + mb * 32 + (lane & 31);
    const float* xr = xrow(p, l, m) + nw0; float* yr = p.Y + (size_t)m * D + nw0;
    float ss = 0;
#pragma unroll
    for (int nb = 0; nb < 2; nb++)
#pragma unroll
      for (int q = 0; q < 4; q++) {
        const int j = nb * 32 + 8 * q + 4 * h;
        f32x4 x = *(const f32x4*)(xr + j), g = *(const f32x4*)(gate + j), o;
#pragma unroll
        for (int e = 0; e < 4; e++) { o[e] = x[e] + g[e] * acc[mb][nb][q * 4 + e]; ss += o[e] * o[e]; }
        *(f32x4*)(yr + j) = o;
        if (l < 3) {
          f32x4 s = *(const f32x4*)(nsc + j), nw = *(const f32x4*)(nnw + j); h16x4 oh;
#pragma unroll
          for (int e = 0; e < 4; e++) oh[e] = (h16)(o[e] * nw[e] * (1.f + s[e]));
          *(h16x4*)(p.xs16 + (size_t)m * D + nw0 + j) = oh;
        }
      }
    if (l < 3) { ss = wsum32(ss); if (h == 0) atomicAdd(p.rowss_l + (size_t)(l + 1) * M + m, ss); }
  }
}
__global__ void __launch_bounds__(512) fk_a2(Params p, int l) {
  __shared__ __attribute__((aligned(16))) char lds[G_LDS];
  const int nq = (M / 256) * 8;
  if ((int)blockIdx.x < nq) qgemm_tile(p, l, blockIdx.x / 8, blockIdx.x % 8, lds);
  else { int b = blockIdx.x - nq; kvgemm_tile(p, l, b / 8, b % 8, lds); }
}
__global__ void __launch_bounds__(512) fk_outproj(Params p, int l) {
  __shared__ __attribute__((aligned(16))) char lds[G_LDS];
  outproj_tile(p, l, blockIdx.x / 8, blockIdx.x % 8, lds);
}
struct AttnItem {
  const h16 *k0, *k1; int kld;
  const h16 *v0, *v1;
  int kr0, nt0, kr1, nt1;
};
constexpr int A_RING = 3 * 32768;

template <int DQK, int NKI, int NVI, int NDB, bool NAMASK>
DEVFN void attn_core(const AttnItem& it, const h16* qptr, int qpitch, int ksel, int ta, int tb, const float* rpbl, int na_dr0  , int na_c,
                     char* lds, f32x16 (&o)[NDB], float& lsum_out) {
  const int TIDX = tid_op();
  constexpr int NIMG = NKI + NVI; constexpr int STG = NIMG * 8192;
  const int tid = TIDX, lane = tid & 63, h = lane >> 5;
  h16x8 qf[DQK / 16];
#pragma unroll
  for (int ks = 0; ks < DQK / 16; ks++) qf[ks] = *(const h16x8*)(qptr + (size_t)(lane & 31) * qpitch + ks * 16 + 8 * h);
#pragma unroll
  for (int db = 0; db < NDB; db++)
#pragma unroll
    for (int r = 0; r < 16; r++) o[db][r] = 0.f;
  float m_run = -1e30f, lsum = 0.f;
  const int nt = it.nt0 + it.nt1;
  auto stage = [&](int t) {
    char* s = lds + (t % 3) * STG; const int kr = t < it.nt0 ? it.kr0 + 64 * t : it.kr1 + 64 * (t - it.nt0);
    stage_rows<64>(it.k0 + (size_t)kr * it.kld, it.kld, s, tid);
    if (NKI == 2) stage_rows<64>(it.k1 + (size_t)kr * it.kld, it.kld, s + 8192, tid);
    stage_rows<64>(it.v0 + kr, KM, s + NKI * 8192, tid);
    if (NVI == 2) stage_rows<64>(it.v1 + kr, KM, s + NKI * 8192 + 8192, tid);
  };
  stage(0); if (nt > 1) stage(1);
  const int l5 = lane & 31;
  const int prow = (l5 & 19) | ((l5 & 4) << 1) | ((l5 & 8) >> 1);
  int na_cs = na_c - 8; na_cs = na_cs < 0 ? 0 : (na_cs > GW - 16 ? GW - 16 : na_cs);
  for (int t = 0; t < nt; t++) {
    if (t + 1 < nt) { if (NIMG == 2) WAITV(2); else if (NIMG == 3) WAITV(3); else WAITV(4); } else WAITV(0);
    RAWBAR();
    if (t + 2 < nt) stage(t + 2);
    const bool active = (t >= it.nt0) || (t >= ta && t < tb);
    if (active) {
      const char* s = lds + (t % 3) * STG;
      f32x16 st[2];
#pragma unroll
      for (int kb = 0; kb < 2; kb++) {
#pragma unroll
        for (int r = 0; r < 16; r++) st[kb][r] = 0.f;
#pragma unroll
        for (int ks = 0; ks < DQK / 16; ks++) {
          const int img = (DQK == 96) ? (ks >> 2) : ksel;
          h16x8 kf = *(const h16x8*)(s + img * 8192 + img_off(32 * kb + prow, 2 * (ks & 3) + h));
          st[kb] = __builtin_amdgcn_mfma_f32_32x32x16_f16(kf, qf[ks], st[kb], 0, 0, 0);
        }
      }
      if (NAMASK && t < it.nt0) {
        const int drow = (na_dr0 + t) * 31 + 15 - na_c;
#pragma unroll
        for (int kb = 0; kb < 2; kb++)
#pragma unroll
          for (int r = 0; r < 16; r++) {
            const int kcol = 32 * kb + (r & 7) + 8 * h + 16 * (r >> 3);
            const bool valid = (unsigned)(kcol - na_cs) < 16u;
            const float bv = rpbl[valid ? drow + kcol : 0];
            st[kb][r] = valid ? st[kb][r] + bv : -1e30f;
          }
      }
      float mx = st[0][0];
#pragma unroll
      for (int r = 1; r < 16; r++) mx = fmaxf(mx, st[0][r]);
#pragma unroll
      for (int r = 0; r < 16; r++) mx = fmaxf(mx, st[1][r]);
      mx = fmaxf(mx, __shfl_xor(mx, 32));
      const float mn = fmaxf(m_run, mx); const float al = __builtin_amdgcn_exp2f(m_run - mn); m_run = mn;
      float sum = 0.f;
#pragma unroll
      for (int kb = 0; kb < 2; kb++)
#pragma unroll
        for (int r = 0; r < 16; r++) { float pe = __builtin_amdgcn_exp2f(st[kb][r] - mn); st[kb][r] = pe; sum += pe; }
      lsum = lsum * al + sum;
#pragma unroll
      for (int db = 0; db < NDB; db++)
#pragma unroll
        for (int r = 0; r < 16; r++) o[db][r] *= al;
      h16x8 pf[4];
#pragma unroll
      for (int sI = 0; sI < 4; sI++)
#pragma unroll
        for (int j = 0; j < 8; j++) pf[sI][j] = (h16)st[sI >> 1][8 * (sI & 1) + j];
      const char* sv = s + NKI * 8192;
#pragma unroll
      for (int db = 0; db < NDB; db++)
#pragma unroll
        for (int sI = 0; sI < 4; sI++) {
          h16x8 vf = *(const h16x8*)(sv + (db >> 1) * 8192 + img_off((db & 1) * 32 + l5, 2 * sI + h));
          o[db] = __builtin_amdgcn_mfma_f32_32x32x16_f16(vf, pf[sI], o[db], 0, 0, 0);
        }
    }
  }
  RAWBAR();
  lsum_out = lsum + __shfl_xor(lsum, 32);
}
template <int NDB>
DEVFN void attn_store_gated(const Params& p, const f32x16 (&o)[NDB], float inv, int m, int col0) {
  const int TIDX = tid_op();
  const int h = (TIDX & 63) >> 5;
#pragma unroll
  for (int db = 0; db < NDB; db++)
#pragma unroll
    for (int q = 0; q < 4; q++) {
      const int c = col0 + 32 * db + 8 * q + 4 * h;
      h16x4 g = *(const h16x4*)(p.gates16 + (size_t)m * 1024 + c), ov;
#pragma unroll
      for (int e = 0; e < 4; e++) ov[e] = (h16)(o[db][q * 4 + e] * inv * (float)g[e]);
      *(h16x4*)(p.O16 + (size_t)m * 1024 + c) = ov;
    }
}
DEVFN void attn_even_item(const Params& p, int l, int item, char* lds) {
  const int TIDX = tid_op();
  const int i = l >> 1; const int lane = TIDX & 63, w = TIDX >> 6, h = lane >> 5;
  const int grp = item >> 7, j = item & 127; const bool smp = grp < 2; const bool isdiff = (grp & 1) == 0;
  AttnItem it{}; it.nt1 = 0; it.kr1 = 0;
  if (isdiff) {
    int b, hh, t0;
    if (smp) { b = j >> 6; hh = (j >> 4) & 3; t0 = (j & 15) * 128; it.kr0 = MP + b * TKS; it.nt0 = TKS / 64; }
    else { b = j >> 3; hh = (j >> 1) & 3; t0 = (j & 1) * 128; it.kr0 = b * SEQ; it.nt0 = SEQ / 64; }
    const int comp = w >> 2;
    const int m0w = (smp ? MP + b * DS : b * SEQ) + t0 + (w & 3) * 32;
    it.k0 = p.KB + (size_t)(2 * hh) * KM * 64; it.k1 = p.KB + (size_t)(2 * hh + 1) * KM * 64; it.kld = 64;
    it.v0 = p.VB + (size_t)(hh * 128) * KM; it.v1 = p.VB + (size_t)(hh * 128 + 64) * KM;
    f32x16 o[4]; float lsum;
    attn_core<64, 2, 2, 4, false>(it, p.QB + ((size_t)m0w * 8 + 2 * hh + comp) * 64, 512, comp, 0, 1 << 30, nullptr, 0, 0, lds, o, lsum);
    const float inv = 1.f / lsum;
    float* a2 = (float*)lds + (size_t)(w & 3) * 32 * 132 + (size_t)(lane & 31) * 132;
    if (comp == 1) {
#pragma unroll
      for (int db = 0; db < 4; db++)
#pragma unroll
        for (int q = 0; q < 4; q++) { f32x4 v = {o[db][q * 4] * inv, o[db][q * 4 + 1] * inv, o[db][q * 4 + 2] * inv, o[db][q * 4 + 3] * inv}; *(f32x4*)(a2 + 32 * db + 8 * q + 4 * h) = v; }
    }
    __syncthreads();
    if (comp == 0) {
      const float lam = p.lamv[i]; const float lam_init = 0.8f - 0.6f * expf(-0.3f * l);
      float ss = 0;
#pragma unroll
      for (int db = 0; db < 4; db++)
#pragma unroll
        for (int q = 0; q < 4; q++) {
          f32x4 v2 = *(const f32x4*)(a2 + 32 * db + 8 * q + 4 * h);
#pragma unroll
          for (int e = 0; e < 4; e++) { float d = o[db][q * 4 + e] * inv - lam * v2[e]; o[db][q * 4 + e] = d; ss += d * d; }
        }
      ss = wsum32(ss);
      const float rr = (1.f - lam_init) / sqrtf(ss * (1.f / 128.f) + EPSN);
      const int m = m0w + (lane & 31);
#pragma unroll
      for (int db = 0; db < 4; db++)
#pragma unroll
        for (int q = 0; q < 4; q++) {
          const int dv = 32 * db + 8 * q + 4 * h; const int c = 512 + hh * 128 + dv;
          f32x4 sg = *(const f32x4*)(p.diff_subln + i * 128 + dv);
          h16x4 g = *(const h16x4*)(p.gates16 + (size_t)m * 1024 + c), ov;
#pragma unroll
          for (int e = 0; e < 4; e++) ov[e] = (h16)(o[db][q * 4 + e] * rr * sg[e] * (float)g[e]);
          *(h16x4*)(p.O16 + (size_t)m * 1024 + c) = ov;
        }
    }
    __syncthreads();
  } else {
    int b, head, t0;
    if (smp) { b = j >> 6; head = (j >> 3) & 7; t0 = (j & 7) * 256; it.kr0 = MP + b * TKS; it.nt0 = TKS / 64; }
    else { b = j >> 3; head = j & 7; t0 = 0; it.kr0 = b * SEQ; it.nt0 = SEQ / 64; }
    const int m0w = (smp ? MP + b * DS : b * SEQ) + t0 + w * 32;
    it.k0 = p.KA + (size_t)head * KM * 128; it.k1 = it.k0 + 64; it.kld = 128;
    it.v0 = p.VA + (size_t)(head * 64) * KM; it.v1 = it.v0;
    f32x16 o[2]; float lsum;
    attn_core<96, 2, 1, 2, false>(it, p.QA + ((size_t)m0w * 8 + head) * 96, 768, 0, 0, 1 << 30, nullptr, 0, 0, lds, o, lsum);
    attn_store_gated<2>(p, o, 1.f / lsum, m0w + (lane & 31), head * 64);
  }
}
DEVFN void attn_odd_item(const Params& p, int l, int item, char* lds) {
  const int TIDX = tid_op();
  const int i = l >> 1; const int lane = TIDX & 63, w = TIDX >> 6;
  const int grp = item >> 7, j = item & 127; const bool smp = grp < 2; const bool isgqa = (grp & 1) == 0;
  AttnItem it{}; it.nt1 = 0; it.kr1 = 0; it.kld = 64;
  f32x16 o[2]; float lsum;
  if (isgqa) {
    int b, kvh, t0;
    if (smp) { b = j >> 6; kvh = (j >> 5) & 1; t0 = (j & 31) * 64; it.kr0 = MP + b * TKS; it.nt0 = TKS / 64; }
    else { b = j >> 3; kvh = (j >> 2) & 1; t0 = (j & 3) * 64; it.kr0 = b * SEQ; it.nt0 = SEQ / 64; }
    const int head = kvh * 4 + (w >> 1);
    const int m0w = (smp ? MP + b * DS : b * SEQ) + t0 + (w & 1) * 32;
    it.k0 = p.KB + (size_t)kvh * KM * 64; it.k1 = it.k0; it.v0 = p.VB + (size_t)(kvh * 64) * KM; it.v1 = it.v0;
    attn_core<64, 1, 1, 2, false>(it, p.QB + ((size_t)m0w * 8 + head) * 64, 512, 0, 0, 1 << 30, nullptr, 0, 0, lds, o, lsum);
    attn_store_gated<2>(p, o, 1.f / lsum, m0w + (lane & 31), 512 + head * 64);
  } else if (!smp) {
    const int b = j >> 3, head = j & 7; it.kr0 = b * SEQ; it.nt0 = SEQ / 64;
    const int m0w = b * SEQ + w * 32;
    it.k0 = p.KA + (size_t)head * KM * 64; it.k1 = it.k0; it.v0 = p.VA + (size_t)(head * 64) * KM; it.v1 = it.v0;
    attn_core<64, 1, 1, 2, false>(it, p.QA + ((size_t)m0w * 8 + head) * 64, 512, 0, 0, 1 << 30, nullptr, 0, 0, lds, o, lsum);
    attn_store_gated<2>(p, o, 1.f / lsum, m0w + (lane & 31), head * 64);
  } else {
    const int b = j >> 6, head = (j >> 3) & 7, r0 = (j & 7) * 4;
    const int r = r0 + (w >> 1), c0 = (w & 1) * 32;
    auto rsf = [](int rr) { int s = rr - 4; return s < 0 ? 0 : (s > GROWS - 8 ? GROWS - 8 : s); };
    const int rlo = rsf(r0), rhi = rsf(r0 + 3) + 8;
    const int kbase = MP + b * TKS;
    it.kr0 = kbase + rlo * 64; it.nt0 = rhi - rlo; it.kr1 = kbase + DS; it.nt1 = PAST / 64;
    it.k0 = p.KA + (size_t)head * KM * 64; it.k1 = it.k0; it.v0 = p.VA + (size_t)(head * 64) * KM; it.v1 = it.v0;
    float* rpbl = (float*)(lds + A_RING);
    { const float* src = p.na_rpb + ((size_t)i * 8 + head) * 465; for (int k = TIDX; k < 465; k += 512) rpbl[k] = src[k] * LOG2E; }
    const int m0w = MP + b * DS + r * 64 + c0;
    const int ta = rsf(r) - rlo;
    attn_core<64, 1, 1, 2, true>(it, p.QA + ((size_t)m0w * 8 + head) * 64, 512, 0, ta, ta + 8, rpbl, rlo - r + 7, c0 + (lane & 31), lds, o, lsum);
    attn_store_gated<2>(p, o, 1.f / lsum, m0w + (lane & 31), head * 64);
  }
}
__global__ void __launch_bounds__(512) fk_attn(Params p, int l) {
  __shared__ __attribute__((aligned(16))) char lds[G_LDS];
  if (l & 1) attn_odd_item(p, l, blockIdx.x, lds); else attn_even_item(p, l, blockIdx.x, lds);
}
#define XB_TMO      128
#define XB_XCNT(j)  (256  + 64 * (j))
#define XB_XSUB(j)  (1280 + 64 * (j))
#define XB_XGEN(j)  (2304 + 64 * (j))
#define XB_TOP      3328
#define XB_TOPGEN   3392
#define XCD_BAR_WORDS 3456
#define XB_SPIN_CAP (1u << 20)
#define LAS __attribute__((address_space(3)))
DEVFN unsigned xb_ld(unsigned* p) { return __hip_atomic_load(p, __ATOMIC_RELAXED, __HIP_MEMORY_SCOPE_AGENT); }
DEVFN unsigned xb_add(unsigned* p, unsigned v) { return __hip_atomic_fetch_add(p, v, __ATOMIC_RELAXED, __HIP_MEMORY_SCOPE_AGENT); }
DEVFN unsigned xb_xcc_id() { return (unsigned)__builtin_amdgcn_s_getreg((3 << 11) | 20) & 0xFu; }
#define XB_SPIN(cond, bar) do { unsigned _sp = 0; while (cond) { __builtin_amdgcn_s_sleep(1); \
    if ((++_sp & 255u) == 0u) { if (xb_ld(&(bar)[XB_TMO])) break; if (_sp > XB_SPIN_CAP) { atomicAdd(&(bar)[XB_TMO], 1u); break; } } } } while (0)
struct XcdBarrier { unsigned* bar; unsigned x; volatile LAS unsigned* st; };
DEVFN XcdBarrier xcd_barrier_post(unsigned* bar, volatile LAS unsigned* st) {
  const int TIDX = tid_op();
  XcdBarrier b; b.bar = bar; b.x = xb_xcc_id(); b.st = st;
  if (TIDX == 0) (void)xb_add(&bar[XB_XCNT(b.x)], 1u);
  return b;
}
DEVFN void xcd_barrier_complete(unsigned* bar, unsigned x, unsigned& nloc, unsigned& nx) {
  const unsigned G = gridDim.x * gridDim.y * gridDim.z;
  unsigned sum, cnt, mine, sp = 0u;
  for (;;) {
    sum = 0u; cnt = 0u; mine = 0u;
#pragma unroll
    for (unsigned j = 0; j < 16; ++j) { const unsigned c = xb_ld(&bar[XB_XCNT(j)]); sum += c; cnt += (c > 0u) ? 1u : 0u; mine = (j == x) ? c : mine; }
    if (sum == G) break;
    __builtin_amdgcn_s_sleep(1);
    if ((++sp & 255u) == 0u) { if (xb_ld(&bar[XB_TMO])) break; if (sp > XB_SPIN_CAP) { atomicAdd(&bar[XB_TMO], 1u); break; } }
  }
  nloc = mine > 0u ? mine : 1u; nx = cnt > 0u ? cnt : 1u;
}
DEVFN void xcd_barrier(const XcdBarrier& b) {
  const int TIDX = tid_op();
  asm volatile("s_waitcnt vmcnt(0)" ::: "memory");
  __syncthreads();
  if (TIDX == 0) {
    unsigned* bar = b.bar;
    __builtin_amdgcn_s_waitcnt(0);
    unsigned nloc = b.st[0], nx = b.st[1];
    if (nloc == 0u) { xcd_barrier_complete(bar, b.x, nloc, nx); b.st[0] = nloc; b.st[1] = nx; }
    const unsigned old = xb_add(&bar[XB_XSUB(b.x)], 1u);
    const unsigned gen = old / nloc;
    if (old + 1u == (gen + 1u) * nloc) {
      __builtin_amdgcn_fence(__ATOMIC_RELEASE, "agent");
      asm volatile("s_waitcnt vmcnt(0)" ::: "memory");
      const unsigned og = xb_add(&bar[XB_TOP], 1u);
      const unsigned tg = og / nx;
      if (og + 1u == (tg + 1u) * nx) xb_add(&bar[XB_TOPGEN], 1u);
      else XB_SPIN(xb_ld(&bar[XB_TOPGEN]) == tg, bar);
      __builtin_amdgcn_fence(__ATOMIC_ACQUIRE, "agent");
      xb_add(&bar[XB_XGEN(b.x)], 1u);
      asm volatile("s_waitcnt vmcnt(0)" ::: "memory");
    } else {
      XB_SPIN(xb_ld(&bar[XB_XGEN(b.x)]) == gen, bar);
      __builtin_amdgcn_fence(__ATOMIC_ACQUIRE, "agent");
      asm volatile("s_waitcnt vmcnt(0)" ::: "memory");
    }
  }
  __syncthreads();
}

DEVFN void cache_items(const Params& p, int l, int gtid, int gthreads) {
  const int i = l >> 1;
  if ((l & 1) == 0) {
    const int per = 128 + 32 + 512 + 512;
    for (int e = gtid; e < DB * PAST * per; e += gthreads) {
      const int u = e % per; const int bp = e / per; const int pos = bp % PAST, b = bp / PAST;
      const int kr = MP + b * TKS + DS + pos; const size_t crow = ((size_t)(b * 2 + i) * PAST + pos);
      if (u < 128) p.ckv16[(size_t)kr * 128 + u] = (h16)p.cache_mla_ckv[crow * 128 + u];
      else if (u < 160) p.kpe16[(size_t)kr * 32 + (u - 128)] = (h16)p.cache_mla_kpe[crow * 32 + (u - 128)];
      else if (u < 672) { const int c = u - 160; p.KB[((size_t)(c >> 6) * KM + kr) * 64 + (c & 63)] = (h16)p.cache_diff_k[crow * 512 + c]; }
      else { const int c = u - 672; p.VB[(size_t)c * KM + kr] = (h16)p.cache_diff_v[crow * 512 + c]; }
    }
  } else {
    const int per = 512 + 512 + 128 + 128;
    for (int e = gtid; e < DB * PAST * per; e += gthreads) {
      const int u = e % per; const int bp = e / per; const int pos = bp % PAST, b = bp / PAST;
      const int kr = MP + b * TKS + DS + pos; const size_t crow = ((size_t)(b * 2 + i) * PAST + pos);
      if (u < 512) p.KA[((size_t)(u >> 6) * KM + kr) * 64 + (u & 63)] = (h16)p.cache_na_k[crow * 512 + u];
      else if (u < 1024) { const int c = u - 512; p.VA[(size_t)c * KM + kr] = (h16)p.cache_na_v[crow * 512 + c]; }
      else if (u < 1152) { const int c = u - 1024; p.KB[((size_t)(c >> 6) * KM + kr) * 64 + (c & 63)] = (h16)p.cache_gqa_k[crow * 128 + c]; }
      else { const int c = u - 1152; p.VB[(size_t)c * KM + kr] = (h16)p.cache_gqa_v[crow * 128 + c]; }
    }
  }
}

DEVFN void mod_item(const Params& p, int item, char* lds) {
  const int tid = tid_op();
  const int l = item / 96, rem = item % 96, nchunk = rem / 16, kc = rem % 16;
  float* sil = (float*)lds;
  if (tid < NCV * 64) { const int cv = tid >> 6, k = tid & 63; const float* cvec = cv == 0 ? p.c_ctx : p.c + (size_t)(cv - 1) * D; sil[tid] = siluf(cvec[kc * 64 + k]); }
  __syncthreads();
  const int col = nchunk * 512 + tid;
  const float* w = p.w_mod + ((size_t)l * D + kc * 64) * 3072 + col;
  float acc[NCV];
#pragma unroll
  for (int c = 0; c < NCV; c++) acc[c] = 0.f;
#pragma unroll 16
  for (int k = 0; k < 64; k++) {
    const float wv = w[(size_t)k * 3072];
#pragma unroll
    for (int c = 0; c < NCV; c++) acc[c] += sil[c * 64 + k] * wv;
  }
  const float b = kc == 0 ? p.b_mod[l * 3072 + col] : 0.f;
#pragma unroll
  for (int c = 0; c < NCV; c++) atomicAdd(p.modv + ((size_t)l * NCV + c) * 3072 + col, acc[c] + b);
  __syncthreads();
}
DEVFN void conv_tile(const float* src, h16* dst, int K, int Nsrc, int mode, const float* kscale, int nb, int kb, char* lds) {
  const int tid = tid_op();
  float (*t)[65] = (float (*)[65])lds;
  {
    const int j = tid & 63; const int np = nb + j; int col;
    if (mode == 0) col = np; else if (mode == 1) col = even_col(np); else if (mode == 3) { int hh = (np & 511) >> 6; col = hh * 128 + (np >> 9) * 64 + (np & 63); } else { int h = np >> 7, jj = np & 127; col = jj < 96 ? h * 96 + jj : -1; }
#pragma unroll
    for (int i = 0; i < 8; i++) {
      const int kk = (tid >> 6) + 8 * i; float v = 0.f;
      if (col >= 0) { v = src[(size_t)(kb + kk) * Nsrc + col]; if (kscale) v *= kscale[kb + kk]; }
      t[kk][j] = v;
    }
  }
  __syncthreads();
  {
    const int kk = tid & 63;
#pragma unroll
    for (int i = 0; i < 8; i++) { const int j = (tid >> 6) + 8 * i; dst[(size_t)(nb + j) * K + kb + kk] = (h16)t[kk][j]; }
  }
  __syncthreads();
}
constexpr int CV_WIN_E = (NPE / 64) * 16, CV_WIN_O = (NPO / 64) * 16, CV_WOUT = 256, CV_WQB = 64, CV_WKVB = 32;
constexpr int CV_PER_PAIR = CV_WIN_E + CV_WIN_O + 2 * CV_WOUT + CV_WQB + CV_WKVB;
constexpr int CV_TOTAL = 2 * CV_PER_PAIR;
DEVFN void conv_item(const Params& p, int item, char* lds) {
  const int i = item / CV_PER_PAIR; int r = item % CV_PER_PAIR;
  if (r < CV_WIN_E) { conv_tile(p.w_in_even + (size_t)i * D * EVEN_IN, p.win16 + (size_t)(2 * i) * NPO * D, D, EVEN_IN, 1, nullptr, (r % (NPE / 64)) * 64, (r / (NPE / 64)) * 64, lds); return; }
  r -= CV_WIN_E;
  if (r < CV_WIN_O) { conv_tile(p.w_in_odd + (size_t)i * D * ODD_IN, p.win16 + (size_t)(2 * i + 1) * NPO * D, D, ODD_IN, 0, nullptr, (r % (NPO / 64)) * 64, (r / (NPO / 64)) * 64, lds); return; }
  r -= CV_WIN_O;
  if (r < CV_WOUT) { conv_tile(p.w_out_even + (size_t)i * D * D, p.wout16 + (size_t)(2 * i) * D * D, D, D, 0, nullptr, (r % 16) * 64, (r / 16) * 64, lds); return; }
  r -= CV_WOUT;
  if (r < CV_WOUT) { conv_tile(p.w_out_odd + (size_t)i * D * D, p.wout16 + (size_t)(2 * i + 1) * D * D, D, D, 0, nullptr, (r % 16) * 64, (r / 16) * 64, lds); return; }
  r -= CV_WOUT;
  if (r < CV_WQB) { conv_tile(p.mla_wqb + (size_t)i * 256 * 768, p.wqb16 + (size_t)i * 1024 * 256, 256, 768, 2, p.mla_qa_norm + i * 256, (r % 16) * 64, (r / 16) * 64, lds); return; }
  r -= CV_WQB;
  conv_tile(p.mla_wkvb + (size_t)i * 128 * 1024, p.wkvb16 + (size_t)i * 1024 * 128, 128, 1024, 3, nullptr, (r % 16) * 64, (r / 16) * 64, lds);
}
DEVFN void tab_items(const Params& p, int gtid, int gthreads) {
  for (int g = gtid; g < DS * 48; g += gthreads) {
    if (g < 2) {
      const int i = g, l = 2 * i; float s1 = 0, s2 = 0;
      for (int k = 0; k < 64; k++) { s1 += p.diff_lq1[i * 64 + k] * p.diff_lk1[i * 64 + k]; s2 += p.diff_lq2[i * 64 + k] * p.diff_lk2[i * 64 + k]; }
      p.lamv[i] = expf(s1) - expf(s2) + (0.8f - 0.6f * expf(-0.3f * l));
    }
    const int t = g / 48, j = g % 48;
    const float row = (float)(t / GW), col = (float)(t % GW);
    if (j < 32) { const int f = j & 15; const float inv = powf(10000.f, -(float)(2 * f) / 32.f); const float ang = (j < 16 ? row : col) * inv; p.ropeC64[t * 32 + j] = cosf(ang); p.ropeS64[t * 32 + j] = sinf(ang); }
    else { const int jj = j - 32; const int f = jj & 7; const float inv = powf(10000.f, -(float)(2 * f) / 16.f); const float ang = (jj < 8 ? row : col) * inv; p.ropeC32[t * 16 + jj] = cosf(ang); p.ropeS32[t * 16 + jj] = sinf(ang); }
  }
}
DEVFN void bias_row(const Params& p, int l, int np, int lane) {
  const h16* w = p.win16 + (size_t)l * NPO * D + (size_t)np * D;
  float a[NCV];
#pragma unroll
  for (int c = 0; c < NCV; c++) a[c] = 0;
#pragma unroll
  for (int i = 0; i < 2; i++) {
    const int k = (i * 64 + lane) * 8; h16x8 wv = *(const h16x8*)(w + k);
#pragma unroll
    for (int c = 0; c < NCV; c++) { const float* sh = p.modv + ((size_t)l * NCV + c) * 3072 + k;
#pragma unroll
      for (int e = 0; e < 8; e++) a[c] += sh[e] * (float)wv[e]; }
  }
#pragma unroll
  for (int c = 0; c < NCV; c++) { float v = a[c]; for (int o = 32; o; o >>= 1) v += __shfl_xor(v, o); if (lane == 0) p.biasv[((size_t)l * NCV + c) * NPO + np] = v; }
}
DEVFN void prepx_row(const Params& p, int l, int m, int lane) {
  const float* x = xrow(p, l, m); const float* md = p.modv + ((size_t)l * NCV + tok_cv(m)) * 3072 + 1024; const float* nw = p.norm_w + l * D;
  float ss = 0;
#pragma unroll
  for (int i = 0; i < 4; i++) {
    const int k = (i * 64 + lane) * 4;
    f32x4 v = *(const f32x4*)(x + k); f32x4 s = *(const f32x4*)(md + k); f32x4 w = *(const f32x4*)(nw + k);
    h16x4 o;
#pragma unroll
    for (int e = 0; e < 4; e++) { ss += v[e] * v[e]; o[e] = (h16)(v[e] * w[e] * (1.f + s[e])); }
    *(h16x4*)(p.xs16 + (size_t)m * D + k) = o;
  }
  for (int o = 32; o; o >>= 1) ss += __shfl_xor(ss, o);
  if (lane == 0) p.rowss_l[(size_t)l * M + m] = ss;
}
#define AS4 __attribute__((address_space(4)))
#define PHASE_PARAMS(q) const Params& q = p_unused;
__global__ void __launch_bounds__(512) mega_kernel(Params p_unused) {
  __shared__ __attribute__((aligned(16))) char lds[G_LDS + 16];
  if (threadIdx.x == 0) { volatile LAS unsigned* st = (volatile LAS unsigned*)(lds + G_LDS); st[0] = 0u; st[1] = 0u; st[2] = 0u; st[3] = 0u; }
  __syncthreads();
  XcdBarrier bar;
  { PHASE_PARAMS(p); bar = xcd_barrier_post(p.bar, (volatile LAS unsigned*)(lds + G_LDS)); }
  const int nb = gridDim.x, bid = blockIdx.x;
  { PHASE_PARAMS(p);
    for (int it = bid; it < 384 + CV_TOTAL; it += nb) { if (it < 384) mod_item(p, it, lds); else conv_item(p, it - 384, lds); }
    tab_items(p, bid * 512 + tid_op(), nb * 512); }
  xcd_barrier(bar);
  { PHASE_PARAMS(p);
    const int tid = tid_op(); const int lane = tid & 63, gw = bid * 8 + (tid >> 6), nw = nb * 8;
    for (int r = gw; r < 2 * (NPE + NPO) + M; r += nw) {
      if (r < 2 * (NPE + NPO)) { const int i = r / (NPE + NPO), q = r % (NPE + NPO); if (q < NPE) bias_row(p, 2 * i, q, lane); else bias_row(p, 2 * i + 1, q - NPE, lane); }
      else prepx_row(p, 0, r - 2 * (NPE + NPO), lane);
    } }
  xcd_barrier(bar);
#pragma unroll 1
  for (int l = 0; l < 4; l++) {
    { PHASE_PARAMS(p);
      const int ntn = ((l & 1) ? NPO : NPE) / 128;
      for (int t = bid; t < 32 * ntn; t += nb) inproj_tile(p, l, t % 32, t / 32, lds);
      cache_items(p, l, bid * 512 + tid_op(), nb * 512); }
    xcd_barrier(bar);
    if ((l & 1) == 0) {
      PHASE_PARAMS(p);
      const int nq = (M / 256) * 8, nkv = (KM / 256) * 8;
      for (int t = bid; t < nq + nkv; t += nb) { if (t < nq) qgemm_tile(p, l, t % 32, t / 32, lds); else { const int u = t - nq; kvgemm_tile(p, l, u % (KM / 256), u / (KM / 256), lds); } }
      xcd_barrier(bar);
    }
    { PHASE_PARAMS(p);
      for (int it = bid; it < 512; it += nb) { if (l & 1) attn_odd_item(p, l, it, lds); else attn_even_item(p, l, it, lds); } }
    xcd_barrier(bar);
    { PHASE_PARAMS(p);
      for (int t = bid; t < 32 * 8; t += nb) outproj_tile(p, l, t % 32, t / 32, lds); }
    if (l < 3) xcd_barrier(bar);
  }
}
__global__ void __launch_bounds__(512) fk_inproj_plain(Params p, int l) {
  __shared__ __attribute__((aligned(16))) char lds[G_LDS];
  const int NP = (l & 1) ? NPO : NPE; const int ntn = NP / 128;
  const int mt = blockIdx.x / ntn, ntile = blockIdx.x % ntn;
  const int m0 = mt * 256, n0 = ntile * 128;
  f32x16 acc[2][2];
  gemm_tile<true>(p.xs16, D, (p.win16 + (size_t)l * NPO * D), D, D, m0, n0, lds, acc);
  const int lane = threadIdx.x & 63, w = threadIdx.x >> 6, wm = w >> 1, wn = w & 1;
  for (int mb = 0; mb < 2; mb++) {
    int m = m0 + wm * 64 + mb * 32 + (lane & 31);
    float rstd = 1.f / sqrtf(p.rowss_l[(size_t)l * M + m] / D + EPSN);
    const float* bias = p.biasv + ((size_t)l * NCV + tok_cv(m)) * NPO;
    for (int nb = 0; nb < 2; nb++)
      for (int r = 0; r < 16; r++) {
        int np = n0 + wn * 64 + nb * 32 + (r & 3) + 8 * (r >> 2) + 4 * (lane >> 5);
        int col = (l & 1) ? np : even_col(np);
        if (col >= 0) p.ubuf[(size_t)m * 3328 + col] = (h16)(acc[mb][nb][r] * rstd + bias[np]);
      }
  }
}
#endif

static inline size_t al256(size_t x) { return (x + 255) & ~(size_t)255; }

extern "C" void kernel_launch(void* const* d_in, const int* in_sizes, int n_in, void* d_out, int out_size, void* d_ws, size_t ws_size,
                              hipStream_t stream) {
  Params p{};
  const float** ip = (const float**)&p.x_prompt;
  for (int k = 0; k < 39; k++) ip[k] = (const float*)d_in[k];
  float* o = (float*)d_out;
  p.Y = o; o += (size_t)M * 1024;
  p.o_ckv = o; o += (size_t)BATCH * 2 * SEQ * 128;
  p.o_kpe = o; o += (size_t)BATCH * 2 * SEQ * 32;
  p.o_dk = o; o += (size_t)BATCH * 2 * SEQ * 512;
  p.o_dv = o; o += (size_t)BATCH * 2 * SEQ * 512;
  p.o_nk = o; o += (size_t)BATCH * 2 * SEQ * 512;
  p.o_nv = o; o += (size_t)BATCH * 2 * SEQ * 512;
  p.o_gk = o; o += (size_t)BATCH * 2 * SEQ * 128;
  p.o_gv = o; o += (size_t)BATCH * 2 * SEQ * 128;
  char* w = (char*)d_ws; size_t off = 0;
  auto take = [&](size_t bytes) { char* r = w + off; off += al256(bytes); return r; };
  char* zero0 = w + off;
  p.bar = (unsigned*)take(16384);
  p.modv = (float*)take((size_t)4 * NCV * 3072 * 4);
  p.rowss_qa = (float*)take((size_t)2 * M * 4); p.rowss_l = (float*)take((size_t)4 * M * 4);
  const size_t zero_bytes = (size_t)((w + off) - zero0);
  p.ropeC64 = (float*)take((size_t)DS * 32 * 4); p.ropeS64 = (float*)take((size_t)DS * 32 * 4);
  p.ropeC32 = (float*)take((size_t)DS * 16 * 4); p.ropeS32 = (float*)take((size_t)DS * 16 * 4);
  p.lamv = (float*)take(256);
  p.rstdx = (float*)take((size_t)M * 4);
  p.QA = (h16*)take((size_t)M * 8 * 96 * 2); p.QB = (h16*)take((size_t)M * 8 * 64 * 2);
  p.KA = (h16*)take((size_t)8 * KM * 128 * 2); p.KB = (h16*)take((size_t)8 * KM * 64 * 2);
  p.VA = (h16*)take((size_t)8 * 64 * KM * 2); p.VB = (h16*)take((size_t)8 * 64 * KM * 2);
  p.gates16 = (h16*)take((size_t)M * 1024 * 2); p.O16 = (h16*)take((size_t)M * 1024 * 2);
  p.ckvbuf = (float*)take((size_t)KM * 128 * 4); p.kpebuf = (float*)take((size_t)KM * 32 * 4);
  p.xs16 = (h16*)take((size_t)M * D * 2); p.qa16 = (h16*)take((size_t)M * 256 * 2); p.ckv16 = (h16*)take((size_t)KM * 128 * 2); p.kpe16 = (h16*)take((size_t)KM * 32 * 2); p.biasv = (float*)take((size_t)4 * NCV * NPO * 4);
  p.win16 = (h16*)take((size_t)4 * NPO * D * 2); p.wout16 = (h16*)take((size_t)4 * D * D * 2);
  p.wqb16 = (h16*)take((size_t)2 * 1024 * 256 * 2); p.wkvb16 = (h16*)take((size_t)2 * 1024 * 128 * 2);
  size_t ub = (size_t)M * 3328 * 2, ab = (size_t)M * 1536 * 4;
  char* big = take(ub > ab ? ub : ab);
  p.ubuf = (h16*)big; p.abuf = (float*)big;
  (void)ws_size; (void)n_in; (void)in_sizes; (void)out_size;

#if !defined(CPU_EMU) && MEGA
  {
    (void)hipMemsetAsync(zero0, 0, zero_bytes, stream);
    static int cus = 0;
    if (!cus) { int dev = 0; (void)hipGetDevice(&dev); (void)hipDeviceGetAttribute(&cus, hipDeviceAttributeMultiprocessorCount, dev); }
    void* args[] = {&p};
    (void)hipLaunchCooperativeKernel((void*)mega_kernel, dim3(cus), dim3(512), args, 0, stream);
    return;
  }
#endif
  (void)zero_bytes;
#ifndef CPU_EMU
  (void)hipMemsetAsync(zero0, 0, zero_bytes, stream);
#endif
  launch1d(nk_mod, (long)4 * NCV * 3072, stream, p, (long)4 * NCV * 3072);
  launch1d(nk_tab, (long)DS * 48, stream, p, (long)DS * 48);
#ifndef CPU_EMU
  for (int l = 0; l < 4; l++) {
    const int i = l >> 1;
    if (l & 1) hipLaunchKernelGGL(fk_convw, dim3(NPO / 64, D / 64), dim3(256), 0, stream, p.w_in_odd + (size_t)i * D * ODD_IN, (p.win16 + (size_t)l * NPO * D), D, ODD_IN, NPO, 0, (const float*)nullptr);
    else hipLaunchKernelGGL(fk_convw, dim3(NPE / 64, D / 64), dim3(256), 0, stream, p.w_in_even + (size_t)i * D * EVEN_IN, (p.win16 + (size_t)l * NPO * D), D, EVEN_IN, NPE, 1, (const float*)nullptr);
    hipLaunchKernelGGL(fk_convw, dim3(D / 64, D / 64), dim3(256), 0, stream, ((l & 1) ? p.w_out_odd : p.w_out_even) + (size_t)i * D * D, (p.wout16 + (size_t)l * D * D), D, D, D, 0, (const float*)nullptr);
  }
  for (int i = 0; i < 2; i++) {
    hipLaunchKernelGGL(fk_convw, dim3(1024 / 64, 256 / 64), dim3(256), 0, stream, p.mla_wqb + (size_t)i * 256 * 768, (p.wqb16 + (size_t)i * 1024 * 256), 256, 768, 1024, 2, p.mla_qa_norm + i * 256);
    hipLaunchKernelGGL(fk_convw, dim3(1024 / 64, 128 / 64), dim3(256), 0, stream, p.mla_wkvb + (size_t)i * 128 * 1024, (p.wkvb16 + (size_t)i * 1024 * 128), 128, 1024, 1024, 3, (const float*)nullptr);
  }
#endif
  for (int l = 0; l < 4; l++) {
    const int N = (l & 1) ? ODD_IN : EVEN_IN;
#if defined(CPU_EMU) || !FAST_INPROJ
    launch1d(nk_rstd, (long)M, stream, p, l, (long)M);
    launch1d(nk_inproj, (long)M * N, stream, p, l, (long)M * N);
#else
    {
      const int NP = (l & 1) ? NPO : NPE;
      if (l == 0 || !FAST_OUTPROJ) hipLaunchKernelGGL(fk_prep_x, dim3(M / 4), dim3(256), 0, stream, p, l);
      hipLaunchKernelGGL(fk_bias, dim3(NP / 4), dim3(256), 0, stream, p, l);
#if FAST_INPROJ == 1
      hipLaunchKernelGGL(fk_inproj_plain, dim3((M / 256) * (NP / 128)), dim3(512), 0, stream, p, l);
#else
      hipLaunchKernelGGL(fk_inproj, dim3((M / 256) * (NP / 128)), dim3(512), 0, stream, p, l);
#endif
    }
#endif
    if ((l & 1) == 0) {
#if !defined(CPU_EMU) && FAST_INPROJ == 2 && FAST_A2
      launch1d(nk_cache_even, (long)DB * PAST * 17, stream, p, l, (long)DB * PAST * 17);
      hipLaunchKernelGGL(fk_a2, dim3((M / 256) * 8 + (KM / 256) * 8), dim3(512), 0, stream, p, l);
#else
#if !defined(CPU_EMU) && FAST_INPROJ == 2
      launch1d(nk_epi_even, (long)M * 50, stream, p, l, 1, (long)M * 50);
#else
      launch1d(nk_epi_even, (long)M * 50, stream, p, l, 0, (long)M * 50);
#endif
      launch1d(nk_cache_even, (long)DB * PAST * 17, stream, p, l, (long)DB * PAST * 17);
      launch1d(nk_kv, (long)KM * 16, stream, p, l, (long)KM * 16);
#endif
#if !defined(CPU_EMU) && FAST_ATTN
      hipLaunchKernelGGL(fk_attn, dim3(512), dim3(512), 0, stream, p, l);
#else
      launch1d(nk_attn_dense, (long)M * 8, stream, p, 0, 0, M, (long)M * 8);
      launch1d(nk_attn_dense, (long)M * 16, stream, p, 1, 0, M, (long)M * 16);
      launch1d(nk_fin, (long)M * 12, stream, p, l, (long)M * 12);
#endif
    } else {
#if defined(CPU_EMU) || FAST_INPROJ != 2
      launch1d(nk_epi_odd, (long)M * 52, stream, p, l, (long)M * 52);
#endif
      launch1d(nk_cache_odd, (long)DB * PAST * 20, stream, p, l, (long)DB * PAST * 20);
#if !defined(CPU_EMU) && FAST_ATTN
      hipLaunchKernelGGL(fk_attn, dim3(512), dim3(512), 0, stream, p, l);
#else
      launch1d(nk_attn_dense, (long)MP * 8, stream, p, 2, 0, MP, (long)MP * 8);
      launch1d(nk_attn_na, (long)MS * 8, stream, p, l, (long)MS * 8);
      launch1d(nk_attn_dense, (long)M * 8, stream, p, 3, 0, M, (long)M * 8);
      launch1d(nk_fin, (long)M * 16, stream, p, l, (long)M * 16);
#endif
    }
#if !defined(CPU_EMU) && FAST_OUTPROJ
    hipLaunchKernelGGL(fk_outproj, dim3((M / 256) * 8), dim3(512), 0, stream, p, l);
#else
    launch1d(nk_outproj, (long)M * 1024, stream, p, l, (long)M * 1024);
#endif
  }
}
```

```cpp
#ifndef CPU_EMU
#include <hip/hip_runtime.h>
#endif
#include <stdint.h>
#include <math.h>

#define FAST_INPROJ 2
#define DUAL_WRITE 0
#define FAST_A2 1
#define FAST_OUTPROJ 1
#define FAST_ATTN 1
#define MEGA 1
#define REP_0A 1
#define REP_A 1
#define REP_A2 1
#define REP_B 1
#define REP_C 1
#define REP_BAR 1
#define REP_GK 1
#define REP_0B 1
#ifndef CFG_BATCH
#define CFG_BATCH 16
#endif
#ifndef CFG_DB
#define CFG_DB 2
#endif
#ifndef CFG_DS
#define CFG_DS 2048
#endif
constexpr int D = 1024, BATCH = CFG_BATCH, SEQ = 256, DB = CFG_DB, DS = CFG_DS, PAST = 256;
constexpr int MP = BATCH * SEQ, MS = DB * DS, M = MP + MS;
constexpr int TKS = DS + PAST;
constexpr int KM = MP + DB * TKS;
constexpr int NCV = 1 + DB;
constexpr int GW = 64, GROWS = DS / GW;
constexpr int EVEN_IN = 2976, ODD_IN = 3328;
constexpr int NPE = 3072, NPO = 3328;
constexpr float EPSN = 1e-6f;
constexpr float LOG2E = 1.4426950408889634f;

typedef _Float16 h16;

struct Params {
  const float *x_prompt, *x_sample, *cache_mla_ckv, *cache_mla_kpe, *cache_diff_k, *cache_diff_v, *cache_na_k, *cache_na_v,
      *cache_gqa_k, *cache_gqa_v, *c, *c_ctx, *norm_w, *w_mod, *b_mod, *w_in_even, *w_out_even, *mla_qa_norm, *mla_wqb,
      *mla_kva_norm, *mla_wkvb, *mla_qn_nope, *mla_qn_rope, *mla_kn_nope, *mla_kn_rope, *diff_qn, *diff_kn, *diff_lq1,
      *diff_lk1, *diff_lq2, *diff_lk2, *diff_subln, *w_in_odd, *w_out_odd, *na_qn, *na_kn, *na_rpb, *gqa_qn, *gqa_kn;
  float *Y;
  float *o_ckv, *o_kpe, *o_dk, *o_dv, *o_nk, *o_nv, *o_gk, *o_gv;
  float *modv;
  float *ropeC64, *ropeS64;
  float *ropeC32, *ropeS32;
  float *lamv;
  float *rstdx;
  h16 *ubuf;
  float *abuf;
  float *ckvbuf;
  float *kpebuf;
  h16 *QA, *QB, *KA, *KB, *VA, *VB, *gates16, *O16;
  h16 *xs16;
  float *biasv;
  h16 *win16;
  h16 *wout16;
  h16 *wqb16;
  h16 *wkvb16;
  h16 *qa16;
  float *rowss_qa;
  h16 *ckv16;
  h16 *kpe16;
  float *rowss_l;
  unsigned *bar;
};

#ifdef CPU_EMU
#include <stdio.h>
#include <stdlib.h>
#include <string.h>
typedef void* hipStream_t;
#define KERNEL static void
#define DEVFN static inline
static thread_local long emu_gtid;
#define GTID emu_gtid
template <class... A, class... B>
static void launch1d(void (*f)(A...), long n, hipStream_t, B... a) {
#pragma omp parallel for schedule(dynamic, 64)
  for (long i = 0; i < n; i++) { emu_gtid = i; f(a...); }
}
static inline float exp2f_(float x) { return exp2f(x); }
#else
#define KERNEL __global__ void __launch_bounds__(256)
#define DEVFN __device__ __forceinline__
#define GTID ((long)blockIdx.x * 256 + threadIdx.x)
template <class... A, class... B>
static void launch1d(void (*f)(A...), long n, hipStream_t s, B... a) {
  hipLaunchKernelGGL(f, dim3((unsigned)((n + 255) / 256)), dim3(256), 0, s, a...);
}
DEVFN float exp2f_(float x) { return exp2f(x); }
#endif

DEVFN int tok_cv(int m) { return m < MP ? 0 : 1 + (m - MP) / DS; }
DEVFN int tok_keyrow(int m) { return m < MP ? m : MP + ((m - MP) / DS) * TKS + (m - MP) % DS; }
DEVFN int tok_pos(int m) { return m < MP ? (m % SEQ) : ((m - MP) % DS); }
DEVFN const float* xrow(const Params& p, int l, int m) {
  if (l > 0) return p.Y + (size_t)m * D;
  return m < MP ? p.x_prompt + (size_t)m * D : p.x_sample + (size_t)(m - MP) * D;
}
DEVFN float siluf(float x) { return x / (1.f + expf(-x)); }
DEVFN size_t st_row(int m, int i) { int b = m / SEQ, t = m % SEQ; return ((size_t)(b * 2 + i) * SEQ + t); }

#ifdef CPU_EMU
KERNEL nk_mod(Params p, long n) {
  long g = GTID; if (g >= n) return;
  int col = g % 3072; int cv = (g / 3072) % NCV; int l = g / (3072 * NCV);
  const float* cvec = cv == 0 ? p.c_ctx : p.c + (size_t)(cv - 1) * D;
  const float* w = p.w_mod + (size_t)l * D * 3072 + col;
  float acc = p.b_mod[l * 3072 + col];
  for (int k = 0; k < D; k++) acc += siluf(cvec[k]) * w[(size_t)k * 3072];
  p.modv[((size_t)l * NCV + cv) * 3072 + col] = acc;
}
KERNEL nk_tab(Params p, long n) {
  long g = GTID; if (g >= n) return;
  if (g < 2) {
    int i = g; int l = 2 * i;
    float s1 = 0, s2 = 0;
    for (int k = 0; k < 64; k++) { s1 += p.diff_lq1[i * 64 + k] * p.diff_lk1[i * 64 + k]; s2 += p.diff_lq2[i * 64 + k] * p.diff_lk2[i * 64 + k]; }
    float lam_init = 0.8f - 0.6f * expf(-0.3f * l);
    p.lamv[i] = expf(s1) - expf(s2) + lam_init;
  }
  int t = g / 48, j = g % 48;
  if (t >= DS) return;
  float row = (float)(t / GW), col = (float)(t % GW);
  if (j < 32) {
    int f = j & 15; float inv = powf(10000.f, -(float)(2 * f) / 32.f);
    float ang = (j < 16 ? row : col) * inv;
    p.ropeC64[t * 32 + j] = cosf(ang); p.ropeS64[t * 32 + j] = sinf(ang);
  } else {
    int jj = j - 32; int f = jj & 7; float inv = powf(10000.f, -(float)(2 * f) / 16.f);
    float ang = (jj < 8 ? row : col) * inv;
    p.ropeC32[t * 16 + jj] = cosf(ang); p.ropeS32[t * 16 + jj] = sinf(ang);
  }
}
KERNEL nk_rstd(Params p, int l, long n) {
  long g = GTID; if (g >= n) return;
  const float* x = xrow(p, l, (int)g);
  float s = 0; for (int k = 0; k < D; k++) s += x[k] * x[k];
  p.rstdx[g] = 1.f / sqrtf(s / D + EPSN);
}
KERNEL nk_inproj(Params p, int l, long n) {
  long g = GTID; if (g >= n) return;
  const int N = (l & 1) ? ODD_IN : EVEN_IN;
  int m = g / N, col = g % N;
  const float* W = ((l & 1) ? p.w_in_odd : p.w_in_even) + (size_t)(l >> 1) * D * N + col;
  const float* x = xrow(p, l, m);
  const float* md = p.modv + ((size_t)l * NCV + tok_cv(m)) * 3072;
  const float* nw = p.norm_w + l * D;
  float r = p.rstdx[m], acc = 0;
  for (int k = 0; k < D; k++) { float h = x[k] * r * nw[k] * (1.f + md[1024 + k]) + md[k]; acc += h * W[(size_t)k * N]; }
  p.ubuf[(size_t)m * 3328 + col] = (h16)acc;
}

KERNEL nk_epi_even(Params p, int l, int qa_only, long n) {
  long g = GTID; if (g >= n) return;
  const int i = l >> 1;
  int m = g / 50, u = g % 50;
  if (qa_only && u >= 8) return;
  const h16* ur = qa_only ? p.qa16 + (size_t)m * 256 : p.ubuf + (size_t)m * 3328;
  const bool smp = m >= MP; const int t = tok_pos(m); const int kr = tok_keyrow(m);
  if (u < 8) {
    float ss = 0; for (int k = 0; k < 256; k++) { float v = (float)ur[k]; ss += v * v; }
    float r = 1.f / sqrtf(ss / 256 + EPSN);
    float q[96];
#pragma unroll
    for (int j = 0; j < 96; j++) q[j] = 0;
    const float* W = p.mla_wqb + (size_t)i * 256 * 768 + u * 96;
    for (int k = 0; k < 256; k++) {
      float a = (float)ur[k] * r * p.mla_qa_norm[i * 256 + k];
#pragma unroll
      for (int j = 0; j < 96; j++) q[j] += a * W[(size_t)k * 768 + j];
    }
    float s1 = 0, s2 = 0;
#pragma unroll
    for (int j = 0; j < 64; j++) s1 += q[j] * q[j];
#pragma unroll
    for (int j = 64; j < 96; j++) s2 += q[j] * q[j];
    float r1 = 1.f / sqrtf(s1 / 64 + EPSN), r2 = 1.f / sqrtf(s2 / 32 + EPSN);
#pragma unroll
    for (int j = 0; j < 64; j++) q[j] = q[j] * r1 * p.mla_qn_nope[i * 64 + j];
#pragma unroll
    for (int j = 0; j < 32; j++) q[64 + j] = q[64 + j] * r2 * p.mla_qn_rope[i * 32 + j];
    if (smp) {
#pragma unroll
      for (int j = 0; j < 16; j++) {
        float c = p.ropeC32[t * 16 + j], s = p.ropeS32[t * 16 + j];
        float x1 = q[64 + j], x2 = q[80 + j];
        q[64 + j] = x1 * c - x2 * s; q[80 + j] = x2 * c + x1 * s;
      }
    }
    const float sc = LOG2E / sqrtf(96.f);
    h16* dst = p.QA + ((size_t)m * 8 + u) * 96;
#pragma unroll
    for (int j = 0; j < 96; j++) dst[j] = (h16)(q[j] * sc);
  } else if (u == 8) {
    float ss = 0; for (int k = 0; k < 128; k++) { float v = (float)ur[256 + k]; ss += v * v; }
    float r = 1.f / sqrtf(ss / 128 + EPSN);
    for (int k = 0; k < 128; k++) {
      float v = (float)ur[256 + k] * r * p.mla_kva_norm[i * 128 + k];
      if (!smp) p.o_ckv[st_row(m, i) * 128 + k] = v;
      p.ckvbuf[(size_t)kr * 128 + k] = v;
    }
  } else if (u == 9) {
    float v[32]; float ss = 0;
#pragma unroll
    for (int k = 0; k < 32; k++) { v[k] = (float)ur[384 + k]; ss += v[k] * v[k]; }
    float r = 1.f / sqrtf(ss / 32 + EPSN);
#pragma unroll
    for (int k = 0; k < 32; k++) { v[k] = v[k] * r * p.mla_kn_rope[i * 32 + k]; if (!smp) p.o_kpe[st_row(m, i) * 32 + k] = v[k]; }
    if (smp) {
#pragma unroll
      for (int j = 0; j < 16; j++) {
        float c = p.ropeC32[t * 16 + j], s = p.ropeS32[t * 16 + j];
        float x1 = v[j], x2 = v[16 + j];
        v[j] = x1 * c - x2 * s; v[16 + j] = x2 * c + x1 * s;
      }
    }
#pragma unroll
    for (int k = 0; k < 32; k++) p.kpebuf[(size_t)kr * 32 + k] = v[k];
  } else if (u < 18) {
    int cb = (u - 10) * 64;
    for (int j = 0; j < 64; j++) p.gates16[(size_t)m * 1024 + cb + j] = (h16)siluf((float)ur[416 + cb + j]);
  } else if (u < 34) {
    const bool isq = u < 26; int hc = isq ? u - 18 : u - 26;
    const h16* src = ur + (isq ? 928 : 1440) + hc * 64;
    const float* gn = (isq ? p.diff_qn : p.diff_kn) + i * 64;
    float v[64]; float ss = 0;
#pragma unroll
    for (int k = 0; k < 64; k++) { v[k] = (float)src[k]; ss += v[k] * v[k]; }
    float r = 1.f / sqrtf(ss / 64 + EPSN);
#pragma unroll
    for (int k = 0; k < 64; k++) { v[k] = v[k] * r * gn[k]; if (!isq && !smp) p.o_dk[st_row(m, i) * 512 + hc * 64 + k] = v[k]; }
    if (smp) {
#pragma unroll
      for (int j = 0; j < 32; j++) {
        float c = p.ropeC64[t * 32 + j], s = p.ropeS64[t * 32 + j];
        float x1 = v[j], x2 = v[32 + j];
        v[j] = x1 * c - x2 * s; v[32 + j] = x2 * c + x1 * s;
      }
    }
    if (isq) {
      const float sc = LOG2E / 8.f; h16* dst = p.QB + ((size_t)m * 8 + hc) * 64;
#pragma unroll
      for (int k = 0; k < 64; k++) dst[k] = (h16)(v[k] * sc);
    } else {
      h16* dst = p.KB + ((size_t)hc * KM + kr) * 64;
#pragma unroll
      for (int k = 0; k < 64; k++) dst[k] = (h16)v[k];
    }
  } else if (u < 42) {
    int ch = u - 34; int h = ch >> 1, half = ch & 1;
    for (int j = 0; j < 64; j++) {
      float v = (float)ur[1952 + ch * 64 + j];
      if (!smp) p.o_dv[st_row(m, i) * 512 + ch * 64 + j] = v;
      p.VB[((size_t)h * 128 + half * 64 + j) * KM + kr] = (h16)v;
    }
  } else {
    int cb = (u - 42) * 64;
    for (int j = 0; j < 64; j++) p.gates16[(size_t)m * 1024 + 512 + cb + j] = (h16)siluf((float)ur[2464 + cb + j]);
  }
}
KERNEL nk_cache_even(Params p, int l, long n) {
  long g = GTID; if (g >= n) return;
  const int i = l >> 1;
  int u = g % 17; int pos = (g / 17) % PAST; int b = g / (17 * PAST);
  const int kr = MP + b * TKS + DS + pos;
  const size_t crow = ((size_t)(b * 2 + i) * PAST + pos);
  if (u == 0) {
    for (int k = 0; k < 128; k++) { float v = p.cache_mla_ckv[crow * 128 + k]; p.ckvbuf[(size_t)kr * 128 + k] = v; p.ckv16[(size_t)kr * 128 + k] = (h16)v; }
    for (int k = 0; k < 32; k++) { float v = p.cache_mla_kpe[crow * 32 + k]; p.kpebuf[(size_t)kr * 32 + k] = v; p.kpe16[(size_t)kr * 32 + k] = (h16)v; }
  } else if (u < 9) {
    int hc = u - 1;
    for (int k = 0; k < 64; k++) p.KB[((size_t)hc * KM + kr) * 64 + k] = (h16)p.cache_diff_k[crow * 512 + hc * 64 + k];
  } else {
    int ch = u - 9; int h = ch >> 1, half = ch & 1;
    for (int j = 0; j < 64; j++) p.VB[((size_t)h * 128 + half * 64 + j) * KM + kr] = (h16)p.cache_diff_v[crow * 512 + ch * 64 + j];
  }
}
KERNEL nk_kv(Params p, int l, long n) {
  long g = GTID; if (g >= n) return;
  const int i = l >> 1;
  int part = g & 1; int h = (g >> 1) & 7; int kr = g >> 4;
  const float* cr = p.ckvbuf + (size_t)kr * 128;
  const float* W = p.mla_wkvb + (size_t)i * 128 * 1024 + h * 128 + part * 64;
  float a[64];
#pragma unroll
  for (int j = 0; j < 64; j++) a[j] = 0;
  for (int k = 0; k < 128; k++) {
    float c = (float)(h16)cr[k];
#pragma unroll
    for (int j = 0; j < 64; j++) a[j] += c * W[(size_t)k * 1024 + j];
  }
  if (part == 0) {
    float ss = 0;
#pragma unroll
    for (int j = 0; j < 64; j++) ss += a[j] * a[j];
    float r = 1.f / sqrtf(ss / 64 + EPSN);
    h16* dst = p.KA + ((size_t)h * KM + kr) * 128;
#pragma unroll
    for (int j = 0; j < 64; j++) dst[j] = (h16)(a[j] * r * p.mla_kn_nope[i * 64 + j]);
    for (int j = 0; j < 32; j++) dst[64 + j] = (h16)p.kpebuf[(size_t)kr * 32 + j];
  } else {
#pragma unroll
    for (int j = 0; j < 64; j++) p.VA[((size_t)h * 64 + j) * KM + kr] = (h16)a[j];
  }
}
KERNEL nk_epi_odd(Params p, int l, long n) {
  long g = GTID; if (g >= n) return;
  const int i = l >> 1;
  int m = g / 52, u = g % 52;
  const h16* ur = p.ubuf + (size_t)m * 3328;
  const bool smp = m >= MP; const int t = tok_pos(m); const int kr = tok_keyrow(m);
  if (u < 16 || (u >= 32 && u < 42)) {
    int colbase, head; const float* gn; int kind;
    if (u < 8) { kind = 0; head = u; colbase = head * 64; gn = p.na_qn + i * 64; }
    else if (u < 16) { kind = 1; head = u - 8; colbase = 512 + head * 64; gn = p.na_kn + i * 64; }
    else if (u < 40) { kind = 2; head = u - 32; colbase = 2048 + head * 64; gn = p.gqa_qn + i * 64; }
    else { kind = 3; head = u - 40; colbase = 2560 + head * 64; gn = p.gqa_kn + i * 64; }
    float v[64]; float ss = 0;
#pragma unroll
    for (int k = 0; k < 64; k++) { v[k] = (float)ur[colbase + k]; ss += v[k] * v[k]; }
    float r = 1.f / sqrtf(ss / 64 + EPSN);
#pragma unroll
    for (int k = 0; k < 64; k++) v[k] = v[k] * r * gn[k];
    if (!smp) {
      if (kind == 1) { for (int k = 0; k < 64; k++) p.o_nk[st_row(m, i) * 512 + head * 64 + k] = v[k]; }
      if (kind == 3) { for (int k = 0; k < 64; k++) p.o_gk[st_row(m, i) * 128 + head * 64 + k] = v[k]; }
    }
    if (smp && kind >= 2) {
#pragma unroll
      for (int j = 0; j < 32; j++) {
        float c = p.ropeC64[t * 32 + j], s = p.ropeS64[t * 32 + j];
        float x1 = v[j], x2 = v[32 + j];
        v[j] = x1 * c - x2 * s; v[32 + j] = x2 * c + x1 * s;
      }
    }
    const float sc = LOG2E / 8.f;
    h16* dst;
    if (kind == 0) dst = p.QA + ((size_t)m * 8 + head) * 64;
    else if (kind == 1) dst = p.KA + ((size_t)head * KM + kr) * 64;
    else if (kind == 2) dst = p.QB + ((size_t)m * 8 + head) * 64;
    else dst = p.KB + ((size_t)head * KM + kr) * 64;
    const float mul = (kind == 0 || kind == 2) ? sc : 1.f;
#pragma unroll
    for (int k = 0; k < 64; k++) dst[k] = (h16)(v[k] * mul);
  } else if (u < 24) {
    int head = u - 16;
    for (int j = 0; j < 64; j++) {
      float v = (float)ur[1024 + head * 64 + j];
      if (!smp) p.o_nv[st_row(m, i) * 512 + head * 64 + j] = v;
      p.VA[((size_t)head * 64 + j) * KM + kr] = (h16)v;
    }
  } else if (u < 32) {
    int cb = (u - 24) * 64;
    for (int j = 0; j < 64; j++) p.gates16[(size_t)m * 1024 + cb + j] = (h16)siluf((float)ur[1536 + cb + j]);
  } else if (u < 44) {
    int head = u - 42;
    for (int j = 0; j < 64; j++) {
      float v = (float)ur[2688 + head * 64 + j];
      if (!smp) p.o_gv[st_row(m, i) * 128 + head * 64 + j] = v;
      p.VB[((size_t)head * 64 + j) * KM + kr] = (h16)v;
    }
  } else {
    int cb = (u - 44) * 64;
    for (int j = 0; j < 64; j++) p.gates16[(size_t)m * 1024 + 512 + cb + j] = (h16)siluf((float)ur[2816 + cb + j]);
  }
}
KERNEL nk_cache_odd(Params p, int l, long n) {
  long g = GTID; if (g >= n) return;
  const int i = l >> 1;
  int u = g % 20; int pos = (g / 20) % PAST; int b = g / (20 * PAST);
  const int kr = MP + b * TKS + DS + pos;
  const size_t crow = ((size_t)(b * 2 + i) * PAST + pos);
  if (u < 8) { for (int k = 0; k < 64; k++) p.KA[((size_t)u * KM + kr) * 64 + k] = (h16)p.cache_na_k[crow * 512 + u * 64 + k]; }
  else if (u < 16) { int h = u - 8; for (int j = 0; j < 64; j++) p.VA[((size_t)h * 64 + j) * KM + kr] = (h16)p.cache_na_v[crow * 512 + h * 64 + j]; }
  else if (u < 18) { int h = u - 16; for (int k = 0; k < 64; k++) p.KB[((size_t)h * KM + kr) * 64 + k] = (h16)p.cache_gqa_k[crow * 128 + h * 64 + k]; }
  else { int h = u - 18; for (int j = 0; j < 64; j++) p.VB[((size_t)h * 64 + j) * KM + kr] = (h16)p.cache_gqa_v[crow * 128 + h * 64 + j]; }
}
template <int DQK, int KP>
DEVFN void attn_dense_thread(const h16* q, const h16* K, const h16* VT, int kr0, int nk, float* out) {
  float qf[DQK];
#pragma unroll
  for (int j = 0; j < DQK; j++) qf[j] = (float)q[j];
  float o[64];
#pragma unroll
  for (int j = 0; j < 64; j++) o[j] = 0;
  float mx = -1e30f, sum = 0;
  for (int kk = 0; kk < nk; kk++) {
    const h16* kp = K + (size_t)(kr0 + kk) * KP;
    float s = 0;
#pragma unroll
    for (int j = 0; j < DQK; j++) s += qf[j] * (float)kp[j];
    float mn = fmaxf(mx, s); float al = exp2f_(mx - mn); float pe = exp2f_(s - mn);
    sum = sum * al + pe; mx = mn;
#pragma unroll
    for (int j = 0; j < 64; j++) o[j] = o[j] * al + pe * (float)VT[(size_t)j * KM + kr0 + kk];
  }
  float inv = 1.f / sum;
#pragma unroll
  for (int j = 0; j < 64; j++) out[j] = o[j] * inv;
}
KERNEL nk_attn_dense(Params p, int kind, int mlo, int mhi, long n) {
  long g = GTID; if (g >= n) return;
  const int nch = kind == 1 ? 2 : 1;
  int ch = g % nch; int head = (g / nch) % 8; int m = mlo + g / (nch * 8);
  if (m >= mhi) return;
  int kr0, nk;
  if (m < MP) { kr0 = (m / SEQ) * SEQ; nk = SEQ; } else { kr0 = MP + ((m - MP) / DS) * TKS; nk = TKS; }
  if (kind == 0) {
    attn_dense_thread<96, 128>(p.QA + ((size_t)m * 8 + head) * 96, p.KA + (size_t)head * KM * 128, p.VA + (size_t)head * 64 * KM, kr0, nk,
                          p.abuf + (size_t)m * 1536 + head * 64);
  } else if (kind == 1) {
    attn_dense_thread<64, 64>(p.QB + ((size_t)m * 8 + head) * 64, p.KB + (size_t)head * KM * 64,
                          p.VB + ((size_t)(head >> 1) * 128 + ch * 64) * KM, kr0, nk, p.abuf + (size_t)m * 1536 + 512 + head * 128 + ch * 64);
  } else if (kind == 2) {
    attn_dense_thread<64, 64>(p.QA + ((size_t)m * 8 + head) * 64, p.KA + (size_t)head * KM * 64, p.VA + (size_t)head * 64 * KM, kr0, nk,
                          p.abuf + (size_t)m * 1536 + head * 64);
  } else {
    attn_dense_thread<64, 64>(p.QB + ((size_t)m * 8 + head) * 64, p.KB + (size_t)(head >> 2) * KM * 64, p.VB + (size_t)(head >> 2) * 64 * KM,
                          kr0, nk, p.abuf + (size_t)m * 1536 + 512 + head * 64);
  }
}
KERNEL nk_attn_na(Params p, int l, long n) {
  long g = GTID; if (g >= n) return;
  const int i = l >> 1;
  int head = g & 7; int ms = g >> 3; int m = MP + ms;
  int b = ms / DS, t = ms % DS; int r = t / GW, c = t % GW;
  int rs = r - 4; rs = rs < 0 ? 0 : (rs > GROWS - 8 ? GROWS - 8 : rs);
  int cs = c - 8; cs = cs < 0 ? 0 : (cs > GW - 16 ? GW - 16 : cs);
  const h16* q = p.QA + ((size_t)m * 8 + head) * 64;
  const h16* K = p.KA + (size_t)head * KM * 64; const h16* VT = p.VA + (size_t)head * 64 * KM;
  const int kbase = MP + b * TKS;
  const float* rpb = p.na_rpb + ((size_t)i * 8 + head) * 15 * 31;
  float qf[64], o[64];
#pragma unroll
  for (int j = 0; j < 64; j++) { qf[j] = (float)q[j]; o[j] = 0; }
  float mx = -1e30f, sum = 0;
  for (int kk = 0; kk < 128 + PAST; kk++) {
    int kr; float bias = 0;
    if (kk < 128) { int ri = kk >> 4, cj = kk & 15; kr = kbase + (rs + ri) * GW + cs + cj; bias = rpb[(rs + ri - r + 7) * 31 + (cs + cj - c + 15)] * LOG2E; }
    else kr = kbase + DS + (kk - 128);
    const h16* kp = K + (size_t)kr * 64;
    float s = bias;
#pragma unroll
    for (int j = 0; j < 64; j++) s += qf[j] * (float)kp[j];
    float mn = fmaxf(mx, s); float al = exp2f_(mx - mn); float pe = exp2f_(s - mn);
    sum = sum * al + pe; mx = mn;
#pragma unroll
    for (int j = 0; j < 64; j++) o[j] = o[j] * al + pe * (float)VT[(size_t)j * KM + kr];
  }
  float inv = 1.f / sum; float* out = p.abuf + (size_t)m * 1536 + head * 64;
#pragma unroll
  for (int j = 0; j < 64; j++) out[j] = o[j] * inv;
}
KERNEL nk_fin(Params p, int l, long n) {
  long g = GTID; if (g >= n) return;
  const int i = l >> 1;
  if (l & 1) {
    int ch = g & 15; int m = g >> 4;
    for (int j = 0; j < 64; j++) {
      int col = ch * 64 + j;
      p.O16[(size_t)m * 1024 + col] = (h16)(p.abuf[(size_t)m * 1536 + col] * (float)p.gates16[(size_t)m * 1024 + col]);
    }
  } else {
    int u = g % 12; int m = g / 12;
    if (u < 8) {
      for (int j = 0; j < 64; j++) {
        int col = u * 64 + j;
        p.O16[(size_t)m * 1024 + col] = (h16)(p.abuf[(size_t)m * 1536 + col] * (float)p.gates16[(size_t)m * 1024 + col]);
      }
    } else {
      int h = u - 8; float lam = p.lamv[i]; float lam_init = 0.8f - 0.6f * expf(-0.3f * l);
      const float* a1 = p.abuf + (size_t)m * 1536 + 512 + (h * 2) * 128; const float* a2 = a1 + 128;
      float ss = 0;
      for (int j = 0; j < 128; j++) { float d = a1[j] - lam * a2[j]; ss += d * d; }
      float r = 1.f / sqrtf(ss / 128 + EPSN);
      for (int j = 0; j < 128; j++) {
        float d = (a1[j] - lam * a2[j]) * r * p.diff_subln[i * 128 + j] * (1.f - lam_init);
        int col = 512 + h * 128 + j;
        p.O16[(size_t)m * 1024 + col] = (h16)(d * (float)p.gates16[(size_t)m * 1024 + col]);
      }
    }
  }
}
KERNEL nk_outproj(Params p, int l, long n) {
  long g = GTID; if (g >= n) return;
  int m = g >> 10, col = g & 1023;
  const float* W = ((l & 1) ? p.w_out_odd : p.w_out_even) + (size_t)(l >> 1) * 1024 * 1024 + col;
  const h16* o = p.O16 + (size_t)m * 1024;
  float acc = 0;
  for (int k = 0; k < 1024; k++) acc += (float)o[k] * W[(size_t)k * 1024];
  float gate = p.modv[((size_t)l * NCV + tok_cv(m)) * 3072 + 2048 + col];
  p.Y[(size_t)m * 1024 + col] = xrow(p, l, m)[col] + gate * acc;
}


#endif
#ifndef CPU_EMU
typedef _Float16 h16x8 __attribute__((ext_vector_type(8)));
typedef _Float16 h16x4 __attribute__((ext_vector_type(4)));
typedef float f32x16 __attribute__((ext_vector_type(16)));
typedef float f32x4 __attribute__((ext_vector_type(4)));
typedef unsigned u32x4 __attribute__((ext_vector_type(4)));
DEVFN size_t pidx(int R, int row, int k) { return ((size_t)(k >> 6) * R + row) * 64 + (k & 63); }
DEVFN size_t vidx(int vrow, int kr) { return ((size_t)(kr >> 6) * 512 + vrow) * 64 + (kr & 63); }
DEVFN float max3f(float a, float b, float c) { float r; asm("v_max3_f32 %0, %1, %2, %3" : "=v"(r) : "v"(a), "v"(b), "v"(c)); return r; }
DEVFN int tid_op() { int t = threadIdx.x; asm volatile("" : "+v"(t)); return t; }

DEVFN int even_col(int np) { return np < 416 ? np : (np < 512 ? -1 : np - 96); }

constexpr int G_STAGE = 49152, G_NSTAGE = 3, G_LDS = G_STAGE * G_NSTAGE;
DEVFN int img_off(int r, int c) { return r * 128 + ((c ^ ((r >> 1) & 7)) << 4); }
template <int R>
DEVFN void stage_rows(const h16* g, int ld, char* lds, int tid) {
#pragma unroll
  for (int i = 0; i < R / 64; i++) {
    int r = (tid >> 3) + 64 * i; int c = (tid & 7) ^ ((r >> 1) & 7);
    __builtin_amdgcn_global_load_lds((const unsigned*)(g + (size_t)r * ld + c * 8), (unsigned*)(lds + i * 8192 + tid * 16), 16, 0, 0);
  }
}
#define WAITV(n) asm volatile("s_waitcnt vmcnt(" #n ")" ::: "memory")
#define RAWBAR() do { asm volatile("s_waitcnt lgkmcnt(0)" ::: "memory"); __builtin_amdgcn_s_barrier(); } while (0)
template <bool TR>
DEVFN void gemm_tile(const h16* A, int RA, const h16* Bt, int RB, int K, int m0, int n0, char* lds, f32x16 (&acc)[2][2]) {
  const int TIDX = tid_op();
  const int tid = TIDX, lane = tid & 63, w = tid >> 6, wm = w >> 1, wn = w & 1;
  const int nt = K / 64;
  const h16* Ag = A + (size_t)m0 * 64; const h16* Bg = Bt + (size_t)n0 * 64; const size_t pa = (size_t)RA * 64, pb = (size_t)RB * 64;
#pragma unroll
  for (int a = 0; a < 2; a++)
#pragma unroll
    for (int b = 0; b < 2; b++)
#pragma unroll
      for (int r = 0; r < 16; r++) acc[a][b][r] = 0.f;
  stage_rows<256>(Ag, 64, lds, tid); stage_rows<128>(Bg, 64, lds + 32768, tid);
  if (nt > 1) { stage_rows<256>(Ag + pa, 64, lds + G_STAGE, tid); stage_rows<128>(Bg + pb, 64, lds + G_STAGE + 32768, tid); }
  const int ra = wm * 64 + (lane & 31), rb = wn * 64 + (lane & 31), ch = lane >> 5;
  auto piece = [&](const h16* g, char* s, int i) {
    const int r = (tid >> 3) + 64 * i; const int c = (tid & 7) ^ ((r >> 1) & 7);
    __builtin_amdgcn_global_load_lds((const unsigned*)(g + (size_t)r * 64 + c * 8), (unsigned*)(s + i * 8192 + tid * 16), 16, 0, 0);
  };
  for (int t = 0; t < nt; t++) {
    if (t + 1 < nt) WAITV(6); else WAITV(0);
    RAWBAR();
    const bool pre = t + 2 < nt;
    char* sn = lds + ((t + 2) % 3) * G_STAGE; const h16* An = Ag + (t + 2) * pa; const h16* Bn = Bg + (t + 2) * pb;
    const char* sa = lds + (t % 3) * G_STAGE; const char* sb = sa + 32768;
    h16x8 af[2][2], bf[2][2];
#pragma unroll
    for (int mb = 0; mb < 2; mb++) af[0][mb] = *(const h16x8*)(sa + img_off(ra + mb * 32, ch));
#pragma unroll
    for (int nb = 0; nb < 2; nb++) bf[0][nb] = *(const h16x8*)(sb + img_off(rb + nb * 32, ch));
#pragma unroll
    for (int ks = 0; ks < 4; ks++) {
      const int cur = ks & 1, nxt = cur ^ 1;
      if (ks < 3) {
#pragma unroll
        for (int mb = 0; mb < 2; mb++) af[nxt][mb] = *(const h16x8*)(sa + img_off(ra + mb * 32, 2 * (ks + 1) + ch));
#pragma unroll
        for (int nb = 0; nb < 2; nb++) bf[nxt][nb] = *(const h16x8*)(sb + img_off(rb + nb * 32, 2 * (ks + 1) + ch));
      }
      if (pre) {
        if (ks == 0) { piece(An, sn, 0); piece(An, sn, 1); }
        else if (ks == 1) { piece(An, sn, 2); piece(An, sn, 3); }
        else if (ks == 2) { piece(Bn, sn + 32768, 0); piece(Bn, sn + 32768, 1); }
      }
#pragma unroll
      for (int mb = 0; mb < 2; mb++)
#pragma unroll
        for (int nb = 0; nb < 2; nb++) {
          if (TR) acc[mb][nb] = __builtin_amdgcn_mfma_f32_32x32x16_f16(bf[cur][nb], af[cur][mb], acc[mb][nb], 0, 0, 0);
          else acc[mb][nb] = __builtin_amdgcn_mfma_f32_32x32x16_f16(af[cur][mb], bf[cur][nb], acc[mb][nb], 0, 0, 0);
        }
      __builtin_amdgcn_sched_barrier(0);
    }
  }
  RAWBAR();
}

DEVFN float wsum32(float v) { return v + __shfl_xor(v, 32); }

template <class RsF, class DstF>
DEVFN void epi_head64(const Params& p, const f32x16 (&acc)[2][2], int mbase, RsF rsf, const float* bias, const float* gain, bool rope, float oscale,
                      float* state, int spitch, int scol, int ilayer, DstF dstf) {
  const int TIDX = tid_op();
  const int lane = TIDX & 63, h = lane >> 5;
#pragma unroll
  for (int mb = 0; mb < 2; mb++) {
    const int m = mbase + mb * 32 + (lane & 31);
    const float rs = rsf(m);
    float v[2][16]; float ss = 0;
#pragma unroll
    for (int nb = 0; nb < 2; nb++)
#pragma unroll
      for (int q = 0; q < 4; q++) {
        const int j = nb * 32 + 8 * q + 4 * h;
        f32x4 b = bias ? *(const f32x4*)(bias + j) : (f32x4){0.f, 0.f, 0.f, 0.f};
#pragma unroll
        for (int e = 0; e < 4; e++) { float x = acc[mb][nb][q * 4 + e] * rs + b[e]; v[nb][q * 4 + e] = x; ss += x * x; }
      }
    ss = wsum32(ss);
    const float rr = 1.f / sqrtf(ss * (1.f / 64.f) + EPSN);
#pragma unroll
    for (int nb = 0; nb < 2; nb++)
#pragma unroll
      for (int q = 0; q < 4; q++) {
        const int j = nb * 32 + 8 * q + 4 * h;
        f32x4 g = *(const f32x4*)(gain + j);
#pragma unroll
        for (int e = 0; e < 4; e++) v[nb][q * 4 + e] *= rr * g[e];
      }
    const bool smp = m >= MP;
    if (state && !smp) {
      float* sp = state + st_row(m, ilayer) * spitch + scol;
#pragma unroll
      for (int nb = 0; nb < 2; nb++)
#pragma unroll
        for (int q = 0; q < 4; q++) { f32x4 o = {v[nb][q * 4], v[nb][q * 4 + 1], v[nb][q * 4 + 2], v[nb][q * 4 + 3]}; *(f32x4*)(sp + nb * 32 + 8 * q + 4 * h) = o; }
    }
    if (rope && smp) {
      const int t = tok_pos(m);
#pragma unroll
      for (int q = 0; q < 4; q++) {
        f32x4 c = *(const f32x4*)(p.ropeC64 + t * 32 + 8 * q + 4 * h), s = *(const f32x4*)(p.ropeS64 + t * 32 + 8 * q + 4 * h);
#pragma unroll
        for (int e = 0; e < 4; e++) { float x1 = v[0][q * 4 + e], x2 = v[1][q * 4 + e]; v[0][q * 4 + e] = x1 * c[e] - x2 * s[e]; v[1][q * 4 + e] = x2 * c[e] + x1 * s[e]; }
      }
    }
    h16* dst = dstf(m);
#pragma unroll
    for (int nb = 0; nb < 2; nb++)
#pragma unroll
      for (int q = 0; q < 4; q++) {
        h16x4 o;
#pragma unroll
        for (int e = 0; e < 4; e++) o[e] = (h16)(v[nb][q * 4 + e] * oscale);
        *(h16x4*)(dst + nb * 32 + 8 * q + 4 * h) = o;
      }
  }
}
template <class RsF, class DstF>
DEVFN void epi_head32(const Params& p, const f32x16 (&acc)[2][2], int mbase, RsF rsf, const float* bias, const float* gain, bool rope, float oscale,
                      float* state, int ilayer, DstF dstf, float* dual = nullptr) {
  const int TIDX = tid_op();
  const int lane = TIDX & 63, h = lane >> 5;
#pragma unroll
  for (int mb = 0; mb < 2; mb++) {
    const int m = mbase + mb * 32 + (lane & 31);
    const float rs = rsf(m);
    float v[16]; float ss = 0;
#pragma unroll
    for (int q = 0; q < 4; q++) {
      const int j = 8 * q + 4 * h;
      f32x4 b = bias ? *(const f32x4*)(bias + j) : (f32x4){0.f, 0.f, 0.f, 0.f};
#pragma unroll
      for (int e = 0; e < 4; e++) { float x = acc[mb][0][q * 4 + e] * rs + b[e]; v[q * 4 + e] = x; ss += x * x; }
    }
    ss = wsum32(ss);
    const float rr = 1.f / sqrtf(ss * (1.f / 32.f) + EPSN);
#pragma unroll
    for (int q = 0; q < 4; q++) {
      f32x4 g = *(const f32x4*)(gain + 8 * q + 4 * h);
#pragma unroll
      for (int e = 0; e < 4; e++) v[q * 4 + e] *= rr * g[e];
    }
    const bool smp = m >= MP;
    if (state && !smp) {
      float* sp = state + st_row(m, ilayer) * 32;
#pragma unroll
      for (int q = 0; q < 4; q++) { f32x4 o = {v[q * 4], v[q * 4 + 1], v[q * 4 + 2], v[q * 4 + 3]}; *(f32x4*)(sp + 8 * q + 4 * h) = o; }
    }
    if (rope && smp) {
      const int t = tok_pos(m);
#pragma unroll
      for (int q = 0; q < 2; q++) {
        f32x4 c = *(const f32x4*)(p.ropeC32 + t * 16 + 8 * q + 4 * h), s = *(const f32x4*)(p.ropeS32 + t * 16 + 8 * q + 4 * h);
#pragma unroll
        for (int e = 0; e < 4; e++) { float x1 = v[q * 4 + e], x2 = v[(q + 2) * 4 + e]; v[q * 4 + e] = x1 * c[e] - x2 * s[e]; v[(q + 2) * 4 + e] = x2 * c[e] + x1 * s[e]; }
      }
    }
    h16* dst = dstf(m);
#pragma unroll
    for (int q = 0; q < 4; q++) {
      h16x4 o;
#pragma unroll
      for (int e = 0; e < 4; e++) o[e] = (h16)(v[q * 4 + e] * oscale);
      *(h16x4*)(dst + 8 * q + 4 * h) = o;
      if (dual) { for (int e = 0; e < 4; e++) dual[(size_t)tok_keyrow(m) * 32 + 8 * q + 4 * h + e] = v[q * 4 + e]; }
    }
  }
}
template <class RsF, class KrF>
DEVFN void epi_vt(const f32x16 (&acc)[2][2], int mbase, RsF rsf, const float* bias  , float* state, int spitch, int scol, int ilayer,
                  h16* vbuf, int vrow0, KrF krf) {
  const int TIDX = tid_op();
  const int lane = TIDX & 63, h = lane >> 5, e0 = lane & 31;
#pragma unroll
  for (int mb = 0; mb < 2; mb++)
#pragma unroll
    for (int q = 0; q < 4; q++) {
      const int mq = mbase + mb * 32 + 8 * q + 4 * h;
      float rs[4];
#pragma unroll
      for (int e = 0; e < 4; e++) rs[e] = rsf(mq + e);
      const int kr = krf(mq);
#pragma unroll
      for (int nb = 0; nb < 2; nb++) {
        const int col = nb * 32 + e0; const float b = bias ? bias[col] : 0.f;
        h16x4 o;
#pragma unroll
        for (int e = 0; e < 4; e++) {
          float x = acc[mb][nb][q * 4 + e] * rs[e] + b; o[e] = (h16)x;
          if (state && mq < MP) state[st_row(mq + e, ilayer) * spitch + scol + col] = x;
        }
        *(h16x4*)(vbuf + vidx(vrow0 + col, kr)) = o;
      }
    }
}

DEVFN void inproj_tile(const Params& p, int l, int mt, int ntile, char* lds, bool dry = false) {
  const int TIDX = tid_op();
  const int i = l >> 1; const bool odd = l & 1;
  const int m0 = mt * 256, n0 = ntile * 128;
  const int lane = TIDX & 63, w = TIDX >> 6, wm = w >> 1, wn = w & 1, h = lane >> 5;
  const bool isV = odd ? ((ntile >= 8 && ntile < 12) || ntile == 21) : (ntile >= 16 && ntile < 20);
  f32x16 acc[2][2];
  for (int rk = 1; rk < REP_GK; rk++) {
    f32x16 acc2[2][2];
    gemm_tile<true>(p.xs16, M, (p.win16 + (size_t)l * NPO * D), NPO, D, m0, n0, lds, acc2);
    asm volatile("" :: "v"(acc2[0][0]), "v"(acc2[0][1]), "v"(acc2[1][0]), "v"(acc2[1][1]));
  }
  if (isV) gemm_tile<false>(p.xs16, M, (p.win16 + (size_t)l * NPO * D), NPO, D, m0, n0, lds, acc);
  else gemm_tile<true>(p.xs16, M, (p.win16 + (size_t)l * NPO * D), NPO, D, m0, n0, lds, acc);
  const int mbase = m0 + wm * 64, npw = n0 + wn * 64;
  const int cv = tok_cv(m0);
  const float* bias = p.biasv + ((size_t)l * NCV + cv) * NPO + npw;
  const float* rowss = p.rowss_l + (size_t)l * M;
  auto rsf = [&](int m) { return 1.f / sqrtf(rowss[m] * (1.f / D) + EPSN); };
  auto krf = [&](int m) { return tok_keyrow(m); };
  const float QS = LOG2E / 8.f;
  int gcol = -1;
  if (!odd) { if (ntile >= 4 && ntile < 8) gcol = npw - 512; else if (ntile >= 20) gcol = npw - 2560 + 512; }
  else { if (ntile >= 12 && ntile < 16) gcol = npw - 1536; else if (ntile >= 22) gcol = npw - 2816 + 512; }
  if (gcol >= 0) {
#pragma unroll
    for (int mb = 0; mb < 2; mb++) {
      const int m = mbase + mb * 32 + (lane & 31); const float rs = rsf(m);
#pragma unroll
      for (int nb = 0; nb < 2; nb++)
#pragma unroll
        for (int q = 0; q < 4; q++) {
          const int j = nb * 32 + 8 * q + 4 * h; f32x4 b = *(const f32x4*)(bias + j); h16x4 o;
#pragma unroll
          for (int e = 0; e < 4; e++) o[e] = (h16)siluf(acc[mb][nb][q * 4 + e] * rs + b[e]);
          *(h16x4*)(p.gates16 + (size_t)m * 1024 + gcol + j) = o;
        }
    }
    return;
  }
  if (!odd) {
    if (ntile < 2) {
#pragma unroll
      for (int mb = 0; mb < 2; mb++) {
        const int m = mbase + mb * 32 + (lane & 31); const float rs = rsf(m); float ss = 0;
#pragma unroll
        for (int nb = 0; nb < 2; nb++)
#pragma unroll
          for (int q = 0; q < 4; q++) {
            const int j = nb * 32 + 8 * q + 4 * h; f32x4 b = *(const f32x4*)(bias + j); h16x4 o;
#pragma unroll
            for (int e = 0; e < 4; e++) { float x = acc[mb][nb][q * 4 + e] * rs + b[e]; o[e] = (h16)x; float xr = (float)o[e]; ss += xr * xr; }
            *(h16x4*)(p.qa16 + pidx(M, m, npw + j)) = o;
          }
        ss = wsum32(ss);
        if (h == 0 && !dry) atomicAdd(p.rowss_qa + (size_t)i * M + m, ss);
      }
    } else if (ntile == 2) {
      float* red = (float*)lds;
      float v[2][2][16];
#pragma unroll
      for (int mb = 0; mb < 2; mb++) {
        const int m = mbase + mb * 32 + (lane & 31); const float rs = rsf(m); float ss = 0;
#pragma unroll
        for (int nb = 0; nb < 2; nb++)
#pragma unroll
          for (int q = 0; q < 4; q++) {
            const int j = nb * 32 + 8 * q + 4 * h; f32x4 b = *(const f32x4*)(bias + j);
#pragma unroll
            for (int e = 0; e < 4; e++) { float x = acc[mb][nb][q * 4 + e] * rs + b[e]; v[mb][nb][q * 4 + e] = x; ss += x * x; }
          }
        ss = wsum32(ss);
        if (h == 0) red[wn * 256 + wm * 64 + mb * 32 + lane] = ss;
      }
      __syncthreads();
#pragma unroll
      for (int mb = 0; mb < 2; mb++) {
        const int rl = wm * 64 + mb * 32 + (lane & 31); const int m = m0 + rl;
        const float rr = 1.f / sqrtf((red[rl] + red[256 + rl]) * (1.f / 128.f) + EPSN);
        const int kr = tok_keyrow(m);
#pragma unroll
        for (int nb = 0; nb < 2; nb++)
#pragma unroll
          for (int q = 0; q < 4; q++) {
            const int j = wn * 64 + nb * 32 + 8 * q + 4 * h; f32x4 g = *(const f32x4*)(p.mla_kva_norm + i * 128 + j); f32x4 o; h16x4 oh;
#pragma unroll
            for (int e = 0; e < 4; e++) { o[e] = v[mb][nb][q * 4 + e] * rr * g[e]; oh[e] = (h16)o[e]; }
            if (m < MP) *(f32x4*)(p.o_ckv + st_row(m, i) * 128 + j) = o;
            *(h16x4*)(p.ckv16 + pidx(KM, kr, j)) = oh;
#if DUAL_WRITE
            *(f32x4*)(p.ckvbuf + (size_t)kr * 128 + j) = o;
#endif
          }
      }
      __syncthreads();
    } else if (ntile == 3) {
      if (wn == 0) {
        epi_head32(p, acc, mbase, rsf, bias, p.mla_kn_rope + i * 32, true, 1.f, p.o_kpe, i, [&](int m) { return p.kpe16 + (size_t)tok_keyrow(m) * 32; },
                   DUAL_WRITE ? p.kpebuf : nullptr);
      }
    } else if (ntile < 12) {
      const int hc = (ntile - 8) * 2 + wn;
      epi_head64(p, acc, mbase, rsf, bias, p.diff_qn + i * 64, true, QS, nullptr, 0, 0, i, [&](int m) { return p.QB + ((size_t)m * 8 + hc) * 64; });
    } else if (ntile < 16) {
      const int hc = (ntile - 12) * 2 + wn;
      epi_head64(p, acc, mbase, rsf, bias, p.diff_kn + i * 64, true, 1.f, p.o_dk, 512, hc * 64, i, [&](int m) { return p.KB + ((size_t)hc * KM + tok_keyrow(m)) * 64; });
    } else {
      const int vcol = (ntile - 16) * 128 + wn * 64;
      epi_vt(acc, mbase, rsf, bias, p.o_dv, 512, vcol, i, p.VB, vcol, krf);
    }
  } else {
    if (ntile < 4) {
      const int hd = ntile * 2 + wn;
      epi_head64(p, acc, mbase, rsf, bias, p.na_qn + i * 64, false, QS, nullptr, 0, 0, i, [&](int m) { return p.QA + ((size_t)m * 8 + hd) * 64; });
    } else if (ntile < 8) {
      const int hd = (ntile - 4) * 2 + wn;
      epi_head64(p, acc, mbase, rsf, bias, p.na_kn + i * 64, false, 1.f, p.o_nk, 512, hd * 64, i, [&](int m) { return p.KA + ((size_t)hd * KM + tok_keyrow(m)) * 64; });
    } else if (ntile < 12) {
      const int vcol = (ntile - 8) * 128 + wn * 64;
      epi_vt(acc, mbase, rsf, bias, p.o_nv, 512, vcol, i, p.VA, vcol, krf);
    } else if (ntile < 20) {
      const int hd = (ntile - 16) * 2 + wn;
      epi_head64(p, acc, mbase, rsf, bias, p.gqa_qn + i * 64, true, QS, nullptr, 0, 0, i, [&](int m) { return p.QB + ((size_t)m * 8 + hd) * 64; });
    } else if (ntile == 20) {
      epi_head64(p, acc, mbase, rsf, bias, p.gqa_kn + i * 64, true, 1.f, p.o_gk, 128, wn * 64, i, [&](int m) { return p.KB + ((size_t)wn * KM + tok_keyrow(m)) * 64; });
    } else {
      const int vcol = wn * 64;
      epi_vt(acc, mbase, rsf, bias, p.o_gv, 128, vcol, i, p.VB, vcol, krf);
    }
  }
}
DEVFN void qgemm_tile(const Params& p, int l, int mt, int head, char* lds) {
  const int TIDX = tid_op();
  const int i = l >> 1; const int m0 = mt * 256;
  const int w = TIDX >> 6, wm = w >> 1, wn = w & 1;
  f32x16 acc[2][2];
  gemm_tile<true>(p.qa16, M, (p.wqb16 + (size_t)i * 1024 * 256), 1024, 256, m0, head * 128, lds, acc);
  const float* rq = p.rowss_qa + (size_t)i * M;
  auto rsf = [&](int m) { return 1.f / sqrtf(rq[m] * (1.f / 256.f) + EPSN); };
  const float sc = LOG2E / sqrtf(96.f);
  if (wn == 0) epi_head64(p, acc, m0 + wm * 64, rsf, nullptr, p.mla_qn_nope + i * 64, false, sc, nullptr, 0, 0, i, [&](int m) { return p.QA + ((size_t)m * 8 + head) * 96; });
  else epi_head32(p, acc, m0 + wm * 64, rsf, nullptr, p.mla_qn_rope + i * 32, true, sc, nullptr, i, [&](int m) { return p.QA + ((size_t)m * 8 + head) * 96 + 64; });
}
DEVFN void kvgemm_tile(const Params& p, int l, int mt, int ntile, char* lds) {
  const int TIDX = tid_op();
  const int i = l >> 1; const int m0 = mt * 256;
  const int lane = TIDX & 63, w = TIDX >> 6, wm = w >> 1, wn = w & 1, h = lane >> 5;
  f32x16 acc[2][2];
  auto one = [](int) { return 1.f; };
  if (ntile < 4) {
    gemm_tile<true>(p.ckv16, KM, (p.wkvb16 + (size_t)i * 1024 * 128), 1024, 128, m0, ntile * 128, lds, acc);
    const int head = ntile * 2 + wn;
    epi_head64(p, acc, m0 + wm * 64, one, nullptr, p.mla_kn_nope + i * 64, false, 1.f, nullptr, 0, 0, i, [&](int m) { return p.KA + ((size_t)head * KM + m) * 128; });
#pragma unroll
    for (int mb = 0; mb < 2; mb++) {
      const int kr = m0 + wm * 64 + mb * 32 + (lane & 31);
      const h16x8* s = (const h16x8*)(p.kpe16 + (size_t)kr * 32 + h * 16);
      h16x8* d = (h16x8*)(p.KA + ((size_t)head * KM + kr) * 128 + 64 + h * 16);
      d[0] = s[0]; d[1] = s[1];
    }
  } else {
    gemm_tile<false>(p.ckv16, KM, (p.wkvb16 + (size_t)i * 1024 * 128), 1024, 128, m0, ntile * 128, lds, acc);
    const int head = (ntile - 4) * 2 + wn;
    epi_vt(acc, m0 + wm * 64, one, nullptr, nullptr, 0, 0, i, p.VA, head * 64, [](int m) { return m; });
  }
}
DEVFN void outproj_tile(const Params& p, int l, int mt, int ntile, char* lds, bool dry = false) {
  const int TIDX = tid_op();
  const int m0 = mt * 256, n0 = ntile * 128;
  const int lane = TIDX & 63, w = TIDX >> 6, wm = w >> 1, wn = w & 1, h = lane >> 5;
  f32x16 acc[2][2];
  gemm_tile<true>(p.O16, M, (p.wout16 + (size_t)l * D * D), 1024, D, m0, n0, lds, acc);
  const int cv = tok_cv(m0); const int nw0 = n0 + wn * 64;
  const float* gate = p.modv + ((size_t)l * NCV + cv) * 3072 + 2048 + nw0;
  const float* nsc = p.modv + ((size_t)(l + 1) * NCV + cv) * 3072 + 1024 + nw0;
  const float* nnw = p.norm_w + (l + 1) * D + nw0;
#pragma unroll
  for (int mb = 0; mb < 2; mb++) {
    const int m = m0 + wm * 64 + mb * 32 + (lane & 31);
    const float* xr = xrow(p, l, m) + nw0; float* yr = p.Y + (size_t)m * D + nw0;
    float ss = 0;
#pragma unroll
    for (int nb = 0; nb < 2; nb++)
#pragma unroll
      for (int q = 0; q < 4; q++) {
        const int j = nb * 32 + 8 * q + 4 * h;
        f32x4 x = *(const f32x4*)(xr + j), g = *(const f32x4*)(gate + j), o;
#pragma unroll
        for (int e = 0; e < 4; e++) { o[e] = x[e] + g[e] * acc[mb][nb][q * 4 + e]; ss += o[e] * o[e]; }
        if (!dry) *(f32x4*)(yr + j) = o;
        if (l < 3 && !dry) {
          f32x4 s = *(const f32x4*)(nsc + j), nw = *(const f32x4*)(nnw + j); h16x4 oh;
#pragma unroll
          for (int e = 0; e < 4; e++) oh[e] = (h16)(o[e] * nw[e] * (1.f + s[e]));
          *(h16x4*)(p.xs16 + pidx(M, m, nw0 + j)) = oh;
        }
      }
    if (l < 3 && !dry) { ss = wsum32(ss); if (h == 0) atomicAdd(p.rowss_l + (size_t)(l + 1) * M + m, ss); }
  }
}
struct AttnItem {
  const h16 *k0, *k1; int kld;
  const h16 *v0, *v1;
  int kr0, nt0, kr1, nt1;
};
constexpr int A_RING = 3 * 32768;

template <int DQK, int NKI, int NVI, int NDB, bool NAMASK>
DEVFN void attn_core(const AttnItem& it, const h16* qptr, int qpitch, int ksel, int ta, int tb, const float* rpbl, int na_dr0  , int na_c,
                     char* lds, f32x16 (&o)[NDB], float& lsum_out) {
  const int TIDX = tid_op();
  constexpr int NIMG = NKI + NVI; constexpr int STG = NIMG * 8192;
  const int tid = TIDX, lane = tid & 63, h = lane >> 5;
  h16x8 qf[DQK / 16];
#pragma unroll
  for (int ks = 0; ks < DQK / 16; ks++) qf[ks] = *(const h16x8*)(qptr + (size_t)(lane & 31) * qpitch + ks * 16 + 8 * h);
#pragma unroll
  for (int db = 0; db < NDB; db++)
#pragma unroll
    for (int r = 0; r < 16; r++) o[db][r] = 0.f;
  float m_run = 0.f, lsum = 0.f; bool first = true;
  const int nt = it.nt0 + it.nt1;
  auto stage = [&](int t) {
    char* s = lds + (t % 3) * STG; const int kr = t < it.nt0 ? it.kr0 + 64 * t : it.kr1 + 64 * (t - it.nt0);
    stage_rows<64>(it.k0 + (size_t)kr * it.kld, it.kld, s, tid);
    if (NKI == 2) stage_rows<64>(it.k1 + (size_t)kr * it.kld, it.kld, s + 8192, tid);
    stage_rows<64>(it.v0 + (size_t)(kr >> 6) * (512 * 64), 64, s + NKI * 8192, tid);
    if (NVI == 2) stage_rows<64>(it.v1 + (size_t)(kr >> 6) * (512 * 64), 64, s + NKI * 8192 + 8192, tid);
  };
  stage(0); if (nt > 1) stage(1);
  const int l5 = lane & 31;
  const int prow = (l5 & 19) | ((l5 & 4) << 1) | ((l5 & 8) >> 1);
  int na_cs = na_c - 8; na_cs = na_cs < 0 ? 0 : (na_cs > GW - 16 ? GW - 16 : na_cs);
  for (int t = 0; t < nt; t++) {
    if (t + 1 < nt) { if (NIMG == 2) WAITV(2); else if (NIMG == 3) WAITV(3); else WAITV(4); } else WAITV(0);
    RAWBAR();
    if (t + 2 < nt) stage(t + 2);
    const bool active = (t >= it.nt0) || (t >= ta && t < tb);
    if (active) {
      const char* s = lds + (t % 3) * STG;
      const char* sv = s + NKI * 8192;
      h16x8 kf[2][DQK / 16];
#pragma unroll
      for (int kb = 0; kb < 2; kb++)
#pragma unroll
        for (int ks = 0; ks < DQK / 16; ks++) {
          const int img = (DQK == 96) ? (ks >> 2) : ksel;
          kf[kb][ks] = *(const h16x8*)(s + img * 8192 + img_off(32 * kb + prow, 2 * (ks & 3) + h));
        }
      __builtin_amdgcn_sched_barrier(0);
      f32x16 st[2];
#pragma unroll
      for (int kb = 0; kb < 2; kb++) {
#pragma unroll
        for (int r = 0; r < 16; r++) st[kb][r] = -m_run;
#pragma unroll
        for (int ks = 0; ks < DQK / 16; ks++) st[kb] = __builtin_amdgcn_mfma_f32_32x32x16_f16(kf[kb][ks], qf[ks], st[kb], 0, 0, 0);
      }
      __builtin_amdgcn_sched_barrier(0);
      h16x8 vf[2][4];
#pragma unroll
      for (int db = 0; db < 2; db++)
#pragma unroll
        for (int sI = 0; sI < 4; sI++) vf[db][sI] = *(const h16x8*)(sv + img_off(db * 32 + l5, 2 * sI + h));
      __builtin_amdgcn_sched_barrier(0);
      if (NAMASK && t < it.nt0) {
        const int drow = (na_dr0 + t) * 31 + 15 - na_c;
#pragma unroll
        for (int kb = 0; kb < 2; kb++)
#pragma unroll
          for (int r = 0; r < 16; r++) {
            const int kcol = 32 * kb + (r & 7) + 8 * h + 16 * (r >> 3);
            const bool valid = (unsigned)(kcol - na_cs) < 16u;
            const float bv = rpbl[valid ? drow + kcol : 0];
            st[kb][r] = valid ? st[kb][r] + bv : -1e30f;
          }
      }
      float mx;
      {
        float m0 = max3f(st[0][0], st[0][1], st[0][2]), m1 = max3f(st[1][0], st[1][1], st[1][2]);
#pragma unroll
        for (int r = 3; r < 15; r += 2) { m0 = max3f(m0, st[0][r], st[0][r + 1]); m1 = max3f(m1, st[1][r], st[1][r + 1]); }
        mx = max3f(m0, m1, st[0][15]); mx = fmaxf(mx, st[1][15]);
      }
      { auto sw = __builtin_amdgcn_permlane32_swap(__float_as_uint(mx), __float_as_uint(mx), false, false); mx = fmaxf(__uint_as_float(sw[0]), __uint_as_float(sw[1])); }
      if (first || !__all(mx <= 8.f)) {
        const float delta = first ? mx : fmaxf(mx, 0.f);
        const float al = __builtin_amdgcn_exp2f(-delta); m_run += delta; lsum *= al; first = false;
#pragma unroll
        for (int db = 0; db < NDB; db++)
#pragma unroll
          for (int r = 0; r < 16; r++) o[db][r] *= al;
#pragma unroll
        for (int kb = 0; kb < 2; kb++)
#pragma unroll
          for (int r = 0; r < 16; r++) st[kb][r] -= delta;
      }
      float sum = 0.f;
#pragma unroll
      for (int kb = 0; kb < 2; kb++)
#pragma unroll
        for (int r = 0; r < 16; r++) { float pe = __builtin_amdgcn_exp2f(st[kb][r]); st[kb][r] = pe; sum += pe; }
      lsum += sum;
      h16x8 pf[4];
#pragma unroll
      for (int sI = 0; sI < 4; sI++) {
        u32x4 pk;
#pragma unroll
        for (int j = 0; j < 4; j++) pk[j] = __builtin_bit_cast(unsigned, __builtin_amdgcn_cvt_pkrtz(st[sI >> 1][8 * (sI & 1) + 2 * j], st[sI >> 1][8 * (sI & 1) + 2 * j + 1]));
        pf[sI] = __builtin_bit_cast(h16x8, pk);
      }
      __builtin_amdgcn_sched_barrier(0);
      if (NDB == 4) {
        h16x8 vg[2][4];
#pragma unroll
        for (int db = 0; db < 2; db++)
#pragma unroll
          for (int sI = 0; sI < 4; sI++) vg[db][sI] = *(const h16x8*)(sv + 8192 + img_off(db * 32 + l5, 2 * sI + h));
#pragma unroll
        for (int db = 0; db < 2; db++)
#pragma unroll
          for (int sI = 0; sI < 4; sI++) o[db] = __builtin_amdgcn_mfma_f32_32x32x16_f16(vf[db][sI], pf[sI], o[db], 0, 0, 0);
#pragma unroll
        for (int db = 0; db < 2; db++)
#pragma unroll
          for (int sI = 0; sI < 4; sI++) o[NDB == 4 ? 2 + db : db] = __builtin_amdgcn_mfma_f32_32x32x16_f16(vg[db][sI], pf[sI], o[NDB == 4 ? 2 + db : db], 0, 0, 0);
      } else {
#pragma unroll
        for (int db = 0; db < 2; db++)
#pragma unroll
          for (int sI = 0; sI < 4; sI++) o[db] = __builtin_amdgcn_mfma_f32_32x32x16_f16(vf[db][sI], pf[sI], o[db], 0, 0, 0);
      }
      __builtin_amdgcn_sched_barrier(0);
    }
  }
  RAWBAR();
  lsum_out = lsum + __shfl_xor(lsum, 32);
}
template <int NDB>
DEVFN void attn_store_gated(const Params& p, const f32x16 (&o)[NDB], float inv, int m, int col0) {
  const int TIDX = tid_op();
  const int h = (TIDX & 63) >> 5;
#pragma unroll
  for (int db = 0; db < NDB; db++)
#pragma unroll
    for (int q = 0; q < 4; q++) {
      const int c = col0 + 32 * db + 8 * q + 4 * h;
      h16x4 g = *(const h16x4*)(p.gates16 + (size_t)m * 1024 + c), ov;
#pragma unroll
      for (int e = 0; e < 4; e++) ov[e] = (h16)(o[db][q * 4 + e] * inv * (float)g[e]);
      *(h16x4*)(p.O16 + pidx(M, m, c)) = ov;
    }
}
DEVFN void attn_even_item(const Params& p, int l, int item, char* lds) {
  const int TIDX = tid_op();
  const int i = l >> 1; const int lane = TIDX & 63, w = TIDX >> 6, h = lane >> 5;
  const int grp = item >> 7, j = item & 127; const bool smp = grp < 2; const bool isdiff = (grp & 1) == 0;
  AttnItem it{}; it.nt1 = 0; it.kr1 = 0;
  if (isdiff) {
    int b, hh, t0;
    if (smp) { b = j >> 6; hh = (j >> 4) & 3; t0 = (j & 15) * 128; it.kr0 = MP + b * TKS; it.nt0 = TKS / 64; }
    else { b = j >> 3; hh = (j >> 1) & 3; t0 = (j & 1) * 128; it.kr0 = b * SEQ; it.nt0 = SEQ / 64; }
    const int comp = w >> 2;
    const int m0w = (smp ? MP + b * DS : b * SEQ) + t0 + (w & 3) * 32;
    it.k0 = p.KB + (size_t)(2 * hh) * KM * 64; it.k1 = p.KB + (size_t)(2 * hh + 1) * KM * 64; it.kld = 64;
    it.v0 = p.VB + (size_t)(hh * 128) * 64; it.v1 = p.VB + (size_t)(hh * 128 + 64) * 64;
    f32x16 o[4]; float lsum;
    attn_core<64, 2, 2, 4, false>(it, p.QB + ((size_t)m0w * 8 + 2 * hh + comp) * 64, 512, comp, 0, 1 << 30, nullptr, 0, 0, lds, o, lsum);
    const float inv = 1.f / lsum;
    float* a2 = (float*)lds + (size_t)(w & 3) * 32 * 132 + (size_t)(lane & 31) * 132;
    if (comp == 1) {
#pragma unroll
      for (int db = 0; db < 4; db++)
#pragma unroll
        for (int q = 0; q < 4; q++) { f32x4 v = {o[db][q * 4] * inv, o[db][q * 4 + 1] * inv, o[db][q * 4 + 2] * inv, o[db][q * 4 + 3] * inv}; *(f32x4*)(a2 + 32 * db + 8 * q + 4 * h) = v; }
    }
    __syncthreads();
    if (comp == 0) {
      const float lam = p.lamv[i]; const float lam_init = 0.8f - 0.6f * expf(-0.3f * l);
      float ss = 0;
#pragma unroll
      for (int db = 0; db < 4; db++)
#pragma unroll
        for (int q = 0; q < 4; q++) {
          f32x4 v2 = *(const f32x4*)(a2 + 32 * db + 8 * q + 4 * h);
#pragma unroll
          for (int e = 0; e < 4; e++) { float d = o[db][q * 4 + e] * inv - lam * v2[e]; o[db][q * 4 + e] = d; ss += d * d; }
        }
      ss = wsum32(ss);
      const float rr = (1.f - lam_init) / sqrtf(ss * (1.f / 128.f) + EPSN);
      const int m = m0w + (lane & 31);
#pragma unroll
      for (int db = 0; db < 4; db++)
#pragma unroll
        for (int q = 0; q < 4; q++) {
          const int dv = 32 * db + 8 * q + 4 * h; const int c = 512 + hh * 128 + dv;
          f32x4 sg = *(const f32x4*)(p.diff_subln + i * 128 + dv);
          h16x4 g = *(const h16x4*)(p.gates16 + (size_t)m * 1024 + c), ov;
#pragma unroll
          for (int e = 0; e < 4; e++) ov[e] = (h16)(o[db][q * 4 + e] * rr * sg[e] * (float)g[e]);
          *(h16x4*)(p.O16 + pidx(M, m, c)) = ov;
        }
    }
    __syncthreads();
  } else {
    int b, head, t0;
    if (smp) { b = j >> 6; head = (j >> 3) & 7; t0 = (j & 7) * 256; it.kr0 = MP + b * TKS; it.nt0 = TKS / 64; }
    else { b = j >> 3; head = j & 7; t0 = 0; it.kr0 = b * SEQ; it.nt0 = SEQ / 64; }
    const int m0w = (smp ? MP + b * DS : b * SEQ) + t0 + w * 32;
    it.k0 = p.KA + (size_t)head * KM * 128; it.k1 = it.k0 + 64; it.kld = 128;
    it.v0 = p.VA + (size_t)(head * 64) * 64; it.v1 = it.v0;
    f32x16 o[2]; float lsum;
    attn_core<96, 2, 1, 2, false>(it, p.QA + ((size_t)m0w * 8 + head) * 96, 768, 0, 0, 1 << 30, nullptr, 0, 0, lds, o, lsum);
    attn_store_gated<2>(p, o, 1.f / lsum, m0w + (lane & 31), head * 64);
  }
}
DEVFN void attn_odd_item(const Params& p, int l, int item, char* lds) {
  const int TIDX = tid_op();
  const int i = l >> 1; const int lane = TIDX & 63, w = TIDX >> 6;
  const int grp = item >> 7, j = item & 127; const bool smp = grp < 2; const bool isgqa = (grp & 1) == 0;
  AttnItem it{}; it.nt1 = 0; it.kr1 = 0; it.kld = 64;
  f32x16 o[2]; float lsum;
  if (isgqa) {
    int b, kvh, t0;
    if (smp) { b = j >> 6; kvh = (j >> 5) & 1; t0 = (j & 31) * 64; it.kr0 = MP + b * TKS; it.nt0 = TKS / 64; }
    else { b = j >> 3; kvh = (j >> 2) & 1; t0 = (j & 3) * 64; it.kr0 = b * SEQ; it.nt0 = SEQ / 64; }
    const int head = kvh * 4 + (w >> 1);
    const int m0w = (smp ? MP + b * DS : b * SEQ) + t0 + (w & 1) * 32;
    it.k0 = p.KB + (size_t)kvh * KM * 64; it.k1 = it.k0; it.v0 = p.VB + (size_t)(kvh * 64) * 64; it.v1 = it.v0;
    attn_core<64, 1, 1, 2, false>(it, p.QB + ((size_t)m0w * 8 + head) * 64, 512, 0, 0, 1 << 30, nullptr, 0, 0, lds, o, lsum);
    attn_store_gated<2>(p, o, 1.f / lsum, m0w + (lane & 31), 512 + head * 64);
  } else if (!smp) {
    const int b = j >> 3, head = j & 7; it.kr0 = b * SEQ; it.nt0 = SEQ / 64;
    const int m0w = b * SEQ + w * 32;
    it.k0 = p.KA + (size_t)head * KM * 64; it.k1 = it.k0; it.v0 = p.VA + (size_t)(head * 64) * 64; it.v1 = it.v0;
    attn_core<64, 1, 1, 2, false>(it, p.QA + ((size_t)m0w * 8 + head) * 64, 512, 0, 0, 1 << 30, nullptr, 0, 0, lds, o, lsum);
    attn_store_gated<2>(p, o, 1.f / lsum, m0w + (lane & 31), head * 64);
  } else {
    const int b = j >> 6, head = (j >> 3) & 7, r0 = (j & 7) * 4;
    const int r = r0 + (w >> 1), c0 = (w & 1) * 32;
    auto rsf = [](int rr) { int s = rr - 4; return s < 0 ? 0 : (s > GROWS - 8 ? GROWS - 8 : s); };
    const int rlo = rsf(r0), rhi = rsf(r0 + 3) + 8;
    const int kbase = MP + b * TKS;
    it.kr0 = kbase + rlo * 64; it.nt0 = rhi - rlo; it.kr1 = kbase + DS; it.nt1 = PAST / 64;
    it.k0 = p.KA + (size_t)head * KM * 64; it.k1 = it.k0; it.v0 = p.VA + (size_t)(head * 64) * 64; it.v1 = it.v0;
    float* rpbl = (float*)(lds + A_RING);
    { const float* src = p.na_rpb + ((size_t)i * 8 + head) * 465; for (int k = TIDX; k < 465; k += 512) rpbl[k] = src[k] * LOG2E; }
    const int m0w = MP + b * DS + r * 64 + c0;
    const int ta = rsf(r) - rlo;
    attn_core<64, 1, 1, 2, true>(it, p.QA + ((size_t)m0w * 8 + head) * 64, 512, 0, ta, ta + 8, rpbl, rlo - r + 7, c0 + (lane & 31), lds, o, lsum);
    attn_store_gated<2>(p, o, 1.f / lsum, m0w + (lane & 31), head * 64);
  }
}
#define XB_TMO      128
#define XB_XCNT(j)  (256  + 64 * (j))
#define XB_XSUB(j)  (1280 + 64 * (j))
#define XB_XGEN(j)  (2304 + 64 * (j))
#define XB_TOP      3328
#define XB_TOPGEN   3392
#define XCD_BAR_WORDS 3456
#define XB_SPIN_CAP (1u << 20)
#define LAS __attribute__((address_space(3)))
DEVFN unsigned xb_ld(unsigned* p) { return __hip_atomic_load(p, __ATOMIC_RELAXED, __HIP_MEMORY_SCOPE_AGENT); }
DEVFN unsigned xb_add(unsigned* p, unsigned v) { return __hip_atomic_fetch_add(p, v, __ATOMIC_RELAXED, __HIP_MEMORY_SCOPE_AGENT); }
DEVFN unsigned xb_xcc_id() { return (unsigned)__builtin_amdgcn_s_getreg((3 << 11) | 20) & 0xFu; }
#define XB_SPIN(cond, bar) do { unsigned _sp = 0; while (cond) { __builtin_amdgcn_s_sleep(1); \
    if ((++_sp & 255u) == 0u) { if (xb_ld(&(bar)[XB_TMO])) break; if (_sp > XB_SPIN_CAP) { atomicAdd(&(bar)[XB_TMO], 1u); break; } } } } while (0)
struct XcdBarrier { unsigned* bar; unsigned x; volatile LAS unsigned* st; };
DEVFN XcdBarrier xcd_barrier_post(unsigned* bar, volatile LAS unsigned* st) {
  const int TIDX = tid_op();
  XcdBarrier b; b.bar = bar; b.x = xb_xcc_id(); b.st = st;
  if (TIDX == 0) (void)xb_add(&bar[XB_XCNT(b.x)], 1u);
  return b;
}
DEVFN void xcd_barrier_complete(unsigned* bar, unsigned x, unsigned& nloc, unsigned& nx) {
  const unsigned G = gridDim.x * gridDim.y * gridDim.z;
  unsigned sum, cnt, mine, sp = 0u;
  for (;;) {
    sum = 0u; cnt = 0u; mine = 0u;
#pragma unroll
    for (unsigned j = 0; j < 16; ++j) { const unsigned c = xb_ld(&bar[XB_XCNT(j)]); sum += c; cnt += (c > 0u) ? 1u : 0u; mine = (j == x) ? c : mine; }
    if (sum == G) break;
    __builtin_amdgcn_s_sleep(1);
    if ((++sp & 255u) == 0u) { if (xb_ld(&bar[XB_TMO])) break; if (sp > XB_SPIN_CAP) { atomicAdd(&bar[XB_TMO], 1u); break; } }
  }
  nloc = mine > 0u ? mine : 1u; nx = cnt > 0u ? cnt : 1u;
}
DEVFN void xcd_barrier(const XcdBarrier& b) {
  const int TIDX = tid_op();
  asm volatile("s_waitcnt vmcnt(0)" ::: "memory");
  __syncthreads();
  if (TIDX == 0) {
    unsigned* bar = b.bar;
    __builtin_amdgcn_s_waitcnt(0);
    unsigned nloc = b.st[0], nx = b.st[1];
    if (nloc == 0u) { xcd_barrier_complete(bar, b.x, nloc, nx); b.st[0] = nloc; b.st[1] = nx; }
    const unsigned old = xb_add(&bar[XB_XSUB(b.x)], 1u);
    const unsigned gen = old / nloc;
    if (old + 1u == (gen + 1u) * nloc) {
      __builtin_amdgcn_fence(__ATOMIC_RELEASE, "agent");
      asm volatile("s_waitcnt vmcnt(0)" ::: "memory");
      const unsigned og = xb_add(&bar[XB_TOP], 1u);
      const unsigned tg = og / nx;
      if (og + 1u == (tg + 1u) * nx) xb_add(&bar[XB_TOPGEN], 1u);
      else XB_SPIN(xb_ld(&bar[XB_TOPGEN]) == tg, bar);
      __builtin_amdgcn_fence(__ATOMIC_ACQUIRE, "agent");
      xb_add(&bar[XB_XGEN(b.x)], 1u);
      asm volatile("s_waitcnt vmcnt(0)" ::: "memory");
    } else {
      XB_SPIN(xb_ld(&bar[XB_XGEN(b.x)]) == gen, bar);
      __builtin_amdgcn_fence(__ATOMIC_ACQUIRE, "agent");
      asm volatile("s_waitcnt vmcnt(0)" ::: "memory");
    }
  }
  __syncthreads();
}

DEVFN void cache_items(const Params& p, int l, int gtid, int gthreads) {
  const int i = l >> 1;
  if ((l & 1) == 0) {
    const int per = 128 + 32 + 512 + 512;
    for (int e = gtid; e < DB * PAST * per; e += gthreads) {
      const int u = e % per; const int bp = e / per; const int pos = bp % PAST, b = bp / PAST;
      const int kr = MP + b * TKS + DS + pos; const size_t crow = ((size_t)(b * 2 + i) * PAST + pos);
      if (u < 128) p.ckv16[pidx(KM, kr, u)] = (h16)p.cache_mla_ckv[crow * 128 + u];
      else if (u < 160) p.kpe16[(size_t)kr * 32 + (u - 128)] = (h16)p.cache_mla_kpe[crow * 32 + (u - 128)];
      else if (u < 672) { const int c = u - 160; p.KB[((size_t)(c >> 6) * KM + kr) * 64 + (c & 63)] = (h16)p.cache_diff_k[crow * 512 + c]; }
      else { const int c = u - 672; p.VB[vidx(c, kr)] = (h16)p.cache_diff_v[crow * 512 + c]; }
    }
  } else {
    const int per = 512 + 512 + 128 + 128;
    for (int e = gtid; e < DB * PAST * per; e += gthreads) {
      const int u = e % per; const int bp = e / per; const int pos = bp % PAST, b = bp / PAST;
      const int kr = MP + b * TKS + DS + pos; const size_t crow = ((size_t)(b * 2 + i) * PAST + pos);
      if (u < 512) p.KA[((size_t)(u >> 6) * KM + kr) * 64 + (u & 63)] = (h16)p.cache_na_k[crow * 512 + u];
      else if (u < 1024) { const int c = u - 512; p.VA[vidx(c, kr)] = (h16)p.cache_na_v[crow * 512 + c]; }
      else if (u < 1152) { const int c = u - 1024; p.KB[((size_t)(c >> 6) * KM + kr) * 64 + (c & 63)] = (h16)p.cache_gqa_k[crow * 128 + c]; }
      else { const int c = u - 1152; p.VB[vidx(c, kr)] = (h16)p.cache_gqa_v[crow * 128 + c]; }
    }
  }
}

DEVFN void mod_item(const Params& p, int item, char* lds, bool dry = false) {
  const int tid = tid_op();
  const int l = item / 96, rem = item % 96, nchunk = rem / 16, kc = rem % 16;
  float* sil = (float*)lds;
  if (tid < NCV * 64) { const int cv = tid >> 6, k = tid & 63; const float* cvec = cv == 0 ? p.c_ctx : p.c + (size_t)(cv - 1) * D; sil[tid] = siluf(cvec[kc * 64 + k]); }
  __syncthreads();
  const int col = nchunk * 512 + tid;
  const float* w = p.w_mod + ((size_t)l * D + kc * 64) * 3072 + col;
  float acc[NCV];
#pragma unroll
  for (int c = 0; c < NCV; c++) acc[c] = 0.f;
#pragma unroll 16
  for (int k = 0; k < 64; k++) {
    const float wv = w[(size_t)k * 3072];
#pragma unroll
    for (int c = 0; c < NCV; c++) acc[c] += sil[c * 64 + k] * wv;
  }
  const float b = kc == 0 ? p.b_mod[l * 3072 + col] : 0.f;
#pragma unroll
  for (int c = 0; c < NCV; c++) if (!dry) atomicAdd(p.modv + ((size_t)l * NCV + c) * 3072 + col, acc[c] + b);
  __syncthreads();
}
DEVFN void conv_tile(const float* src, h16* dst, int R, int Nsrc, int mode, const float* kscale, int nb, int kb, char* lds) {
  const int tid = tid_op();
  float (*t)[65] = (float (*)[65])lds;
  {
    const int j = tid & 63; const int np = nb + j; int col;
    if (mode == 0) col = np; else if (mode == 1) col = even_col(np); else if (mode == 3) { int hh = (np & 511) >> 6; col = hh * 128 + (np >> 9) * 64 + (np & 63); } else { int h = np >> 7, jj = np & 127; col = jj < 96 ? h * 96 + jj : -1; }
    const int colc = col < 0 ? 0 : col; const float msk = col < 0 ? 0.f : 1.f;
    float v[8];
#pragma unroll
    for (int i = 0; i < 8; i++) v[i] = src[(size_t)(kb + (tid >> 6) + 8 * i) * Nsrc + colc];
    if (kscale) {
#pragma unroll
      for (int i = 0; i < 8; i++) v[i] *= kscale[kb + (tid >> 6) + 8 * i];
    }
#pragma unroll
    for (int i = 0; i < 8; i++) t[(tid >> 6) + 8 * i][j] = v[i] * msk;
  }
  __syncthreads();
  {
    const int kk = tid & 63;
#pragma unroll
    for (int i = 0; i < 8; i++) { const int j = (tid >> 6) + 8 * i; dst[pidx(R, nb + j, kb + kk)] = (h16)t[kk][j]; }
  }
  __syncthreads();
}
constexpr int CV_WIN_E = (NPE / 64) * 16, CV_WIN_O = (NPO / 64) * 16, CV_WOUT = 256, CV_WQB = 64, CV_WKVB = 32;
constexpr int CV_PER_PAIR = CV_WIN_E + CV_WIN_O + 2 * CV_WOUT + CV_WQB + CV_WKVB;
constexpr int CV_TOTAL = 2 * CV_PER_PAIR;
DEVFN void conv_item(const Params& p, int item, char* lds) {
  const int i = item / CV_PER_PAIR; int r = item % CV_PER_PAIR;
  if (r < CV_WIN_E) { conv_tile(p.w_in_even + (size_t)i * D * EVEN_IN, p.win16 + (size_t)(2 * i) * NPO * D, NPO, EVEN_IN, 1, nullptr, (r % (NPE / 64)) * 64, (r / (NPE / 64)) * 64, lds); return; }
  r -= CV_WIN_E;
  if (r < CV_WIN_O) { conv_tile(p.w_in_odd + (size_t)i * D * ODD_IN, p.win16 + (size_t)(2 * i + 1) * NPO * D, NPO, ODD_IN, 0, nullptr, (r % (NPO / 64)) * 64, (r / (NPO / 64)) * 64, lds); return; }
  r -= CV_WIN_O;
  if (r < CV_WOUT) { conv_tile(p.w_out_even + (size_t)i * D * D, p.wout16 + (size_t)(2 * i) * D * D, 1024, D, 0, nullptr, (r % 16) * 64, (r / 16) * 64, lds); return; }
  r -= CV_WOUT;
  if (r < CV_WOUT) { conv_tile(p.w_out_odd + (size_t)i * D * D, p.wout16 + (size_t)(2 * i + 1) * D * D, 1024, D, 0, nullptr, (r % 16) * 64, (r / 16) * 64, lds); return; }
  r -= CV_WOUT;
  if (r < CV_WQB) { conv_tile(p.mla_wqb + (size_t)i * 256 * 768, p.wqb16 + (size_t)i * 1024 * 256, 1024, 768, 2, p.mla_qa_norm + i * 256, (r % 16) * 64, (r / 16) * 64, lds); return; }
  r -= CV_WQB;
  conv_tile(p.mla_wkvb + (size_t)i * 128 * 1024, p.wkvb16 + (size_t)i * 1024 * 128, 1024, 1024, 3, nullptr, (r % 16) * 64, (r / 16) * 64, lds);
}
DEVFN void tab_items(const Params& p, int gtid, int gthreads) {
  for (int g = gtid; g < DS * 48; g += gthreads) {
    if (g < 2) {
      const int i = g, l = 2 * i; float s1 = 0, s2 = 0;
      for (int k = 0; k < 64; k++) { s1 += p.diff_lq1[i * 64 + k] * p.diff_lk1[i * 64 + k]; s2 += p.diff_lq2[i * 64 + k] * p.diff_lk2[i * 64 + k]; }
      p.lamv[i] = expf(s1) - expf(s2) + (0.8f - 0.6f * expf(-0.3f * l));
    }
    const int t = g / 48, j = g % 48;
    const float row = (float)(t / GW), col = (float)(t % GW);
    if (j < 32) { const int f = j & 15; const float inv = powf(10000.f, -(float)(2 * f) / 32.f); const float ang = (j < 16 ? row : col) * inv; p.ropeC64[t * 32 + j] = cosf(ang); p.ropeS64[t * 32 + j] = sinf(ang); }
    else { const int jj = j - 32; const int f = jj & 7; const float inv = powf(10000.f, -(float)(2 * f) / 16.f); const float ang = (jj < 8 ? row : col) * inv; p.ropeC32[t * 16 + jj] = cosf(ang); p.ropeS32[t * 16 + jj] = sinf(ang); }
  }
}
DEVFN void bias_row(const Params& p, int l, int np, int lane) {
  const h16* w = p.win16 + (size_t)l * NPO * D;
  float a[NCV];
#pragma unroll
  for (int c = 0; c < NCV; c++) a[c] = 0;
#pragma unroll
  for (int i = 0; i < 2; i++) {
    const int k = (i * 64 + lane) * 8; h16x8 wv = *(const h16x8*)(w + pidx(NPO, np, k));
#pragma unroll
    for (int c = 0; c < NCV; c++) { const float* sh = p.modv + ((size_t)l * NCV + c) * 3072 + k;
#pragma unroll
      for (int e = 0; e < 8; e++) a[c] += sh[e] * (float)wv[e]; }
  }
#pragma unroll
  for (int c = 0; c < NCV; c++) { float v = a[c]; for (int o = 32; o; o >>= 1) v += __shfl_xor(v, o); if (lane == 0) p.biasv[((size_t)l * NCV + c) * NPO + np] = v; }
}
DEVFN void prepx_row(const Params& p, int l, int m, int lane) {
  const float* x = xrow(p, l, m); const float* md = p.modv + ((size_t)l * NCV + tok_cv(m)) * 3072 + 1024; const float* nw = p.norm_w + l * D;
  float ss = 0;
#pragma unroll
  for (int i = 0; i < 4; i++) {
    const int k = (i * 64 + lane) * 4;
    f32x4 v = *(const f32x4*)(x + k); f32x4 s = *(const f32x4*)(md + k); f32x4 w = *(const f32x4*)(nw + k);
    h16x4 o;
#pragma unroll
    for (int e = 0; e < 4; e++) { ss += v[e] * v[e]; o[e] = (h16)(v[e] * w[e] * (1.f + s[e])); }
    *(h16x4*)(p.xs16 + pidx(M, m, k)) = o;
  }
  for (int o = 32; o; o >>= 1) ss += __shfl_xor(ss, o);
  if (lane == 0) p.rowss_l[(size_t)l * M + m] = ss;
}
#define AS4 __attribute__((address_space(4)))
#define PHASE_PARAMS(q) const Params& q = p_unused;
__global__ void __launch_bounds__(512) mega_kernel(Params p_unused) {
  __shared__ __attribute__((aligned(16))) char lds[G_LDS + 16];
  if (threadIdx.x == 0) { volatile LAS unsigned* st = (volatile LAS unsigned*)(lds + G_LDS); st[0] = 0u; st[1] = 0u; st[2] = 0u; st[3] = 0u; }
  __syncthreads();
  XcdBarrier bar;
  { PHASE_PARAMS(p); bar = xcd_barrier_post(p.bar, (volatile LAS unsigned*)(lds + G_LDS)); }
  const int nb = gridDim.x, bid = blockIdx.x;
  { PHASE_PARAMS(p);
    for (int rep = 0; rep < REP_0A; rep++)
    for (int it = bid; it < 384 + CV_TOTAL; it += nb) { if (it < 384) mod_item(p, it, lds, rep > 0); else conv_item(p, it - 384, lds); }
    tab_items(p, bid * 512 + tid_op(), nb * 512); }
  xcd_barrier(bar);
  { PHASE_PARAMS(p);
    const int tid = tid_op(); const int lane = tid & 63, gw = bid * 8 + (tid >> 6), nw = nb * 8;
    for (int rep = 0; rep < REP_0B; rep++)
    for (int r = gw; r < 2 * (NPE + NPO) + M; r += nw) {
      if (r < 2 * (NPE + NPO)) { const int i = r / (NPE + NPO), q = r % (NPE + NPO); if (q < NPE) bias_row(p, 2 * i, q, lane); else bias_row(p, 2 * i + 1, q - NPE, lane); }
      else prepx_row(p, 0, r - 2 * (NPE + NPO), lane);
    } }
  xcd_barrier(bar);
#pragma unroll 1
  for (int l = 0; l < 4; l++) {
    { PHASE_PARAMS(p);
      const int ntn = ((l & 1) ? NPO : NPE) / 128;
      for (int rep = 0; rep < REP_A; rep++)
      for (int t = bid; t < 32 * ntn; t += nb) inproj_tile(p, l, t % 32, t / 32, lds, rep > 0);
      for (int rep = 0; rep < REP_0B; rep++) cache_items(p, l, bid * 512 + tid_op(), nb * 512); }
    xcd_barrier(bar);
    if ((l & 1) == 0) {
      PHASE_PARAMS(p);
      const int nq = (M / 256) * 8, nkv = (KM / 256) * 8;
      for (int rep = 0; rep < REP_A2; rep++)
      for (int t = bid; t < nq + nkv; t += nb) { if (t < nq) qgemm_tile(p, l, t % 32, t / 32, lds); else { const int u = t - nq; kvgemm_tile(p, l, u % (KM / 256), u / (KM / 256), lds); } }
      xcd_barrier(bar);
    }
    { PHASE_PARAMS(p);
      for (int rep = 0; rep < REP_B; rep++)
      for (int it = bid; it < 512; it += nb) { if (l & 1) attn_odd_item(p, l, it, lds); else attn_even_item(p, l, it, lds); } }
    xcd_barrier(bar);
    { PHASE_PARAMS(p);
      for (int rep = 0; rep < REP_C; rep++)
      for (int t = bid; t < 32 * 8; t += nb) outproj_tile(p, l, t % 32, t / 32, lds, rep < REP_C - 1); }
    if (l < 3) { for (int rep = 0; rep < REP_BAR; rep++) xcd_barrier(bar); }
  }
}
#endif

static inline size_t al256(size_t x) { return (x + 255) & ~(size_t)255; }

extern "C" void kernel_launch(void* const* d_in, const int* in_sizes, int n_in, void* d_out, int out_size, void* d_ws, size_t ws_size,
                              hipStream_t stream) {
  Params p{};
  const float** ip = (const float**)&p.x_prompt;
  for (int k = 0; k < 39; k++) ip[k] = (const float*)d_in[k];
  float* o = (float*)d_out;
  p.Y = o; o += (size_t)M * 1024;
  p.o_ckv = o; o += (size_t)BATCH * 2 * SEQ * 128;
  p.o_kpe = o; o += (size_t)BATCH * 2 * SEQ * 32;
  p.o_dk = o; o += (size_t)BATCH * 2 * SEQ * 512;
  p.o_dv = o; o += (size_t)BATCH * 2 * SEQ * 512;
  p.o_nk = o; o += (size_t)BATCH * 2 * SEQ * 512;
  p.o_nv = o; o += (size_t)BATCH * 2 * SEQ * 512;
  p.o_gk = o; o += (size_t)BATCH * 2 * SEQ * 128;
  p.o_gv = o; o += (size_t)BATCH * 2 * SEQ * 128;
  char* w = (char*)d_ws; size_t off = 0;
  auto take = [&](size_t bytes) { char* r = w + off; off += al256(bytes); return r; };
  char* zero0 = w + off;
  p.bar = (unsigned*)take(16384);
  p.modv = (float*)take((size_t)4 * NCV * 3072 * 4);
  p.rowss_qa = (float*)take((size_t)2 * M * 4); p.rowss_l = (float*)take((size_t)4 * M * 4);
  const size_t zero_bytes = (size_t)((w + off) - zero0);
  p.ropeC64 = (float*)take((size_t)DS * 32 * 4); p.ropeS64 = (float*)take((size_t)DS * 32 * 4);
  p.ropeC32 = (float*)take((size_t)DS * 16 * 4); p.ropeS32 = (float*)take((size_t)DS * 16 * 4);
  p.lamv = (float*)take(256);
  p.rstdx = (float*)take((size_t)M * 4);
  p.QA = (h16*)take((size_t)M * 8 * 96 * 2); p.QB = (h16*)take((size_t)M * 8 * 64 * 2);
  p.KA = (h16*)take((size_t)8 * KM * 128 * 2); p.KB = (h16*)take((size_t)8 * KM * 64 * 2);
  p.VA = (h16*)take((size_t)8 * 64 * KM * 2); p.VB = (h16*)take((size_t)8 * 64 * KM * 2);
  p.gates16 = (h16*)take((size_t)M * 1024 * 2); p.O16 = (h16*)take((size_t)M * 1024 * 2);
  p.ckvbuf = (float*)take((size_t)KM * 128 * 4); p.kpebuf = (float*)take((size_t)KM * 32 * 4);
  p.xs16 = (h16*)take((size_t)M * D * 2); p.qa16 = (h16*)take((size_t)M * 256 * 2); p.ckv16 = (h16*)take((size_t)KM * 128 * 2); p.kpe16 = (h16*)take((size_t)KM * 32 * 2); p.biasv = (float*)take((size_t)4 * NCV * NPO * 4);
  p.win16 = (h16*)take((size_t)4 * NPO * D * 2); p.wout16 = (h16*)take((size_t)4 * D * D * 2);
  p.wqb16 = (h16*)take((size_t)2 * 1024 * 256 * 2); p.wkvb16 = (h16*)take((size_t)2 * 1024 * 128 * 2);
  size_t ub = (size_t)M * 3328 * 2, ab = (size_t)M * 1536 * 4;
  char* big = take(ub > ab ? ub : ab);
  p.ubuf = (h16*)big; p.abuf = (float*)big;
  (void)ws_size; (void)n_in; (void)in_sizes; (void)out_size;

#ifndef CPU_EMU
  {
    (void)hipMemsetAsync(zero0, 0, zero_bytes, stream);
    static int cus = 0;
    if (!cus) { int dev = 0; (void)hipGetDevice(&dev); (void)hipDeviceGetAttribute(&cus, hipDeviceAttributeMultiprocessorCount, dev); }
    void* args[] = {&p};
    (void)hipLaunchCooperativeKernel((void*)mega_kernel, dim3(cus), dim3(512), args, 0, stream);
  }
#else
  (void)zero0; (void)zero_bytes;
  launch1d(nk_mod, (long)4 * NCV * 3072, stream, p, (long)4 * NCV * 3072);
  launch1d(nk_tab, (long)DS * 48, stream, p, (long)DS * 48);
  for (int l = 0; l < 4; l++) {
    const int N = (l & 1) ? ODD_IN : EVEN_IN;
    launch1d(nk_rstd, (long)M, stream, p, l, (long)M);
    launch1d(nk_inproj, (long)M * N, stream, p, l, (long)M * N);
    if ((l & 1) == 0) {
      launch1d(nk_epi_even, (long)M * 50, stream, p, l, 0, (long)M * 50);
      launch1d(nk_cache_even, (long)DB * PAST * 17, stream, p, l, (long)DB * PAST * 17);
      launch1d(nk_kv, (long)KM * 16, stream, p, l, (long)KM * 16);
      launch1d(nk_attn_dense, (long)M * 8, stream, p, 0, 0, M, (long)M * 8);
      launch1d(nk_attn_dense, (long)M * 16, stream, p, 1, 0, M, (long)M * 16);
      launch1d(nk_fin, (long)M * 12, stream, p, l, (long)M * 12);
    } else {
      launch1d(nk_epi_odd, (long)M * 52, stream, p, l, (long)M * 52);
      launch1d(nk_cache_odd, (long)DB * PAST * 20, stream, p, l, (long)DB * PAST * 20);
      launch1d(nk_attn_dense, (long)MP * 8, stream, p, 2, 0, MP, (long)MP * 8);
      launch1d(nk_attn_na, (long)MS * 8, stream, p, l, (long)MS * 8);
      launch1d(nk_attn_dense, (long)M * 8, stream, p, 3, 0, M, (long)M * 8);
      launch1d(nk_fin, (long)M * 16, stream, p, l, (long)M * 16);
    }
    launch1d(nk_outproj, (long)M * 1024, stream, p, l, (long)M * 1024);
  }
#endif
}
```

```cpp
#ifndef CPU_EMU
#include <hip/hip_runtime.h>
#endif
#include <stdint.h>
#include <math.h>

#define FAST_INPROJ 2
#define DUAL_WRITE 0
#define FAST_A2 1
#define FAST_OUTPROJ 1
#define FAST_ATTN 1
#define MEGA 1
#define REP_0A 1
#define REP_A 1
#define REP_A2 1
#define REP_B 1
#define REP_C 1
#define REP_BAR 1
#define REP_GK 1
#define REP_0B 1
#define REP_EPI 1
#ifndef CFG_BATCH
#define CFG_BATCH 16
#endif
#ifndef CFG_DB
#define CFG_DB 2
#endif
#ifndef CFG_DS
#define CFG_DS 2048
#endif
constexpr int D = 1024, BATCH = CFG_BATCH, SEQ = 256, DB = CFG_DB, DS = CFG_DS, PAST = 256;
constexpr int MP = BATCH * SEQ, MS = DB * DS, M = MP + MS;
constexpr int TKS = DS + PAST;
constexpr int KM = MP + DB * TKS;
constexpr int NCV = 1 + DB;
constexpr int GW = 64, GROWS = DS / GW;
constexpr int EVEN_IN = 2976, ODD_IN = 3328;
constexpr int NPE = 3072, NPO = 3328;
constexpr float EPSN = 1e-6f;
constexpr float LOG2E = 1.4426950408889634f;

typedef _Float16 h16;

struct Params {
  const float *x_prompt, *x_sample, *cache_mla_ckv, *cache_mla_kpe, *cache_diff_k, *cache_diff_v, *cache_na_k, *cache_na_v,
      *cache_gqa_k, *cache_gqa_v, *c, *c_ctx, *norm_w, *w_mod, *b_mod, *w_in_even, *w_out_even, *mla_qa_norm, *mla_wqb,
      *mla_kva_norm, *mla_wkvb, *mla_qn_nope, *mla_qn_rope, *mla_kn_nope, *mla_kn_rope, *diff_qn, *diff_kn, *diff_lq1,
      *diff_lk1, *diff_lq2, *diff_lk2, *diff_subln, *w_in_odd, *w_out_odd, *na_qn, *na_kn, *na_rpb, *gqa_qn, *gqa_kn;
  float *Y;
  float *o_ckv, *o_kpe, *o_dk, *o_dv, *o_nk, *o_nv, *o_gk, *o_gv;
  float *modv;
  float *ropeC64, *ropeS64;
  float *ropeC32, *ropeS32;
  float *lamv;
  float *rstdx;
  h16 *ubuf;
  float *abuf;
  float *ckvbuf;
  float *kpebuf;
  h16 *QA, *QB, *KA, *KB, *VA, *VB, *gates16, *O16;
  h16 *xs16;
  float *biasv;
  h16 *win16;
  h16 *wout16;
  h16 *wqb16;
  h16 *wkvb16;
  h16 *qa16;
  float *rowss_qa;
  h16 *ckv16;
  h16 *kpe16;
  float *rowss_l;
  float *rowss_ckv;
  unsigned *bar;
};

#ifdef CPU_EMU
#include <stdio.h>
#include <stdlib.h>
#include <string.h>
typedef void* hipStream_t;
#define KERNEL static void
#define DEVFN static inline
static thread_local long emu_gtid;
#define GTID emu_gtid
template <class... A, class... B>
static void launch1d(void (*f)(A...), long n, hipStream_t, B... a) {
#pragma omp parallel for schedule(dynamic, 64)
  for (long i = 0; i < n; i++) { emu_gtid = i; f(a...); }
}
static inline float exp2f_(float x) { return exp2f(x); }
#else
#define KERNEL __global__ void __launch_bounds__(256)
#define DEVFN __device__ __forceinline__
#define GTID ((long)blockIdx.x * 256 + threadIdx.x)
template <class... A, class... B>
static void launch1d(void (*f)(A...), long n, hipStream_t s, B... a) {
  hipLaunchKernelGGL(f, dim3((unsigned)((n + 255) / 256)), dim3(256), 0, s, a...);
}
DEVFN float exp2f_(float x) { return exp2f(x); }
#endif

DEVFN int tok_cv(int m) { return m < MP ? 0 : 1 + (m - MP) / DS; }
DEVFN int tok_keyrow(int m) { return m < MP ? m : MP + ((m - MP) / DS) * TKS + (m - MP) % DS; }
DEVFN int tok_pos(int m) { return m < MP ? (m % SEQ) : ((m - MP) % DS); }
DEVFN const float* xrow(const Params& p, int l, int m) {
  if (l > 0) return p.Y + (size_t)m * D;
  return m < MP ? p.x_prompt + (size_t)m * D : p.x_sample + (size_t)(m - MP) * D;
}
DEVFN float siluf(float x) { return x / (1.f + expf(-x)); }
DEVFN size_t st_row(int m, int i) { int b = m / SEQ, t = m % SEQ; return ((size_t)(b * 2 + i) * SEQ + t); }

#ifdef CPU_EMU
KERNEL nk_mod(Params p, long n) {
  long g = GTID; if (g >= n) return;
  int col = g % 3072; int cv = (g / 3072) % NCV; int l = g / (3072 * NCV);
  const float* cvec = cv == 0 ? p.c_ctx : p.c + (size_t)(cv - 1) * D;
  const float* w = p.w_mod + (size_t)l * D * 3072 + col;
  float acc = p.b_mod[l * 3072 + col];
  for (int k = 0; k < D; k++) acc += siluf(cvec[k]) * w[(size_t)k * 3072];
  p.modv[((size_t)l * NCV + cv) * 3072 + col] = acc;
}
KERNEL nk_tab(Params p, long n) {
  long g = GTID; if (g >= n) return;
  if (g < 2) {
    int i = g; int l = 2 * i;
    float s1 = 0, s2 = 0;
    for (int k = 0; k < 64; k++) { s1 += p.diff_lq1[i * 64 + k] * p.diff_lk1[i * 64 + k]; s2 += p.diff_lq2[i * 64 + k] * p.diff_lk2[i * 64 + k]; }
    float lam_init = 0.8f - 0.6f * expf(-0.3f * l);
    p.lamv[i] = expf(s1) - expf(s2) + lam_init;
  }
  int t = g / 48, j = g % 48;
  if (t >= DS) return;
  float row = (float)(t / GW), col = (float)(t % GW);
  if (j < 32) {
    int f = j & 15; float inv = powf(10000.f, -(float)(2 * f) / 32.f);
    float ang = (j < 16 ? row : col) * inv;
    p.ropeC64[t * 32 + j] = cosf(ang); p.ropeS64[t * 32 + j] = sinf(ang);
  } else {
    int jj = j - 32; int f = jj & 7; float inv = powf(10000.f, -(float)(2 * f) / 16.f);
    float ang = (jj < 8 ? row : col) * inv;
    p.ropeC32[t * 16 + jj] = cosf(ang); p.ropeS32[t * 16 + jj] = sinf(ang);
  }
}
KERNEL nk_rstd(Params p, int l, long n) {
  long g = GTID; if (g >= n) return;
  const float* x = xrow(p, l, (int)g);
  float s = 0; for (int k = 0; k < D; k++) s += x[k] * x[k];
  p.rstdx[g] = 1.f / sqrtf(s / D + EPSN);
}
KERNEL nk_inproj(Params p, int l, long n) {
  long g = GTID; if (g >= n) return;
  const int N = (l & 1) ? ODD_IN : EVEN_IN;
  int m = g / N, col = g % N;
  const float* W = ((l & 1) ? p.w_in_odd : p.w_in_even) + (size_t)(l >> 1) * D * N + col;
  const float* x = xrow(p, l, m);
  const float* md = p.modv + ((size_t)l * NCV + tok_cv(m)) * 3072;
  const float* nw = p.norm_w + l * D;
  float r = p.rstdx[m], acc = 0;
  for (int k = 0; k < D; k++) { float h = x[k] * r * nw[k] * (1.f + md[1024 + k]) + md[k]; acc += h * W[(size_t)k * N]; }
  p.ubuf[(size_t)m * 3328 + col] = (h16)acc;
}

KERNEL nk_epi_even(Params p, int l, int qa_only, long n) {
  long g = GTID; if (g >= n) return;
  const int i = l >> 1;
  int m = g / 50, u = g % 50;
  if (qa_only && u >= 8) return;
  const h16* ur = qa_only ? p.qa16 + (size_t)m * 256 : p.ubuf + (size_t)m * 3328;
  const bool smp = m >= MP; const int t = tok_pos(m); const int kr = tok_keyrow(m);
  if (u < 8) {
    float ss = 0; for (int k = 0; k < 256; k++) { float v = (float)ur[k]; ss += v * v; }
    float r = 1.f / sqrtf(ss / 256 + EPSN);
    float q[96];
#pragma unroll
    for (int j = 0; j < 96; j++) q[j] = 0;
    const float* W = p.mla_wqb + (size_t)i * 256 * 768 + u * 96;
    for (int k = 0; k < 256; k++) {
      float a = (float)ur[k] * r * p.mla_qa_norm[i * 256 + k];
#pragma unroll
      for (int j = 0; j < 96; j++) q[j] += a * W[(size_t)k * 768 + j];
    }
    float s1 = 0, s2 = 0;
#pragma unroll
    for (int j = 0; j < 64; j++) s1 += q[j] * q[j];
#pragma unroll
    for (int j = 64; j < 96; j++) s2 += q[j] * q[j];
    float r1 = 1.f / sqrtf(s1 / 64 + EPSN), r2 = 1.f / sqrtf(s2 / 32 + EPSN);
#pragma unroll
    for (int j = 0; j < 64; j++) q[j] = q[j] * r1 * p.mla_qn_nope[i * 64 + j];
#pragma unroll
    for (int j = 0; j < 32; j++) q[64 + j] = q[64 + j] * r2 * p.mla_qn_rope[i * 32 + j];
    if (smp) {
#pragma unroll
      for (int j = 0; j < 16; j++) {
        float c = p.ropeC32[t * 16 + j], s = p.ropeS32[t * 16 + j];
        float x1 = q[64 + j], x2 = q[80 + j];
        q[64 + j] = x1 * c - x2 * s; q[80 + j] = x2 * c + x1 * s;
      }
    }
    const float sc = LOG2E / sqrtf(96.f);
    h16* dst = p.QA + ((size_t)m * 8 + u) * 96;
#pragma unroll
    for (int j = 0; j < 96; j++) dst[j] = (h16)(q[j] * sc);
  } else if (u == 8) {
    float ss = 0; for (int k = 0; k < 128; k++) { float v = (float)ur[256 + k]; ss += v * v; }
    float r = 1.f / sqrtf(ss / 128 + EPSN);
    for (int k = 0; k < 128; k++) {
      float v = (float)ur[256 + k] * r * p.mla_kva_norm[i * 128 + k];
      if (!smp) p.o_ckv[st_row(m, i) * 128 + k] = v;
      p.ckvbuf[(size_t)kr * 128 + k] = v;
    }
  } else if (u == 9) {
    float v[32]; float ss = 0;
#pragma unroll
    for (int k = 0; k < 32; k++) { v[k] = (float)ur[384 + k]; ss += v[k] * v[k]; }
    float r = 1.f / sqrtf(ss / 32 + EPSN);
#pragma unroll
    for (int k = 0; k < 32; k++) { v[k] = v[k] * r * p.mla_kn_rope[i * 32 + k]; if (!smp) p.o_kpe[st_row(m, i) * 32 + k] = v[k]; }
    if (smp) {
#pragma unroll
      for (int j = 0; j < 16; j++) {
        float c = p.ropeC32[t * 16 + j], s = p.ropeS32[t * 16 + j];
        float x1 = v[j], x2 = v[16 + j];
        v[j] = x1 * c - x2 * s; v[16 + j] = x2 * c + x1 * s;
      }
    }
#pragma unroll
    for (int k = 0; k < 32; k++) p.kpebuf[(size_t)kr * 32 + k] = v[k];
  } else if (u < 18) {
    int cb = (u - 10) * 64;
    for (int j = 0; j < 64; j++) p.gates16[(size_t)m * 1024 + cb + j] = (h16)siluf((float)ur[416 + cb + j]);
  } else if (u < 34) {
    const bool isq = u < 26; int hc = isq ? u - 18 : u - 26;
    const h16* src = ur + (isq ? 928 : 1440) + hc * 64;
    const float* gn = (isq ? p.diff_qn : p.diff_kn) + i * 64;
    float v[64]; float ss = 0;
#pragma unroll
    for (int k = 0; k < 64; k++) { v[k] = (float)src[k]; ss += v[k] * v[k]; }
    float r = 1.f / sqrtf(ss / 64 + EPSN);
#pragma unroll
    for (int k = 0; k < 64; k++) { v[k] = v[k] * r * gn[k]; if (!isq && !smp) p.o_dk[st_row(m, i) * 512 + hc * 64 + k] = v[k]; }
    if (smp) {
#pragma unroll
      for (int j = 0; j < 32; j++) {
        float c = p.ropeC64[t * 32 + j], s = p.ropeS64[t * 32 + j];
        float x1 = v[j], x2 = v[32 + j];
        v[j] = x1 * c - x2 * s; v[32 + j] = x2 * c + x1 * s;
      }
    }
    if (isq) {
      const float sc = LOG2E / 8.f; h16* dst = p.QB + ((size_t)m * 8 + hc) * 64;
#pragma unroll
      for (int k = 0; k < 64; k++) dst[k] = (h16)(v[k] * sc);
    } else {
      h16* dst = p.KB + ((size_t)hc * KM + kr) * 64;
#pragma unroll
      for (int k = 0; k < 64; k++) dst[k] = (h16)v[k];
    }
  } else if (u < 42) {
    int ch = u - 34; int h = ch >> 1, half = ch & 1;
    for (int j = 0; j < 64; j++) {
      float v = (float)ur[1952 + ch * 64 + j];
      if (!smp) p.o_dv[st_row(m, i) * 512 + ch * 64 + j] = v;
      p.VB[((size_t)h * 128 + half * 64 + j) * KM + kr] = (h16)v;
    }
  } else {
    int cb = (u - 42) * 64;
    for (int j = 0; j < 64; j++) p.gates16[(size_t)m * 1024 + 512 + cb + j] = (h16)siluf((float)ur[2464 + cb + j]);
  }
}
KERNEL nk_cache_even(Params p, int l, long n) {
  long g = GTID; if (g >= n) return;
  const int i = l >> 1;
  int u = g % 17; int pos = (g / 17) % PAST; int b = g / (17 * PAST);
  const int kr = MP + b * TKS + DS + pos;
  const size_t crow = ((size_t)(b * 2 + i) * PAST + pos);
  if (u == 0) {
    for (int k = 0; k < 128; k++) { float v = p.cache_mla_ckv[crow * 128 + k]; p.ckvbuf[(size_t)kr * 128 + k] = v; p.ckv16[(size_t)kr * 128 + k] = (h16)v; }
    for (int k = 0; k < 32; k++) { float v = p.cache_mla_kpe[crow * 32 + k]; p.kpebuf[(size_t)kr * 32 + k] = v; p.kpe16[(size_t)kr * 32 + k] = (h16)v; }
  } else if (u < 9) {
    int hc = u - 1;
    for (int k = 0; k < 64; k++) p.KB[((size_t)hc * KM + kr) * 64 + k] = (h16)p.cache_diff_k[crow * 512 + hc * 64 + k];
  } else {
    int ch = u - 9; int h = ch >> 1, half = ch & 1;
    for (int j = 0; j < 64; j++) p.VB[((size_t)h * 128 + half * 64 + j) * KM + kr] = (h16)p.cache_diff_v[crow * 512 + ch * 64 + j];
  }
}
KERNEL nk_kv(Params p, int l, long n) {
  long g = GTID; if (g >= n) return;
  const int i = l >> 1;
  int part = g & 1; int h = (g >> 1) & 7; int kr = g >> 4;
  const float* cr = p.ckvbuf + (size_t)kr * 128;
  const float* W = p.mla_wkvb + (size_t)i * 128 * 1024 + h * 128 + part * 64;
  float a[64];
#pragma unroll
  for (int j = 0; j < 64; j++) a[j] = 0;
  for (int k = 0; k < 128; k++) {
    float c = (float)(h16)cr[k];
#pragma unroll
    for (int j = 0; j < 64; j++) a[j] += c * W[(size_t)k * 1024 + j];
  }
  if (part == 0) {
    float ss = 0;
#pragma unroll
    for (int j = 0; j < 64; j++) ss += a[j] * a[j];
    float r = 1.f / sqrtf(ss / 64 + EPSN);
    h16* dst = p.KA + ((size_t)h * KM + kr) * 128;
#pragma unroll
    for (int j = 0; j < 64; j++) dst[j] = (h16)(a[j] * r * p.mla_kn_nope[i * 64 + j]);
    for (int j = 0; j < 32; j++) dst[64 + j] = (h16)p.kpebuf[(size_t)kr * 32 + j];
  } else {
#pragma unroll
    for (int j = 0; j < 64; j++) p.VA[((size_t)h * 64 + j) * KM + kr] = (h16)a[j];
  }
}
KERNEL nk_epi_odd(Params p, int l, long n) {
  long g = GTID; if (g >= n) return;
  const int i = l >> 1;
  int m = g / 52, u = g % 52;
  const h16* ur = p.ubuf + (size_t)m * 3328;
  const bool smp = m >= MP; const int t = tok_pos(m); const int kr = tok_keyrow(m);
  if (u < 16 || (u >= 32 && u < 42)) {
    int colbase, head; const float* gn; int kind;
    if (u < 8) { kind = 0; head = u; colbase = head * 64; gn = p.na_qn + i * 64; }
    else if (u < 16) { kind = 1; head = u - 8; colbase = 512 + head * 64; gn = p.na_kn + i * 64; }
    else if (u < 40) { kind = 2; head = u - 32; colbase = 2048 + head * 64; gn = p.gqa_qn + i * 64; }
    else { kind = 3; head = u - 40; colbase = 2560 + head * 64; gn = p.gqa_kn + i * 64; }
    float v[64]; float ss = 0;
#pragma unroll
    for (int k = 0; k < 64; k++) { v[k] = (float)ur[colbase + k]; ss += v[k] * v[k]; }
    float r = 1.f / sqrtf(ss / 64 + EPSN);
#pragma unroll
    for (int k = 0; k < 64; k++) v[k] = v[k] * r * gn[k];
    if (!smp) {
      if (kind == 1) { for (int k = 0; k < 64; k++) p.o_nk[st_row(m, i) * 512 + head * 64 + k] = v[k]; }
      if (kind == 3) { for (int k = 0; k < 64; k++) p.o_gk[st_row(m, i) * 128 + head * 64 + k] = v[k]; }
    }
    if (smp && kind >= 2) {
#pragma unroll
      for (int j = 0; j < 32; j++) {
        float c = p.ropeC64[t * 32 + j], s = p.ropeS64[t * 32 + j];
        float x1 = v[j], x2 = v[32 + j];
        v[j] = x1 * c - x2 * s; v[32 + j] = x2 * c + x1 * s;
      }
    }
    const float sc = LOG2E / 8.f;
    h16* dst;
    if (kind == 0) dst = p.QA + ((size_t)m * 8 + head) * 64;
    else if (kind == 1) dst = p.KA + ((size_t)head * KM + kr) * 64;
    else if (kind == 2) dst = p.QB + ((size_t)m * 8 + head) * 64;
    else dst = p.KB + ((size_t)head * KM + kr) * 64;
    const float mul = (kind == 0 || kind == 2) ? sc : 1.f;
#pragma unroll
    for (int k = 0; k < 64; k++) dst[k] = (h16)(v[k] * mul);
  } else if (u < 24) {
    int head = u - 16;
    for (int j = 0; j < 64; j++) {
      float v = (float)ur[1024 + head * 64 + j];
      if (!smp) p.o_nv[st_row(m, i) * 512 + head * 64 + j] = v;
      p.VA[((size_t)head * 64 + j) * KM + kr] = (h16)v;
    }
  } else if (u < 32) {
    int cb = (u - 24) * 64;
    for (int j = 0; j < 64; j++) p.gates16[(size_t)m * 1024 + cb + j] = (h16)siluf((float)ur[1536 + cb + j]);
  } else if (u < 44) {
    int head = u - 42;
    for (int j = 0; j < 64; j++) {
      float v = (float)ur[2688 + head * 64 + j];
      if (!smp) p.o_gv[st_row(m, i) * 128 + head * 64 + j] = v;
      p.VB[((size_t)head * 64 + j) * KM + kr] = (h16)v;
    }
  } else {
    int cb = (u - 44) * 64;
    for (int j = 0; j < 64; j++) p.gates16[(size_t)m * 1024 + 512 + cb + j] = (h16)siluf((float)ur[2816 + cb + j]);
  }
}
KERNEL nk_cache_odd(Params p, int l, long n) {
  long g = GTID; if (g >= n) return;
  const int i = l >> 1;
  int u = g % 20; int pos = (g / 20) % PAST; int b = g / (20 * PAST);
  const int kr = MP + b * TKS + DS + pos;
  const size_t crow = ((size_t)(b * 2 + i) * PAST + pos);
  if (u < 8) { for (int k = 0; k < 64; k++) p.KA[((size_t)u * KM + kr) * 64 + k] = (h16)p.cache_na_k[crow * 512 + u * 64 + k]; }
  else if (u < 16) { int h = u - 8; for (int j = 0; j < 64; j++) p.VA[((size_t)h * 64 + j) * KM + kr] = (h16)p.cache_na_v[crow * 512 + h * 64 + j]; }
  else if (u < 18) { int h = u - 16; for (int k = 0; k < 64; k++) p.KB[((size_t)h * KM + kr) * 64 + k] = (h16)p.cache_gqa_k[crow * 128 + h * 64 + k]; }
  else { int h = u - 18; for (int j = 0; j < 64; j++) p.VB[((size_t)h * 64 + j) * KM + kr] = (h16)p.cache_gqa_v[crow * 128 + h * 64 + j]; }
}
template <int DQK, int KP>
DEVFN void attn_dense_thread(const h16* q, const h16* K, const h16* VT, int kr0, int nk, float* out) {
  float qf[DQK];
#pragma unroll
  for (int j = 0; j < DQK; j++) qf[j] = (float)q[j];
  float o[64];
#pragma unroll
  for (int j = 0; j < 64; j++) o[j] = 0;
  float mx = -1e30f, sum = 0;
  for (int kk = 0; kk < nk; kk++) {
    const h16* kp = K + (size_t)(kr0 + kk) * KP;
    float s = 0;
#pragma unroll
    for (int j = 0; j < DQK; j++) s += qf[j] * (float)kp[j];
    float mn = fmaxf(mx, s); float al = exp2f_(mx - mn); float pe = exp2f_(s - mn);
    sum = sum * al + pe; mx = mn;
#pragma unroll
    for (int j = 0; j < 64; j++) o[j] = o[j] * al + pe * (float)VT[(size_t)j * KM + kr0 + kk];
  }
  float inv = 1.f / sum;
#pragma unroll
  for (int j = 0; j < 64; j++) out[j] = o[j] * inv;
}
KERNEL nk_attn_dense(Params p, int kind, int mlo, int mhi, long n) {
  long g = GTID; if (g >= n) return;
  const int nch = kind == 1 ? 2 : 1;
  int ch = g % nch; int head = (g / nch) % 8; int m = mlo + g / (nch * 8);
  if (m >= mhi) return;
  int kr0, nk;
  if (m < MP) { kr0 = (m / SEQ) * SEQ; nk = SEQ; } else { kr0 = MP + ((m - MP) / DS) * TKS; nk = TKS; }
  if (kind == 0) {
    attn_dense_thread<96, 128>(p.QA + ((size_t)m * 8 + head) * 96, p.KA + (size_t)head * KM * 128, p.VA + (size_t)head * 64 * KM, kr0, nk,
                          p.abuf + (size_t)m * 1536 + head * 64);
  } else if (kind == 1) {
    attn_dense_thread<64, 64>(p.QB + ((size_t)m * 8 + head) * 64, p.KB + (size_t)head * KM * 64,
                          p.VB + ((size_t)(head >> 1) * 128 + ch * 64) * KM, kr0, nk, p.abuf + (size_t)m * 1536 + 512 + head * 128 + ch * 64);
  } else if (kind == 2) {
    attn_dense_thread<64, 64>(p.QA + ((size_t)m * 8 + head) * 64, p.KA + (size_t)head * KM * 64, p.VA + (size_t)head * 64 * KM, kr0, nk,
                          p.abuf + (size_t)m * 1536 + head * 64);
  } else {
    attn_dense_thread<64, 64>(p.QB + ((size_t)m * 8 + head) * 64, p.KB + (size_t)(head >> 2) * KM * 64, p.VB + (size_t)(head >> 2) * 64 * KM,
                          kr0, nk, p.abuf + (size_t)m * 1536 + 512 + head * 64);
  }
}
KERNEL nk_attn_na(Params p, int l, long n) {
  long g = GTID; if (g >= n) return;
  const int i = l >> 1;
  int head = g & 7; int ms = g >> 3; int m = MP + ms;
  int b = ms / DS, t = ms % DS; int r = t / GW, c = t % GW;
  int rs = r - 4; rs = rs < 0 ? 0 : (rs > GROWS - 8 ? GROWS - 8 : rs);
  int cs = c - 8; cs = cs < 0 ? 0 : (cs > GW - 16 ? GW - 16 : cs);
  const h16* q = p.QA + ((size_t)m * 8 + head) * 64;
  const h16* K = p.KA + (size_t)head * KM * 64; const h16* VT = p.VA + (size_t)head * 64 * KM;
  const int kbase = MP + b * TKS;
  const float* rpb = p.na_rpb + ((size_t)i * 8 + head) * 15 * 31;
  float qf[64], o[64];
#pragma unroll
  for (int j = 0; j < 64; j++) { qf[j] = (float)q[j]; o[j] = 0; }
  float mx = -1e30f, sum = 0;
  for (int kk = 0; kk < 128 + PAST; kk++) {
    int kr; float bias = 0;
    if (kk < 128) { int ri = kk >> 4, cj = kk & 15; kr = kbase + (rs + ri) * GW + cs + cj; bias = rpb[(rs + ri - r + 7) * 31 + (cs + cj - c + 15)] * LOG2E; }
    else kr = kbase + DS + (kk - 128);
    const h16* kp = K + (size_t)kr * 64;
    float s = bias;
#pragma unroll
    for (int j = 0; j < 64; j++) s += qf[j] * (float)kp[j];
    float mn = fmaxf(mx, s); float al = exp2f_(mx - mn); float pe = exp2f_(s - mn);
    sum = sum * al + pe; mx = mn;
#pragma unroll
    for (int j = 0; j < 64; j++) o[j] = o[j] * al + pe * (float)VT[(size_t)j * KM + kr];
  }
  float inv = 1.f / sum; float* out = p.abuf + (size_t)m * 1536 + head * 64;
#pragma unroll
  for (int j = 0; j < 64; j++) out[j] = o[j] * inv;
}
KERNEL nk_fin(Params p, int l, long n) {
  long g = GTID; if (g >= n) return;
  const int i = l >> 1;
  if (l & 1) {
    int ch = g & 15; int m = g >> 4;
    for (int j = 0; j < 64; j++) {
      int col = ch * 64 + j;
      p.O16[(size_t)m * 1024 + col] = (h16)(p.abuf[(size_t)m * 1536 + col] * (float)p.gates16[(size_t)m * 1024 + col]);
    }
  } else {
    int u = g % 12; int m = g / 12;
    if (u < 8) {
      for (int j = 0; j < 64; j++) {
        int col = u * 64 + j;
        p.O16[(size_t)m * 1024 + col] = (h16)(p.abuf[(size_t)m * 1536 + col] * (float)p.gates16[(size_t)m * 1024 + col]);
      }
    } else {
      int h = u - 8; float lam = p.lamv[i]; float lam_init = 0.8f - 0.6f * expf(-0.3f * l);
      const float* a1 = p.abuf + (size_t)m * 1536 + 512 + (h * 2) * 128; const float* a2 = a1 + 128;
      float ss = 0;
      for (int j = 0; j < 128; j++) { float d = a1[j] - lam * a2[j]; ss += d * d; }
      float r = 1.f / sqrtf(ss / 128 + EPSN);
      for (int j = 0; j < 128; j++) {
        float d = (a1[j] - lam * a2[j]) * r * p.diff_subln[i * 128 + j] * (1.f - lam_init);
        int col = 512 + h * 128 + j;
        p.O16[(size_t)m * 1024 + col] = (h16)(d * (float)p.gates16[(size_t)m * 1024 + col]);
      }
    }
  }
}
KERNEL nk_outproj(Params p, int l, long n) {
  long g = GTID; if (g >= n) return;
  int m = g >> 10, col = g & 1023;
  const float* W = ((l & 1) ? p.w_out_odd : p.w_out_even) + (size_t)(l >> 1) * 1024 * 1024 + col;
  const h16* o = p.O16 + (size_t)m * 1024;
  float acc = 0;
  for (int k = 0; k < 1024; k++) acc += (float)o[k] * W[(size_t)k * 1024];
  float gate = p.modv[((size_t)l * NCV + tok_cv(m)) * 3072 + 2048 + col];
  p.Y[(size_t)m * 1024 + col] = xrow(p, l, m)[col] + gate * acc;
}


#endif
#ifndef CPU_EMU
typedef _Float16 h16x8 __attribute__((ext_vector_type(8)));
typedef _Float16 h16x4 __attribute__((ext_vector_type(4)));
typedef float f32x16 __attribute__((ext_vector_type(16)));
typedef float f32x4 __attribute__((ext_vector_type(4)));
#define LAS __attribute__((address_space(3)))
typedef unsigned u32x4 __attribute__((ext_vector_type(4)));
DEVFN size_t pidx(int R, int row, int k) { return ((size_t)(k >> 6) * R + row) * 64 + (k & 63); }
DEVFN size_t vidx(int vrow, int kr) { return ((size_t)(kr >> 6) * 512 + vrow) * 64 + (kr & 63); }
DEVFN float max3f(float a, float b, float c) { float r; asm("v_max3_f32 %0, %1, %2, %3" : "=v"(r) : "v"(a), "v"(b), "v"(c)); return r; }
DEVFN float frsq(float x) { return __builtin_amdgcn_rsqf(x); }
DEVFN float fsilu(float x) { return x * __builtin_amdgcn_rcpf(1.f + __builtin_amdgcn_exp2f(-LOG2E * x)); }
DEVFN int tid_op() { int t = threadIdx.x; asm volatile("" : "+v"(t)); return t; }

DEVFN int even_col(int np) { return np < 416 ? np : (np < 512 ? -1 : np - 96); }

constexpr int G_STAGE = 49152, G_NSTAGE = 3, G_LDS = G_STAGE * G_NSTAGE;
constexpr int G_LDS2 = 131072 + 8 * 3072;
DEVFN int img_off(int r, int c) { return r * 128 + ((c ^ ((r >> 1) & 7)) << 4); }
template <int R>
DEVFN void stage_rows(const h16* g, int ld, char* lds, int tid) {
#pragma unroll
  for (int i = 0; i < R / 64; i++) {
    int r = (tid >> 3) + 64 * i; int c = (tid & 7) ^ ((r >> 1) & 7);
    __builtin_amdgcn_global_load_lds((const unsigned*)(g + (size_t)r * ld + c * 8), (unsigned*)(lds + i * 8192 + tid * 16), 16, 0, 0);
  }
}
#define WAITV(n) asm volatile("s_waitcnt vmcnt(" #n ")" ::: "memory")
#define RAWBAR() do { asm volatile("s_waitcnt lgkmcnt(0)" ::: "memory"); __builtin_amdgcn_s_barrier(); } while (0)
template <bool TR>
DEVFN void gemm_tile(const h16* A, int RA, const h16* Bt, int RB, int K, int m0, int n0, char* lds, f32x16 (&acc)[2][2]) {
  const int TIDX = tid_op();
  const int tid = TIDX, lane = tid & 63, w = tid >> 6, wm = w >> 1, wn = w & 1;
  const int nt = K / 64;
  const h16* Ag = A + (size_t)m0 * 64; const h16* Bg = Bt + (size_t)n0 * 64; const size_t pa = (size_t)RA * 64, pb = (size_t)RB * 64;
#pragma unroll
  for (int a = 0; a < 2; a++)
#pragma unroll
    for (int b = 0; b < 2; b++)
#pragma unroll
      for (int r = 0; r < 16; r++) acc[a][b][r] = 0.f;
  stage_rows<256>(Ag, 64, lds, tid); stage_rows<128>(Bg, 64, lds + 32768, tid);
  if (nt > 1) { stage_rows<256>(Ag + pa, 64, lds + G_STAGE, tid); stage_rows<128>(Bg + pb, 64, lds + G_STAGE + 32768, tid); }
  const int ra = wm * 64 + (lane & 31), rb = wn * 64 + (lane & 31), ch = lane >> 5;
  auto piece = [&](const h16* g, char* s, int i) {
    const int r = (tid >> 3) + 64 * i; const int c = (tid & 7) ^ ((r >> 1) & 7);
    __builtin_amdgcn_global_load_lds((const unsigned*)(g + (size_t)r * 64 + c * 8), (unsigned*)(s + i * 8192 + tid * 16), 16, 0, 0);
  };
  for (int t = 0; t < nt; t++) {
    if (t + 1 < nt) WAITV(6); else WAITV(0);
    RAWBAR();
    const bool pre = t + 2 < nt;
    char* sn = lds + ((t + 2) % 3) * G_STAGE; const h16* An = Ag + (t + 2) * pa; const h16* Bn = Bg + (t + 2) * pb;
    const char* sa = lds + (t % 3) * G_STAGE; const char* sb = sa + 32768;
    h16x8 af[2][2], bf[2][2];
#pragma unroll
    for (int mb = 0; mb < 2; mb++) af[0][mb] = *(const h16x8*)(sa + img_off(ra + mb * 32, ch));
#pragma unroll
    for (int nb = 0; nb < 2; nb++) bf[0][nb] = *(const h16x8*)(sb + img_off(rb + nb * 32, ch));
#pragma unroll
    for (int ks = 0; ks < 4; ks++) {
      const int cur = ks & 1, nxt = cur ^ 1;
      if (ks < 3) {
#pragma unroll
        for (int mb = 0; mb < 2; mb++) af[nxt][mb] = *(const h16x8*)(sa + img_off(ra + mb * 32, 2 * (ks + 1) + ch));
#pragma unroll
        for (int nb = 0; nb < 2; nb++) bf[nxt][nb] = *(const h16x8*)(sb + img_off(rb + nb * 32, 2 * (ks + 1) + ch));
      }
      if (pre) {
        if (ks == 0) { piece(An, sn, 0); piece(An, sn, 1); }
        else if (ks == 1) { piece(An, sn, 2); piece(An, sn, 3); }
        else if (ks == 2) { piece(Bn, sn + 32768, 0); piece(Bn, sn + 32768, 1); }
      }
#pragma unroll
      for (int mb = 0; mb < 2; mb++)
#pragma unroll
        for (int nb = 0; nb < 2; nb++) {
          if (TR) acc[mb][nb] = __builtin_amdgcn_mfma_f32_32x32x16_f16(bf[cur][nb], af[cur][mb], acc[mb][nb], 0, 0, 0);
          else acc[mb][nb] = __builtin_amdgcn_mfma_f32_32x32x16_f16(af[cur][mb], bf[cur][nb], acc[mb][nb], 0, 0, 0);
        }
      __builtin_amdgcn_sched_barrier(0);
    }
  }
  RAWBAR();
}

DEVFN float wsum32(float v) { return v + __shfl_xor(v, 32); }

template <class RsF, class DstF>
DEVFN void epi_head64(const Params& p, const f32x16 (&acc)[2][2], int mbase, RsF rsf, const float* bias, const float* gain, bool rope, float oscale,
                      float* state, int spitch, int scol, int ilayer, DstF dstf) {
  const int TIDX = tid_op();
  const int lane = TIDX & 63, h = lane >> 5;
#pragma unroll
  for (int mb = 0; mb < 2; mb++) {
    const int m = mbase + mb * 32 + (lane & 31);
    const float rs = rsf(m);
    float v[2][16]; float ss = 0;
#pragma unroll
    for (int nb = 0; nb < 2; nb++)
#pragma unroll
      for (int q = 0; q < 4; q++) {
        const int j = nb * 32 + 8 * q + 4 * h;
        f32x4 b = bias ? *(const f32x4*)(bias + j) : (f32x4){0.f, 0.f, 0.f, 0.f};
#pragma unroll
        for (int e = 0; e < 4; e++) { float x = acc[mb][nb][q * 4 + e] * rs + b[e]; v[nb][q * 4 + e] = x; ss += x * x; }
      }
    ss = wsum32(ss);
    const float rr = frsq(ss * (1.f / 64.f) + EPSN);
#pragma unroll
    for (int nb = 0; nb < 2; nb++)
#pragma unroll
      for (int q = 0; q < 4; q++) {
        const int j = nb * 32 + 8 * q + 4 * h;
        f32x4 g = *(const f32x4*)(gain + j);
#pragma unroll
        for (int e = 0; e < 4; e++) v[nb][q * 4 + e] *= rr * g[e];
      }
    const bool smp = m >= MP;
    if (state && !smp) {
      float* sp = state + st_row(m, ilayer) * spitch + scol;
#pragma unroll
      for (int nb = 0; nb < 2; nb++)
#pragma unroll
        for (int q = 0; q < 4; q++) { f32x4 o = {v[nb][q * 4], v[nb][q * 4 + 1], v[nb][q * 4 + 2], v[nb][q * 4 + 3]}; *(f32x4*)(sp + nb * 32 + 8 * q + 4 * h) = o; }
    }
    if (rope && smp) {
      const int t = tok_pos(m);
#pragma unroll
      for (int q = 0; q < 4; q++) {
        f32x4 c = *(const f32x4*)(p.ropeC64 + t * 32 + 8 * q + 4 * h), s = *(const f32x4*)(p.ropeS64 + t * 32 + 8 * q + 4 * h);
#pragma unroll
        for (int e = 0; e < 4; e++) { float x1 = v[0][q * 4 + e], x2 = v[1][q * 4 + e]; v[0][q * 4 + e] = x1 * c[e] - x2 * s[e]; v[1][q * 4 + e] = x2 * c[e] + x1 * s[e]; }
      }
    }
    h16* dst = dstf(m);
#pragma unroll
    for (int nb = 0; nb < 2; nb++)
#pragma unroll
      for (int q = 0; q < 4; q++) {
        h16x4 o;
#pragma unroll
        for (int e = 0; e < 4; e++) o[e] = (h16)(v[nb][q * 4 + e] * oscale);
        *(h16x4*)(dst + nb * 32 + 8 * q + 4 * h) = o;
      }
  }
}
template <class RsF, class DstF>
DEVFN void epi_head32(const Params& p, const f32x16 (&acc)[2][2], int mbase, RsF rsf, const float* bias, const float* gain, bool rope, float oscale,
                      float* state, int ilayer, DstF dstf, float* dual = nullptr) {
  const int TIDX = tid_op();
  const int lane = TIDX & 63, h = lane >> 5;
#pragma unroll
  for (int mb = 0; mb < 2; mb++) {
    const int m = mbase + mb * 32 + (lane & 31);
    const float rs = rsf(m);
    float v[16]; float ss = 0;
#pragma unroll
    for (int q = 0; q < 4; q++) {
      const int j = 8 * q + 4 * h;
      f32x4 b = bias ? *(const f32x4*)(bias + j) : (f32x4){0.f, 0.f, 0.f, 0.f};
#pragma unroll
      for (int e = 0; e < 4; e++) { float x = acc[mb][0][q * 4 + e] * rs + b[e]; v[q * 4 + e] = x; ss += x * x; }
    }
    ss = wsum32(ss);
    const float rr = frsq(ss * (1.f / 32.f) + EPSN);
#pragma unroll
    for (int q = 0; q < 4; q++) {
      f32x4 g = *(const f32x4*)(gain + 8 * q + 4 * h);
#pragma unroll
      for (int e = 0; e < 4; e++) v[q * 4 + e] *= rr * g[e];
    }
    const bool smp = m >= MP;
    if (state && !smp) {
      float* sp = state + st_row(m, ilayer) * 32;
#pragma unroll
      for (int q = 0; q < 4; q++) { f32x4 o = {v[q * 4], v[q * 4 + 1], v[q * 4 + 2], v[q * 4 + 3]}; *(f32x4*)(sp + 8 * q + 4 * h) = o; }
    }
    if (rope && smp) {
      const int t = tok_pos(m);
#pragma unroll
      for (int q = 0; q < 2; q++) {
        f32x4 c = *(const f32x4*)(p.ropeC32 + t * 16 + 8 * q + 4 * h), s = *(const f32x4*)(p.ropeS32 + t * 16 + 8 * q + 4 * h);
#pragma unroll
        for (int e = 0; e < 4; e++) { float x1 = v[q * 4 + e], x2 = v[(q + 2) * 4 + e]; v[q * 4 + e] = x1 * c[e] - x2 * s[e]; v[(q + 2) * 4 + e] = x2 * c[e] + x1 * s[e]; }
      }
    }
    h16* dst = dstf(m);
#pragma unroll
    for (int q = 0; q < 4; q++) {
      h16x4 o;
#pragma unroll
      for (int e = 0; e < 4; e++) o[e] = (h16)(v[q * 4 + e] * oscale);
      *(h16x4*)(dst + 8 * q + 4 * h) = o;
      if (dual) { for (int e = 0; e < 4; e++) dual[(size_t)tok_keyrow(m) * 32 + 8 * q + 4 * h + e] = v[q * 4 + e]; }
    }
  }
}
template <class RsF, class KrF>
DEVFN void epi_vt(const f32x16 (&acc)[2][2], int mbase, RsF rsf, const float* bias  , float* state, int spitch, int scol, int ilayer,
                  h16* vbuf, int vrow0, KrF krf) {
  const int TIDX = tid_op();
  const int lane = TIDX & 63, h = lane >> 5, e0 = lane & 31;
#pragma unroll
  for (int mb = 0; mb < 2; mb++)
#pragma unroll
    for (int q = 0; q < 4; q++) {
      const int mq = mbase + mb * 32 + 8 * q + 4 * h;
      float rs[4];
#pragma unroll
      for (int e = 0; e < 4; e++) rs[e] = rsf(mq + e);
      const int kr = krf(mq);
#pragma unroll
      for (int nb = 0; nb < 2; nb++) {
        const int col = nb * 32 + e0; const float b = bias ? bias[col] : 0.f;
        h16x4 o;
#pragma unroll
        for (int e = 0; e < 4; e++) {
          float x = acc[mb][nb][q * 4 + e] * rs[e] + b; o[e] = (h16)x;
          if (state && mq < MP) state[st_row(mq + e, ilayer) * spitch + scol + col] = x;
        }
        *(h16x4*)(vbuf + vidx(vrow0 + col, kr)) = o;
      }
    }
}

DEVFN void qgemm_tile(const Params& p, int l, int mt, int head, char* lds) {
  const int TIDX = tid_op();
  const int i = l >> 1; const int m0 = mt * 256;
  const int w = TIDX >> 6, wm = w >> 1, wn = w & 1;
  f32x16 acc[2][2];
  gemm_tile<true>(p.qa16, M, (p.wqb16 + (size_t)i * 1024 * 256), 1024, 256, m0, head * 128, lds, acc);
  const float* rq = p.rowss_qa + (size_t)i * M;
  auto rsf = [&](int m) { return frsq(rq[m] * (1.f / 256.f) + EPSN); };
  const float sc = LOG2E / sqrtf(96.f);
  if (wn == 0) epi_head64(p, acc, m0 + wm * 64, rsf, nullptr, p.mla_qn_nope + i * 64, false, sc, nullptr, 0, 0, i, [&](int m) { return p.QA + ((size_t)m * 8 + head) * 96; });
  else epi_head32(p, acc, m0 + wm * 64, rsf, nullptr, p.mla_qn_rope + i * 32, true, sc, nullptr, i, [&](int m) { return p.QA + ((size_t)m * 8 + head) * 96 + 64; });
}
DEVFN void kvgemm_tile(const Params& p, int l, int mt, int ntile, char* lds) {
  const int TIDX = tid_op();
  const int i = l >> 1; const int m0 = mt * 256;
  const int lane = TIDX & 63, w = TIDX >> 6, wm = w >> 1, wn = w & 1, h = lane >> 5;
  f32x16 acc[2][2];
  const float* rck = p.rowss_ckv + (size_t)i * KM;
  auto one = [&](int m) { return frsq(rck[m] * (1.f / 128.f) + EPSN); };
  if (ntile < 4) {
    gemm_tile<true>(p.ckv16, KM, (p.wkvb16 + (size_t)i * 1024 * 128), 1024, 128, m0, ntile * 128, lds, acc);
    const int head = ntile * 2 + wn;
    epi_head64(p, acc, m0 + wm * 64, one, nullptr, p.mla_kn_nope + i * 64, false, 1.f, nullptr, 0, 0, i, [&](int m) { return p.KA + ((size_t)head * KM + m) * 128; });
#pragma unroll
    for (int mb = 0; mb < 2; mb++) {
      const int kr = m0 + wm * 64 + mb * 32 + (lane & 31);
      const h16x8* s = (const h16x8*)(p.kpe16 + (size_t)kr * 32 + h * 16);
      h16x8* d = (h16x8*)(p.KA + ((size_t)head * KM + kr) * 128 + 64 + h * 16);
      d[0] = s[0]; d[1] = s[1];
    }
  } else {
    gemm_tile<false>(p.ckv16, KM, (p.wkvb16 + (size_t)i * 1024 * 128), 1024, 128, m0, ntile * 128, lds, acc);
    const int head = (ntile - 4) * 2 + wn;
    epi_vt(acc, m0 + wm * 64, one, nullptr, nullptr, 0, 0, i, p.VA, head * 64, [](int m) { return m; });
  }
}
DEVFN void outproj_tile(const Params& p, int l, int mt, int ntile, char* lds, bool dry = false) {
  const int TIDX = tid_op();
  const int m0 = mt * 256, n0 = ntile * 128;
  const int lane = TIDX & 63, w = TIDX >> 6, wm = w >> 1, wn = w & 1, h = lane >> 5;
  f32x16 acc[2][2];
  gemm_tile<true>(p.O16, M, (p.wout16 + (size_t)l * D * D), 1024, D, m0, n0, lds, acc);
  const int cv = tok_cv(m0); const int nw0 = n0 + wn * 64;
  const float* gate = p.modv + ((size_t)l * NCV + cv) * 3072 + 2048 + nw0;
  const float* nsc = p.modv + ((size_t)(l + 1) * NCV + cv) * 3072 + 1024 + nw0;
  const float* nnw = p.norm_w + (l + 1) * D + nw0;
#pragma unroll
  for (int mb = 0; mb < 2; mb++) {
    const int m = m0 + wm * 64 + mb * 32 + (lane & 31);
    const float* xr = xrow(p, l, m) + nw0; float* yr = p.Y + (size_t)m * D + nw0;
    float ss = 0;
#pragma unroll
    for (int nb = 0; nb < 2; nb++)
#pragma unroll
      for (int q = 0; q < 4; q++) {
        const int j = nb * 32 + 8 * q + 4 * h;
        f32x4 x = *(const f32x4*)(xr + j), g = *(const f32x4*)(gate + j), o;
#pragma unroll
        for (int e = 0; e < 4; e++) { o[e] = x[e] + g[e] * acc[mb][nb][q * 4 + e]; ss += o[e] * o[e]; }
        if (!dry) *(f32x4*)(yr + j) = o;
        if (l < 3 && !dry) {
          f32x4 s = *(const f32x4*)(nsc + j), nw = *(const f32x4*)(nnw + j); h16x4 oh;
#pragma unroll
          for (int e = 0; e < 4; e++) oh[e] = (h16)(o[e] * nw[e] * (1.f + s[e]));
          *(h16x4*)(p.xs16 + pidx(M, m, nw0 + j)) = oh;
        }
      }
    if (l < 3 && !dry) { ss = wsum32(ss); if (h == 0) atomicAdd(p.rowss_l + (size_t)(l + 1) * M + m, ss); }
  }
}
struct AttnItem {
  const h16 *k0, *k1; int kld;
  const h16 *v0, *v1;
  int kr0, nt0, kr1, nt1;
};
constexpr int A_RING = 3 * 32768;

template <int DQK, int NKI, int NVI, int NDB, bool NAMASK>
DEVFN void attn_core(const AttnItem& it, const h16* qptr, int qpitch, int ksel, int ta, int tb, const float* rpbl, int na_dr0  , int na_c,
                     char* lds, f32x16 (&o)[NDB], float& lsum_out) {
  const int TIDX = tid_op();
  constexpr int NIMG = NKI + NVI; constexpr int STG = NIMG * 8192;
  const int tid = TIDX, lane = tid & 63, h = lane >> 5;
  h16x8 qf[DQK / 16];
#pragma unroll
  for (int ks = 0; ks < DQK / 16; ks++) qf[ks] = *(const h16x8*)(qptr + (size_t)(lane & 31) * qpitch + ks * 16 + 8 * h);
#pragma unroll
  for (int db = 0; db < NDB; db++)
#pragma unroll
    for (int r = 0; r < 16; r++) o[db][r] = 0.f;
  float m_run = 0.f, lsum = 0.f; bool first = true;
  const int nt = it.nt0 + it.nt1;
  auto stage = [&](int t) {
    char* s = lds + (t % 3) * STG; const int kr = t < it.nt0 ? it.kr0 + 64 * t : it.kr1 + 64 * (t - it.nt0);
    stage_rows<64>(it.k0 + (size_t)kr * it.kld, it.kld, s, tid);
    if (NKI == 2) stage_rows<64>(it.k1 + (size_t)kr * it.kld, it.kld, s + 8192, tid);
    stage_rows<64>(it.v0 + (size_t)(kr >> 6) * (512 * 64), 64, s + NKI * 8192, tid);
    if (NVI == 2) stage_rows<64>(it.v1 + (size_t)(kr >> 6) * (512 * 64), 64, s + NKI * 8192 + 8192, tid);
  };
  stage(0); if (nt > 1) stage(1);
  const int l5 = lane & 31;
  const int prow = (l5 & 19) | ((l5 & 4) << 1) | ((l5 & 8) >> 1);
  int na_cs = na_c - 8; na_cs = na_cs < 0 ? 0 : (na_cs > GW - 16 ? GW - 16 : na_cs);
  for (int t = 0; t < nt; t++) {
    if (t + 1 < nt) { if (NIMG == 2) WAITV(2); else if (NIMG == 3) WAITV(3); else WAITV(4); } else WAITV(0);
    RAWBAR();
    if (t + 2 < nt) stage(t + 2);
    const bool active = (t >= it.nt0) || (t >= ta && t < tb);
    if (active) {
      const char* s = lds + (t % 3) * STG;
      const char* sv = s + NKI * 8192;
      h16x8 kf[2][DQK / 16];
#pragma unroll
      for (int kb = 0; kb < 2; kb++)
#pragma unroll
        for (int ks = 0; ks < DQK / 16; ks++) {
          const int img = (DQK == 96) ? (ks >> 2) : ksel;
          kf[kb][ks] = *(const h16x8*)(s + img * 8192 + img_off(32 * kb + prow, 2 * (ks & 3) + h));
        }
      __builtin_amdgcn_sched_barrier(0);
      f32x16 st[2];
#pragma unroll
      for (int kb = 0; kb < 2; kb++) {
#pragma unroll
        for (int r = 0; r < 16; r++) st[kb][r] = -m_run;
#pragma unroll
        for (int ks = 0; ks < DQK / 16; ks++) st[kb] = __builtin_amdgcn_mfma_f32_32x32x16_f16(kf[kb][ks], qf[ks], st[kb], 0, 0, 0);
      }
      __builtin_amdgcn_sched_barrier(0);
      h16x8 vf[2][4];
#pragma unroll
      for (int db = 0; db < 2; db++)
#pragma unroll
        for (int sI = 0; sI < 4; sI++) vf[db][sI] = *(const h16x8*)(sv + img_off(db * 32 + l5, 2 * sI + h));
      __builtin_amdgcn_sched_barrier(0);
      if (NAMASK && t < it.nt0) {
        const int drow = (na_dr0 + t) * 31 + 15 - na_c;
#pragma unroll
        for (int kb = 0; kb < 2; kb++)
#pragma unroll
          for (int r = 0; r < 16; r++) {
            const int kcol = 32 * kb + (r & 7) + 8 * h + 16 * (r >> 3);
            const bool valid = (unsigned)(kcol - na_cs) < 16u;
            const float bv = rpbl[valid ? drow + kcol : 0];
            st[kb][r] = valid ? st[kb][r] + bv : -1e30f;
          }
      }
      float mx;
      {
        float m0 = max3f(st[0][0], st[0][1], st[0][2]), m1 = max3f(st[1][0], st[1][1], st[1][2]);
#pragma unroll
        for (int r = 3; r < 15; r += 2) { m0 = max3f(m0, st[0][r], st[0][r + 1]); m1 = max3f(m1, st[1][r], st[1][r + 1]); }
        mx = max3f(m0, m1, st[0][15]); mx = fmaxf(mx, st[1][15]);
      }
      { auto sw = __builtin_amdgcn_permlane32_swap(__float_as_uint(mx), __float_as_uint(mx), false, false); mx = fmaxf(__uint_as_float(sw[0]), __uint_as_float(sw[1])); }
      if (first || !__all(mx <= 8.f)) {
        const float delta = first ? mx : fmaxf(mx, 0.f);
        const float al = __builtin_amdgcn_exp2f(-delta); m_run += delta; lsum *= al; first = false;
#pragma unroll
        for (int db = 0; db < NDB; db++)
#pragma unroll
          for (int r = 0; r < 16; r++) o[db][r] *= al;
#pragma unroll
        for (int kb = 0; kb < 2; kb++)
#pragma unroll
          for (int r = 0; r < 16; r++) st[kb][r] -= delta;
      }
      float sum = 0.f;
#pragma unroll
      for (int kb = 0; kb < 2; kb++)
#pragma unroll
        for (int r = 0; r < 16; r++) { float pe = __builtin_amdgcn_exp2f(st[kb][r]); st[kb][r] = pe; sum += pe; }
      lsum += sum;
      h16x8 pf[4];
#pragma unroll
      for (int sI = 0; sI < 4; sI++) {
        u32x4 pk;
#pragma unroll
        for (int j = 0; j < 4; j++) pk[j] = __builtin_bit_cast(unsigned, __builtin_amdgcn_cvt_pkrtz(st[sI >> 1][8 * (sI & 1) + 2 * j], st[sI >> 1][8 * (sI & 1) + 2 * j + 1]));
        pf[sI] = __builtin_bit_cast(h16x8, pk);
      }
      __builtin_amdgcn_sched_barrier(0);
      if (NDB == 4) {
        h16x8 vg[2][4];
#pragma unroll
        for (int db = 0; db < 2; db++)
#pragma unroll
          for (int sI = 0; sI < 4; sI++) vg[db][sI] = *(const h16x8*)(sv + 8192 + img_off(db * 32 + l5, 2 * sI + h));
#pragma unroll
        for (int db = 0; db < 2; db++)
#pragma unroll
          for (int sI = 0; sI < 4; sI++) o[db] = __builtin_amdgcn_mfma_f32_32x32x16_f16(vf[db][sI], pf[sI], o[db], 0, 0, 0);
#pragma unroll
        for (int db = 0; db < 2; db++)
#pragma unroll
          for (int sI = 0; sI < 4; sI++) o[NDB == 4 ? 2 + db : db] = __builtin_amdgcn_mfma_f32_32x32x16_f16(vg[db][sI], pf[sI], o[NDB == 4 ? 2 + db : db], 0, 0, 0);
      } else {
#pragma unroll
        for (int db = 0; db < 2; db++)
#pragma unroll
          for (int sI = 0; sI < 4; sI++) o[db] = __builtin_amdgcn_mfma_f32_32x32x16_f16(vf[db][sI], pf[sI], o[db], 0, 0, 0);
      }
      __builtin_amdgcn_sched_barrier(0);
    }
  }
  RAWBAR();
  lsum_out = lsum + __shfl_xor(lsum, 32);
}
template <int NDB>
DEVFN void attn_store_gated(const Params& p, const f32x16 (&o)[NDB], float inv, int m, int col0) {
  const int TIDX = tid_op();
  const int h = (TIDX & 63) >> 5;
#pragma unroll
  for (int db = 0; db < NDB; db++)
#pragma unroll
    for (int q = 0; q < 4; q++) {
      const int c = col0 + 32 * db + 8 * q + 4 * h;
      h16x4 g = *(const h16x4*)(p.gates16 + (size_t)m * 1024 + c), ov;
#pragma unroll
      for (int e = 0; e < 4; e++) ov[e] = (h16)(o[db][q * 4 + e] * inv * (float)g[e]);
      *(h16x4*)(p.O16 + pidx(M, m, c)) = ov;
    }
}
DEVFN void attn_even_item(const Params& p, int l, int item, char* lds) {
  const int TIDX = tid_op();
  const int i = l >> 1; const int lane = TIDX & 63, w = TIDX >> 6, h = lane >> 5;
  const int grp = item >> 7, j = item & 127; const bool smp = grp < 2; const bool isdiff = (grp & 1) == 0;
  AttnItem it{}; it.nt1 = 0; it.kr1 = 0;
  if (isdiff) {
    int b, hh, t0;
    if (smp) { b = j >> 6; hh = (j >> 4) & 3; t0 = (j & 15) * 128; it.kr0 = MP + b * TKS; it.nt0 = TKS / 64; }
    else { b = j >> 3; hh = (j >> 1) & 3; t0 = (j & 1) * 128; it.kr0 = b * SEQ; it.nt0 = SEQ / 64; }
    const int comp = w >> 2;
    const int m0w = (smp ? MP + b * DS : b * SEQ) + t0 + (w & 3) * 32;
    it.k0 = p.KB + (size_t)(2 * hh) * KM * 64; it.k1 = p.KB + (size_t)(2 * hh + 1) * KM * 64; it.kld = 64;
    it.v0 = p.VB + (size_t)(hh * 128) * 64; it.v1 = p.VB + (size_t)(hh * 128 + 64) * 64;
    f32x16 o[4]; float lsum;
    attn_core<64, 2, 2, 4, false>(it, p.QB + ((size_t)m0w * 8 + 2 * hh + comp) * 64, 512, comp, 0, 1 << 30, nullptr, 0, 0, lds, o, lsum);
    const float inv = 1.f / lsum;
    float* a2 = (float*)lds + (size_t)(w & 3) * 32 * 132 + (size_t)(lane & 31) * 132;
    if (comp == 1) {
#pragma unroll
      for (int db = 0; db < 4; db++)
#pragma unroll
        for (int q = 0; q < 4; q++) { f32x4 v = {o[db][q * 4] * inv, o[db][q * 4 + 1] * inv, o[db][q * 4 + 2] * inv, o[db][q * 4 + 3] * inv}; *(f32x4*)(a2 + 32 * db + 8 * q + 4 * h) = v; }
    }
    __syncthreads();
    if (comp == 0) {
      const float lam = p.lamv[i]; const float lam_init = 0.8f - 0.6f * expf(-0.3f * l);
      float ss = 0;
#pragma unroll
      for (int db = 0; db < 4; db++)
#pragma unroll
        for (int q = 0; q < 4; q++) {
          f32x4 v2 = *(const f32x4*)(a2 + 32 * db + 8 * q + 4 * h);
#pragma unroll
          for (int e = 0; e < 4; e++) { float d = o[db][q * 4 + e] * inv - lam * v2[e]; o[db][q * 4 + e] = d; ss += d * d; }
        }
      ss = wsum32(ss);
      const float rr = (1.f - lam_init) * frsq(ss * (1.f / 128.f) + EPSN);
      const int m = m0w + (lane & 31);
#pragma unroll
      for (int db = 0; db < 4; db++)
#pragma unroll
        for (int q = 0; q < 4; q++) {
          const int dv = 32 * db + 8 * q + 4 * h; const int c = 512 + hh * 128 + dv;
          f32x4 sg = *(const f32x4*)(p.diff_subln + i * 128 + dv);
          h16x4 g = *(const h16x4*)(p.gates16 + (size_t)m * 1024 + c), ov;
#pragma unroll
          for (int e = 0; e < 4; e++) ov[e] = (h16)(o[db][q * 4 + e] * rr * sg[e] * (float)g[e]);
          *(h16x4*)(p.O16 + pidx(M, m, c)) = ov;
        }
    }
    __syncthreads();
  } else {
    int b, head, t0;
    if (smp) { b = j >> 6; head = (j >> 3) & 7; t0 = (j & 7) * 256; it.kr0 = MP + b * TKS; it.nt0 = TKS / 64; }
    else { b = j >> 3; head = j & 7; t0 = 0; it.kr0 = b * SEQ; it.nt0 = SEQ / 64; }
    const int m0w = (smp ? MP + b * DS : b * SEQ) + t0 + w * 32;
    it.k0 = p.KA + (size_t)head * KM * 128; it.k1 = it.k0 + 64; it.kld = 128;
    it.v0 = p.VA + (size_t)(head * 64) * 64; it.v1 = it.v0;
    f32x16 o[2]; float lsum;
    attn_core<96, 2, 1, 2, false>(it, p.QA + ((size_t)m0w * 8 + head) * 96, 768, 0, 0, 1 << 30, nullptr, 0, 0, lds, o, lsum);
    attn_store_gated<2>(p, o, 1.f / lsum, m0w + (lane & 31), head * 64);
  }
}
DEVFN void attn_odd_item(const Params& p, int l, int item, char* lds) {
  const int TIDX = tid_op();
  const int i = l >> 1; const int lane = TIDX & 63, w = TIDX >> 6;
  const int grp = item >> 7, j = item & 127; const bool smp = grp < 2; const bool isgqa = (grp & 1) == 0;
  AttnItem it{}; it.nt1 = 0; it.kr1 = 0; it.kld = 64;
  f32x16 o[2]; float lsum;
  if (isgqa) {
    int b, kvh, t0;
    if (smp) { b = j >> 6; kvh = (j >> 5) & 1; t0 = (j & 31) * 64; it.kr0 = MP + b * TKS; it.nt0 = TKS / 64; }
    else { b = j >> 3; kvh = (j >> 2) & 1; t0 = (j & 3) * 64; it.kr0 = b * SEQ; it.nt0 = SEQ / 64; }
    const int head = kvh * 4 + (w >> 1);
    const int m0w = (smp ? MP + b * DS : b * SEQ) + t0 + (w & 1) * 32;
    it.k0 = p.KB + (size_t)kvh * KM * 64; it.k1 = it.k0; it.v0 = p.VB + (size_t)(kvh * 64) * 64; it.v1 = it.v0;
    attn_core<64, 1, 1, 2, false>(it, p.QB + ((size_t)m0w * 8 + head) * 64, 512, 0, 0, 1 << 30, nullptr, 0, 0, lds, o, lsum);
    attn_store_gated<2>(p, o, 1.f / lsum, m0w + (lane & 31), 512 + head * 64);
  } else if (!smp) {
    const int b = j >> 3, head = j & 7; it.kr0 = b * SEQ; it.nt0 = SEQ / 64;
    const int m0w = b * SEQ + w * 32;
    it.k0 = p.KA + (size_t)head * KM * 64; it.k1 = it.k0; it.v0 = p.VA + (size_t)(head * 64) * 64; it.v1 = it.v0;
    attn_core<64, 1, 1, 2, false>(it, p.QA + ((size_t)m0w * 8 + head) * 64, 512, 0, 0, 1 << 30, nullptr, 0, 0, lds, o, lsum);
    attn_store_gated<2>(p, o, 1.f / lsum, m0w + (lane & 31), head * 64);
  } else {
    const int b = j >> 6, head = (j >> 3) & 7, r0 = (j & 7) * 4;
    const int r = r0 + (w >> 1), c0 = (w & 1) * 32;
    auto rsf = [](int rr) { int s = rr - 4; return s < 0 ? 0 : (s > GROWS - 8 ? GROWS - 8 : s); };
    const int rlo = rsf(r0), rhi = rsf(r0 + 3) + 8;
    const int kbase = MP + b * TKS;
    it.kr0 = kbase + rlo * 64; it.nt0 = rhi - rlo; it.kr1 = kbase + DS; it.nt1 = PAST / 64;
    it.k0 = p.KA + (size_t)head * KM * 64; it.k1 = it.k0; it.v0 = p.VA + (size_t)(head * 64) * 64; it.v1 = it.v0;
    float* rpbl = (float*)(lds + A_RING);
    { const float* src = p.na_rpb + ((size_t)i * 8 + head) * 465; for (int k = TIDX; k < 465; k += 512) rpbl[k] = src[k] * LOG2E; }
    const int m0w = MP + b * DS + r * 64 + c0;
    const int ta = rsf(r) - rlo;
    attn_core<64, 1, 1, 2, true>(it, p.QA + ((size_t)m0w * 8 + head) * 64, 512, 0, ta, ta + 8, rpbl, rlo - r + 7, c0 + (lane & 31), lds, o, lsum);
    attn_store_gated<2>(p, o, 1.f / lsum, m0w + (lane & 31), head * 64);
  }
}
constexpr int G8_HTB = 128 * 64 * 2, G8_STAGE = 8 * G8_HTB;
DEVFN int g8_lds_byte(int r, int c) { const int st = (r >> 4) * 2 + (c >> 5), rr = r & 15, cc = c & 31, ob = rr * 64 + cc * 2; return st * 1024 + (ob ^ (((ob >> 9) & 1) << 5)); }
DEVFN void g8_stage_rc(int b, int& R, int& C) { const int st = b / 1024, sb = b % 1024, swz = sb ^ (((sb >> 9) & 1) << 5); R = (st >> 1) * 16 + swz / 64; C = (st & 1) * 32 + (swz % 64) / 2; }
DEVFN int g8_perm32(int rho) { const int n = rho >> 4, i = rho & 15; return 8 * (i >> 2) + 4 * n + (i & 3); }
struct G8Unit { int pm, pn; };
DEVFN bool g8_next(int i, int nM, int nN, int G, int c, G8Unit& u) {
  const int nwg = nM * nN; const long L = (long)i * G + c; if (L >= nwg) return false;
  int wgid = (int)L; { const int q = nwg / 8, r = nwg % 8, xcd = wgid % 8, off = wgid / 8; wgid = (xcd < r ? xcd * (q + 1) : r * (q + 1) + (xcd - r) * q) + off; }
  const int nig = 8 * nN, gid = wgid / nig, fm = gid * 8, gsz = (nM - fm) < 8 ? (nM - fm) : 8;
  u.pm = fm + ((wgid % nig) % gsz); u.pn = (wgid % nig) / gsz; return true;
}
template <class Epi>
DEVFN void gemm8_phase(LAS unsigned char* lds, const h16* A, int RA, const h16* Bt, int RB, int K, int nM, int nN, const Epi& E) {
  const int tid = tid_op(), wid = __builtin_amdgcn_readfirstlane(tid >> 6), lane = tid & 63, wr = wid >> 2, wc = wid & 3, fr = lane & 15, fq = lane >> 4;
  const int nt = K / 64; const int Gg = gridDim.x, cc = blockIdx.x;
  unsigned voffA[2], voffB[2];
#pragma unroll
  for (int i = 0; i < 2; ++i) { int R, C; g8_stage_rc(tid * 16 + i * 8192, R, C); const int Rb = (R & ~31) + g8_perm32(R & 31);
    voffA[i] = (unsigned)(R * 64 + C) * 2u; voffB[i] = (unsigned)(Rb * 64 + C) * 2u; }
  const size_t kstepA = (size_t)RA * 128, kstepB = (size_t)RB * 128;
  const size_t hstep = (size_t)128 * 128;
  const size_t tstep = 2 * hstep;
  const unsigned ldsw = (unsigned)wid * 1024u;
  const int aoff = g8_lds_byte(wr * 64 + fr, fq * 8), boff = g8_lds_byte(wc * 32 + fr, fq * 8);
#define G8_SA(b, h) (((b) * 2 + (h)) * G8_HTB)
#define G8_SB(b, h) ((4 + (b) * 2 + (h)) * G8_HTB)
#define G8_STAGE_(bufoff, gbase, voff) do { _Pragma("unroll") for (int _i = 0; _i < 2; ++_i) \
    __builtin_amdgcn_global_load_lds((const unsigned*)((const char*)(gbase) + (voff)[_i]), (LAS unsigned*)(lds + (bufoff) + ldsw + _i * 8192), 16, 0, 0); } while (0)
#define G8_LDA(dst, b, h) do { _Pragma("unroll") for (int m = 0; m < 4; ++m) _Pragma("unroll") for (int k = 0; k < 2; ++k) dst[m][k] = *(const LAS h16x8*)(lds + G8_SA(b, h) + aoff + m * 2048 + k * 1024); } while (0)
#define G8_LDB(dst, b, h) do { _Pragma("unroll") for (int n = 0; n < 2; ++n) _Pragma("unroll") for (int k = 0; k < 2; ++k) dst[n][k] = *(const LAS h16x8*)(lds + G8_SB(b, h) + boff + n * 2048 + k * 1024); } while (0)
#define G8_MMA(ai, bj, At, Bt_) do { __builtin_amdgcn_s_setprio(1); _Pragma("unroll") for (int m = 0; m < 4; ++m) _Pragma("unroll") for (int n = 0; n < 2; ++n) _Pragma("unroll") for (int k = 0; k < 2; ++k) \
    acc[ai][bj][m][n] = __builtin_amdgcn_mfma_f32_16x16x32_f16(Bt_[n][k], At[m][k], acc[ai][bj][m][n], 0, 0, 0); __builtin_amdgcn_s_setprio(0); } while (0)
#define G8_WAIT_L(n) asm volatile("s_waitcnt lgkmcnt(" #n ")" ::: "memory")
#define G8_BAR __builtin_amdgcn_s_barrier()
#define G8_SCHED __builtin_amdgcn_sched_barrier(0)
  G8Unit cur, nxt; int ui = 0;
  if (!g8_next(0, nM, nN, Gg, cc, cur)) return;
  f32x4 acc[2][2][4][2];
#pragma unroll
  for (int a = 0; a < 2; ++a)
#pragma unroll
    for (int b = 0; b < 2; ++b)
#pragma unroll
      for (int m = 0; m < 4; ++m)
#pragma unroll
        for (int n = 0; n < 2; ++n) acc[a][b][m][n] = (f32x4){0.f, 0.f, 0.f, 0.f};
  h16x8 At[4][2], B0[2][2], B1[2][2];
  const char* cA = (const char*)A + (size_t)cur.pm * tstep; const char* cB = (const char*)Bt + (size_t)cur.pn * tstep;
  G8_STAGE_(G8_SB(0, 0), cB, voffB); G8_STAGE_(G8_SA(0, 0), cA, voffA); G8_STAGE_(G8_SB(0, 1), cB + hstep, voffB); G8_STAGE_(G8_SA(0, 1), cA + hstep, voffA);
  if (wr == 1) G8_BAR;
  WAITV(4); G8_BAR;
  G8_STAGE_(G8_SB(1, 0), cB + kstepB, voffB); G8_STAGE_(G8_SA(1, 0), cA + kstepA, voffA); G8_STAGE_(G8_SB(1, 1), cB + hstep + kstepB, voffB);
  WAITV(6); G8_BAR;
  for (;;) {
    const bool has_next = g8_next(ui + 1, nM, nN, Gg, cc, nxt);
    const char* nA = has_next ? (const char*)A + (size_t)nxt.pm * tstep : cA; const char* nB = has_next ? (const char*)Bt + (size_t)nxt.pn * tstep : cB;
    for (int t = 0; t < nt; t += 2) {
      const bool last = (t == nt - 2);
      const char* a1 = cA + (size_t)(t + 1) * kstepA;
      const char* a2 = last ? nA : cA + (size_t)(t + 2) * kstepA; const char* b2 = last ? nB : cB + (size_t)(t + 2) * kstepB;
      const char* a3 = a2 + kstepA; const char* b3 = b2 + kstepB;
      G8_LDB(B0, 0, 0); G8_SCHED; G8_LDA(At, 0, 0); G8_STAGE_(G8_SA(1, 1), a1 + hstep, voffA);
      G8_WAIT_L(8); G8_BAR; G8_WAIT_L(0); G8_MMA(0, 0, At, B0); G8_BAR; G8_SCHED;
      G8_LDB(B1, 0, 1); G8_STAGE_(G8_SB(0, 0), b2, voffB);
      G8_BAR; G8_WAIT_L(0); G8_MMA(0, 1, At, B1); G8_BAR;
      G8_LDA(At, 0, 1); G8_STAGE_(G8_SA(0, 0), a2, voffA);
      G8_BAR; G8_WAIT_L(0); G8_MMA(1, 0, At, B0); G8_BAR; G8_SCHED;
      G8_STAGE_(G8_SB(0, 1), b2 + hstep, voffB);
      WAITV(6); G8_BAR; G8_MMA(1, 1, At, B1); G8_BAR;
      G8_LDB(B0, 1, 0); G8_SCHED; G8_LDA(At, 1, 0); G8_STAGE_(G8_SA(0, 1), a2 + hstep, voffA);
      G8_WAIT_L(8); G8_BAR; G8_WAIT_L(0); G8_MMA(0, 0, At, B0); G8_BAR; G8_SCHED;
      G8_LDB(B1, 1, 1); G8_STAGE_(G8_SB(1, 0), b3, voffB);
      G8_BAR; G8_WAIT_L(0); G8_MMA(0, 1, At, B1); G8_BAR;
      G8_LDA(At, 1, 1); G8_STAGE_(G8_SA(1, 0), a3, voffA);
      G8_BAR; G8_WAIT_L(0); G8_MMA(1, 0, At, B0); G8_BAR; G8_SCHED;
      G8_STAGE_(G8_SB(1, 1), b3 + hstep, voffB);
      WAITV(6); G8_BAR; G8_MMA(1, 1, At, B1); G8_BAR;
    }
#pragma unroll 1
    for (int e_ = 0; e_ < REP_EPI; e_++)
    E(acc, cur, wr, wc, fr, fq, e_ > 0);
    if (!has_next) break;
#pragma unroll
    for (int a = 0; a < 2; ++a)
#pragma unroll
      for (int b = 0; b < 2; ++b)
#pragma unroll
        for (int m = 0; m < 4; ++m)
#pragma unroll
          for (int n = 0; n < 2; ++n) acc[a][b][m][n] = (f32x4){0.f, 0.f, 0.f, 0.f};
    cur = nxt; cA = nA; cB = nB; ++ui;
  }
  WAITV(0);
  if (wr == 0) G8_BAR;
  G8_BAR;
#undef G8_SA
#undef G8_SB
#undef G8_STAGE_
#undef G8_LDA
#undef G8_LDB
#undef G8_MMA
#undef G8_WAIT_L
#undef G8_BAR
#undef G8_SCHED
}

DEVFN float fq_sum(float v) {
  auto a = __builtin_amdgcn_permlane16_swap(__float_as_uint(v), __float_as_uint(v), false, false); v = __uint_as_float(a[0]) + __uint_as_float(a[1]);
  auto b = __builtin_amdgcn_permlane32_swap(__float_as_uint(v), __float_as_uint(v), false, false); return __uint_as_float(b[0]) + __uint_as_float(b[1]);
}
struct InprojEpi {
  const Params& p; int l; bool dry; LAS unsigned char* scratch;
  DEVFN void operator()(const f32x4 (&acc)[2][2][4][2], const G8Unit& u_, int wr, int wc, int fr_, int fq_, bool dry2) const {
    int fr = fr_, fq = fq_; G8Unit u = u_;
    asm volatile("" : "+v"(fr), "+v"(fq), "+s"(u.pm), "+s"(u.pn));
    const int lane = fr + 16 * fq;
    const int i = l >> 1; const bool odd = l & 1;
    const int G = 4 * u.pn + wc;
    LAS unsigned char* tbase = scratch + (wr * 4 + wc) * 3072;
    const int m0 = u.pm * 256; const bool smp = m0 >= MP;
    enum { T_PAD, T_GATE, T_QHEAD, T_KHEAD, T_VT, T_QA, T_CKV, T_KPE };
    int ty = T_PAD, gcol = 0, head = 0, spitch = 0, scol = 0; bool rope = false; float oscale = 1.f;
    const float* gain = nullptr; float* state = nullptr; h16* qdst = nullptr; h16* kbuf = nullptr; h16* vbuf = nullptr;
    const float QS = LOG2E / 8.f;
    if (!odd) {
      if (G < 4) ty = T_QA;
      else if (G < 6) ty = T_CKV;
      else if (G == 6) { ty = T_KPE; gain = p.mla_kn_rope + i * 32; }
      else if (G == 7) ty = T_PAD;
      else if (G < 16) { ty = T_GATE; gcol = (G - 8) * 64; }
      else if (G < 24) { ty = T_QHEAD; head = G - 16; gain = p.diff_qn + i * 64; rope = true; oscale = QS; qdst = p.QB; }
      else if (G < 32) { ty = T_KHEAD; head = G - 24; gain = p.diff_kn + i * 64; rope = true; state = p.o_dk; spitch = 512; scol = head * 64; kbuf = p.KB; }
      else if (G < 40) { ty = T_VT; head = G - 32; state = p.o_dv; spitch = 512; scol = head * 64; vbuf = p.VB; }
      else { ty = T_GATE; gcol = 512 + (G - 40) * 64; }
    } else {
      if (G < 8) { ty = T_QHEAD; head = G; gain = p.na_qn + i * 64; oscale = QS; qdst = p.QA; }
      else if (G < 16) { ty = T_KHEAD; head = G - 8; gain = p.na_kn + i * 64; state = p.o_nk; spitch = 512; scol = head * 64; kbuf = p.KA; }
      else if (G < 24) { ty = T_VT; head = G - 16; state = p.o_nv; spitch = 512; scol = head * 64; vbuf = p.VA; }
      else if (G < 32) { ty = T_GATE; gcol = (G - 24) * 64; }
      else if (G < 40) { ty = T_QHEAD; head = G - 32; gain = p.gqa_qn + i * 64; rope = true; oscale = QS; qdst = p.QB; }
      else if (G < 42) { ty = T_KHEAD; head = G - 40; gain = p.gqa_kn + i * 64; rope = true; state = p.o_gk; spitch = 128; scol = head * 64; kbuf = p.KB; }
      else if (G < 44) { ty = T_VT; head = G - 42; state = p.o_gv; spitch = 128; scol = head * 64; vbuf = p.VB; }
      else { ty = T_GATE; gcol = 512 + (G - 44) * 64; }
    }
    if (ty == T_PAD) return;
    LAS float* cst = (LAS float*)(tbase + 2048);
    {
      const float* rowss = p.rowss_l + (size_t)l * M + m0 + 64 * wr;
      const float s0 = rowss[lane], s1 = rowss[128 + lane];
      const float bv = p.biasv[((size_t)l * NCV + tok_cv(m0)) * NPO + 256 * u.pn + 32 * wc + 128 * (lane >> 5) + (lane & 31)];
      const bool hasg = gain != nullptr && (ty != T_KPE || lane < 32);
      const float gv = hasg ? gain[lane] : 1.f;
      cst[lane] = frsq(s0 * (1.f / D) + EPSN); cst[64 + lane] = frsq(s1 * (1.f / D) + EPSN);
      cst[128 + lane] = bv; cst[192 + lane] = gv;
    }
    const bool roped = rope && smp;
    float invf[2][4];
    if (roped || (ty == T_KPE && smp)) {
      const float step = ty == T_KPE ? (2.f / 16.f) : (2.f / 32.f);
#pragma unroll
      for (int n = 0; n < 2; n++)
#pragma unroll
        for (int j = 0; j < 4; j++) {
          const int jj = ty == T_KPE ? (8 * (fq & 1) + 4 * n + j) & 7 : (8 * fq + 4 * n + j) & 15;
          invf[n][j] = __builtin_amdgcn_exp2f(-13.287712379549449f * step * (float)jj) * 0.15915494309189535f;
        }
    }
#pragma unroll
    for (int ai = 0; ai < 2; ai++)
#pragma unroll
      for (int m = 0; m < 4; m++) {
        const int r = m0 + 128 * ai + 64 * wr + 16 * m + fr;
        const float rs = cst[ai * 64 + m * 16 + fr];
        float v[2][2][4];
#pragma unroll
        for (int bj = 0; bj < 2; bj++)
#pragma unroll
          for (int n = 0; n < 2; n++) {
            const f32x4 b = *(const LAS f32x4*)(cst + 128 + 32 * bj + 8 * fq + 4 * n);
#pragma unroll
            for (int j = 0; j < 4; j++) v[bj][n][j] = acc[ai][bj][m][n][j] * rs + b[j];
          }
        float c2[2][4], s2[2][4];
        if (roped) {
          const int t = tok_pos(r); const float base = (float)(fq < 2 ? (t >> 6) : (t & 63));
#pragma unroll
          for (int n = 0; n < 2; n++)
#pragma unroll
            for (int j = 0; j < 4; j++) { const float x = base * invf[n][j]; c2[n][j] = __builtin_amdgcn_cosf(x); s2[n][j] = __builtin_amdgcn_sinf(x); }
        }
        if (ty == T_GATE) {
#pragma unroll
          for (int bj = 0; bj < 2; bj++) {
            h16x8 o;
#pragma unroll
            for (int n = 0; n < 2; n++)
#pragma unroll
              for (int j = 0; j < 4; j++) o[n * 4 + j] = (h16)fsilu(v[bj][n][j]);
            *(h16x8*)(p.gates16 + (size_t)r * 1024 + gcol + 32 * bj + 8 * fq) = o;
          }
        } else if (ty == T_QHEAD || ty == T_KHEAD) {
          float ss = 0;
#pragma unroll
          for (int bj = 0; bj < 2; bj++)
#pragma unroll
            for (int n = 0; n < 2; n++)
#pragma unroll
              for (int j = 0; j < 4; j++) ss += v[bj][n][j] * v[bj][n][j];
          ss = fq_sum(ss);
          const float rr = frsq(ss * (1.f / 64.f) + EPSN);
#pragma unroll
          for (int bj = 0; bj < 2; bj++)
#pragma unroll
            for (int n = 0; n < 2; n++) {
              const f32x4 g = *(const LAS f32x4*)(cst + 192 + 32 * bj + 8 * fq + 4 * n);
#pragma unroll
              for (int j = 0; j < 4; j++) v[bj][n][j] *= rr * g[j];
            }
          if (state && !smp) {
            float* sp = state + st_row(r, i) * spitch + scol + 8 * fq;
#pragma unroll
            for (int bj = 0; bj < 2; bj++)
#pragma unroll
              for (int n = 0; n < 2; n++) { f32x4 o = {v[bj][n][0], v[bj][n][1], v[bj][n][2], v[bj][n][3]}; *(f32x4*)(sp + 32 * bj + 4 * n) = o; }
          }
          if (roped) {
#pragma unroll
            for (int n = 0; n < 2; n++)
#pragma unroll
              for (int j = 0; j < 4; j++) { const float x1 = v[0][n][j], x2 = v[1][n][j]; v[0][n][j] = x1 * c2[n][j] - x2 * s2[n][j]; v[1][n][j] = x2 * c2[n][j] + x1 * s2[n][j]; }
          }
          h16* dst = ty == T_QHEAD ? qdst + ((size_t)r * 8 + head) * 64 : kbuf + ((size_t)head * KM + tok_keyrow(r)) * 64;
#pragma unroll
          for (int bj = 0; bj < 2; bj++) {
            h16x8 o;
#pragma unroll
            for (int n = 0; n < 2; n++)
#pragma unroll
              for (int j = 0; j < 4; j++) o[n * 4 + j] = (h16)(v[bj][n][j] * oscale);
            *(h16x8*)(dst + 32 * bj + 8 * fq) = o;
          }
        } else if (ty == T_VT) {
          const int kr = tok_keyrow(r);
          if (!smp) {
            float* sp = state + st_row(r, i) * spitch + scol + 8 * fq;
#pragma unroll
            for (int bj = 0; bj < 2; bj++)
#pragma unroll
              for (int n = 0; n < 2; n++) { f32x4 o = {v[bj][n][0], v[bj][n][1], v[bj][n][2], v[bj][n][3]}; *(f32x4*)(sp + 32 * bj + 4 * n) = o; }
          }
          {
            LAS h16* tb = (LAS h16*)(tbase);
#pragma unroll
            for (int bj = 0; bj < 2; bj++)
#pragma unroll
              for (int n = 0; n < 2; n++)
#pragma unroll
                for (int j = 0; j < 4; j++) tb[(32 * bj + 8 * fq + 4 * n + j) * 16 + fr] = (h16)v[bj][n][j];
            const h16x8 lo = *(const LAS h16x8*)(tb + lane * 16), hi = *(const LAS h16x8*)(tb + lane * 16 + 8);
            h16* dstv = vbuf + vidx(head * 64 + lane, kr - fr);
            *(h16x8*)dstv = lo; *(h16x8*)(dstv + 8) = hi;
          }
        } else if (ty == T_QA) {
          float ss = 0;
#pragma unroll
          for (int bj = 0; bj < 2; bj++) {
            h16x8 o;
#pragma unroll
            for (int n = 0; n < 2; n++)
#pragma unroll
              for (int j = 0; j < 4; j++) { o[n * 4 + j] = (h16)v[bj][n][j]; const float xr = (float)o[n * 4 + j]; ss += xr * xr; }
            *(h16x8*)(p.qa16 + pidx(M, r, 64 * G + 32 * bj + 8 * fq)) = o;
          }
          ss = fq_sum(ss);
          if (fq == 0 && !dry && !dry2) atomicAdd(p.rowss_qa + (size_t)i * M + r, ss);
        } else if (ty == T_CKV) {
          const int kr = tok_keyrow(r);
          float ss = 0;
#pragma unroll
          for (int bj = 0; bj < 2; bj++) {
            h16x8 o;
#pragma unroll
            for (int n = 0; n < 2; n++)
#pragma unroll
              for (int j = 0; j < 4; j++) { o[n * 4 + j] = (h16)v[bj][n][j]; const float xr = (float)o[n * 4 + j]; ss += xr * xr; }
            *(h16x8*)(p.ckv16 + pidx(KM, kr, 64 * (G - 4) + 32 * bj + 8 * fq)) = o;
          }
          ss = fq_sum(ss);
          if (fq == 0 && !dry && !dry2) atomicAdd(p.rowss_ckv + (size_t)i * KM + kr, ss);
        } else {
          float ss = 0;
#pragma unroll
          for (int n = 0; n < 2; n++)
#pragma unroll
            for (int j = 0; j < 4; j++) ss += v[0][n][j] * v[0][n][j];
          ss = fq_sum(ss);
          const float rr = frsq(ss * (1.f / 32.f) + EPSN);
          float w[2][4];
#pragma unroll
          for (int n = 0; n < 2; n++) {
            const f32x4 g = *(const LAS f32x4*)(cst + 192 + 8 * fq + 4 * n);
#pragma unroll
            for (int j = 0; j < 4; j++) w[n][j] = v[0][n][j] * rr * g[j];
          }
          if (!smp) {
            float* sp = p.o_kpe + st_row(r, i) * 32 + 8 * fq;
#pragma unroll
            for (int n = 0; n < 2; n++) { f32x4 o = {w[n][0], w[n][1], w[n][2], w[n][3]}; *(f32x4*)(sp + 4 * n) = o; }
          } else {
            const int t = tok_pos(r); const float base = (float)((fq & 1) == 0 ? (t >> 6) : (t & 63));
#pragma unroll
            for (int n = 0; n < 2; n++)
#pragma unroll
              for (int j = 0; j < 4; j++) {
                const float x = base * invf[n][j]; const float c = __builtin_amdgcn_cosf(x), s = __builtin_amdgcn_sinf(x);
                const float own = w[n][j], oth = __shfl_xor(own, 32);
                w[n][j] = fq < 2 ? own * c - oth * s : own * c + oth * s;
              }
          }
          h16x8 o;
#pragma unroll
          for (int n = 0; n < 2; n++)
#pragma unroll
            for (int j = 0; j < 4; j++) o[n * 4 + j] = (h16)w[n][j];
          *(h16x8*)(p.kpe16 + (size_t)tok_keyrow(r) * 32 + 8 * fq) = o;
        }
      }
  }
};
struct NullEpi {
  DEVFN void operator()(const f32x4 (&acc)[2][2][4][2], const G8Unit&, int, int, int, int, bool) const {
#pragma unroll
    for (int a = 0; a < 2; a++)
#pragma unroll
      for (int b = 0; b < 2; b++)
#pragma unroll
        for (int m = 0; m < 4; m++) asm volatile("" :: "v"(acc[a][b][m][0]), "v"(acc[a][b][m][1]));
  }
};
DEVFN int inproj_pos_col(int np) { const int pn = np >> 8, bj = (np >> 7) & 1, wc = (np >> 5) & 3, g = np & 31; return 64 * (4 * pn + wc) + 32 * bj + g; }

#define XB_TMO      128
#define XB_XCNT(j)  (256  + 64 * (j))
#define XB_XSUB(j)  (1280 + 64 * (j))
#define XB_XGEN(j)  (2304 + 64 * (j))
#define XB_TOP      3328
#define XB_TOPGEN   3392
#define XCD_BAR_WORDS 3456
#define XB_SPIN_CAP (1u << 20)
DEVFN unsigned xb_ld(unsigned* p) { return __hip_atomic_load(p, __ATOMIC_RELAXED, __HIP_MEMORY_SCOPE_AGENT); }
DEVFN unsigned xb_add(unsigned* p, unsigned v) { return __hip_atomic_fetch_add(p, v, __ATOMIC_RELAXED, __HIP_MEMORY_SCOPE_AGENT); }
DEVFN unsigned xb_xcc_id() { return (unsigned)__builtin_amdgcn_s_getreg((3 << 11) | 20) & 0xFu; }
#define XB_SPIN(cond, bar) do { unsigned _sp = 0; while (cond) { __builtin_amdgcn_s_sleep(1); \
    if ((++_sp & 255u) == 0u) { if (xb_ld(&(bar)[XB_TMO])) break; if (_sp > XB_SPIN_CAP) { atomicAdd(&(bar)[XB_TMO], 1u); break; } } } } while (0)
struct XcdBarrier { unsigned* bar; unsigned x; volatile LAS unsigned* st; };
DEVFN XcdBarrier xcd_barrier_post(unsigned* bar, volatile LAS unsigned* st) {
  const int TIDX = tid_op();
  XcdBarrier b; b.bar = bar; b.x = xb_xcc_id(); b.st = st;
  if (TIDX == 0) (void)xb_add(&bar[XB_XCNT(b.x)], 1u);
  return b;
}
DEVFN void xcd_barrier_complete(unsigned* bar, unsigned x, unsigned& nloc, unsigned& nx) {
  const unsigned G = gridDim.x * gridDim.y * gridDim.z;
  unsigned sum, cnt, mine, sp = 0u;
  for (;;) {
    sum = 0u; cnt = 0u; mine = 0u;
#pragma unroll
    for (unsigned j = 0; j < 16; ++j) { const unsigned c = xb_ld(&bar[XB_XCNT(j)]); sum += c; cnt += (c > 0u) ? 1u : 0u; mine = (j == x) ? c : mine; }
    if (sum == G) break;
    __builtin_amdgcn_s_sleep(1);
    if ((++sp & 255u) == 0u) { if (xb_ld(&bar[XB_TMO])) break; if (sp > XB_SPIN_CAP) { atomicAdd(&bar[XB_TMO], 1u); break; } }
  }
  nloc = mine > 0u ? mine : 1u; nx = cnt > 0u ? cnt : 1u;
}
DEVFN void xcd_barrier(const XcdBarrier& b) {
  const int TIDX = tid_op();
  asm volatile("s_waitcnt vmcnt(0)" ::: "memory");
  __syncthreads();
  if (TIDX == 0) {
    unsigned* bar = b.bar;
    __builtin_amdgcn_s_waitcnt(0);
    unsigned nloc = b.st[0], nx = b.st[1];
    if (nloc == 0u) { xcd_barrier_complete(bar, b.x, nloc, nx); b.st[0] = nloc; b.st[1] = nx; }
    const unsigned old = xb_add(&bar[XB_XSUB(b.x)], 1u);
    const unsigned gen = old / nloc;
    if (old + 1u == (gen + 1u) * nloc) {
      __builtin_amdgcn_fence(__ATOMIC_RELEASE, "agent");
      asm volatile("s_waitcnt vmcnt(0)" ::: "memory");
      const unsigned og = xb_add(&bar[XB_TOP], 1u);
      const unsigned tg = og / nx;
      if (og + 1u == (tg + 1u) * nx) xb_add(&bar[XB_TOPGEN], 1u);
      else XB_SPIN(xb_ld(&bar[XB_TOPGEN]) == tg, bar);
      __builtin_amdgcn_fence(__ATOMIC_ACQUIRE, "agent");
      xb_add(&bar[XB_XGEN(b.x)], 1u);
      asm volatile("s_waitcnt vmcnt(0)" ::: "memory");
    } else {
      XB_SPIN(xb_ld(&bar[XB_XGEN(b.x)]) == gen, bar);
      __builtin_amdgcn_fence(__ATOMIC_ACQUIRE, "agent");
      asm volatile("s_waitcnt vmcnt(0)" ::: "memory");
    }
  }
  __syncthreads();
}

DEVFN void cache_items(const Params& p, int l, int gtid, int gthreads) {
  const int i = l >> 1;
  if ((l & 1) == 0) {
    const int per = 128 + 32 + 512 + 512;
    for (int e = gtid; e < DB * PAST * per; e += gthreads) {
      const int u = e % per; const int bp = e / per; const int pos = bp % PAST, b = bp / PAST;
      const int kr = MP + b * TKS + DS + pos; const size_t crow = ((size_t)(b * 2 + i) * PAST + pos);
      if (u < 128) { p.ckv16[pidx(KM, kr, u)] = (h16)(p.cache_mla_ckv[crow * 128 + u] / p.mla_kva_norm[i * 128 + u]); if (u == 0) p.rowss_ckv[(size_t)i * KM + kr] = 128.f * (1.f - EPSN); }
      else if (u < 160) p.kpe16[(size_t)kr * 32 + (u - 128)] = (h16)p.cache_mla_kpe[crow * 32 + (u - 128)];
      else if (u < 672) { const int c = u - 160; p.KB[((size_t)(c >> 6) * KM + kr) * 64 + (c & 63)] = (h16)p.cache_diff_k[crow * 512 + c]; }
      else { const int c = u - 672; p.VB[vidx(c, kr)] = (h16)p.cache_diff_v[crow * 512 + c]; }
    }
  } else {
    const int per = 512 + 512 + 128 + 128;
    for (int e = gtid; e < DB * PAST * per; e += gthreads) {
      const int u = e % per; const int bp = e / per; const int pos = bp % PAST, b = bp / PAST;
      const int kr = MP + b * TKS + DS + pos; const size_t crow = ((size_t)(b * 2 + i) * PAST + pos);
      if (u < 512) p.KA[((size_t)(u >> 6) * KM + kr) * 64 + (u & 63)] = (h16)p.cache_na_k[crow * 512 + u];
      else if (u < 1024) { const int c = u - 512; p.VA[vidx(c, kr)] = (h16)p.cache_na_v[crow * 512 + c]; }
      else if (u < 1152) { const int c = u - 1024; p.KB[((size_t)(c >> 6) * KM + kr) * 64 + (c & 63)] = (h16)p.cache_gqa_k[crow * 128 + c]; }
      else { const int c = u - 1152; p.VB[vidx(c, kr)] = (h16)p.cache_gqa_v[crow * 128 + c]; }
    }
  }
}

DEVFN void mod_item(const Params& p, int item, char* lds, bool dry = false) {
  const int tid = tid_op();
  const int l = item / 96, rem = item % 96, nchunk = rem / 16, kc = rem % 16;
  float* sil = (float*)lds;
  if (tid < NCV * 64) { const int cv = tid >> 6, k = tid & 63; const float* cvec = cv == 0 ? p.c_ctx : p.c + (size_t)(cv - 1) * D; sil[tid] = siluf(cvec[kc * 64 + k]); }
  __syncthreads();
  const int col = nchunk * 512 + tid;
  const float* w = p.w_mod + ((size_t)l * D + kc * 64) * 3072 + col;
  float acc[NCV];
#pragma unroll
  for (int c = 0; c < NCV; c++) acc[c] = 0.f;
#pragma unroll 16
  for (int k = 0; k < 64; k++) {
    const float wv = w[(size_t)k * 3072];
#pragma unroll
    for (int c = 0; c < NCV; c++) acc[c] += sil[c * 64 + k] * wv;
  }
  const float b = kc == 0 ? p.b_mod[l * 3072 + col] : 0.f;
#pragma unroll
  for (int c = 0; c < NCV; c++) if (!dry) atomicAdd(p.modv + ((size_t)l * NCV + c) * 3072 + col, acc[c] + b);
  __syncthreads();
}
DEVFN void conv_tile(const float* src, h16* dst, int R, int Nsrc, int mode, const float* kscale, int nb, int kb, char* lds) {
  const int tid = tid_op();
  float (*t)[65] = (float (*)[65])lds;
  {
    const int j = tid & 63; const int np = nb + j; int col;
    if (mode == 0) col = np; else if (mode == 1) col = even_col(np); else if (mode == 4) col = even_col(inproj_pos_col(np)); else if (mode == 5) col = inproj_pos_col(np); else if (mode == 3) { int hh = (np & 511) >> 6; col = hh * 128 + (np >> 9) * 64 + (np & 63); } else { int h = np >> 7, jj = np & 127; col = jj < 96 ? h * 96 + jj : -1; }
    const int colc = col < 0 ? 0 : col; const float msk = col < 0 ? 0.f : 1.f;
    float v[8];
#pragma unroll
    for (int i = 0; i < 8; i++) v[i] = src[(size_t)(kb + (tid >> 6) + 8 * i) * Nsrc + colc];
    if (kscale) {
#pragma unroll
      for (int i = 0; i < 8; i++) v[i] *= kscale[kb + (tid >> 6) + 8 * i];
    }
#pragma unroll
    for (int i = 0; i < 8; i++) t[(tid >> 6) + 8 * i][j] = v[i] * msk;
  }
  __syncthreads();
  {
    const int kk = tid & 63;
#pragma unroll
    for (int i = 0; i < 8; i++) { const int j = (tid >> 6) + 8 * i; dst[pidx(R, nb + j, kb + kk)] = (h16)t[kk][j]; }
  }
  __syncthreads();
}
constexpr int CV_WIN_E = (NPE / 64) * 16, CV_WIN_O = (NPO / 64) * 16, CV_WOUT = 256, CV_WQB = 64, CV_WKVB = 32;
constexpr int CV_PER_PAIR = CV_WIN_E + CV_WIN_O + 2 * CV_WOUT + CV_WQB + CV_WKVB;
constexpr int CV_TOTAL = 2 * CV_PER_PAIR;
DEVFN void conv_item(const Params& p, int item, char* lds) {
  const int i = item / CV_PER_PAIR; int r = item % CV_PER_PAIR;
  if (r < CV_WIN_E) { conv_tile(p.w_in_even + (size_t)i * D * EVEN_IN, p.win16 + (size_t)(2 * i) * NPO * D, NPO, EVEN_IN, 4, nullptr, (r % (NPE / 64)) * 64, (r / (NPE / 64)) * 64, lds); return; }
  r -= CV_WIN_E;
  if (r < CV_WIN_O) { conv_tile(p.w_in_odd + (size_t)i * D * ODD_IN, p.win16 + (size_t)(2 * i + 1) * NPO * D, NPO, ODD_IN, 5, nullptr, (r % (NPO / 64)) * 64, (r / (NPO / 64)) * 64, lds); return; }
  r -= CV_WIN_O;
  if (r < CV_WOUT) { conv_tile(p.w_out_even + (size_t)i * D * D, p.wout16 + (size_t)(2 * i) * D * D, 1024, D, 0, nullptr, (r % 16) * 64, (r / 16) * 64, lds); return; }
  r -= CV_WOUT;
  if (r < CV_WOUT) { conv_tile(p.w_out_odd + (size_t)i * D * D, p.wout16 + (size_t)(2 * i + 1) * D * D, 1024, D, 0, nullptr, (r % 16) * 64, (r / 16) * 64, lds); return; }
  r -= CV_WOUT;
  if (r < CV_WQB) { conv_tile(p.mla_wqb + (size_t)i * 256 * 768, p.wqb16 + (size_t)i * 1024 * 256, 1024, 768, 2, p.mla_qa_norm + i * 256, (r % 16) * 64, (r / 16) * 64, lds); return; }
  r -= CV_WQB;
  conv_tile(p.mla_wkvb + (size_t)i * 128 * 1024, p.wkvb16 + (size_t)i * 1024 * 128, 1024, 1024, 3, p.mla_kva_norm + i * 128, (r % 16) * 64, (r / 16) * 64, lds);
}
DEVFN void tab_items(const Params& p, int gtid, int gthreads) {
  for (int g = gtid; g < DS * 48; g += gthreads) {
    if (g < 2) {
      const int i = g, l = 2 * i; float s1 = 0, s2 = 0;
      for (int k = 0; k < 64; k++) { s1 += p.diff_lq1[i * 64 + k] * p.diff_lk1[i * 64 + k]; s2 += p.diff_lq2[i * 64 + k] * p.diff_lk2[i * 64 + k]; }
      p.lamv[i] = expf(s1) - expf(s2) + (0.8f - 0.6f * expf(-0.3f * l));
    }
    const int t = g / 48, j = g % 48;
    const float row = (float)(t / GW), col = (float)(t % GW);
    if (j < 32) { const int f = j & 15; const float inv = powf(10000.f, -(float)(2 * f) / 32.f); const float ang = (j < 16 ? row : col) * inv; p.ropeC64[t * 32 + j] = cosf(ang); p.ropeS64[t * 32 + j] = sinf(ang); }
    else { const int jj = j - 32; const int f = jj & 7; const float inv = powf(10000.f, -(float)(2 * f) / 16.f); const float ang = (jj < 8 ? row : col) * inv; p.ropeC32[t * 16 + jj] = cosf(ang); p.ropeS32[t * 16 + jj] = sinf(ang); }
  }
}
DEVFN void bias_row(const Params& p, int l, int np, int lane) {
  const h16* w = p.win16 + (size_t)l * NPO * D;
  float a[NCV];
#pragma unroll
  for (int c = 0; c < NCV; c++) a[c] = 0;
#pragma unroll
  for (int i = 0; i < 2; i++) {
    const int k = (i * 64 + lane) * 8; h16x8 wv = *(const h16x8*)(w + pidx(NPO, np, k));
#pragma unroll
    for (int c = 0; c < NCV; c++) { const float* sh = p.modv + ((size_t)l * NCV + c) * 3072 + k;
#pragma unroll
      for (int e = 0; e < 8; e++) a[c] += sh[e] * (float)wv[e]; }
  }
#pragma unroll
  for (int c = 0; c < NCV; c++) { float v = a[c]; for (int o = 32; o; o >>= 1) v += __shfl_xor(v, o); if (lane == 0) p.biasv[((size_t)l * NCV + c) * NPO + np] = v; }
}
DEVFN void prepx_row(const Params& p, int l, int m, int lane) {
  const float* x = xrow(p, l, m); const float* md = p.modv + ((size_t)l * NCV + tok_cv(m)) * 3072 + 1024; const float* nw = p.norm_w + l * D;
  float ss = 0;
#pragma unroll
  for (int i = 0; i < 4; i++) {
    const int k = (i * 64 + lane) * 4;
    f32x4 v = *(const f32x4*)(x + k); f32x4 s = *(const f32x4*)(md + k); f32x4 w = *(const f32x4*)(nw + k);
    h16x4 o;
#pragma unroll
    for (int e = 0; e < 4; e++) { ss += v[e] * v[e]; o[e] = (h16)(v[e] * w[e] * (1.f + s[e])); }
    *(h16x4*)(p.xs16 + pidx(M, m, k)) = o;
  }
  for (int o = 32; o; o >>= 1) ss += __shfl_xor(ss, o);
  if (lane == 0) p.rowss_l[(size_t)l * M + m] = ss;
}
#define AS4 __attribute__((address_space(4)))
#define PHASE_PARAMS(q) const Params& q = p_unused;
__global__ void __launch_bounds__(512) mega_kernel(Params p_unused) {
  __shared__ __attribute__((aligned(16))) char lds[G_LDS2 + 16];
  if (threadIdx.x == 0) { volatile LAS unsigned* st = (volatile LAS unsigned*)(lds + G_LDS2); st[0] = 0u; st[1] = 0u; st[2] = 0u; st[3] = 0u; }
  __syncthreads();
  XcdBarrier bar;
  { PHASE_PARAMS(p); bar = xcd_barrier_post(p.bar, (volatile LAS unsigned*)(lds + G_LDS2)); }
  const int nb = gridDim.x, bid = blockIdx.x;
  LAS unsigned char* ldsa = (LAS unsigned char*)lds;
  { PHASE_PARAMS(p);
    for (int rep = 0; rep < REP_0A; rep++)
    for (int it = bid; it < 384 + CV_TOTAL; it += nb) { if (it < 384) mod_item(p, it, lds, rep > 0); else conv_item(p, it - 384, lds); }
    tab_items(p, bid * 512 + tid_op(), nb * 512); }
  xcd_barrier(bar);
  { PHASE_PARAMS(p);
    const int tid = tid_op(); const int lane = tid & 63, gw = bid * 8 + (tid >> 6), nw = nb * 8;
    for (int rep = 0; rep < REP_0B; rep++)
    for (int r = gw; r < 2 * (NPE + NPO) + M; r += nw) {
      if (r < 2 * (NPE + NPO)) { const int i = r / (NPE + NPO), q = r % (NPE + NPO); if (q < NPE) bias_row(p, 2 * i, q, lane); else bias_row(p, 2 * i + 1, q - NPE, lane); }
      else prepx_row(p, 0, r - 2 * (NPE + NPO), lane);
    } }
  xcd_barrier(bar);
#pragma unroll 1
  for (int l = 0; l < 4; l++) {
    { PHASE_PARAMS(p);
#pragma unroll 1
      for (int rep = 1; rep < REP_GK; rep++) { NullEpi ne; gemm8_phase(ldsa, p.xs16, M, p.win16 + (size_t)l * NPO * D, NPO, D, M / 256, ((l & 1) ? NPO : NPE) / 256, ne); }
#pragma unroll 1
      for (int rep = 0; rep < REP_A; rep++) {
        InprojEpi epi{p, l, rep > 0, ldsa + G8_STAGE};
        gemm8_phase(ldsa, p.xs16, M, p.win16 + (size_t)l * NPO * D, NPO, D, M / 256, ((l & 1) ? NPO : NPE) / 256, epi);
      }
      for (int rep = 0; rep < REP_0B; rep++) cache_items(p, l, bid * 512 + tid_op(), nb * 512); }
    xcd_barrier(bar);
    if ((l & 1) == 0) {
      PHASE_PARAMS(p);
      const int nq = (M / 256) * 8, nkv = (KM / 256) * 8;
      for (int rep = 0; rep < REP_A2; rep++)
      for (int t = bid; t < nq + nkv; t += nb) { if (t < nq) qgemm_tile(p, l, t % 32, t / 32, lds); else { const int u = t - nq; kvgemm_tile(p, l, u % (KM / 256), u / (KM / 256), lds); } }
      { const float* rck = p.rowss_ckv + (size_t)(l >> 1) * KM; const int i = l >> 1;
        for (int e = bid * 512 + tid_op(); e < MP * 128; e += nb * 512) {
          const int m = e >> 7, j = e & 127;
          p.o_ckv[st_row(m, i) * 128 + j] = (float)p.ckv16[pidx(KM, m, j)] * (frsq(rck[m] * (1.f / 128.f) + EPSN)) * p.mla_kva_norm[i * 128 + j];
        } }
      xcd_barrier(bar);
    }
    { PHASE_PARAMS(p);
      for (int rep = 0; rep < REP_B; rep++)
      for (int it = bid; it < 512; it += nb) { if (l & 1) attn_odd_item(p, l, it, lds); else attn_even_item(p, l, it, lds); } }
    xcd_barrier(bar);
    { PHASE_PARAMS(p);
      for (int rep = 0; rep < REP_C; rep++)
      for (int t = bid; t < 32 * 8; t += nb) outproj_tile(p, l, t % 32, t / 32, lds, rep < REP_C - 1); }
    if (l < 3) { for (int rep = 0; rep < REP_BAR; rep++) xcd_barrier(bar); }
  }
}
#endif

static inline size_t al256(size_t x) { return (x + 255) & ~(size_t)255; }

extern "C" void kernel_launch(void* const* d_in, const int* in_sizes, int n_in, void* d_out, int out_size, void* d_ws, size_t ws_size,
                              hipStream_t stream) {
  Params p{};
  const float** ip = (const float**)&p.x_prompt;
  for (int k = 0; k < 39; k++) ip[k] = (const float*)d_in[k];
  float* o = (float*)d_out;
  p.Y = o; o += (size_t)M * 1024;
  p.o_ckv = o; o += (size_t)BATCH * 2 * SEQ * 128;
  p.o_kpe = o; o += (size_t)BATCH * 2 * SEQ * 32;
  p.o_dk = o; o += (size_t)BATCH * 2 * SEQ * 512;
  p.o_dv = o; o += (size_t)BATCH * 2 * SEQ * 512;
  p.o_nk = o; o += (size_t)BATCH * 2 * SEQ * 512;
  p.o_nv = o; o += (size_t)BATCH * 2 * SEQ * 512;
  p.o_gk = o; o += (size_t)BATCH * 2 * SEQ * 128;
  p.o_gv = o; o += (size_t)BATCH * 2 * SEQ * 128;
  char* w = (char*)d_ws; size_t off = 0;
  auto take = [&](size_t bytes) { char* r = w + off; off += al256(bytes); return r; };
  char* zero0 = w + off;
  p.bar = (unsigned*)take(16384);
  p.modv = (float*)take((size_t)4 * NCV * 3072 * 4);
  p.rowss_qa = (float*)take((size_t)2 * M * 4); p.rowss_l = (float*)take((size_t)4 * M * 4); p.rowss_ckv = (float*)take((size_t)2 * KM * 4);
  const size_t zero_bytes = (size_t)((w + off) - zero0);
  p.ropeC64 = (float*)take((size_t)DS * 32 * 4); p.ropeS64 = (float*)take((size_t)DS * 32 * 4);
  p.ropeC32 = (float*)take((size_t)DS * 16 * 4); p.ropeS32 = (float*)take((size_t)DS * 16 * 4);
  p.lamv = (float*)take(256);
  p.rstdx = (float*)take((size_t)M * 4);
  p.QA = (h16*)take((size_t)M * 8 * 96 * 2); p.QB = (h16*)take((size_t)M * 8 * 64 * 2);
  p.KA = (h16*)take((size_t)8 * KM * 128 * 2); p.KB = (h16*)take((size_t)8 * KM * 64 * 2);
  p.VA = (h16*)take((size_t)8 * 64 * KM * 2); p.VB = (h16*)take((size_t)8 * 64 * KM * 2);
  p.gates16 = (h16*)take((size_t)M * 1024 * 2); p.O16 = (h16*)take((size_t)M * 1024 * 2);
  p.ckvbuf = (float*)take((size_t)KM * 128 * 4); p.kpebuf = (float*)take((size_t)KM * 32 * 4);
  p.xs16 = (h16*)take((size_t)M * D * 2); p.qa16 = (h16*)take((size_t)M * 256 * 2); p.ckv16 = (h16*)take((size_t)KM * 128 * 2); p.kpe16 = (h16*)take((size_t)KM * 32 * 2); p.biasv = (float*)take((size_t)4 * NCV * NPO * 4);
  p.win16 = (h16*)take((size_t)4 * NPO * D * 2); p.wout16 = (h16*)take((size_t)4 * D * D * 2);
  p.wqb16 = (h16*)take((size_t)2 * 1024 * 256 * 2); p.wkvb16 = (h16*)take((size_t)2 * 1024 * 128 * 2);
  size_t ub = (size_t)M * 3328 * 2, ab = (size_t)M * 1536 * 4;
  char* big = take(ub > ab ? ub : ab);
  p.ubuf = (h16*)big; p.abuf = (float*)big;
  (void)ws_size; (void)n_in; (void)in_sizes; (void)out_size;

#ifndef CPU_EMU
  {
    (void)hipMemsetAsync(zero0, 0, zero_bytes, stream);
    static int cus = 0;
    if (!cus) { int dev = 0; (void)hipGetDevice(&dev); (void)hipDeviceGetAttribute(&cus, hipDeviceAttributeMultiprocessorCount, dev); }
    void* args[] = {&p};
    (void)hipLaunchCooperativeKernel((void*)mega_kernel, dim3(cus), dim3(512), args, 0, stream);
  }
#else
  (void)zero0; (void)zero_bytes;
  launch1d(nk_mod, (long)4 * NCV * 3072, stream, p, (long)4 * NCV * 3072);
  launch1d(nk_tab, (long)DS * 48, stream, p, (long)DS * 48);
  for (int l = 0; l < 4; l++) {
    const int N = (l & 1) ? ODD_IN : EVEN_IN;
    launch1d(nk_rstd, (long)M, stream, p, l, (long)M);
    launch1d(nk_inproj, (long)M * N, stream, p, l, (long)M * N);
    if ((l & 1) == 0) {
      launch1d(nk_epi_even, (long)M * 50, stream, p, l, 0, (long)M * 50);
      launch1d(nk_cache_even, (long)DB * PAST * 17, stream, p, l, (long)DB * PAST * 17);
      launch1d(nk_kv, (long)KM * 16, stream, p, l, (long)KM * 16);
      launch1d(nk_attn_dense, (long)M * 8, stream, p, 0, 0, M, (long)M * 8);
      launch1d(nk_attn_dense, (long)M * 16, stream, p, 1, 0, M, (long)M * 16);
      launch1d(nk_fin, (long)M * 12, stream, p, l, (long)M * 12);
    } else {
      launch1d(nk_epi_odd, (long)M * 52, stream, p, l, (long)M * 52);
      launch1d(nk_cache_odd, (long)DB * PAST * 20, stream, p, l, (long)DB * PAST * 20);
      launch1d(nk_attn_dense, (long)MP * 8, stream, p, 2, 0, MP, (long)MP * 8);
      launch1d(nk_attn_na, (long)MS * 8, stream, p, l, (long)MS * 8);
      launch1d(nk_attn_dense, (long)M * 8, stream, p, 3, 0, M, (long)M * 8);
      launch1d(nk_fin, (long)M * 16, stream, p, l, (long)M * 16);
    }
    launch1d(nk_outproj, (long)M * 1024, stream, p, l, (long)M * 1024);
  }
#endif
}
```

```cpp
#ifndef CPU_EMU
#include <hip/hip_runtime.h>
#endif
#include <stdint.h>
#include <math.h>

#define FAST_INPROJ 2
#define DUAL_WRITE 0
#define FAST_A2 1
#define FAST_OUTPROJ 1
#define FAST_ATTN 1
#define MEGA 1
#define REP_0A 1
#define REP_A 1
#define REP_A2 1
#define REP_B 1
#define REP_C 1
#define REP_BAR 1
#define REP_GK 1
#define REP_0B 1
#define REP_EPI 1
#ifndef CFG_BATCH
#define CFG_BATCH 16
#endif
#ifndef CFG_DB
#define CFG_DB 2
#endif
#ifndef CFG_DS
#define CFG_DS 2048
#endif
constexpr int D = 1024, BATCH = CFG_BATCH, SEQ = 256, DB = CFG_DB, DS = CFG_DS, PAST = 256;
constexpr int MP = BATCH * SEQ, MS = DB * DS, M = MP + MS;
constexpr int TKS = DS + PAST;
constexpr int KM = MP + DB * TKS;
constexpr int NCV = 1 + DB;
constexpr int GW = 64, GROWS = DS / GW;
constexpr int EVEN_IN = 2976, ODD_IN = 3328;
constexpr int NPE = 3072, NPO = 3328;
constexpr float EPSN = 1e-6f;
constexpr float LOG2E = 1.4426950408889634f;

typedef _Float16 h16;

struct Params {
  const float *x_prompt, *x_sample, *cache_mla_ckv, *cache_mla_kpe, *cache_diff_k, *cache_diff_v, *cache_na_k, *cache_na_v,
      *cache_gqa_k, *cache_gqa_v, *c, *c_ctx, *norm_w, *w_mod, *b_mod, *w_in_even, *w_out_even, *mla_qa_norm, *mla_wqb,
      *mla_kva_norm, *mla_wkvb, *mla_qn_nope, *mla_qn_rope, *mla_kn_nope, *mla_kn_rope, *diff_qn, *diff_kn, *diff_lq1,
      *diff_lk1, *diff_lq2, *diff_lk2, *diff_subln, *w_in_odd, *w_out_odd, *na_qn, *na_kn, *na_rpb, *gqa_qn, *gqa_kn;
  float *Y;
  float *o_ckv, *o_kpe, *o_dk, *o_dv, *o_nk, *o_nv, *o_gk, *o_gv;
  float *modv;
  float *ropeC64, *ropeS64;
  float *ropeC32, *ropeS32;
  float *lamv;
  float *rstdx;
  h16 *ubuf;
  float *abuf;
  float *ckvbuf;
  float *kpebuf;
  h16 *QA, *QB, *KA, *KB, *VA, *VB, *gates16, *O16;
  h16 *xs16;
  float *biasv;
  h16 *win16;
  h16 *wout16;
  h16 *wqb16;
  h16 *wkvb16;
  h16 *qa16;
  float *rowss_qa;
  h16 *ckv16;
  h16 *kpe16;
  float *rowss_l;
  float *rowss_ckv;
  unsigned *bar;
};

#ifdef CPU_EMU
#include <stdio.h>
#include <stdlib.h>
#include <string.h>
typedef void* hipStream_t;
#define KERNEL static void
#define DEVFN static inline
static thread_local long emu_gtid;
#define GTID emu_gtid
template <class... A, class... B>
static void launch1d(void (*f)(A...), long n, hipStream_t, B... a) {
#pragma omp parallel for schedule(dynamic, 64)
  for (long i = 0; i < n; i++) { emu_gtid = i; f(a...); }
}
static inline float exp2f_(float x) { return exp2f(x); }
#else
#define KERNEL __global__ void __launch_bounds__(256)
#define DEVFN __device__ __forceinline__
#define GTID ((long)blockIdx.x * 256 + threadIdx.x)
template <class... A, class... B>
static void launch1d(void (*f)(A...), long n, hipStream_t s, B... a) {
  hipLaunchKernelGGL(f, dim3((unsigned)((n + 255) / 256)), dim3(256), 0, s, a...);
}
DEVFN float exp2f_(float x) { return exp2f(x); }
#endif

DEVFN int tok_cv(int m) { return m < MP ? 0 : 1 + (m - MP) / DS; }
DEVFN int tok_keyrow(int m) { return m < MP ? m : MP + ((m - MP) / DS) * TKS + (m - MP) % DS; }
DEVFN int tok_pos(int m) { return m < MP ? (m % SEQ) : ((m - MP) % DS); }
DEVFN const float* xrow(const Params& p, int l, int m) {
  if (l > 0) return p.Y + (size_t)m * D;
  return m < MP ? p.x_prompt + (size_t)m * D : p.x_sample + (size_t)(m - MP) * D;
}
DEVFN float siluf(float x) { return x / (1.f + expf(-x)); }
DEVFN size_t st_row(int m, int i) { int b = m / SEQ, t = m % SEQ; return ((size_t)(b * 2 + i) * SEQ + t); }

#ifdef CPU_EMU
KERNEL nk_mod(Params p, long n) {
  long g = GTID; if (g >= n) return;
  int col = g % 3072; int cv = (g / 3072) % NCV; int l = g / (3072 * NCV);
  const float* cvec = cv == 0 ? p.c_ctx : p.c + (size_t)(cv - 1) * D;
  const float* w = p.w_mod + (size_t)l * D * 3072 + col;
  float acc = p.b_mod[l * 3072 + col];
  for (int k = 0; k < D; k++) acc += siluf(cvec[k]) * w[(size_t)k * 3072];
  p.modv[((size_t)l * NCV + cv) * 3072 + col] = acc;
}
KERNEL nk_tab(Params p, long n) {
  long g = GTID; if (g >= n) return;
  if (g < 2) {
    int i = g; int l = 2 * i;
    float s1 = 0, s2 = 0;
    for (int k = 0; k < 64; k++) { s1 += p.diff_lq1[i * 64 + k] * p.diff_lk1[i * 64 + k]; s2 += p.diff_lq2[i * 64 + k] * p.diff_lk2[i * 64 + k]; }
    float lam_init = 0.8f - 0.6f * expf(-0.3f * l);
    p.lamv[i] = expf(s1) - expf(s2) + lam_init;
  }
  int t = g / 48, j = g % 48;
  if (t >= DS) return;
  float row = (float)(t / GW), col = (float)(t % GW);
  if (j < 32) {
    int f = j & 15; float inv = powf(10000.f, -(float)(2 * f) / 32.f);
    float ang = (j < 16 ? row : col) * inv;
    p.ropeC64[t * 32 + j] = cosf(ang); p.ropeS64[t * 32 + j] = sinf(ang);
  } else {
    int jj = j - 32; int f = jj & 7; float inv = powf(10000.f, -(float)(2 * f) / 16.f);
    float ang = (jj < 8 ? row : col) * inv;
    p.ropeC32[t * 16 + jj] = cosf(ang); p.ropeS32[t * 16 + jj] = sinf(ang);
  }
}
KERNEL nk_rstd(Params p, int l, long n) {
  long g = GTID; if (g >= n) return;
  const float* x = xrow(p, l, (int)g);
  float s = 0; for (int k = 0; k < D; k++) s += x[k] * x[k];
  p.rstdx[g] = 1.f / sqrtf(s / D + EPSN);
}
KERNEL nk_inproj(Params p, int l, long n) {
  long g = GTID; if (g >= n) return;
  const int N = (l & 1) ? ODD_IN : EVEN_IN;
  int m = g / N, col = g % N;
  const float* W = ((l & 1) ? p.w_in_odd : p.w_in_even) + (size_t)(l >> 1) * D * N + col;
  const float* x = xrow(p, l, m);
  const float* md = p.modv + ((size_t)l * NCV + tok_cv(m)) * 3072;
  const float* nw = p.norm_w + l * D;
  float r = p.rstdx[m], acc = 0;
  for (int k = 0; k < D; k++) { float h = x[k] * r * nw[k] * (1.f + md[1024 + k]) + md[k]; acc += h * W[(size_t)k * N]; }
  p.ubuf[(size_t)m * 3328 + col] = (h16)acc;
}

KERNEL nk_epi_even(Params p, int l, int qa_only, long n) {
  long g = GTID; if (g >= n) return;
  const int i = l >> 1;
  int m = g / 50, u = g % 50;
  if (qa_only && u >= 8) return;
  const h16* ur = qa_only ? p.qa16 + (size_t)m * 256 : p.ubuf + (size_t)m * 3328;
  const bool smp = m >= MP; const int t = tok_pos(m); const int kr = tok_keyrow(m);
  if (u < 8) {
    float ss = 0; for (int k = 0; k < 256; k++) { float v = (float)ur[k]; ss += v * v; }
    float r = 1.f / sqrtf(ss / 256 + EPSN);
    float q[96];
#pragma unroll
    for (int j = 0; j < 96; j++) q[j] = 0;
    const float* W = p.mla_wqb + (size_t)i * 256 * 768 + u * 96;
    for (int k = 0; k < 256; k++) {
      float a = (float)ur[k] * r * p.mla_qa_norm[i * 256 + k];
#pragma unroll
      for (int j = 0; j < 96; j++) q[j] += a * W[(size_t)k * 768 + j];
    }
    float s1 = 0, s2 = 0;
#pragma unroll
    for (int j = 0; j < 64; j++) s1 += q[j] * q[j];
#pragma unroll
    for (int j = 64; j < 96; j++) s2 += q[j] * q[j];
    float r1 = 1.f / sqrtf(s1 / 64 + EPSN), r2 = 1.f / sqrtf(s2 / 32 + EPSN);
#pragma unroll
    for (int j = 0; j < 64; j++) q[j] = q[j] * r1 * p.mla_qn_nope[i * 64 + j];
#pragma unroll
    for (int j = 0; j < 32; j++) q[64 + j] = q[64 + j] * r2 * p.mla_qn_rope[i * 32 + j];
    if (smp) {
#pragma unroll
      for (int j = 0; j < 16; j++) {
        float c = p.ropeC32[t * 16 + j], s = p.ropeS32[t * 16 + j];
        float x1 = q[64 + j], x2 = q[80 + j];
        q[64 + j] = x1 * c - x2 * s; q[80 + j] = x2 * c + x1 * s;
      }
    }
    const float sc = LOG2E / sqrtf(96.f);
    h16* dst = p.QA + ((size_t)m * 8 + u) * 96;
#pragma unroll
    for (int j = 0; j < 96; j++) dst[j] = (h16)(q[j] * sc);
  } else if (u == 8) {
    float ss = 0; for (int k = 0; k < 128; k++) { float v = (float)ur[256 + k]; ss += v * v; }
    float r = 1.f / sqrtf(ss / 128 + EPSN);
    for (int k = 0; k < 128; k++) {
      float v = (float)ur[256 + k] * r * p.mla_kva_norm[i * 128 + k];
      if (!smp) p.o_ckv[st_row(m, i) * 128 + k] = v;
      p.ckvbuf[(size_t)kr * 128 + k] = v;
    }
  } else if (u == 9) {
    float v[32]; float ss = 0;
#pragma unroll
    for (int k = 0; k < 32; k++) { v[k] = (float)ur[384 + k]; ss += v[k] * v[k]; }
    float r = 1.f / sqrtf(ss / 32 + EPSN);
#pragma unroll
    for (int k = 0; k < 32; k++) { v[k] = v[k] * r * p.mla_kn_rope[i * 32 + k]; if (!smp) p.o_kpe[st_row(m, i) * 32 + k] = v[k]; }
    if (smp) {
#pragma unroll
      for (int j = 0; j < 16; j++) {
        float c = p.ropeC32[t * 16 + j], s = p.ropeS32[t * 16 + j];
        float x1 = v[j], x2 = v[16 + j];
        v[j] = x1 * c - x2 * s; v[16 + j] = x2 * c + x1 * s;
      }
    }
#pragma unroll
    for (int k = 0; k < 32; k++) p.kpebuf[(size_t)kr * 32 + k] = v[k];
  } else if (u < 18) {
    int cb = (u - 10) * 64;
    for (int j = 0; j < 64; j++) p.gates16[(size_t)m * 1024 + cb + j] = (h16)siluf((float)ur[416 + cb + j]);
  } else if (u < 34) {
    const bool isq = u < 26; int hc = isq ? u - 18 : u - 26;
    const h16* src = ur + (isq ? 928 : 1440) + hc * 64;
    const float* gn = (isq ? p.diff_qn : p.diff_kn) + i * 64;
    float v[64]; float ss = 0;
#pragma unroll
    for (int k = 0; k < 64; k++) { v[k] = (float)src[k]; ss += v[k] * v[k]; }
    float r = 1.f / sqrtf(ss / 64 + EPSN);
#pragma unroll
    for (int k = 0; k < 64; k++) { v[k] = v[k] * r * gn[k]; if (!isq && !smp) p.o_dk[st_row(m, i) * 512 + hc * 64 + k] = v[k]; }
    if (smp) {
#pragma unroll
      for (int j = 0; j < 32; j++) {
        float c = p.ropeC64[t * 32 + j], s = p.ropeS64[t * 32 + j];
        float x1 = v[j], x2 = v[32 + j];
        v[j] = x1 * c - x2 * s; v[32 + j] = x2 * c + x1 * s;
      }
    }
    if (isq) {
      const float sc = LOG2E / 8.f; h16* dst = p.QB + ((size_t)m * 8 + hc) * 64;
#pragma unroll
      for (int k = 0; k < 64; k++) dst[k] = (h16)(v[k] * sc);
    } else {
      h16* dst = p.KB + ((size_t)hc * KM + kr) * 64;
#pragma unroll
      for (int k = 0; k < 64; k++) dst[k] = (h16)v[k];
    }
  } else if (u < 42) {
    int ch = u - 34; int h = ch >> 1, half = ch & 1;
    for (int j = 0; j < 64; j++) {
      float v = (float)ur[1952 + ch * 64 + j];
      if (!smp) p.o_dv[st_row(m, i) * 512 + ch * 64 + j] = v;
      p.VB[((size_t)h * 128 + half * 64 + j) * KM + kr] = (h16)v;
    }
  } else {
    int cb = (u - 42) * 64;
    for (int j = 0; j < 64; j++) p.gates16[(size_t)m * 1024 + 512 + cb + j] = (h16)siluf((float)ur[2464 + cb + j]);
  }
}
KERNEL nk_cache_even(Params p, int l, long n) {
  long g = GTID; if (g >= n) return;
  const int i = l >> 1;
  int u = g % 17; int pos = (g / 17) % PAST; int b = g / (17 * PAST);
  const int kr = MP + b * TKS + DS + pos;
  const size_t crow = ((size_t)(b * 2 + i) * PAST + pos);
  if (u == 0) {
    for (int k = 0; k < 128; k++) { float v = p.cache_mla_ckv[crow * 128 + k]; p.ckvbuf[(size_t)kr * 128 + k] = v; p.ckv16[(size_t)kr * 128 + k] = (h16)v; }
    for (int k = 0; k < 32; k++) { float v = p.cache_mla_kpe[crow * 32 + k]; p.kpebuf[(size_t)kr * 32 + k] = v; p.kpe16[(size_t)kr * 32 + k] = (h16)v; }
  } else if (u < 9) {
    int hc = u - 1;
    for (int k = 0; k < 64; k++) p.KB[((size_t)hc * KM + kr) * 64 + k] = (h16)p.cache_diff_k[crow * 512 + hc * 64 + k];
  } else {
    int ch = u - 9; int h = ch >> 1, half = ch & 1;
    for (int j = 0; j < 64; j++) p.VB[((size_t)h * 128 + half * 64 + j) * KM + kr] = (h16)p.cache_diff_v[crow * 512 + ch * 64 + j];
  }
}
KERNEL nk_kv(Params p, int l, long n) {
  long g = GTID; if (g >= n) return;
  const int i = l >> 1;
  int part = g & 1; int h = (g >> 1) & 7; int kr = g >> 4;
  const float* cr = p.ckvbuf + (size_t)kr * 128;
  const float* W = p.mla_wkvb + (size_t)i * 128 * 1024 + h * 128 + part * 64;
  float a[64];
#pragma unroll
  for (int j = 0; j < 64; j++) a[j] = 0;
  for (int k = 0; k < 128; k++) {
    float c = (float)(h16)cr[k];
#pragma unroll
    for (int j = 0; j < 64; j++) a[j] += c * W[(size_t)k * 1024 + j];
  }
  if (part == 0) {
    float ss = 0;
#pragma unroll
    for (int j = 0; j < 64; j++) ss += a[j] * a[j];
    float r = 1.f / sqrtf(ss / 64 + EPSN);
    h16* dst = p.KA + ((size_t)h * KM + kr) * 128;
#pragma unroll
    for (int j = 0; j < 64; j++) dst[j] = (h16)(a[j] * r * p.mla_kn_nope[i * 64 + j]);
    for (int j = 0; j < 32; j++) dst[64 + j] = (h16)p.kpebuf[(size_t)kr * 32 + j];
  } else {
#pragma unroll
    for (int j = 0; j < 64; j++) p.VA[((size_t)h * 64 + j) * KM + kr] = (h16)a[j];
  }
}
KERNEL nk_epi_odd(Params p, int l, long n) {
  long g = GTID; if (g >= n) return;
  const int i = l >> 1;
  int m = g / 52, u = g % 52;
  const h16* ur = p.ubuf + (size_t)m * 3328;
  const bool smp = m >= MP; const int t = tok_pos(m); const int kr = tok_keyrow(m);
  if (u < 16 || (u >= 32 && u < 42)) {
    int colbase, head; const float* gn; int kind;
    if (u < 8) { kind = 0; head = u; colbase = head * 64; gn = p.na_qn + i * 64; }
    else if (u < 16) { kind = 1; head = u - 8; colbase = 512 + head * 64; gn = p.na_kn + i * 64; }
    else if (u < 40) { kind = 2; head = u - 32; colbase = 2048 + head * 64; gn = p.gqa_qn + i * 64; }
    else { kind = 3; head = u - 40; colbase = 2560 + head * 64; gn = p.gqa_kn + i * 64; }
    float v[64]; float ss = 0;
#pragma unroll
    for (int k = 0; k < 64; k++) { v[k] = (float)ur[colbase + k]; ss += v[k] * v[k]; }
    float r = 1.f / sqrtf(ss / 64 + EPSN);
#pragma unroll
    for (int k = 0; k < 64; k++) v[k] = v[k] * r * gn[k];
    if (!smp) {
      if (kind == 1) { for (int k = 0; k < 64; k++) p.o_nk[st_row(m, i) * 512 + head * 64 + k] = v[k]; }
      if (kind == 3) { for (int k = 0; k < 64; k++) p.o_gk[st_row(m, i) * 128 + head * 64 + k] = v[k]; }
    }
    if (smp && kind >= 2) {
#pragma unroll
      for (int j = 0; j < 32; j++) {
        float c = p.ropeC64[t * 32 + j], s = p.ropeS64[t * 32 + j];
        float x1 = v[j], x2 = v[32 + j];
        v[j] = x1 * c - x2 * s; v[32 + j] = x2 * c + x1 * s;
      }
    }
    const float sc = LOG2E / 8.f;
    h16* dst;
    if (kind == 0) dst = p.QA + ((size_t)m * 8 + head) * 64;
    else if (kind == 1) dst = p.KA + ((size_t)head * KM + kr) * 64;
    else if (kind == 2) dst = p.QB + ((size_t)m * 8 + head) * 64;
    else dst = p.KB + ((size_t)head * KM + kr) * 64;
    const float mul = (kind == 0 || kind == 2) ? sc : 1.f;
#pragma unroll
    for (int k = 0; k < 64; k++) dst[k] = (h16)(v[k] * mul);
  } else if (u < 24) {
    int head = u - 16;
    for (int j = 0; j < 64; j++) {
      float v = (float)ur[1024 + head * 64 + j];
      if (!smp) p.o_nv[st_row(m, i) * 512 + head * 64 + j] = v;
      p.VA[((size_t)head * 64 + j) * KM + kr] = (h16)v;
    }
  } else if (u < 32) {
    int cb = (u - 24) * 64;
    for (int j = 0; j < 64; j++) p.gates16[(size_t)m * 1024 + cb + j] = (h16)siluf((float)ur[1536 + cb + j]);
  } else if (u < 44) {
    int head = u - 42;
    for (int j = 0; j < 64; j++) {
      float v = (float)ur[2688 + head * 64 + j];
      if (!smp) p.o_gv[st_row(m, i) * 128 + head * 64 + j] = v;
      p.VB[((size_t)head * 64 + j) * KM + kr] = (h16)v;
    }
  } else {
    int cb = (u - 44) * 64;
    for (int j = 0; j < 64; j++) p.gates16[(size_t)m * 1024 + 512 + cb + j] = (h16)siluf((float)ur[2816 + cb + j]);
  }
}
KERNEL nk_cache_odd(Params p, int l, long n) {
  long g = GTID; if (g >= n) return;
  const int i = l >> 1;
  int u = g % 20; int pos = (g / 20) % PAST; int b = g / (20 * PAST);
  const int kr = MP + b * TKS + DS + pos;
  const size_t crow = ((size_t)(b * 2 + i) * PAST + pos);
  if (u < 8) { for (int k = 0; k < 64; k++) p.KA[((size_t)u * KM + kr) * 64 + k] = (h16)p.cache_na_k[crow * 512 + u * 64 + k]; }
  else if (u < 16) { int h = u - 8; for (int j = 0; j < 64; j++) p.VA[((size_t)h * 64 + j) * KM + kr] = (h16)p.cache_na_v[crow * 512 + h * 64 + j]; }
  else if (u < 18) { int h = u - 16; for (int k = 0; k < 64; k++) p.KB[((size_t)h * KM + kr) * 64 + k] = (h16)p.cache_gqa_k[crow * 128 + h * 64 + k]; }
  else { int h = u - 18; for (int j = 0; j < 64; j++) p.VB[((size_t)h * 64 + j) * KM + kr] = (h16)p.cache_gqa_v[crow * 128 + h * 64 + j]; }
}
template <int DQK, int KP>
DEVFN void attn_dense_thread(const h16* q, const h16* K, const h16* VT, int kr0, int nk, float* out) {
  float qf[DQK];
#pragma unroll
  for (int j = 0; j < DQK; j++) qf[j] = (float)q[j];
  float o[64];
#pragma unroll
  for (int j = 0; j < 64; j++) o[j] = 0;
  float mx = -1e30f, sum = 0;
  for (int kk = 0; kk < nk; kk++) {
    const h16* kp = K + (size_t)(kr0 + kk) * KP;
    float s = 0;
#pragma unroll
    for (int j = 0; j < DQK; j++) s += qf[j] * (float)kp[j];
    float mn = fmaxf(mx, s); float al = exp2f_(mx - mn); float pe = exp2f_(s - mn);
    sum = sum * al + pe; mx = mn;
#pragma unroll
    for (int j = 0; j < 64; j++) o[j] = o[j] * al + pe * (float)VT[(size_t)j * KM + kr0 + kk];
  }
  float inv = 1.f / sum;
#pragma unroll
  for (int j = 0; j < 64; j++) out[j] = o[j] * inv;
}
KERNEL nk_attn_dense(Params p, int kind, int mlo, int mhi, long n) {
  long g = GTID; if (g >= n) return;
  const int nch = kind == 1 ? 2 : 1;
  int ch = g % nch; int head = (g / nch) % 8; int m = mlo + g / (nch * 8);
  if (m >= mhi) return;
  int kr0, nk;
  if (m < MP) { kr0 = (m / SEQ) * SEQ; nk = SEQ; } else { kr0 = MP + ((m - MP) / DS) * TKS; nk = TKS; }
  if (kind == 0) {
    attn_dense_thread<96, 128>(p.QA + ((size_t)m * 8 + head) * 96, p.KA + (size_t)head * KM * 128, p.VA + (size_t)head * 64 * KM, kr0, nk,
                          p.abuf + (size_t)m * 1536 + head * 64);
  } else if (kind == 1) {
    attn_dense_thread<64, 64>(p.QB + ((size_t)m * 8 + head) * 64, p.KB + (size_t)head * KM * 64,
                          p.VB + ((size_t)(head >> 1) * 128 + ch * 64) * KM, kr0, nk, p.abuf + (size_t)m * 1536 + 512 + head * 128 + ch * 64);
  } else if (kind == 2) {
    attn_dense_thread<64, 64>(p.QA + ((size_t)m * 8 + head) * 64, p.KA + (size_t)head * KM * 64, p.VA + (size_t)head * 64 * KM, kr0, nk,
                          p.abuf + (size_t)m * 1536 + head * 64);
  } else {
    attn_dense_thread<64, 64>(p.QB + ((size_t)m * 8 + head) * 64, p.KB + (size_t)(head >> 2) * KM * 64, p.VB + (size_t)(head >> 2) * 64 * KM,
                          kr0, nk, p.abuf + (size_t)m * 1536 + 512 + head * 64);
  }
}
KERNEL nk_attn_na(Params p, int l, long n) {
  long g = GTID; if (g >= n) return;
  const int i = l >> 1;
  int head = g & 7; int ms = g >> 3; int m = MP + ms;
  int b = ms / DS, t = ms % DS; int r = t / GW, c = t % GW;
  int rs = r - 4; rs = rs < 0 ? 0 : (rs > GROWS - 8 ? GROWS - 8 : rs);
  int cs = c - 8; cs = cs < 0 ? 0 : (cs > GW - 16 ? GW - 16 : cs);
  const h16* q = p.QA + ((size_t)m * 8 + head) * 64;
  const h16* K = p.KA + (size_t)head * KM * 64; const h16* VT = p.VA + (size_t)head * 64 * KM;
  const int kbase = MP + b * TKS;
  const float* rpb = p.na_rpb + ((size_t)i * 8 + head) * 15 * 31;
  float qf[64], o[64];
#pragma unroll
  for (int j = 0; j < 64; j++) { qf[j] = (float)q[j]; o[j] = 0; }
  float mx = -1e30f, sum = 0;
  for (int kk = 0; kk < 128 + PAST; kk++) {
    int kr; float bias = 0;
    if (kk < 128) { int ri = kk >> 4, cj = kk & 15; kr = kbase + (rs + ri) * GW + cs + cj; bias = rpb[(rs + ri - r + 7) * 31 + (cs + cj - c + 15)] * LOG2E; }
    else kr = kbase + DS + (kk - 128);
    const h16* kp = K + (size_t)kr * 64;
    float s = bias;
#pragma unroll
    for (int j = 0; j < 64; j++) s += qf[j] * (float)kp[j];
    float mn = fmaxf(mx, s); float al = exp2f_(mx - mn); float pe = exp2f_(s - mn);
    sum = sum * al + pe; mx = mn;
#pragma unroll
    for (int j = 0; j < 64; j++) o[j] = o[j] * al + pe * (float)VT[(size_t)j * KM + kr];
  }
  float inv = 1.f / sum; float* out = p.abuf + (size_t)m * 1536 + head * 64;
#pragma unroll
  for (int j = 0; j < 64; j++) out[j] = o[j] * inv;
}
KERNEL nk_fin(Params p, int l, long n) {
  long g = GTID; if (g >= n) return;
  const int i = l >> 1;
  if (l & 1) {
    int ch = g & 15; int m = g >> 4;
    for (int j = 0; j < 64; j++) {
      int col = ch * 64 + j;
      p.O16[(size_t)m * 1024 + col] = (h16)(p.abuf[(size_t)m * 1536 + col] * (float)p.gates16[(size_t)m * 1024 + col]);
    }
  } else {
    int u = g % 12; int m = g / 12;
    if (u < 8) {
      for (int j = 0; j < 64; j++) {
        int col = u * 64 + j;
        p.O16[(size_t)m * 1024 + col] = (h16)(p.abuf[(size_t)m * 1536 + col] * (float)p.gates16[(size_t)m * 1024 + col]);
      }
    } else {
      int h = u - 8; float lam = p.lamv[i]; float lam_init = 0.8f - 0.6f * expf(-0.3f * l);
      const float* a1 = p.abuf + (size_t)m * 1536 + 512 + (h * 2) * 128; const float* a2 = a1 + 128;
      float ss = 0;
      for (int j = 0; j < 128; j++) { float d = a1[j] - lam * a2[j]; ss += d * d; }
      float r = 1.f / sqrtf(ss / 128 + EPSN);
      for (int j = 0; j < 128; j++) {
        float d = (a1[j] - lam * a2[j]) * r * p.diff_subln[i * 128 + j] * (1.f - lam_init);
        int col = 512 + h * 128 + j;
        p.O16[(size_t)m * 1024 + col] = (h16)(d * (float)p.gates16[(size_t)m * 1024 + col]);
      }
    }
  }
}
KERNEL nk_outproj(Params p, int l, long n) {
  long g = GTID; if (g >= n) return;
  int m = g >> 10, col = g & 1023;
  const float* W = ((l & 1) ? p.w_out_odd : p.w_out_even) + (size_t)(l >> 1) * 1024 * 1024 + col;
  const h16* o = p.O16 + (size_t)m * 1024;
  float acc = 0;
  for (int k = 0; k < 1024; k++) acc += (float)o[k] * W[(size_t)k * 1024];
  float gate = p.modv[((size_t)l * NCV + tok_cv(m)) * 3072 + 2048 + col];
  p.Y[(size_t)m * 1024 + col] = xrow(p, l, m)[col] + gate * acc;
}


#endif
#ifndef CPU_EMU
typedef _Float16 h16x8 __attribute__((ext_vector_type(8)));
typedef _Float16 h16x4 __attribute__((ext_vector_type(4)));
typedef float f32x16 __attribute__((ext_vector_type(16)));
typedef float f32x4 __attribute__((ext_vector_type(4)));
#define LAS __attribute__((address_space(3)))
typedef unsigned u32x4 __attribute__((ext_vector_type(4)));
DEVFN size_t pidx(int R, int row, int k) { return ((size_t)(k >> 6) * R + row) * 64 + (k & 63); }
DEVFN size_t vidx(int vrow, int kr) { return ((size_t)(kr >> 6) * 512 + vrow) * 64 + (kr & 63); }
DEVFN float max3f(float a, float b, float c) { float r; asm("v_max3_f32 %0, %1, %2, %3" : "=v"(r) : "v"(a), "v"(b), "v"(c)); return r; }
DEVFN float frsq(float x) { return __builtin_amdgcn_rsqf(x); }
DEVFN float fsilu(float x) { return x * __builtin_amdgcn_rcpf(1.f + __builtin_amdgcn_exp2f(-LOG2E * x)); }
DEVFN int tid_op() { int t = threadIdx.x; asm volatile("" : "+v"(t)); return t; }

DEVFN int even_col(int np) { return np < 416 ? np : (np < 512 ? -1 : np - 96); }

constexpr int G_STAGE = 49152, G_NSTAGE = 3, G_LDS = G_STAGE * G_NSTAGE;
constexpr int G_LDS2 = 131072 + 8 * 3072;
DEVFN int img_off(int r, int c) { return r * 128 + ((c ^ ((r >> 1) & 7)) << 4); }
template <int R>
DEVFN void stage_rows(const h16* g, int ld, char* lds, int tid) {
#pragma unroll
  for (int i = 0; i < R / 64; i++) {
    int r = (tid >> 3) + 64 * i; int c = (tid & 7) ^ ((r >> 1) & 7);
    __builtin_amdgcn_global_load_lds((const unsigned*)(g + (size_t)r * ld + c * 8), (unsigned*)(lds + i * 8192 + tid * 16), 16, 0, 0);
  }
}
#define WAITV(n) asm volatile("s_waitcnt vmcnt(" #n ")" ::: "memory")
#define RAWBAR() do { asm volatile("s_waitcnt lgkmcnt(0)" ::: "memory"); __builtin_amdgcn_s_barrier(); } while (0)
template <bool TR>
DEVFN void gemm_tile(const h16* A, int RA, const h16* Bt, int RB, int K, int m0, int n0, char* lds, f32x16 (&acc)[2][2]) {
  const int TIDX = tid_op();
  const int tid = TIDX, lane = tid & 63, w = tid >> 6, wm = w >> 1, wn = w & 1;
  const int nt = K / 64;
  const h16* Ag = A + (size_t)m0 * 64; const h16* Bg = Bt + (size_t)n0 * 64; const size_t pa = (size_t)RA * 64, pb = (size_t)RB * 64;
#pragma unroll
  for (int a = 0; a < 2; a++)
#pragma unroll
    for (int b = 0; b < 2; b++)
#pragma unroll
      for (int r = 0; r < 16; r++) acc[a][b][r] = 0.f;
  stage_rows<256>(Ag, 64, lds, tid); stage_rows<128>(Bg, 64, lds + 32768, tid);
  if (nt > 1) { stage_rows<256>(Ag + pa, 64, lds + G_STAGE, tid); stage_rows<128>(Bg + pb, 64, lds + G_STAGE + 32768, tid); }
  const int ra = wm * 64 + (lane & 31), rb = wn * 64 + (lane & 31), ch = lane >> 5;
  auto piece = [&](const h16* g, char* s, int i) {
    const int r = (tid >> 3) + 64 * i; const int c = (tid & 7) ^ ((r >> 1) & 7);
    __builtin_amdgcn_global_load_lds((const unsigned*)(g + (size_t)r * 64 + c * 8), (unsigned*)(s + i * 8192 + tid * 16), 16, 0, 0);
  };
  for (int t = 0; t < nt; t++) {
    if (t + 1 < nt) WAITV(6); else WAITV(0);
    RAWBAR();
    const bool pre = t + 2 < nt;
    char* sn = lds + ((t + 2) % 3) * G_STAGE; const h16* An = Ag + (t + 2) * pa; const h16* Bn = Bg + (t + 2) * pb;
    const char* sa = lds + (t % 3) * G_STAGE; const char* sb = sa + 32768;
    h16x8 af[2][2], bf[2][2];
#pragma unroll
    for (int mb = 0; mb < 2; mb++) af[0][mb] = *(const h16x8*)(sa + img_off(ra + mb * 32, ch));
#pragma unroll
    for (int nb = 0; nb < 2; nb++) bf[0][nb] = *(const h16x8*)(sb + img_off(rb + nb * 32, ch));
#pragma unroll
    for (int ks = 0; ks < 4; ks++) {
      const int cur = ks & 1, nxt = cur ^ 1;
      if (ks < 3) {
#pragma unroll
        for (int mb = 0; mb < 2; mb++) af[nxt][mb] = *(const h16x8*)(sa + img_off(ra + mb * 32, 2 * (ks + 1) + ch));
#pragma unroll
        for (int nb = 0; nb < 2; nb++) bf[nxt][nb] = *(const h16x8*)(sb + img_off(rb + nb * 32, 2 * (ks + 1) + ch));
      }
      if (pre) {
        if (ks == 0) { piece(An, sn, 0); piece(An, sn, 1); }
        else if (ks == 1) { piece(An, sn, 2); piece(An, sn, 3); }
        else if (ks == 2) { piece(Bn, sn + 32768, 0); piece(Bn, sn + 32768, 1); }
      }
#pragma unroll
      for (int mb = 0; mb < 2; mb++)
#pragma unroll
        for (int nb = 0; nb < 2; nb++) {
          if (TR) acc[mb][nb] = __builtin_amdgcn_mfma_f32_32x32x16_f16(bf[cur][nb], af[cur][mb], acc[mb][nb], 0, 0, 0);
          else acc[mb][nb] = __builtin_amdgcn_mfma_f32_32x32x16_f16(af[cur][mb], bf[cur][nb], acc[mb][nb], 0, 0, 0);
        }
      __builtin_amdgcn_sched_barrier(0);
    }
  }
  RAWBAR();
}

DEVFN float wsum32(float v) { return v + __shfl_xor(v, 32); }

template <class RsF, class DstF>
DEVFN void epi_head64(const Params& p, const f32x16 (&acc)[2][2], int mbase, RsF rsf, const float* bias, const float* gain, bool rope, float oscale,
                      float* state, int spitch, int scol, int ilayer, DstF dstf) {
  const int TIDX = tid_op();
  const int lane = TIDX & 63, h = lane >> 5;
#pragma unroll
  for (int mb = 0; mb < 2; mb++) {
    const int m = mbase + mb * 32 + (lane & 31);
    const float rs = rsf(m);
    float v[2][16]; float ss = 0;
#pragma unroll
    for (int nb = 0; nb < 2; nb++)
#pragma unroll
      for (int q = 0; q < 4; q++) {
        const int j = nb * 32 + 8 * q + 4 * h;
        f32x4 b = bias ? *(const f32x4*)(bias + j) : (f32x4){0.f, 0.f, 0.f, 0.f};
#pragma unroll
        for (int e = 0; e < 4; e++) { float x = acc[mb][nb][q * 4 + e] * rs + b[e]; v[nb][q * 4 + e] = x; ss += x * x; }
      }
    ss = wsum32(ss);
    const float rr = frsq(ss * (1.f / 64.f) + EPSN);
#pragma unroll
    for (int nb = 0; nb < 2; nb++)
#pragma unroll
      for (int q = 0; q < 4; q++) {
        const int j = nb * 32 + 8 * q + 4 * h;
        f32x4 g = *(const f32x4*)(gain + j);
#pragma unroll
        for (int e = 0; e < 4; e++) v[nb][q * 4 + e] *= rr * g[e];
      }
    const bool smp = m >= MP;
    if (state && !smp) {
      float* sp = state + st_row(m, ilayer) * spitch + scol;
#pragma unroll
      for (int nb = 0; nb < 2; nb++)
#pragma unroll
        for (int q = 0; q < 4; q++) { f32x4 o = {v[nb][q * 4], v[nb][q * 4 + 1], v[nb][q * 4 + 2], v[nb][q * 4 + 3]}; *(f32x4*)(sp + nb * 32 + 8 * q + 4 * h) = o; }
    }
    if (rope && smp) {
      const int t = tok_pos(m);
#pragma unroll
      for (int q = 0; q < 4; q++) {
        f32x4 c = *(const f32x4*)(p.ropeC64 + t * 32 + 8 * q + 4 * h), s = *(const f32x4*)(p.ropeS64 + t * 32 + 8 * q + 4 * h);
#pragma unroll
        for (int e = 0; e < 4; e++) { float x1 = v[0][q * 4 + e], x2 = v[1][q * 4 + e]; v[0][q * 4 + e] = x1 * c[e] - x2 * s[e]; v[1][q * 4 + e] = x2 * c[e] + x1 * s[e]; }
      }
    }
    h16* dst = dstf(m);
#pragma unroll
    for (int nb = 0; nb < 2; nb++)
#pragma unroll
      for (int q = 0; q < 4; q++) {
        h16x4 o;
#pragma unroll
        for (int e = 0; e < 4; e++) o[e] = (h16)(v[nb][q * 4 + e] * oscale);
        *(h16x4*)(dst + nb * 32 + 8 * q + 4 * h) = o;
      }
  }
}
template <class RsF, class DstF>
DEVFN void epi_head32(const Params& p, const f32x16 (&acc)[2][2], int mbase, RsF rsf, const float* bias, const float* gain, bool rope, float oscale,
                      float* state, int ilayer, DstF dstf, float* dual = nullptr) {
  const int TIDX = tid_op();
  const int lane = TIDX & 63, h = lane >> 5;
#pragma unroll
  for (int mb = 0; mb < 2; mb++) {
    const int m = mbase + mb * 32 + (lane & 31);
    const float rs = rsf(m);
    float v[16]; float ss = 0;
#pragma unroll
    for (int q = 0; q < 4; q++) {
      const int j = 8 * q + 4 * h;
      f32x4 b = bias ? *(const f32x4*)(bias + j) : (f32x4){0.f, 0.f, 0.f, 0.f};
#pragma unroll
      for (int e = 0; e < 4; e++) { float x = acc[mb][0][q * 4 + e] * rs + b[e]; v[q * 4 + e] = x; ss += x * x; }
    }
    ss = wsum32(ss);
    const float rr = frsq(ss * (1.f / 32.f) + EPSN);
#pragma unroll
    for (int q = 0; q < 4; q++) {
      f32x4 g = *(const f32x4*)(gain + 8 * q + 4 * h);
#pragma unroll
      for (int e = 0; e < 4; e++) v[q * 4 + e] *= rr * g[e];
    }
    const bool smp = m >= MP;
    if (state && !smp) {
      float* sp = state + st_row(m, ilayer) * 32;
#pragma unroll
      for (int q = 0; q < 4; q++) { f32x4 o = {v[q * 4], v[q * 4 + 1], v[q * 4 + 2], v[q * 4 + 3]}; *(f32x4*)(sp + 8 * q + 4 * h) = o; }
    }
    if (rope && smp) {
      const int t = tok_pos(m);
#pragma unroll
      for (int q = 0; q < 2; q++) {
        f32x4 c = *(const f32x4*)(p.ropeC32 + t * 16 + 8 * q + 4 * h), s = *(const f32x4*)(p.ropeS32 + t * 16 + 8 * q + 4 * h);
#pragma unroll
        for (int e = 0; e < 4; e++) { float x1 = v[q * 4 + e], x2 = v[(q + 2) * 4 + e]; v[q * 4 + e] = x1 * c[e] - x2 * s[e]; v[(q + 2) * 4 + e] = x2 * c[e] + x1 * s[e]; }
      }
    }
    h16* dst = dstf(m);
#pragma unroll
    for (int q = 0; q < 4; q++) {
      h16x4 o;
#pragma unroll
      for (int e = 0; e < 4; e++) o[e] = (h16)(v[q * 4 + e] * oscale);
      *(h16x4*)(dst + 8 * q + 4 * h) = o;
      if (dual) { for (int e = 0; e < 4; e++) dual[(size_t)tok_keyrow(m) * 32 + 8 * q + 4 * h + e] = v[q * 4 + e]; }
    }
  }
}
template <class RsF, class KrF>
DEVFN void epi_vt(const f32x16 (&acc)[2][2], int mbase, RsF rsf, const float* bias  , float* state, int spitch, int scol, int ilayer,
                  h16* vbuf, int vrow0, KrF krf) {
  const int TIDX = tid_op();
  const int lane = TIDX & 63, h = lane >> 5, e0 = lane & 31;
#pragma unroll
  for (int mb = 0; mb < 2; mb++)
#pragma unroll
    for (int q = 0; q < 4; q++) {
      const int mq = mbase + mb * 32 + 8 * q + 4 * h;
      float rs[4];
#pragma unroll
      for (int e = 0; e < 4; e++) rs[e] = rsf(mq + e);
      const int kr = krf(mq);
#pragma unroll
      for (int nb = 0; nb < 2; nb++) {
        const int col = nb * 32 + e0; const float b = bias ? bias[col] : 0.f;
        h16x4 o;
#pragma unroll
        for (int e = 0; e < 4; e++) {
          float x = acc[mb][nb][q * 4 + e] * rs[e] + b; o[e] = (h16)x;
          if (state && mq < MP) state[st_row(mq + e, ilayer) * spitch + scol + col] = x;
        }
        *(h16x4*)(vbuf + vidx(vrow0 + col, kr)) = o;
      }
    }
}

DEVFN void qgemm_tile(const Params& p, int l, int mt, int head, char* lds) {
  const int TIDX = tid_op();
  const int i = l >> 1; const int m0 = mt * 256;
  const int w = TIDX >> 6, wm = w >> 1, wn = w & 1;
  f32x16 acc[2][2];
  gemm_tile<true>(p.qa16, M, (p.wqb16 + (size_t)i * 1024 * 256), 1024, 256, m0, head * 128, lds, acc);
  const float* rq = p.rowss_qa + (size_t)i * M;
  auto rsf = [&](int m) { return frsq(rq[m] * (1.f / 256.f) + EPSN); };
  const float sc = LOG2E / sqrtf(96.f);
  if (wn == 0) epi_head64(p, acc, m0 + wm * 64, rsf, nullptr, p.mla_qn_nope + i * 64, false, sc, nullptr, 0, 0, i, [&](int m) { return p.QA + ((size_t)m * 8 + head) * 96; });
  else epi_head32(p, acc, m0 + wm * 64, rsf, nullptr, p.mla_qn_rope + i * 32, true, sc, nullptr, i, [&](int m) { return p.QA + ((size_t)m * 8 + head) * 96 + 64; });
}
DEVFN void kvgemm_tile(const Params& p, int l, int mt, int ntile, char* lds) {
  const int TIDX = tid_op();
  const int i = l >> 1; const int m0 = mt * 256;
  const int lane = TIDX & 63, w = TIDX >> 6, wm = w >> 1, wn = w & 1, h = lane >> 5;
  f32x16 acc[2][2];
  const float* rck = p.rowss_ckv + (size_t)i * KM;
  auto one = [&](int m) { return frsq(rck[m] * (1.f / 128.f) + EPSN); };
  if (ntile < 4) {
    gemm_tile<true>(p.ckv16, KM, (p.wkvb16 + (size_t)i * 1024 * 128), 1024, 128, m0, ntile * 128, lds, acc);
    const int head = ntile * 2 + wn;
    epi_head64(p, acc, m0 + wm * 64, one, nullptr, p.mla_kn_nope + i * 64, false, 1.f, nullptr, 0, 0, i, [&](int m) { return p.KA + ((size_t)head * KM + m) * 128; });
#pragma unroll
    for (int mb = 0; mb < 2; mb++) {
      const int kr = m0 + wm * 64 + mb * 32 + (lane & 31);
      const h16x8* s = (const h16x8*)(p.kpe16 + (size_t)kr * 32 + h * 16);
      h16x8* d = (h16x8*)(p.KA + ((size_t)head * KM + kr) * 128 + 64 + h * 16);
      d[0] = s[0]; d[1] = s[1];
    }
  } else {
    gemm_tile<false>(p.ckv16, KM, (p.wkvb16 + (size_t)i * 1024 * 128), 1024, 128, m0, ntile * 128, lds, acc);
    const int head = (ntile - 4) * 2 + wn;
    epi_vt(acc, m0 + wm * 64, one, nullptr, nullptr, 0, 0, i, p.VA, head * 64, [](int m) { return m; });
  }
}
DEVFN void outproj_tile(const Params& p, int l, int mt, int ntile, char* lds, bool dry = false) {
  const int TIDX = tid_op();
  const int m0 = mt * 256, n0 = ntile * 128;
  const int lane = TIDX & 63, w = TIDX >> 6, wm = w >> 1, wn = w & 1, h = lane >> 5;
  f32x16 acc[2][2];
  gemm_tile<true>(p.O16, M, (p.wout16 + (size_t)l * D * D), 1024, D, m0, n0, lds, acc);
  const int cv = tok_cv(m0); const int nw0 = n0 + wn * 64;
  const float* gate = p.modv + ((size_t)l * NCV + cv) * 3072 + 2048 + nw0;
  const float* nsc = p.modv + ((size_t)(l + 1) * NCV + cv) * 3072 + 1024 + nw0;
  const float* nnw = p.norm_w + (l + 1) * D + nw0;
#pragma unroll
  for (int mb = 0; mb < 2; mb++) {
    const int m = m0 + wm * 64 + mb * 32 + (lane & 31);
    const float* xr = xrow(p, l, m) + nw0; float* yr = p.Y + (size_t)m * D + nw0;
    float ss = 0;
#pragma unroll
    for (int nb = 0; nb < 2; nb++)
#pragma unroll
      for (int q = 0; q < 4; q++) {
        const int j = nb * 32 + 8 * q + 4 * h;
        f32x4 x = *(const f32x4*)(xr + j), g = *(const f32x4*)(gate + j), o;
#pragma unroll
        for (int e = 0; e < 4; e++) { o[e] = x[e] + g[e] * acc[mb][nb][q * 4 + e]; ss += o[e] * o[e]; }
        if (!dry) *(f32x4*)(yr + j) = o;
        if (l < 3 && !dry) {
          f32x4 s = *(const f32x4*)(nsc + j), nw = *(const f32x4*)(nnw + j); h16x4 oh;
#pragma unroll
          for (int e = 0; e < 4; e++) oh[e] = (h16)(o[e] * nw[e] * (1.f + s[e]));
          *(h16x4*)(p.xs16 + pidx(M, m, nw0 + j)) = oh;
        }
      }
    if (l < 3 && !dry) { ss = wsum32(ss); if (h == 0) atomicAdd(p.rowss_l + (size_t)(l + 1) * M + m, ss); }
  }
}
struct AttnItem {
  const h16 *k0, *k1; int kld;
  const h16 *v0, *v1;
  int kr0, nt0, kr1, nt1;
};
constexpr int A_RING = 3 * 32768;

template <int DQK, int NKI, int NVI, int NDB, bool NAMASK>
DEVFN void attn_core(const AttnItem& it, const h16* qptr, int qpitch, int ksel, int ta, int tb, const float* rpbl, int na_dr0  , int na_c,
                     char* lds, f32x16 (&o)[NDB], float& lsum_out) {
  const int TIDX = tid_op();
  constexpr int NIMG = NKI + NVI; constexpr int STG = NIMG * 8192;
  const int tid = TIDX, lane = tid & 63, h = lane >> 5;
  h16x8 qf[DQK / 16];
#pragma unroll
  for (int ks = 0; ks < DQK / 16; ks++) qf[ks] = *(const h16x8*)(qptr + (size_t)(lane & 31) * qpitch + ks * 16 + 8 * h);
#pragma unroll
  for (int db = 0; db < NDB; db++)
#pragma unroll
    for (int r = 0; r < 16; r++) o[db][r] = 0.f;
  float m_run = 0.f, lsum = 0.f; bool first = true;
  const int nt = it.nt0 + it.nt1;
  auto stage = [&](int t) {
    char* s = lds + (t % 3) * STG; const int kr = t < it.nt0 ? it.kr0 + 64 * t : it.kr1 + 64 * (t - it.nt0);
    stage_rows<64>(it.k0 + (size_t)kr * it.kld, it.kld, s, tid);
    if (NKI == 2) stage_rows<64>(it.k1 + (size_t)kr * it.kld, it.kld, s + 8192, tid);
    stage_rows<64>(it.v0 + (size_t)(kr >> 6) * (512 * 64), 64, s + NKI * 8192, tid);
    if (NVI == 2) stage_rows<64>(it.v1 + (size_t)(kr >> 6) * (512 * 64), 64, s + NKI * 8192 + 8192, tid);
  };
  stage(0); if (nt > 1) stage(1);
  const int l5 = lane & 31;
  const int prow = (l5 & 19) | ((l5 & 4) << 1) | ((l5 & 8) >> 1);
  int na_cs = na_c - 8; na_cs = na_cs < 0 ? 0 : (na_cs > GW - 16 ? GW - 16 : na_cs);
  for (int t = 0; t < nt; t++) {
    if (t + 1 < nt) { if (NIMG == 2) WAITV(2); else if (NIMG == 3) WAITV(3); else WAITV(4); } else WAITV(0);
    RAWBAR();
    if (t + 2 < nt) stage(t + 2);
    const bool active = (t >= it.nt0) || (t >= ta && t < tb);
    if (active) {
      const char* s = lds + (t % 3) * STG;
      const char* sv = s + NKI * 8192;
      h16x8 kf[2][DQK / 16];
#pragma unroll
      for (int kb = 0; kb < 2; kb++)
#pragma unroll
        for (int ks = 0; ks < DQK / 16; ks++) {
          const int img = (DQK == 96) ? (ks >> 2) : ksel;
          kf[kb][ks] = *(const h16x8*)(s + img * 8192 + img_off(32 * kb + prow, 2 * (ks & 3) + h));
        }
      __builtin_amdgcn_sched_barrier(0);
      f32x16 st[2];
#pragma unroll
      for (int kb = 0; kb < 2; kb++) {
#pragma unroll
        for (int r = 0; r < 16; r++) st[kb][r] = -m_run;
#pragma unroll
        for (int ks = 0; ks < DQK / 16; ks++) st[kb] = __builtin_amdgcn_mfma_f32_32x32x16_f16(kf[kb][ks], qf[ks], st[kb], 0, 0, 0);
      }
      __builtin_amdgcn_sched_barrier(0);
      h16x8 vf[2][4];
#pragma unroll
      for (int db = 0; db < 2; db++)
#pragma unroll
        for (int sI = 0; sI < 4; sI++) vf[db][sI] = *(const h16x8*)(sv + img_off(db * 32 + l5, 2 * sI + h));
      __builtin_amdgcn_sched_barrier(0);
      if (NAMASK && t < it.nt0) {
        const int drow = (na_dr0 + t) * 31 + 15 - na_c;
#pragma unroll
        for (int kb = 0; kb < 2; kb++)
#pragma unroll
          for (int r = 0; r < 16; r++) {
            const int kcol = 32 * kb + (r & 7) + 8 * h + 16 * (r >> 3);
            const bool valid = (unsigned)(kcol - na_cs) < 16u;
            const float bv = rpbl[valid ? drow + kcol : 0];
            st[kb][r] = valid ? st[kb][r] + bv : -1e30f;
          }
      }
      float mx;
      {
        float m0 = max3f(st[0][0], st[0][1], st[0][2]), m1 = max3f(st[1][0], st[1][1], st[1][2]);
#pragma unroll
        for (int r = 3; r < 15; r += 2) { m0 = max3f(m0, st[0][r], st[0][r + 1]); m1 = max3f(m1, st[1][r], st[1][r + 1]); }
        mx = max3f(m0, m1, st[0][15]); mx = fmaxf(mx, st[1][15]);
      }
      { auto sw = __builtin_amdgcn_permlane32_swap(__float_as_uint(mx), __float_as_uint(mx), false, false); mx = fmaxf(__uint_as_float(sw[0]), __uint_as_float(sw[1])); }
      if (first || !__all(mx <= 8.f)) {
        const float delta = first ? mx : fmaxf(mx, 0.f);
        const float al = __builtin_amdgcn_exp2f(-delta); m_run += delta; lsum *= al; first = false;
#pragma unroll
        for (int db = 0; db < NDB; db++)
#pragma unroll
          for (int r = 0; r < 16; r++) o[db][r] *= al;
#pragma unroll
        for (int kb = 0; kb < 2; kb++)
#pragma unroll
          for (int r = 0; r < 16; r++) st[kb][r] -= delta;
      }
      float sum = 0.f;
#pragma unroll
      for (int kb = 0; kb < 2; kb++)
#pragma unroll
        for (int r = 0; r < 16; r++) { float pe = __builtin_amdgcn_exp2f(st[kb][r]); st[kb][r] = pe; sum += pe; }
      lsum += sum;
      h16x8 pf[4];
#pragma unroll
      for (int sI = 0; sI < 4; sI++) {
        u32x4 pk;
#pragma unroll
        for (int j = 0; j < 4; j++) pk[j] = __builtin_bit_cast(unsigned, __builtin_amdgcn_cvt_pkrtz(st[sI >> 1][8 * (sI & 1) + 2 * j], st[sI >> 1][8 * (sI & 1) + 2 * j + 1]));
        pf[sI] = __builtin_bit_cast(h16x8, pk);
      }
      __builtin_amdgcn_sched_barrier(0);
      if (NDB == 4) {
        h16x8 vg[2][4];
#pragma unroll
        for (int db = 0; db < 2; db++)
#pragma unroll
          for (int sI = 0; sI < 4; sI++) vg[db][sI] = *(const h16x8*)(sv + 8192 + img_off(db * 32 + l5, 2 * sI + h));
#pragma unroll
        for (int db = 0; db < 2; db++)
#pragma unroll
          for (int sI = 0; sI < 4; sI++) o[db] = __builtin_amdgcn_mfma_f32_32x32x16_f16(vf[db][sI], pf[sI], o[db], 0, 0, 0);
#pragma unroll
        for (int db = 0; db < 2; db++)
#pragma unroll
          for (int sI = 0; sI < 4; sI++) o[NDB == 4 ? 2 + db : db] = __builtin_amdgcn_mfma_f32_32x32x16_f16(vg[db][sI], pf[sI], o[NDB == 4 ? 2 + db : db], 0, 0, 0);
      } else {
#pragma unroll
        for (int db = 0; db < 2; db++)
#pragma unroll
          for (int sI = 0; sI < 4; sI++) o[db] = __builtin_amdgcn_mfma_f32_32x32x16_f16(vf[db][sI], pf[sI], o[db], 0, 0, 0);
      }
      __builtin_amdgcn_sched_barrier(0);
    }
  }
  RAWBAR();
  lsum_out = lsum + __shfl_xor(lsum, 32);
}
template <int NDB>
DEVFN void attn_store_gated(const Params& p, const f32x16 (&o)[NDB], float inv, int m, int col0) {
  const int TIDX = tid_op();
  const int h = (TIDX & 63) >> 5;
#pragma unroll
  for (int db = 0; db < NDB; db++)
#pragma unroll
    for (int q = 0; q < 4; q++) {
      const int c = col0 + 32 * db + 8 * q + 4 * h;
      h16x4 g = *(const h16x4*)(p.gates16 + (size_t)m * 1024 + c), ov;
#pragma unroll
      for (int e = 0; e < 4; e++) ov[e] = (h16)(o[db][q * 4 + e] * inv * (float)g[e]);
      *(h16x4*)(p.O16 + pidx(M, m, c)) = ov;
    }
}
DEVFN void attn_even_item(const Params& p, int l, int item, char* lds) {
  const int TIDX = tid_op();
  const int i = l >> 1; const int lane = TIDX & 63, w = TIDX >> 6, h = lane >> 5;
  const int grp = item >> 7, j = item & 127; const bool smp = grp < 2; const bool isdiff = (grp & 1) == 0;
  AttnItem it{}; it.nt1 = 0; it.kr1 = 0;
  if (isdiff) {
    int b, hh, t0;
    if (smp) { b = j >> 6; hh = (j >> 4) & 3; t0 = (j & 15) * 128; it.kr0 = MP + b * TKS; it.nt0 = TKS / 64; }
    else { b = j >> 3; hh = (j >> 1) & 3; t0 = (j & 1) * 128; it.kr0 = b * SEQ; it.nt0 = SEQ / 64; }
    const int comp = w >> 2;
    const int m0w = (smp ? MP + b * DS : b * SEQ) + t0 + (w & 3) * 32;
    it.k0 = p.KB + (size_t)(2 * hh) * KM * 64; it.k1 = p.KB + (size_t)(2 * hh + 1) * KM * 64; it.kld = 64;
    it.v0 = p.VB + (size_t)(hh * 128) * 64; it.v1 = p.VB + (size_t)(hh * 128 + 64) * 64;
    f32x16 o[4]; float lsum;
    attn_core<64, 2, 2, 4, false>(it, p.QB + ((size_t)m0w * 8 + 2 * hh + comp) * 64, 512, comp, 0, 1 << 30, nullptr, 0, 0, lds, o, lsum);
    const float inv = 1.f / lsum;
    float* a2 = (float*)lds + (size_t)(w & 3) * 32 * 132 + (size_t)(lane & 31) * 132;
    if (comp == 1) {
#pragma unroll
      for (int db = 0; db < 4; db++)
#pragma unroll
        for (int q = 0; q < 4; q++) { f32x4 v = {o[db][q * 4] * inv, o[db][q * 4 + 1] * inv, o[db][q * 4 + 2] * inv, o[db][q * 4 + 3] * inv}; *(f32x4*)(a2 + 32 * db + 8 * q + 4 * h) = v; }
    }
    __syncthreads();
    if (comp == 0) {
      const float lam = p.lamv[i]; const float lam_init = 0.8f - 0.6f * expf(-0.3f * l);
      float ss = 0;
#pragma unroll
      for (int db = 0; db < 4; db++)
#pragma unroll
        for (int q = 0; q < 4; q++) {
          f32x4 v2 = *(const f32x4*)(a2 + 32 * db + 8 * q + 4 * h);
#pragma unroll
          for (int e = 0; e < 4; e++) { float d = o[db][q * 4 + e] * inv - lam * v2[e]; o[db][q * 4 + e] = d; ss += d * d; }
        }
      ss = wsum32(ss);
      const float rr = (1.f - lam_init) * frsq(ss * (1.f / 128.f) + EPSN);
      const int m = m0w + (lane & 31);
#pragma unroll
      for (int db = 0; db < 4; db++)
#pragma unroll
        for (int q = 0; q < 4; q++) {
          const int dv = 32 * db + 8 * q + 4 * h; const int c = 512 + hh * 128 + dv;
          f32x4 sg = *(const f32x4*)(p.diff_subln + i * 128 + dv);
          h16x4 g = *(const h16x4*)(p.gates16 + (size_t)m * 1024 + c), ov;
#pragma unroll
          for (int e = 0; e < 4; e++) ov[e] = (h16)(o[db][q * 4 + e] * rr * sg[e] * (float)g[e]);
          *(h16x4*)(p.O16 + pidx(M, m, c)) = ov;
        }
    }
    __syncthreads();
  } else {
    int b, head, t0;
    if (smp) { b = j >> 6; head = (j >> 3) & 7; t0 = (j & 7) * 256; it.kr0 = MP + b * TKS; it.nt0 = TKS / 64; }
    else { b = j >> 3; head = j & 7; t0 = 0; it.kr0 = b * SEQ; it.nt0 = SEQ / 64; }
    const int m0w = (smp ? MP + b * DS : b * SEQ) + t0 + w * 32;
    it.k0 = p.KA + (size_t)head * KM * 128; it.k1 = it.k0 + 64; it.kld = 128;
    it.v0 = p.VA + (size_t)(head * 64) * 64; it.v1 = it.v0;
    f32x16 o[2]; float lsum;
    attn_core<96, 2, 1, 2, false>(it, p.QA + ((size_t)m0w * 8 + head) * 96, 768, 0, 0, 1 << 30, nullptr, 0, 0, lds, o, lsum);
    attn_store_gated<2>(p, o, 1.f / lsum, m0w + (lane & 31), head * 64);
  }
}
DEVFN void attn_odd_item(const Params& p, int l, int item, char* lds) {
  const int TIDX = tid_op();
  const int i = l >> 1; const int lane = TIDX & 63, w = TIDX >> 6;
  const int grp = item >> 7, j = item & 127; const bool smp = grp < 2; const bool isgqa = (grp & 1) == 0;
  AttnItem it{}; it.nt1 = 0; it.kr1 = 0; it.kld = 64;
  f32x16 o[2]; float lsum;
  if (isgqa) {
    int b, kvh, t0;
    if (smp) { b = j >> 6; kvh = (j >> 5) & 1; t0 = (j & 31) * 64; it.kr0 = MP + b * TKS; it.nt0 = TKS / 64; }
    else { b = j >> 3; kvh = (j >> 2) & 1; t0 = (j & 3) * 64; it.kr0 = b * SEQ; it.nt0 = SEQ / 64; }
    const int head = kvh * 4 + (w >> 1);
    const int m0w = (smp ? MP + b * DS : b * SEQ) + t0 + (w & 1) * 32;
    it.k0 = p.KB + (size_t)kvh * KM * 64; it.k1 = it.k0; it.v0 = p.VB + (size_t)(kvh * 64) * 64; it.v1 = it.v0;
    attn_core<64, 1, 1, 2, false>(it, p.QB + ((size_t)m0w * 8 + head) * 64, 512, 0, 0, 1 << 30, nullptr, 0, 0, lds, o, lsum);
    attn_store_gated<2>(p, o, 1.f / lsum, m0w + (lane & 31), 512 + head * 64);
  } else if (!smp) {
    const int b = j >> 3, head = j & 7; it.kr0 = b * SEQ; it.nt0 = SEQ / 64;
    const int m0w = b * SEQ + w * 32;
    it.k0 = p.KA + (size_t)head * KM * 64; it.k1 = it.k0; it.v0 = p.VA + (size_t)(head * 64) * 64; it.v1 = it.v0;
    attn_core<64, 1, 1, 2, false>(it, p.QA + ((size_t)m0w * 8 + head) * 64, 512, 0, 0, 1 << 30, nullptr, 0, 0, lds, o, lsum);
    attn_store_gated<2>(p, o, 1.f / lsum, m0w + (lane & 31), head * 64);
  } else {
    const int b = j >> 6, head = (j >> 3) & 7, r0 = (j & 7) * 4;
    const int r = r0 + (w >> 1), c0 = (w & 1) * 32;
    auto rsf = [](int rr) { int s = rr - 4; return s < 0 ? 0 : (s > GROWS - 8 ? GROWS - 8 : s); };
    const int rlo = rsf(r0), rhi = rsf(r0 + 3) + 8;
    const int kbase = MP + b * TKS;
    it.kr0 = kbase + rlo * 64; it.nt0 = rhi - rlo; it.kr1 = kbase + DS; it.nt1 = PAST / 64;
    it.k0 = p.KA + (size_t)head * KM * 64; it.k1 = it.k0; it.v0 = p.VA + (size_t)(head * 64) * 64; it.v1 = it.v0;
    float* rpbl = (float*)(lds + A_RING);
    { const float* src = p.na_rpb + ((size_t)i * 8 + head) * 465; for (int k = TIDX; k < 465; k += 512) rpbl[k] = src[k] * LOG2E; }
    const int m0w = MP + b * DS + r * 64 + c0;
    const int ta = rsf(r) - rlo;
    attn_core<64, 1, 1, 2, true>(it, p.QA + ((size_t)m0w * 8 + head) * 64, 512, 0, ta, ta + 8, rpbl, rlo - r + 7, c0 + (lane & 31), lds, o, lsum);
    attn_store_gated<2>(p, o, 1.f / lsum, m0w + (lane & 31), head * 64);
  }
}
constexpr int G8_HTB = 128 * 64 * 2, G8_STAGE = 8 * G8_HTB;
DEVFN int g8_lds_byte(int r, int c) { const int st = (r >> 4) * 2 + (c >> 5), rr = r & 15, cc = c & 31, ob = rr * 64 + cc * 2; return st * 1024 + (ob ^ (((ob >> 9) & 1) << 5)); }
DEVFN void g8_stage_rc(int b, int& R, int& C) { const int st = b / 1024, sb = b % 1024, swz = sb ^ (((sb >> 9) & 1) << 5); R = (st >> 1) * 16 + swz / 64; C = (st & 1) * 32 + (swz % 64) / 2; }
DEVFN int g8_perm32(int rho) { const int n = rho >> 4, i = rho & 15; return 8 * (i >> 2) + 4 * n + (i & 3); }
struct G8Unit { int pm, pn; };
DEVFN bool g8_next(int i, int nM, int nN, int G, int c, G8Unit& u) {
  const int nwg = nM * nN; const long L = (long)i * G + c; if (L >= nwg) return false;
  int wgid = (int)L; { const int q = nwg / 8, r = nwg % 8, xcd = wgid % 8, off = wgid / 8; wgid = (xcd < r ? xcd * (q + 1) : r * (q + 1) + (xcd - r) * q) + off; }
  const int nig = 8 * nN, gid = wgid / nig, fm = gid * 8, gsz = (nM - fm) < 8 ? (nM - fm) : 8;
  u.pm = fm + ((wgid % nig) % gsz); u.pn = (wgid % nig) / gsz; return true;
}
template <class Epi>
DEVFN void gemm8_phase(LAS unsigned char* lds, const h16* A, int RA, const h16* Bt, int RB, int K, int nM, int nN, const Epi& E) {
  const int tid = tid_op(), wid = __builtin_amdgcn_readfirstlane(tid >> 6), lane = tid & 63, wr = wid >> 2, wc = wid & 3, fr = lane & 15, fq = lane >> 4;
  const int nt = K / 64; const int Gg = gridDim.x, cc = blockIdx.x;
  unsigned voffA[2], voffB[2];
#pragma unroll
  for (int i = 0; i < 2; ++i) { int R, C; g8_stage_rc(tid * 16 + i * 8192, R, C); const int Rb = (R & ~31) + g8_perm32(R & 31);
    voffA[i] = (unsigned)(R * 64 + C) * 2u; voffB[i] = (unsigned)(Rb * 64 + C) * 2u; }
  const size_t kstepA = (size_t)RA * 128, kstepB = (size_t)RB * 128;
  const size_t hstep = (size_t)128 * 128;
  const size_t tstep = 2 * hstep;
  const unsigned ldsw = (unsigned)wid * 1024u;
  const int aoff = g8_lds_byte(wr * 64 + fr, fq * 8), boff = g8_lds_byte(wc * 32 + fr, fq * 8);
#define G8_SA(b, h) (((b) * 2 + (h)) * G8_HTB)
#define G8_SB(b, h) ((4 + (b) * 2 + (h)) * G8_HTB)
#define G8_STAGE_(bufoff, gbase, voff) do { _Pragma("unroll") for (int _i = 0; _i < 2; ++_i) \
    __builtin_amdgcn_global_load_lds((const unsigned*)((const char*)(gbase) + (voff)[_i]), (LAS unsigned*)(lds + (bufoff) + ldsw + _i * 8192), 16, 0, 0); } while (0)
#define G8_LDA(dst, b, h) do { _Pragma("unroll") for (int m = 0; m < 4; ++m) _Pragma("unroll") for (int k = 0; k < 2; ++k) dst[m][k] = *(const LAS h16x8*)(lds + G8_SA(b, h) + aoff + m * 2048 + k * 1024); } while (0)
#define G8_LDB(dst, b, h) do { _Pragma("unroll") for (int n = 0; n < 2; ++n) _Pragma("unroll") for (int k = 0; k < 2; ++k) dst[n][k] = *(const LAS h16x8*)(lds + G8_SB(b, h) + boff + n * 2048 + k * 1024); } while (0)
#define G8_MMA(ai, bj, At, Bt_) do { __builtin_amdgcn_s_setprio(1); _Pragma("unroll") for (int m = 0; m < 4; ++m) _Pragma("unroll") for (int n = 0; n < 2; ++n) _Pragma("unroll") for (int k = 0; k < 2; ++k) \
    acc[ai][bj][m][n] = __builtin_amdgcn_mfma_f32_16x16x32_f16(Bt_[n][k], At[m][k], acc[ai][bj][m][n], 0, 0, 0); __builtin_amdgcn_s_setprio(0); } while (0)
#define G8_WAIT_L(n) asm volatile("s_waitcnt lgkmcnt(" #n ")" ::: "memory")
#define G8_BAR __builtin_amdgcn_s_barrier()
#define G8_SCHED __builtin_amdgcn_sched_barrier(0)
  G8Unit cur, nxt; int ui = 0;
  if (!g8_next(0, nM, nN, Gg, cc, cur)) return;
  f32x4 acc[2][2][4][2];
#pragma unroll
  for (int a = 0; a < 2; ++a)
#pragma unroll
    for (int b = 0; b < 2; ++b)
#pragma unroll
      for (int m = 0; m < 4; ++m)
#pragma unroll
        for (int n = 0; n < 2; ++n) acc[a][b][m][n] = (f32x4){0.f, 0.f, 0.f, 0.f};
  h16x8 At[4][2], B0[2][2], B1[2][2];
  const char* cA = (const char*)A + (size_t)cur.pm * tstep; const char* cB = (const char*)Bt + (size_t)cur.pn * tstep;
  G8_STAGE_(G8_SB(0, 0), cB, voffB); G8_STAGE_(G8_SA(0, 0), cA, voffA); G8_STAGE_(G8_SB(0, 1), cB + hstep, voffB); G8_STAGE_(G8_SA(0, 1), cA + hstep, voffA);
  if (wr == 1) G8_BAR;
  WAITV(4); G8_BAR;
  G8_STAGE_(G8_SB(1, 0), cB + kstepB, voffB); G8_STAGE_(G8_SA(1, 0), cA + kstepA, voffA); G8_STAGE_(G8_SB(1, 1), cB + hstep + kstepB, voffB);
  WAITV(6); G8_BAR;
  for (;;) {
    const bool has_next = g8_next(ui + 1, nM, nN, Gg, cc, nxt);
    const char* nA = has_next ? (const char*)A + (size_t)nxt.pm * tstep : cA; const char* nB = has_next ? (const char*)Bt + (size_t)nxt.pn * tstep : cB;
    for (int t = 0; t < nt; t += 2) {
      const bool last = (t == nt - 2);
      const char* a1 = cA + (size_t)(t + 1) * kstepA;
      const char* a2 = last ? nA : cA + (size_t)(t + 2) * kstepA; const char* b2 = last ? nB : cB + (size_t)(t + 2) * kstepB;
      const char* a3 = a2 + kstepA; const char* b3 = b2 + kstepB;
      G8_LDB(B0, 0, 0); G8_SCHED; G8_LDA(At, 0, 0); G8_STAGE_(G8_SA(1, 1), a1 + hstep, voffA);
      G8_WAIT_L(8); G8_BAR; G8_WAIT_L(0); G8_MMA(0, 0, At, B0); G8_BAR; G8_SCHED;
      G8_LDB(B1, 0, 1); G8_STAGE_(G8_SB(0, 0), b2, voffB);
      G8_BAR; G8_WAIT_L(0); G8_MMA(0, 1, At, B1); G8_BAR;
      G8_LDA(At, 0, 1); G8_STAGE_(G8_SA(0, 0), a2, voffA);
      G8_BAR; G8_WAIT_L(0); G8_MMA(1, 0, At, B0); G8_BAR; G8_SCHED;
      G8_STAGE_(G8_SB(0, 1), b2 + hstep, voffB);
      WAITV(6); G8_BAR; G8_MMA(1, 1, At, B1); G8_BAR;
      G8_LDB(B0, 1, 0); G8_SCHED; G8_LDA(At, 1, 0); G8_STAGE_(G8_SA(0, 1), a2 + hstep, voffA);
      G8_WAIT_L(8); G8_BAR; G8_WAIT_L(0); G8_MMA(0, 0, At, B0); G8_BAR; G8_SCHED;
      G8_LDB(B1, 1, 1); G8_STAGE_(G8_SB(1, 0), b3, voffB);
      G8_BAR; G8_WAIT_L(0); G8_MMA(0, 1, At, B1); G8_BAR;
      G8_LDA(At, 1, 1); G8_STAGE_(G8_SA(1, 0), a3, voffA);
      G8_BAR; G8_WAIT_L(0); G8_MMA(1, 0, At, B0); G8_BAR; G8_SCHED;
      G8_STAGE_(G8_SB(1, 1), b3 + hstep, voffB);
      WAITV(6); G8_BAR; G8_MMA(1, 1, At, B1); G8_BAR;
    }
#pragma unroll 1
    for (int e_ = 0; e_ < REP_EPI; e_++)
    E(acc, cur, wr, wc, fr, fq, e_ > 0);
    if (!has_next) break;
#pragma unroll
    for (int a = 0; a < 2; ++a)
#pragma unroll
      for (int b = 0; b < 2; ++b)
#pragma unroll
        for (int m = 0; m < 4; ++m)
#pragma unroll
          for (int n = 0; n < 2; ++n) acc[a][b][m][n] = (f32x4){0.f, 0.f, 0.f, 0.f};
    cur = nxt; cA = nA; cB = nB; ++ui;
  }
  WAITV(0);
  if (wr == 0) G8_BAR;
  G8_BAR;
#undef G8_SA
#undef G8_SB
#undef G8_STAGE_
#undef G8_LDA
#undef G8_LDB
#undef G8_MMA
#undef G8_WAIT_L
#undef G8_BAR
#undef G8_SCHED
}

DEVFN float fq_sum(float v) {
  auto a = __builtin_amdgcn_permlane16_swap(__float_as_uint(v), __float_as_uint(v), false, false); v = __uint_as_float(a[0]) + __uint_as_float(a[1]);
  auto b = __builtin_amdgcn_permlane32_swap(__float_as_uint(v), __float_as_uint(v), false, false); return __uint_as_float(b[0]) + __uint_as_float(b[1]);
}
struct InprojEpi {
  const Params& p; int l; bool dry; LAS unsigned char* scratch;
  DEVFN void operator()(const f32x4 (&acc)[2][2][4][2], const G8Unit& u_, int wr, int wc, int fr_, int fq_, bool dry2) const {
    int fr = fr_, fq = fq_; G8Unit u = u_;
    asm volatile("" : "+v"(fr), "+v"(fq), "+s"(u.pm), "+s"(u.pn));
    const int lane = fr + 16 * fq;
    const int i = l >> 1; const bool odd = l & 1;
    const int G = 4 * u.pn + wc;
    LAS unsigned char* tbase = scratch + (wr * 4 + wc) * 3072;
    const int m0 = u.pm * 256; const bool smp = m0 >= MP;
    enum { T_PAD, T_GATE, T_QHEAD, T_KHEAD, T_VT, T_QA, T_CKV, T_KPE };
    int ty = T_PAD, gcol = 0, head = 0, spitch = 0, scol = 0; bool rope = false; float oscale = 1.f;
    const float* gain = nullptr; float* state = nullptr; h16* qdst = nullptr; h16* kbuf = nullptr; h16* vbuf = nullptr;
    const float QS = LOG2E / 8.f;
    if (!odd) {
      if (G < 4) ty = T_QA;
      else if (G < 6) ty = T_CKV;
      else if (G == 6) { ty = T_KPE; gain = p.mla_kn_rope + i * 32; }
      else if (G == 7) ty = T_PAD;
      else if (G < 16) { ty = T_GATE; gcol = (G - 8) * 64; }
      else if (G < 24) { ty = T_QHEAD; head = G - 16; gain = p.diff_qn + i * 64; rope = true; oscale = QS; qdst = p.QB; }
      else if (G < 32) { ty = T_KHEAD; head = G - 24; gain = p.diff_kn + i * 64; rope = true; state = p.o_dk; spitch = 512; scol = head * 64; kbuf = p.KB; }
      else if (G < 40) { ty = T_VT; head = G - 32; state = p.o_dv; spitch = 512; scol = head * 64; vbuf = p.VB; }
      else { ty = T_GATE; gcol = 512 + (G - 40) * 64; }
    } else {
      if (G < 8) { ty = T_QHEAD; head = G; gain = p.na_qn + i * 64; oscale = QS; qdst = p.QA; }
      else if (G < 16) { ty = T_KHEAD; head = G - 8; gain = p.na_kn + i * 64; state = p.o_nk; spitch = 512; scol = head * 64; kbuf = p.KA; }
      else if (G < 24) { ty = T_VT; head = G - 16; state = p.o_nv; spitch = 512; scol = head * 64; vbuf = p.VA; }
      else if (G < 32) { ty = T_GATE; gcol = (G - 24) * 64; }
      else if (G < 40) { ty = T_QHEAD; head = G - 32; gain = p.gqa_qn + i * 64; rope = true; oscale = QS; qdst = p.QB; }
      else if (G < 42) { ty = T_KHEAD; head = G - 40; gain = p.gqa_kn + i * 64; rope = true; state = p.o_gk; spitch = 128; scol = head * 64; kbuf = p.KB; }
      else if (G < 44) { ty = T_VT; head = G - 42; state = p.o_gv; spitch = 128; scol = head * 64; vbuf = p.VB; }
      else { ty = T_GATE; gcol = 512 + (G - 44) * 64; }
    }
    if (ty == T_PAD) return;
    LAS float* cst = (LAS float*)(tbase + 2048);
    {
      const float* rowss = p.rowss_l + (size_t)l * M + m0 + 64 * wr;
      const float s0 = rowss[lane], s1 = rowss[128 + lane];
      const float bv = p.biasv[((size_t)l * NCV + tok_cv(m0)) * NPO + 256 * u.pn + 32 * wc + 128 * (lane >> 5) + (lane & 31)];
      const bool hasg = gain != nullptr && (ty != T_KPE || lane < 32);
      const float gv = hasg ? gain[lane] : 1.f;
      cst[lane] = frsq(s0 * (1.f / D) + EPSN); cst[64 + lane] = frsq(s1 * (1.f / D) + EPSN);
      cst[128 + lane] = bv; cst[192 + lane] = gv;
    }
    const bool roped = rope && smp;
    float invf[2][4];
    if (roped || (ty == T_KPE && smp)) {
      const float step = ty == T_KPE ? (2.f / 16.f) : (2.f / 32.f);
#pragma unroll
      for (int n = 0; n < 2; n++)
#pragma unroll
        for (int j = 0; j < 4; j++) {
          const int jj = ty == T_KPE ? (8 * (fq & 1) + 4 * n + j) & 7 : (8 * fq + 4 * n + j) & 15;
          invf[n][j] = __builtin_amdgcn_exp2f(-13.287712379549449f * step * (float)jj) * 0.15915494309189535f;
        }
    }
#pragma unroll
    for (int ai = 0; ai < 2; ai++)
#pragma unroll
      for (int m = 0; m < 4; m++) {
        const int r = m0 + 128 * ai + 64 * wr + 16 * m + fr;
        const float rs = cst[ai * 64 + m * 16 + fr];
        float v[2][2][4];
#pragma unroll
        for (int bj = 0; bj < 2; bj++)
#pragma unroll
          for (int n = 0; n < 2; n++) {
            const f32x4 b = *(const LAS f32x4*)(cst + 128 + 32 * bj + 8 * fq + 4 * n);
#pragma unroll
            for (int j = 0; j < 4; j++) v[bj][n][j] = acc[ai][bj][m][n][j] * rs + b[j];
          }
        float c2[2][4], s2[2][4];
        if (roped) {
          const int t = tok_pos(r); const float base = (float)(fq < 2 ? (t >> 6) : (t & 63));
#pragma unroll
          for (int n = 0; n < 2; n++)
#pragma unroll
            for (int j = 0; j < 4; j++) { const float x = base * invf[n][j]; c2[n][j] = __builtin_amdgcn_cosf(x); s2[n][j] = __builtin_amdgcn_sinf(x); }
        }
        if (ty == T_GATE) {
#pragma unroll
          for (int bj = 0; bj < 2; bj++) {
            h16x8 o;
#pragma unroll
            for (int n = 0; n < 2; n++)
#pragma unroll
              for (int j = 0; j < 4; j++) o[n * 4 + j] = (h16)fsilu(v[bj][n][j]);
            *(h16x8*)(p.gates16 + (size_t)r * 1024 + gcol + 32 * bj + 8 * fq) = o;
          }
        } else if (ty == T_QHEAD || ty == T_KHEAD) {
          float ss = 0;
#pragma unroll
          for (int bj = 0; bj < 2; bj++)
#pragma unroll
            for (int n = 0; n < 2; n++)
#pragma unroll
              for (int j = 0; j < 4; j++) ss += v[bj][n][j] * v[bj][n][j];
          ss = fq_sum(ss);
          const float rr = frsq(ss * (1.f / 64.f) + EPSN);
#pragma unroll
          for (int bj = 0; bj < 2; bj++)
#pragma unroll
            for (int n = 0; n < 2; n++) {
              const f32x4 g = *(const LAS f32x4*)(cst + 192 + 32 * bj + 8 * fq + 4 * n);
#pragma unroll
              for (int j = 0; j < 4; j++) v[bj][n][j] *= rr * g[j];
            }
          if (state && !smp) {
            float* sp = state + st_row(r, i) * spitch + scol + 8 * fq;
#pragma unroll
            for (int bj = 0; bj < 2; bj++)
#pragma unroll
              for (int n = 0; n < 2; n++) { f32x4 o = {v[bj][n][0], v[bj][n][1], v[bj][n][2], v[bj][n][3]}; *(f32x4*)(sp + 32 * bj + 4 * n) = o; }
          }
          if (roped) {
#pragma unroll
            for (int n = 0; n < 2; n++)
#pragma unroll
              for (int j = 0; j < 4; j++) { const float x1 = v[0][n][j], x2 = v[1][n][j]; v[0][n][j] = x1 * c2[n][j] - x2 * s2[n][j]; v[1][n][j] = x2 * c2[n][j] + x1 * s2[n][j]; }
          }
          h16* dst = ty == T_QHEAD ? qdst + ((size_t)r * 8 + head) * 64 : kbuf + ((size_t)head * KM + tok_keyrow(r)) * 64;
#pragma unroll
          for (int bj = 0; bj < 2; bj++) {
            h16x8 o;
#pragma unroll
            for (int n = 0; n < 2; n++)
#pragma unroll
              for (int j = 0; j < 4; j++) o[n * 4 + j] = (h16)(v[bj][n][j] * oscale);
            *(h16x8*)(dst + 32 * bj + 8 * fq) = o;
          }
        } else if (ty == T_VT) {
          const int kr = tok_keyrow(r);
          if (!smp) {
            float* sp = state + st_row(r, i) * spitch + scol + 8 * fq;
#pragma unroll
            for (int bj = 0; bj < 2; bj++)
#pragma unroll
              for (int n = 0; n < 2; n++) { f32x4 o = {v[bj][n][0], v[bj][n][1], v[bj][n][2], v[bj][n][3]}; *(f32x4*)(sp + 32 * bj + 4 * n) = o; }
          }
          {
            LAS h16* tb = (LAS h16*)(tbase);
#pragma unroll
            for (int bj = 0; bj < 2; bj++)
#pragma unroll
              for (int n = 0; n < 2; n++)
#pragma unroll
                for (int j = 0; j < 4; j++) tb[(32 * bj + 8 * fq + 4 * n + j) * 16 + fr] = (h16)v[bj][n][j];
            const h16x8 lo = *(const LAS h16x8*)(tb + lane * 16), hi = *(const LAS h16x8*)(tb + lane * 16 + 8);
            h16* dstv = vbuf + vidx(head * 64 + lane, kr - fr);
            *(h16x8*)dstv = lo; *(h16x8*)(dstv + 8) = hi;
          }
        } else if (ty == T_QA) {
          float ss = 0;
#pragma unroll
          for (int bj = 0; bj < 2; bj++) {
            h16x8 o;
#pragma unroll
            for (int n = 0; n < 2; n++)
#pragma unroll
              for (int j = 0; j < 4; j++) { o[n * 4 + j] = (h16)v[bj][n][j]; const float xr = (float)o[n * 4 + j]; ss += xr * xr; }
            *(h16x8*)(p.qa16 + pidx(M, r, 64 * G + 32 * bj + 8 * fq)) = o;
          }
          ss = fq_sum(ss);
          if (fq == 0 && !dry && !dry2) atomicAdd(p.rowss_qa + (size_t)i * M + r, ss);
        } else if (ty == T_CKV) {
          const int kr = tok_keyrow(r);
          float ss = 0;
#pragma unroll
          for (int bj = 0; bj < 2; bj++) {
            h16x8 o;
#pragma unroll
            for (int n = 0; n < 2; n++)
#pragma unroll
              for (int j = 0; j < 4; j++) { o[n * 4 + j] = (h16)v[bj][n][j]; const float xr = (float)o[n * 4 + j]; ss += xr * xr; }
            *(h16x8*)(p.ckv16 + pidx(KM, kr, 64 * (G - 4) + 32 * bj + 8 * fq)) = o;
          }
          ss = fq_sum(ss);
          if (fq == 0 && !dry && !dry2) atomicAdd(p.rowss_ckv + (size_t)i * KM + kr, ss);
        } else {
          float ss = 0;
#pragma unroll
          for (int n = 0; n < 2; n++)
#pragma unroll
            for (int j = 0; j < 4; j++) ss += v[0][n][j] * v[0][n][j];
          ss = fq_sum(ss);
          const float rr = frsq(ss * (1.f / 32.f) + EPSN);
          float w[2][4];
#pragma unroll
          for (int n = 0; n < 2; n++) {
            const f32x4 g = *(const LAS f32x4*)(cst + 192 + 8 * fq + 4 * n);
#pragma unroll
            for (int j = 0; j < 4; j++) w[n][j] = v[0][n][j] * rr * g[j];
          }
          if (!smp) {
            float* sp = p.o_kpe + st_row(r, i) * 32 + 8 * fq;
#pragma unroll
            for (int n = 0; n < 2; n++) { f32x4 o = {w[n][0], w[n][1], w[n][2], w[n][3]}; *(f32x4*)(sp + 4 * n) = o; }
          } else {
            const int t = tok_pos(r); const float base = (float)((fq & 1) == 0 ? (t >> 6) : (t & 63));
#pragma unroll
            for (int n = 0; n < 2; n++)
#pragma unroll
              for (int j = 0; j < 4; j++) {
                const float x = base * invf[n][j]; const float c = __builtin_amdgcn_cosf(x), s = __builtin_amdgcn_sinf(x);
                const float own = w[n][j], oth = __shfl_xor(own, 32);
                w[n][j] = fq < 2 ? own * c - oth * s : own * c + oth * s;
              }
          }
          h16x8 o;
#pragma unroll
          for (int n = 0; n < 2; n++)
#pragma unroll
            for (int j = 0; j < 4; j++) o[n * 4 + j] = (h16)w[n][j];
          *(h16x8*)(p.kpe16 + (size_t)tok_keyrow(r) * 32 + 8 * fq) = o;
        }
      }
  }
};
struct NullEpi {
  DEVFN void operator()(const f32x4 (&acc)[2][2][4][2], const G8Unit&, int, int, int, int, bool) const {
#pragma unroll
    for (int a = 0; a < 2; a++)
#pragma unroll
      for (int b = 0; b < 2; b++)
#pragma unroll
        for (int m = 0; m < 4; m++) asm volatile("" :: "v"(acc[a][b][m][0]), "v"(acc[a][b][m][1]));
  }
};
DEVFN int inproj_pos_col(int np) { const int pn = np >> 8, bj = (np >> 7) & 1, wc = (np >> 5) & 3, g = np & 31; return 64 * (4 * pn + wc) + 32 * bj + g; }

#define XB_TMO      128
#define XB_XCNT(j)  (256  + 64 * (j))
#define XB_XSUB(j)  (1280 + 64 * (j))
#define XB_XGEN(j)  (2304 + 64 * (j))
#define XB_TOP      3328
#define XB_TOPGEN   3392
#define XCD_BAR_WORDS 3456
#define XB_SPIN_CAP (1u << 20)
DEVFN unsigned xb_ld(unsigned* p) { return __hip_atomic_load(p, __ATOMIC_RELAXED, __HIP_MEMORY_SCOPE_AGENT); }
DEVFN unsigned xb_add(unsigned* p, unsigned v) { return __hip_atomic_fetch_add(p, v, __ATOMIC_RELAXED, __HIP_MEMORY_SCOPE_AGENT); }
DEVFN unsigned xb_xcc_id() { return (unsigned)__builtin_amdgcn_s_getreg((3 << 11) | 20) & 0xFu; }
#define XB_SPIN(cond, bar) do { unsigned _sp = 0; while (cond) { __builtin_amdgcn_s_sleep(1); \
    if ((++_sp & 255u) == 0u) { if (xb_ld(&(bar)[XB_TMO])) break; if (_sp > XB_SPIN_CAP) { atomicAdd(&(bar)[XB_TMO], 1u); break; } } } } while (0)
struct XcdBarrier { unsigned* bar; unsigned x; volatile LAS unsigned* st; };
DEVFN XcdBarrier xcd_barrier_post(unsigned* bar, volatile LAS unsigned* st) {
  const int TIDX = tid_op();
  XcdBarrier b; b.bar = bar; b.x = xb_xcc_id(); b.st = st;
  if (TIDX == 0) (void)xb_add(&bar[XB_XCNT(b.x)], 1u);
  return b;
}
DEVFN void xcd_barrier_complete(unsigned* bar, unsigned x, unsigned& nloc, unsigned& nx) {
  const unsigned G = gridDim.x * gridDim.y * gridDim.z;
  unsigned sum, cnt, mine, sp = 0u;
  for (;;) {
    sum = 0u; cnt = 0u; mine = 0u;
#pragma unroll
    for (unsigned j = 0; j < 16; ++j) { const unsigned c = xb_ld(&bar[XB_XCNT(j)]); sum += c; cnt += (c > 0u) ? 1u : 0u; mine = (j == x) ? c : mine; }
    if (sum == G) break;
    __builtin_amdgcn_s_sleep(1);
    if ((++sp & 255u) == 0u) { if (xb_ld(&bar[XB_TMO])) break; if (sp > XB_SPIN_CAP) { atomicAdd(&bar[XB_TMO], 1u); break; } }
  }
  nloc = mine > 0u ? mine : 1u; nx = cnt > 0u ? cnt : 1u;
}
DEVFN void xcd_barrier(const XcdBarrier& b) {
  const int TIDX = tid_op();
  asm volatile("s_waitcnt vmcnt(0)" ::: "memory");
  __syncthreads();
  if (TIDX == 0) {
    unsigned* bar = b.bar;
    __builtin_amdgcn_s_waitcnt(0);
    unsigned nloc = b.st[0], nx = b.st[1];
    if (nloc == 0u) { xcd_barrier_complete(bar, b.x, nloc, nx); b.st[0] = nloc; b.st[1] = nx; }
    const unsigned old = xb_add(&bar[XB_XSUB(b.x)], 1u);
    const unsigned gen = old / nloc;
    if (old + 1u == (gen + 1u) * nloc) {
      __builtin_amdgcn_fence(__ATOMIC_RELEASE, "agent");
      asm volatile("s_waitcnt vmcnt(0)" ::: "memory");
      const unsigned og = xb_add(&bar[XB_TOP], 1u);
      const unsigned tg = og / nx;
      if (og + 1u == (tg + 1u) * nx) xb_add(&bar[XB_TOPGEN], 1u);
      else XB_SPIN(xb_ld(&bar[XB_TOPGEN]) == tg, bar);
      __builtin_amdgcn_fence(__ATOMIC_ACQUIRE, "agent");
      xb_add(&bar[XB_XGEN(b.x)], 1u);
      asm volatile("s_waitcnt vmcnt(0)" ::: "memory");
    } else {
      XB_SPIN(xb_ld(&bar[XB_XGEN(b.x)]) == gen, bar);
      __builtin_amdgcn_fence(__ATOMIC_ACQUIRE, "agent");
      asm volatile("s_waitcnt vmcnt(0)" ::: "memory");
    }
  }
  __syncthreads();
}

DEVFN void cache_items(const Params& p, int l, int gtid, int gthreads) {
  const int i = l >> 1;
  if ((l & 1) == 0) {
    const int per = 128 + 32 + 512 + 512;
    for (int e = gtid; e < DB * PAST * per; e += gthreads) {
      const int u = e % per; const int bp = e / per; const int pos = bp % PAST, b = bp / PAST;
      const int kr = MP + b * TKS + DS + pos; const size_t crow = ((size_t)(b * 2 + i) * PAST + pos);
      if (u < 128) { p.ckv16[pidx(KM, kr, u)] = (h16)(p.cache_mla_ckv[crow * 128 + u] / p.mla_kva_norm[i * 128 + u]); if (u == 0) p.rowss_ckv[(size_t)i * KM + kr] = 128.f * (1.f - EPSN); }
      else if (u < 160) p.kpe16[(size_t)kr * 32 + (u - 128)] = (h16)p.cache_mla_kpe[crow * 32 + (u - 128)];
      else if (u < 672) { const int c = u - 160; p.KB[((size_t)(c >> 6) * KM + kr) * 64 + (c & 63)] = (h16)p.cache_diff_k[crow * 512 + c]; }
      else { const int c = u - 672; p.VB[vidx(c, kr)] = (h16)p.cache_diff_v[crow * 512 + c]; }
    }
  } else {
    const int per = 512 + 512 + 128 + 128;
    for (int e = gtid; e < DB * PAST * per; e += gthreads) {
      const int u = e % per; const int bp = e / per; const int pos = bp % PAST, b = bp / PAST;
      const int kr = MP + b * TKS + DS + pos; const size_t crow = ((size_t)(b * 2 + i) * PAST + pos);
      if (u < 512) p.KA[((size_t)(u >> 6) * KM + kr) * 64 + (u & 63)] = (h16)p.cache_na_k[crow * 512 + u];
      else if (u < 1024) { const int c = u - 512; p.VA[vidx(c, kr)] = (h16)p.cache_na_v[crow * 512 + c]; }
      else if (u < 1152) { const int c = u - 1024; p.KB[((size_t)(c >> 6) * KM + kr) * 64 + (c & 63)] = (h16)p.cache_gqa_k[crow * 128 + c]; }
      else { const int c = u - 1152; p.VB[vidx(c, kr)] = (h16)p.cache_gqa_v[crow * 128 + c]; }
    }
  }
}

DEVFN void mod_item(const Params& p, int item, char* lds, bool dry = false) {
  const int tid = tid_op();
  const int l = item / 96, rem = item % 96, nchunk = rem / 16, kc = rem % 16;
  float* sil = (float*)lds;
  if (tid < NCV * 64) { const int cv = tid >> 6, k = tid & 63; const float* cvec = cv == 0 ? p.c_ctx : p.c + (size_t)(cv - 1) * D; sil[tid] = siluf(cvec[kc * 64 + k]); }
  __syncthreads();
  const int col = nchunk * 512 + tid;
  const float* w = p.w_mod + ((size_t)l * D + kc * 64) * 3072 + col;
  float acc[NCV];
#pragma unroll
  for (int c = 0; c < NCV; c++) acc[c] = 0.f;
#pragma unroll 16
  for (int k = 0; k < 64; k++) {
    const float wv = w[(size_t)k * 3072];
#pragma unroll
    for (int c = 0; c < NCV; c++) acc[c] += sil[c * 64 + k] * wv;
  }
  const float b = kc == 0 ? p.b_mod[l * 3072 + col] : 0.f;
#pragma unroll
  for (int c = 0; c < NCV; c++) if (!dry) atomicAdd(p.modv + ((size_t)l * NCV + c) * 3072 + col, acc[c] + b);
  __syncthreads();
}
DEVFN void conv_tile(const float* src, h16* dst, int R, int Nsrc, int mode, const float* kscale, bool has_scale, int nb, int kb, char* lds) {
  const int tid = tid_op();
  float (*t)[65] = (float (*)[65])lds;
  {
    const int j = tid & 63; const int np = nb + j; int col;
    if (mode == 0) col = np; else if (mode == 1) col = even_col(np); else if (mode == 4) col = even_col(inproj_pos_col(np)); else if (mode == 5) col = inproj_pos_col(np); else if (mode == 3) { int hh = (np & 511) >> 6; col = hh * 128 + (np >> 9) * 64 + (np & 63); } else { int h = np >> 7, jj = np & 127; col = jj < 96 ? h * 96 + jj : -1; }
    const int colc = col < 0 ? 0 : col; const float msk = col < 0 ? 0.f : 1.f;
    float v[8];
#pragma unroll
    for (int i = 0; i < 8; i++) v[i] = src[(size_t)(kb + (tid >> 6) + 8 * i) * Nsrc + colc];
    if (has_scale) {
#pragma unroll
      for (int i = 0; i < 8; i++) v[i] *= kscale[kb + (tid >> 6) + 8 * i];
    }
#pragma unroll
    for (int i = 0; i < 8; i++) t[(tid >> 6) + 8 * i][j] = v[i] * msk;
  }
  __syncthreads();
  {
    const int kk = tid & 63;
#pragma unroll
    for (int i = 0; i < 8; i++) { const int j = (tid >> 6) + 8 * i; dst[pidx(R, nb + j, kb + kk)] = (h16)t[kk][j]; }
  }
  __syncthreads();
}
constexpr int CV_WIN_E = (NPE / 64) * 16, CV_WIN_O = (NPO / 64) * 16, CV_WOUT = 256, CV_WQB = 64, CV_WKVB = 32;
constexpr int CV_PER_PAIR = CV_WIN_E + CV_WIN_O + 2 * CV_WOUT + CV_WQB + CV_WKVB;
constexpr int CV_TOTAL = 2 * CV_PER_PAIR;
DEVFN void conv_item(const Params& p, int item, char* lds) {
  const int i = item / CV_PER_PAIR; int r = item % CV_PER_PAIR;
  if (r < CV_WIN_E) { conv_tile(p.w_in_even + (size_t)i * D * EVEN_IN, p.win16 + (size_t)(2 * i) * NPO * D, NPO, EVEN_IN, 4, nullptr, false, (r % (NPE / 64)) * 64, (r / (NPE / 64)) * 64, lds); return; }
  r -= CV_WIN_E;
  if (r < CV_WIN_O) { conv_tile(p.w_in_odd + (size_t)i * D * ODD_IN, p.win16 + (size_t)(2 * i + 1) * NPO * D, NPO, ODD_IN, 5, nullptr, false, (r % (NPO / 64)) * 64, (r / (NPO / 64)) * 64, lds); return; }
  r -= CV_WIN_O;
  if (r < CV_WOUT) { conv_tile(p.w_out_even + (size_t)i * D * D, p.wout16 + (size_t)(2 * i) * D * D, 1024, D, 0, nullptr, false, (r % 16) * 64, (r / 16) * 64, lds); return; }
  r -= CV_WOUT;
  if (r < CV_WOUT) { conv_tile(p.w_out_odd + (size_t)i * D * D, p.wout16 + (size_t)(2 * i + 1) * D * D, 1024, D, 0, nullptr, false, (r % 16) * 64, (r / 16) * 64, lds); return; }
  r -= CV_WOUT;
  if (r < CV_WQB) { conv_tile(p.mla_wqb + (size_t)i * 256 * 768, p.wqb16 + (size_t)i * 1024 * 256, 1024, 768, 2, p.mla_qa_norm + i * 256, true, (r % 16) * 64, (r / 16) * 64, lds); return; }
  r -= CV_WQB;
  conv_tile(p.mla_wkvb + (size_t)i * 128 * 1024, p.wkvb16 + (size_t)i * 1024 * 128, 1024, 1024, 3, p.mla_kva_norm + i * 128, true, (r % 16) * 64, (r / 16) * 64, lds);
}
DEVFN void tab_items(const Params& p, int gtid, int gthreads) {
  for (int g = gtid; g < DS * 48; g += gthreads) {
    if (g < 2) {
      const int i = g, l = 2 * i; float s1 = 0, s2 = 0;
      for (int k = 0; k < 64; k++) { s1 += p.diff_lq1[i * 64 + k] * p.diff_lk1[i * 64 + k]; s2 += p.diff_lq2[i * 64 + k] * p.diff_lk2[i * 64 + k]; }
      p.lamv[i] = expf(s1) - expf(s2) + (0.8f - 0.6f * expf(-0.3f * l));
    }
    const int t = g / 48, j = g % 48;
    const float row = (float)(t / GW), col = (float)(t % GW);
    if (j < 32) { const int f = j & 15; const float inv = powf(10000.f, -(float)(2 * f) / 32.f); const float ang = (j < 16 ? row : col) * inv; p.ropeC64[t * 32 + j] = cosf(ang); p.ropeS64[t * 32 + j] = sinf(ang); }
    else { const int jj = j - 32; const int f = jj & 7; const float inv = powf(10000.f, -(float)(2 * f) / 16.f); const float ang = (jj < 8 ? row : col) * inv; p.ropeC32[t * 16 + jj] = cosf(ang); p.ropeS32[t * 16 + jj] = sinf(ang); }
  }
}
DEVFN void bias_row(const Params& p, int l, int np, int lane) {
  const h16* w = p.win16 + (size_t)l * NPO * D;
  float a[NCV];
#pragma unroll
  for (int c = 0; c < NCV; c++) a[c] = 0;
#pragma unroll
  for (int i = 0; i < 2; i++) {
    const int k = (i * 64 + lane) * 8; h16x8 wv = *(const h16x8*)(w + pidx(NPO, np, k));
#pragma unroll
    for (int c = 0; c < NCV; c++) { const float* sh = p.modv + ((size_t)l * NCV + c) * 3072 + k;
#pragma unroll
      for (int e = 0; e < 8; e++) a[c] += sh[e] * (float)wv[e]; }
  }
#pragma unroll
  for (int c = 0; c < NCV; c++) { float v = a[c]; for (int o = 32; o; o >>= 1) v += __shfl_xor(v, o); if (lane == 0) p.biasv[((size_t)l * NCV + c) * NPO + np] = v; }
}
DEVFN void prepx_row(const Params& p, int l, int m, int lane) {
  const float* x = xrow(p, l, m); const float* md = p.modv + ((size_t)l * NCV + tok_cv(m)) * 3072 + 1024; const float* nw = p.norm_w + l * D;
  float ss = 0;
#pragma unroll
  for (int i = 0; i < 4; i++) {
    const int k = (i * 64 + lane) * 4;
    f32x4 v = *(const f32x4*)(x + k); f32x4 s = *(const f32x4*)(md + k); f32x4 w = *(const f32x4*)(nw + k);
    h16x4 o;
#pragma unroll
    for (int e = 0; e < 4; e++) { ss += v[e] * v[e]; o[e] = (h16)(v[e] * w[e] * (1.f + s[e])); }
    *(h16x4*)(p.xs16 + pidx(M, m, k)) = o;
  }
  for (int o = 32; o; o >>= 1) ss += __shfl_xor(ss, o);
  if (lane == 0) p.rowss_l[(size_t)l * M + m] = ss;
}
#define AS4 __attribute__((address_space(4)))
#define PHASE_PARAMS(q) const Params& q = p_unused;
__global__ void __launch_bounds__(512) mega_kernel(Params p_unused) {
  __shared__ __attribute__((aligned(16))) char lds[G_LDS2 + 16];
  if (threadIdx.x == 0) { volatile LAS unsigned* st = (volatile LAS unsigned*)(lds + G_LDS2); st[0] = 0u; st[1] = 0u; st[2] = 0u; st[3] = 0u; }
  __syncthreads();
  XcdBarrier bar;
  { PHASE_PARAMS(p); bar = xcd_barrier_post(p.bar, (volatile LAS unsigned*)(lds + G_LDS2)); }
  const int nb = gridDim.x, bid = blockIdx.x;
  LAS unsigned char* ldsa = (LAS unsigned char*)lds;
  { PHASE_PARAMS(p);
    for (int rep = 0; rep < REP_0A; rep++)
    for (int it = bid; it < 384 + CV_PER_PAIR; it += nb) { if (it < 384) mod_item(p, it, lds, rep > 0); else conv_item(p, it - 384, lds); }
    tab_items(p, bid * 512 + tid_op(), nb * 512); }
  xcd_barrier(bar);
  { PHASE_PARAMS(p);
    const int tid = tid_op(); const int lane = tid & 63, gw = bid * 8 + (tid >> 6), nw = nb * 8;
    for (int rep = 0; rep < REP_0B; rep++)
    for (int r = gw; r < (NPE + NPO) + M; r += nw) {
      if (r < NPE + NPO) bias_row(p, r < NPE ? 0 : 1, r < NPE ? r : r - NPE, lane);
      else prepx_row(p, 0, r - (NPE + NPO), lane);
    } }
  xcd_barrier(bar);
#pragma unroll 1
  for (int l = 0; l < 4; l++) {
    { PHASE_PARAMS(p);
#pragma unroll 1
      for (int rep = 1; rep < REP_GK; rep++) { NullEpi ne; gemm8_phase(ldsa, p.xs16, M, p.win16 + (size_t)l * NPO * D, NPO, D, M / 256, ((l & 1) ? NPO : NPE) / 256, ne); }
#pragma unroll 1
      for (int rep = 0; rep < REP_A; rep++) {
        InprojEpi epi{p, l, rep > 0, ldsa + G8_STAGE};
        gemm8_phase(ldsa, p.xs16, M, p.win16 + (size_t)l * NPO * D, NPO, D, M / 256, ((l & 1) ? NPO : NPE) / 256, epi);
      }
      for (int rep = 0; rep < REP_0B; rep++) cache_items(p, l, bid * 512 + tid_op(), nb * 512);
      if (l < 2) {
        const int nun = (M / 256) * (((l & 1) ? NPO : NPE) / 256); const int fi = nun - nb;
        const bool part = fi > 0 && fi < nb;
        const int start = part ? bid - fi : bid, stride = part ? nb - fi : nb;
        if (start >= 0) {
          if (l == 0) {
#pragma unroll 1
            for (int it = CV_PER_PAIR + start; it < CV_TOTAL; it += stride) conv_item(p, it, lds);
          } else {
            const int tid = tid_op(); const int lane = tid & 63;
#pragma unroll 1
            for (int r = start * 8 + (tid >> 6); r < NPE + NPO; r += stride * 8) bias_row(p, r < NPE ? 2 : 3, r < NPE ? r : r - NPE, lane);
          }
        }
      }
    }
    xcd_barrier(bar);
    if ((l & 1) == 0) {
      PHASE_PARAMS(p);
      const int nq = (M / 256) * 8, nkv = (KM / 256) * 8;
      for (int rep = 0; rep < REP_A2; rep++)
      for (int t = bid; t < nq + nkv; t += nb) { if (t < nq) qgemm_tile(p, l, t % 32, t / 32, lds); else { const int u = t - nq; kvgemm_tile(p, l, u % (KM / 256), u / (KM / 256), lds); } }
      { const float* rck = p.rowss_ckv + (size_t)(l >> 1) * KM; const int i = l >> 1;
        for (int e = bid * 512 + tid_op(); e < MP * 128; e += nb * 512) {
          const int m = e >> 7, j = e & 127;
          p.o_ckv[st_row(m, i) * 128 + j] = (float)p.ckv16[pidx(KM, m, j)] * (frsq(rck[m] * (1.f / 128.f) + EPSN)) * p.mla_kva_norm[i * 128 + j];
        } }
      xcd_barrier(bar);
    }
    { PHASE_PARAMS(p);
      for (int rep = 0; rep < REP_B; rep++)
      for (int it = bid; it < 512; it += nb) { if (l & 1) attn_odd_item(p, l, it, lds); else attn_even_item(p, l, it, lds); } }
    xcd_barrier(bar);
    { PHASE_PARAMS(p);
      for (int rep = 0; rep < REP_C; rep++)
      for (int t = bid; t < 32 * 8; t += nb) outproj_tile(p, l, t % 32, t / 32, lds, rep < REP_C - 1); }
    if (l < 3) { for (int rep = 0; rep < REP_BAR; rep++) xcd_barrier(bar); }
  }
}
#endif

static inline size_t al256(size_t x) { return (x + 255) & ~(size_t)255; }

extern "C" void kernel_launch(void* const* d_in, const int* in_sizes, int n_in, void* d_out, int out_size, void* d_ws, size_t ws_size,
                              hipStream_t stream) {
  Params p{};
  const float** ip = (const float**)&p.x_prompt;
  for (int k = 0; k < 39; k++) ip[k] = (const float*)d_in[k];
  float* o = (float*)d_out;
  p.Y = o; o += (size_t)M * 1024;
  p.o_ckv = o; o += (size_t)BATCH * 2 * SEQ * 128;
  p.o_kpe = o; o += (size_t)BATCH * 2 * SEQ * 32;
  p.o_dk = o; o += (size_t)BATCH * 2 * SEQ * 512;
  p.o_dv = o; o += (size_t)BATCH * 2 * SEQ * 512;
  p.o_nk = o; o += (size_t)BATCH * 2 * SEQ * 512;
  p.o_nv = o; o += (size_t)BATCH * 2 * SEQ * 512;
  p.o_gk = o; o += (size_t)BATCH * 2 * SEQ * 128;
  p.o_gv = o; o += (size_t)BATCH * 2 * SEQ * 128;
  char* w = (char*)d_ws; size_t off = 0;
  auto take = [&](size_t bytes) { char* r = w + off; off += al256(bytes); return r; };
  char* zero0 = w + off;
  p.bar = (unsigned*)take(16384);
  p.modv = (float*)take((size_t)4 * NCV * 3072 * 4);
  p.rowss_qa = (float*)take((size_t)2 * M * 4); p.rowss_l = (float*)take((size_t)4 * M * 4); p.rowss_ckv = (float*)take((size_t)2 * KM * 4);
  const size_t zero_bytes = (size_t)((w + off) - zero0);
  p.ropeC64 = (float*)take((size_t)DS * 32 * 4); p.ropeS64 = (float*)take((size_t)DS * 32 * 4);
  p.ropeC32 = (float*)take((size_t)DS * 16 * 4); p.ropeS32 = (float*)take((size_t)DS * 16 * 4);
  p.lamv = (float*)take(256);
  p.rstdx = (float*)take((size_t)M * 4);
  p.QA = (h16*)take((size_t)M * 8 * 96 * 2); p.QB = (h16*)take((size_t)M * 8 * 64 * 2);
  p.KA = (h16*)take((size_t)8 * KM * 128 * 2); p.KB = (h16*)take((size_t)8 * KM * 64 * 2);
  p.VA = (h16*)take((size_t)8 * 64 * KM * 2); p.VB = (h16*)take((size_t)8 * 64 * KM * 2);
  p.gates16 = (h16*)take((size_t)M * 1024 * 2); p.O16 = (h16*)take((size_t)M * 1024 * 2);
  p.ckvbuf = (float*)take((size_t)KM * 128 * 4); p.kpebuf = (float*)take((size_t)KM * 32 * 4);
  p.xs16 = (h16*)take((size_t)M * D * 2); p.qa16 = (h16*)take((size_t)M * 256 * 2); p.ckv16 = (h16*)take((size_t)KM * 128 * 2); p.kpe16 = (h16*)take((size_t)KM * 32 * 2); p.biasv = (float*)take((size_t)4 * NCV * NPO * 4);
  p.win16 = (h16*)take((size_t)4 * NPO * D * 2); p.wout16 = (h16*)take((size_t)4 * D * D * 2);
  p.wqb16 = (h16*)take((size_t)2 * 1024 * 256 * 2); p.wkvb16 = (h16*)take((size_t)2 * 1024 * 128 * 2);
  size_t ub = (size_t)M * 3328 * 2, ab = (size_t)M * 1536 * 4;
  char* big = take(ub > ab ? ub : ab);
  p.ubuf = (h16*)big; p.abuf = (float*)big;
  (void)ws_size; (void)n_in; (void)in_sizes; (void)out_size;

#ifndef CPU_EMU
  {
    (void)hipMemsetAsync(zero0, 0, zero_bytes, stream);
    static int cus = 0;
    if (!cus) { int dev = 0; (void)hipGetDevice(&dev); (void)hipDeviceGetAttribute(&cus, hipDeviceAttributeMultiprocessorCount, dev); }
    void* args[] = {&p};
    (void)hipLaunchCooperativeKernel((void*)mega_kernel, dim3(cus), dim3(512), args, 0, stream);
  }
#else
  (void)zero0; (void)zero_bytes;
  launch1d(nk_mod, (long)4 * NCV * 3072, stream, p, (long)4 * NCV * 3072);
  launch1d(nk_tab, (long)DS * 48, stream, p, (long)DS * 48);
  for (int l = 0; l < 4; l++) {
    const int N = (l & 1) ? ODD_IN : EVEN_IN;
    launch1d(nk_rstd, (long)M, stream, p, l, (long)M);
    launch1d(nk_inproj, (long)M * N, stream, p, l, (long)M * N);
    if ((l & 1) == 0) {
      launch1d(nk_epi_even, (long)M * 50, stream, p, l, 0, (long)M * 50);
      launch1d(nk_cache_even, (long)DB * PAST * 17, stream, p, l, (long)DB * PAST * 17);
      launch1d(nk_kv, (long)KM * 16, stream, p, l, (long)KM * 16);
      launch1d(nk_attn_dense, (long)M * 8, stream, p, 0, 0, M, (long)M * 8);
      launch1d(nk_attn_dense, (long)M * 16, stream, p, 1, 0, M, (long)M * 16);
      launch1d(nk_fin, (long)M * 12, stream, p, l, (long)M * 12);
    } else {
      launch1d(nk_epi_odd, (long)M * 52, stream, p, l, (long)M * 52);
      launch1d(nk_cache_odd, (long)DB * PAST * 20, stream, p, l, (long)DB * PAST * 20);
      launch1d(nk_attn_dense, (long)MP * 8, stream, p, 2, 0, MP, (long)MP * 8);
      launch1d(nk_attn_na, (long)MS * 8, stream, p, l, (long)MS * 8);
      launch1d(nk_attn_dense, (long)M * 8, stream, p, 3, 0, M, (long)M * 8);
      launch1d(nk_fin, (long)M * 16, stream, p, l, (long)M * 16);
    }
    launch1d(nk_outproj, (long)M * 1024, stream, p, l, (long)M * 1024);
  }
#endif
}
```

```cpp
#ifndef CPU_EMU
#include <hip/hip_runtime.h>
#endif
#include <stdint.h>
#include <math.h>

#define FAST_INPROJ 2
#define DUAL_WRITE 0
#define FAST_A2 1
#define FAST_OUTPROJ 1
#define FAST_ATTN 1
#define MEGA 1
#define REP_0A 1
#define REP_A 1
#define REP_A2 1
#define REP_B 1
#define REP_C 1
#define REP_BAR 1
#define REP_GK 1
#define REP_0B 1
#define REP_EPI 1
#ifndef CFG_BATCH
#define CFG_BATCH 16
#endif
#ifndef CFG_DB
#define CFG_DB 2
#endif
#ifndef CFG_DS
#define CFG_DS 2048
#endif
constexpr int D = 1024, BATCH = CFG_BATCH, SEQ = 256, DB = CFG_DB, DS = CFG_DS, PAST = 256;
constexpr int MP = BATCH * SEQ, MS = DB * DS, M = MP + MS;
constexpr int TKS = DS + PAST;
constexpr int KM = MP + DB * TKS;
constexpr int NCV = 1 + DB;
constexpr int GW = 64, GROWS = DS / GW;
constexpr int EVEN_IN = 2976, ODD_IN = 3328;
constexpr int NPE = 3072, NPO = 3328;
constexpr float EPSN = 1e-6f;
constexpr float LOG2E = 1.4426950408889634f;

typedef _Float16 h16;

struct Params {
  const float *x_prompt, *x_sample, *cache_mla_ckv, *cache_mla_kpe, *cache_diff_k, *cache_diff_v, *cache_na_k, *cache_na_v,
      *cache_gqa_k, *cache_gqa_v, *c, *c_ctx, *norm_w, *w_mod, *b_mod, *w_in_even, *w_out_even, *mla_qa_norm, *mla_wqb,
      *mla_kva_norm, *mla_wkvb, *mla_qn_nope, *mla_qn_rope, *mla_kn_nope, *mla_kn_rope, *diff_qn, *diff_kn, *diff_lq1,
      *diff_lk1, *diff_lq2, *diff_lk2, *diff_subln, *w_in_odd, *w_out_odd, *na_qn, *na_kn, *na_rpb, *gqa_qn, *gqa_kn;
  float *Y;
  float *o_ckv, *o_kpe, *o_dk, *o_dv, *o_nk, *o_nv, *o_gk, *o_gv;
  float *modv;
  float *ropeC64, *ropeS64;
  float *ropeC32, *ropeS32;
  float *lamv;
  float *rstdx;
  h16 *ubuf;
  float *abuf;
  float *ckvbuf;
  float *kpebuf;
  h16 *QA, *QB, *KA, *KB, *VA, *VB, *gates16, *O16;
  h16 *xs16;
  float *biasv;
  h16 *win16;
  h16 *wout16;
  h16 *wqb16;
  h16 *wkvb16;
  h16 *qa16;
  float *rowss_qa;
  h16 *ckv16;
  h16 *kpe16;
  float *rowss_l;
  float *rowss_ckv;
  unsigned *bar;
};

#ifdef CPU_EMU
#include <stdio.h>
#include <stdlib.h>
#include <string.h>
typedef void* hipStream_t;
#define KERNEL static void
#define DEVFN static inline
static thread_local long emu_gtid;
#define GTID emu_gtid
template <class... A, class... B>
static void launch1d(void (*f)(A...), long n, hipStream_t, B... a) {
#pragma omp parallel for schedule(dynamic, 64)
  for (long i = 0; i < n; i++) { emu_gtid = i; f(a...); }
}
static inline float exp2f_(float x) { return exp2f(x); }
#else
#define KERNEL __global__ void __launch_bounds__(256)
#define DEVFN __device__ __forceinline__
#define GTID ((long)blockIdx.x * 256 + threadIdx.x)
template <class... A, class... B>
static void launch1d(void (*f)(A...), long n, hipStream_t s, B... a) {
  hipLaunchKernelGGL(f, dim3((unsigned)((n + 255) / 256)), dim3(256), 0, s, a...);
}
DEVFN float exp2f_(float x) { return exp2f(x); }
#endif

DEVFN int tok_cv(int m) { return m < MP ? 0 : 1 + (m - MP) / DS; }
DEVFN int tok_keyrow(int m) { return m < MP ? m : MP + ((m - MP) / DS) * TKS + (m - MP) % DS; }
DEVFN int tok_pos(int m) { return m < MP ? (m % SEQ) : ((m - MP) % DS); }
DEVFN const float* xrow(const Params& p, int l, int m) {
  if (l > 0) return p.Y + (size_t)m * D;
  return m < MP ? p.x_prompt + (size_t)m * D : p.x_sample + (size_t)(m - MP) * D;
}
DEVFN float siluf(float x) { return x / (1.f + expf(-x)); }
DEVFN size_t st_row(int m, int i) { int b = m / SEQ, t = m % SEQ; return ((size_t)(b * 2 + i) * SEQ + t); }

#ifdef CPU_EMU
KERNEL nk_mod(Params p, long n) {
  long g = GTID; if (g >= n) return;
  int col = g % 3072; int cv = (g / 3072) % NCV; int l = g / (3072 * NCV);
  const float* cvec = cv == 0 ? p.c_ctx : p.c + (size_t)(cv - 1) * D;
  const float* w = p.w_mod + (size_t)l * D * 3072 + col;
  float acc = p.b_mod[l * 3072 + col];
  for (int k = 0; k < D; k++) acc += siluf(cvec[k]) * w[(size_t)k * 3072];
  p.modv[((size_t)l * NCV + cv) * 3072 + col] = acc;
}
KERNEL nk_tab(Params p, long n) {
  long g = GTID; if (g >= n) return;
  if (g < 2) {
    int i = g; int l = 2 * i;
    float s1 = 0, s2 = 0;
    for (int k = 0; k < 64; k++) { s1 += p.diff_lq1[i * 64 + k] * p.diff_lk1[i * 64 + k]; s2 += p.diff_lq2[i * 64 + k] * p.diff_lk2[i * 64 + k]; }
    float lam_init = 0.8f - 0.6f * expf(-0.3f * l);
    p.lamv[i] = expf(s1) - expf(s2) + lam_init;
  }
  int t = g / 48, j = g % 48;
  if (t >= DS) return;
  float row = (float)(t / GW), col = (float)(t % GW);
  if (j < 32) {
    int f = j & 15; float inv = powf(10000.f, -(float)(2 * f) / 32.f);
    float ang = (j < 16 ? row : col) * inv;
    p.ropeC64[t * 32 + j] = cosf(ang); p.ropeS64[t * 32 + j] = sinf(ang);
  } else {
    int jj = j - 32; int f = jj & 7; float inv = powf(10000.f, -(float)(2 * f) / 16.f);
    float ang = (jj < 8 ? row : col) * inv;
    p.ropeC32[t * 16 + jj] = cosf(ang); p.ropeS32[t * 16 + jj] = sinf(ang);
  }
}
KERNEL nk_rstd(Params p, int l, long n) {
  long g = GTID; if (g >= n) return;
  const float* x = xrow(p, l, (int)g);
  float s = 0; for (int k = 0; k < D; k++) s += x[k] * x[k];
  p.rstdx[g] = 1.f / sqrtf(s / D + EPSN);
}
KERNEL nk_inproj(Params p, int l, long n) {
  long g = GTID; if (g >= n) return;
  const int N = (l & 1) ? ODD_IN : EVEN_IN;
  int m = g / N, col = g % N;
  const float* W = ((l & 1) ? p.w_in_odd : p.w_in_even) + (size_t)(l >> 1) * D * N + col;
  const float* x = xrow(p, l, m);
  const float* md = p.modv + ((size_t)l * NCV + tok_cv(m)) * 3072;
  const float* nw = p.norm_w + l * D;
  float r = p.rstdx[m], acc = 0;
  for (int k = 0; k < D; k++) { float h = x[k] * r * nw[k] * (1.f + md[1024 + k]) + md[k]; acc += h * W[(size_t)k * N]; }
  p.ubuf[(size_t)m * 3328 + col] = (h16)acc;
}

KERNEL nk_epi_even(Params p, int l, int qa_only, long n) {
  long g = GTID; if (g >= n) return;
  const int i = l >> 1;
  int m = g / 50, u = g % 50;
  if (qa_only && u >= 8) return;
  const h16* ur = qa_only ? p.qa16 + (size_t)m * 256 : p.ubuf + (size_t)m * 3328;
  const bool smp = m >= MP; const int t = tok_pos(m); const int kr = tok_keyrow(m);
  if (u < 8) {
    float ss = 0; for (int k = 0; k < 256; k++) { float v = (float)ur[k]; ss += v * v; }
    float r = 1.f / sqrtf(ss / 256 + EPSN);
    float q[96];
#pragma unroll
    for (int j = 0; j < 96; j++) q[j] = 0;
    const float* W = p.mla_wqb + (size_t)i * 256 * 768 + u * 96;
    for (int k = 0; k < 256; k++) {
      float a = (float)ur[k] * r * p.mla_qa_norm[i * 256 + k];
#pragma unroll
      for (int j = 0; j < 96; j++) q[j] += a * W[(size_t)k * 768 + j];
    }
    float s1 = 0, s2 = 0;
#pragma unroll
    for (int j = 0; j < 64; j++) s1 += q[j] * q[j];
#pragma unroll
    for (int j = 64; j < 96; j++) s2 += q[j] * q[j];
    float r1 = 1.f / sqrtf(s1 / 64 + EPSN), r2 = 1.f / sqrtf(s2 / 32 + EPSN);
#pragma unroll
    for (int j = 0; j < 64; j++) q[j] = q[j] * r1 * p.mla_qn_nope[i * 64 + j];
#pragma unroll
    for (int j = 0; j < 32; j++) q[64 + j] = q[64 + j] * r2 * p.mla_qn_rope[i * 32 + j];
    if (smp) {
#pragma unroll
      for (int j = 0; j < 16; j++) {
        float c = p.ropeC32[t * 16 + j], s = p.ropeS32[t * 16 + j];
        float x1 = q[64 + j], x2 = q[80 + j];
        q[64 + j] = x1 * c - x2 * s; q[80 + j] = x2 * c + x1 * s;
      }
    }
    const float sc = LOG2E / sqrtf(96.f);
    h16* dst = p.QA + ((size_t)m * 8 + u) * 96;
#pragma unroll
    for (int j = 0; j < 96; j++) dst[j] = (h16)(q[j] * sc);
  } else if (u == 8) {
    float ss = 0; for (int k = 0; k < 128; k++) { float v = (float)ur[256 + k]; ss += v * v; }
    float r = 1.f / sqrtf(ss / 128 + EPSN);
    for (int k = 0; k < 128; k++) {
      float v = (float)ur[256 + k] * r * p.mla_kva_norm[i * 128 + k];
      if (!smp) p.o_ckv[st_row(m, i) * 128 + k] = v;
      p.ckvbuf[(size_t)kr * 128 + k] = v;
    }
  } else if (u == 9) {
    float v[32]; float ss = 0;
#pragma unroll
    for (int k = 0; k < 32; k++) { v[k] = (float)ur[384 + k]; ss += v[k] * v[k]; }
    float r = 1.f / sqrtf(ss / 32 + EPSN);
#pragma unroll
    for (int k = 0; k < 32; k++) { v[k] = v[k] * r * p.mla_kn_rope[i * 32 + k]; if (!smp) p.o_kpe[st_row(m, i) * 32 + k] = v[k]; }
    if (smp) {
#pragma unroll
      for (int j = 0; j < 16; j++) {
        float c = p.ropeC32[t * 16 + j], s = p.ropeS32[t * 16 + j];
        float x1 = v[j], x2 = v[16 + j];
        v[j] = x1 * c - x2 * s; v[16 + j] = x2 * c + x1 * s;
      }
    }
#pragma unroll
    for (int k = 0; k < 32; k++) p.kpebuf[(size_t)kr * 32 + k] = v[k];
  } else if (u < 18) {
    int cb = (u - 10) * 64;
    for (int j = 0; j < 64; j++) p.gates16[(size_t)m * 1024 + cb + j] = (h16)siluf((float)ur[416 + cb + j]);
  } else if (u < 34) {
    const bool isq = u < 26; int hc = isq ? u - 18 : u - 26;
    const h16* src = ur + (isq ? 928 : 1440) + hc * 64;
    const float* gn = (isq ? p.diff_qn : p.diff_kn) + i * 64;
    float v[64]; float ss = 0;
#pragma unroll
    for (int k = 0; k < 64; k++) { v[k] = (float)src[k]; ss += v[k] * v[k]; }
    float r = 1.f / sqrtf(ss / 64 + EPSN);
#pragma unroll
    for (int k = 0; k < 64; k++) { v[k] = v[k] * r * gn[k]; if (!isq && !smp) p.o_dk[st_row(m, i) * 512 + hc * 64 + k] = v[k]; }
    if (smp) {
#pragma unroll
      for (int j = 0; j < 32; j++) {
        float c = p.ropeC64[t * 32 + j], s = p.ropeS64[t * 32 + j];
        float x1 = v[j], x2 = v[32 + j];
        v[j] = x1 * c - x2 * s; v[32 + j] = x2 * c + x1 * s;
      }
    }
    if (isq) {
      const float sc = LOG2E / 8.f; h16* dst = p.QB + ((size_t)m * 8 + hc) * 64;
#pragma unroll
      for (int k = 0; k < 64; k++) dst[k] = (h16)(v[k] * sc);
    } else {
      h16* dst = p.KB + ((size_t)hc * KM + kr) * 64;
#pragma unroll
      for (int k = 0; k < 64; k++) dst[k] = (h16)v[k];
    }
  } else if (u < 42) {
    int ch = u - 34; int h = ch >> 1, half = ch & 1;
    for (int j = 0; j < 64; j++) {
      float v = (float)ur[1952 + ch * 64 + j];
      if (!smp) p.o_dv[st_row(m, i) * 512 + ch * 64 + j] = v;
      p.VB[((size_t)h * 128 + half * 64 + j) * KM + kr] = (h16)v;
    }
  } else {
    int cb = (u - 42) * 64;
    for (int j = 0; j < 64; j++) p.gates16[(size_t)m * 1024 + 512 + cb + j] = (h16)siluf((float)ur[2464 + cb + j]);
  }
}
KERNEL nk_cache_even(Params p, int l, long n) {
  long g = GTID; if (g >= n) return;
  const int i = l >> 1;
  int u = g % 17; int pos = (g / 17) % PAST; int b = g / (17 * PAST);
  const int kr = MP + b * TKS + DS + pos;
  const size_t crow = ((size_t)(b * 2 + i) * PAST + pos);
  if (u == 0) {
    for (int k = 0; k < 128; k++) { float v = p.cache_mla_ckv[crow * 128 + k]; p.ckvbuf[(size_t)kr * 128 + k] = v; p.ckv16[(size_t)kr * 128 + k] = (h16)v; }
    for (int k = 0; k < 32; k++) { float v = p.cache_mla_kpe[crow * 32 + k]; p.kpebuf[(size_t)kr * 32 + k] = v; p.kpe16[(size_t)kr * 32 + k] = (h16)v; }
  } else if (u < 9) {
    int hc = u - 1;
    for (int k = 0; k < 64; k++) p.KB[((size_t)hc * KM + kr) * 64 + k] = (h16)p.cache_diff_k[crow * 512 + hc * 64 + k];
  } else {
    int ch = u - 9; int h = ch >> 1, half = ch & 1;
    for (int j = 0; j < 64; j++) p.VB[((size_t)h * 128 + half * 64 + j) * KM + kr] = (h16)p.cache_diff_v[crow * 512 + ch * 64 + j];
  }
}
KERNEL nk_kv(Params p, int l, long n) {
  long g = GTID; if (g >= n) return;
  const int i = l >> 1;
  int part = g & 1; int h = (g >> 1) & 7; int kr = g >> 4;
  const float* cr = p.ckvbuf + (size_t)kr * 128;
  const float* W = p.mla_wkvb + (size_t)i * 128 * 1024 + h * 128 + part * 64;
  float a[64];
#pragma unroll
  for (int j = 0; j < 64; j++) a[j] = 0;
  for (int k = 0; k < 128; k++) {
    float c = (float)(h16)cr[k];
#pragma unroll
    for (int j = 0; j < 64; j++) a[j] += c * W[(size_t)k * 1024 + j];
  }
  if (part == 0) {
    float ss = 0;
#pragma unroll
    for (int j = 0; j < 64; j++) ss += a[j] * a[j];
    float r = 1.f / sqrtf(ss / 64 + EPSN);
    h16* dst = p.KA + ((size_t)h * KM + kr) * 128;
#pragma unroll
    for (int j = 0; j < 64; j++) dst[j] = (h16)(a[j] * r * p.mla_kn_nope[i * 64 + j]);
    for (int j = 0; j < 32; j++) dst[64 + j] = (h16)p.kpebuf[(size_t)kr * 32 + j];
  } else {
#pragma unroll
    for (int j = 0; j < 64; j++) p.VA[((size_t)h * 64 + j) * KM + kr] = (h16)a[j];
  }
}
KERNEL nk_epi_odd(Params p, int l, long n) {
  long g = GTID; if (g >= n) return;
  const int i = l >> 1;
  int m = g / 52, u = g % 52;
  const h16* ur = p.ubuf + (size_t)m * 3328;
  const bool smp = m >= MP; const int t = tok_pos(m); const int kr = tok_keyrow(m);
  if (u < 16 || (u >= 32 && u < 42)) {
    int colbase, head; const float* gn; int kind;
    if (u < 8) { kind = 0; head = u; colbase = head * 64; gn = p.na_qn + i * 64; }
    else if (u < 16) { kind = 1; head = u - 8; colbase = 512 + head * 64; gn = p.na_kn + i * 64; }
    else if (u < 40) { kind = 2; head = u - 32; colbase = 2048 + head * 64; gn = p.gqa_qn + i * 64; }
    else { kind = 3; head = u - 40; colbase = 2560 + head * 64; gn = p.gqa_kn + i * 64; }
    float v[64]; float ss = 0;
#pragma unroll
    for (int k = 0; k < 64; k++) { v[k] = (float)ur[colbase + k]; ss += v[k] * v[k]; }
    float r = 1.f / sqrtf(ss / 64 + EPSN);
#pragma unroll
    for (int k = 0; k < 64; k++) v[k] = v[k] * r * gn[k];
    if (!smp) {
      if (kind == 1) { for (int k = 0; k < 64; k++) p.o_nk[st_row(m, i) * 512 + head * 64 + k] = v[k]; }
      if (kind == 3) { for (int k = 0; k < 64; k++) p.o_gk[st_row(m, i) * 128 + head * 64 + k] = v[k]; }
    }
    if (smp && kind >= 2) {
#pragma unroll
      for (int j = 0; j < 32; j++) {
        float c = p.ropeC64[t * 32 + j], s = p.ropeS64[t * 32 + j];
        float x1 = v[j], x2 = v[32 + j];
        v[j] = x1 * c - x2 * s; v[32 + j] = x2 * c + x1 * s;
      }
    }
    const float sc = LOG2E / 8.f;
    h16* dst;
    if (kind == 0) dst = p.QA + ((size_t)m * 8 + head) * 64;
    else if (kind == 1) dst = p.KA + ((size_t)head * KM + kr) * 64;
    else if (kind == 2) dst = p.QB + ((size_t)m * 8 + head) * 64;
    else dst = p.KB + ((size_t)head * KM + kr) * 64;
    const float mul = (kind == 0 || kind == 2) ? sc : 1.f;
#pragma unroll
    for (int k = 0; k < 64; k++) dst[k] = (h16)(v[k] * mul);
  } else if (u < 24) {
    int head = u - 16;
    for (int j = 0; j < 64; j++) {
      float v = (float)ur[1024 + head * 64 + j];
      if (!smp) p.o_nv[st_row(m, i) * 512 + head * 64 + j] = v;
      p.VA[((size_t)head * 64 + j) * KM + kr] = (h16)v;
    }
  } else if (u < 32) {
    int cb = (u - 24) * 64;
    for (int j = 0; j < 64; j++) p.gates16[(size_t)m * 1024 + cb + j] = (h16)siluf((float)ur[1536 + cb + j]);
  } else if (u < 44) {
    int head = u - 42;
    for (int j = 0; j < 64; j++) {
      float v = (float)ur[2688 + head * 64 + j];
      if (!smp) p.o_gv[st_row(m, i) * 128 + head * 64 + j] = v;
      p.VB[((size_t)head * 64 + j) * KM + kr] = (h16)v;
    }
  } else {
    int cb = (u - 44) * 64;
    for (int j = 0; j < 64; j++) p.gates16[(size_t)m * 1024 + 512 + cb + j] = (h16)siluf((float)ur[2816 + cb + j]);
  }
}
KERNEL nk_cache_odd(Params p, int l, long n) {
  long g = GTID; if (g >= n) return;
  const int i = l >> 1;
  int u = g % 20; int pos = (g / 20) % PAST; int b = g / (20 * PAST);
  const int kr = MP + b * TKS + DS + pos;
  const size_t crow = ((size_t)(b * 2 + i) * PAST + pos);
  if (u < 8) { for (int k = 0; k < 64; k++) p.KA[((size_t)u * KM + kr) * 64 + k] = (h16)p.cache_na_k[crow * 512 + u * 64 + k]; }
  else if (u < 16) { int h = u - 8; for (int j = 0; j < 64; j++) p.VA[((size_t)h * 64 + j) * KM + kr] = (h16)p.cache_na_v[crow * 512 + h * 64 + j]; }
  else if (u < 18) { int h = u - 16; for (int k = 0; k < 64; k++) p.KB[((size_t)h * KM + kr) * 64 + k] = (h16)p.cache_gqa_k[crow * 128 + h * 64 + k]; }
  else { int h = u - 18; for (int j = 0; j < 64; j++) p.VB[((size_t)h * 64 + j) * KM + kr] = (h16)p.cache_gqa_v[crow * 128 + h * 64 + j]; }
}
template <int DQK, int KP>
DEVFN void attn_dense_thread(const h16* q, const h16* K, const h16* VT, int kr0, int nk, float* out) {
  float qf[DQK];
#pragma unroll
  for (int j = 0; j < DQK; j++) qf[j] = (float)q[j];
  float o[64];
#pragma unroll
  for (int j = 0; j < 64; j++) o[j] = 0;
  float mx = -1e30f, sum = 0;
  for (int kk = 0; kk < nk; kk++) {
    const h16* kp = K + (size_t)(kr0 + kk) * KP;
    float s = 0;
#pragma unroll
    for (int j = 0; j < DQK; j++) s += qf[j] * (float)kp[j];
    float mn = fmaxf(mx, s); float al = exp2f_(mx - mn); float pe = exp2f_(s - mn);
    sum = sum * al + pe; mx = mn;
#pragma unroll
    for (int j = 0; j < 64; j++) o[j] = o[j] * al + pe * (float)VT[(size_t)j * KM + kr0 + kk];
  }
  float inv = 1.f / sum;
#pragma unroll
  for (int j = 0; j < 64; j++) out[j] = o[j] * inv;
}
KERNEL nk_attn_dense(Params p, int kind, int mlo, int mhi, long n) {
  long g = GTID; if (g >= n) return;
  const int nch = kind == 1 ? 2 : 1;
  int ch = g % nch; int head = (g / nch) % 8; int m = mlo + g / (nch * 8);
  if (m >= mhi) return;
  int kr0, nk;
  if (m < MP) { kr0 = (m / SEQ) * SEQ; nk = SEQ; } else { kr0 = MP + ((m - MP) / DS) * TKS; nk = TKS; }
  if (kind == 0) {
    attn_dense_thread<96, 128>(p.QA + ((size_t)m * 8 + head) * 96, p.KA + (size_t)head * KM * 128, p.VA + (size_t)head * 64 * KM, kr0, nk,
                          p.abuf + (size_t)m * 1536 + head * 64);
  } else if (kind == 1) {
    attn_dense_thread<64, 64>(p.QB + ((size_t)m * 8 + head) * 64, p.KB + (size_t)head * KM * 64,
                          p.VB + ((size_t)(head >> 1) * 128 + ch * 64) * KM, kr0, nk, p.abuf + (size_t)m * 1536 + 512 + head * 128 + ch * 64);
  } else if (kind == 2) {
    attn_dense_thread<64, 64>(p.QA + ((size_t)m * 8 + head) * 64, p.KA + (size_t)head * KM * 64, p.VA + (size_t)head * 64 * KM, kr0, nk,
                          p.abuf + (size_t)m * 1536 + head * 64);
  } else {
    attn_dense_thread<64, 64>(p.QB + ((size_t)m * 8 + head) * 64, p.KB + (size_t)(head >> 2) * KM * 64, p.VB + (size_t)(head >> 2) * 64 * KM,
                          kr0, nk, p.abuf + (size_t)m * 1536 + 512 + head * 64);
  }
}
KERNEL nk_attn_na(Params p, int l, long n) {
  long g = GTID; if (g >= n) return;
  const int i = l >> 1;
  int head = g & 7; int ms = g >> 3; int m = MP + ms;
  int b = ms / DS, t = ms % DS; int r = t / GW, c = t % GW;
  int rs = r - 4; rs = rs < 0 ? 0 : (rs > GROWS - 8 ? GROWS - 8 : rs);
  int cs = c - 8; cs = cs < 0 ? 0 : (cs > GW - 16 ? GW - 16 : cs);
  const h16* q = p.QA + ((size_t)m * 8 + head) * 64;
  const h16* K = p.KA + (size_t)head * KM * 64; const h16* VT = p.VA + (size_t)head * 64 * KM;
  const int kbase = MP + b * TKS;
  const float* rpb = p.na_rpb + ((size_t)i * 8 + head) * 15 * 31;
  float qf[64], o[64];
#pragma unroll
  for (int j = 0; j < 64; j++) { qf[j] = (float)q[j]; o[j] = 0; }
  float mx = -1e30f, sum = 0;
  for (int kk = 0; kk < 128 + PAST; kk++) {
    int kr; float bias = 0;
    if (kk < 128) { int ri = kk >> 4, cj = kk & 15; kr = kbase + (rs + ri) * GW + cs + cj; bias = rpb[(rs + ri - r + 7) * 31 + (cs + cj - c + 15)] * LOG2E; }
    else kr = kbase + DS + (kk - 128);
    const h16* kp = K + (size_t)kr * 64;
    float s = bias;
#pragma unroll
    for (int j = 0; j < 64; j++) s += qf[j] * (float)kp[j];
    float mn = fmaxf(mx, s); float al = exp2f_(mx - mn); float pe = exp2f_(s - mn);
    sum = sum * al + pe; mx = mn;
#pragma unroll
    for (int j = 0; j < 64; j++) o[j] = o[j] * al + pe * (float)VT[(size_t)j * KM + kr];
  }
  float inv = 1.f / sum; float* out = p.abuf + (size_t)m * 1536 + head * 64;
#pragma unroll
  for (int j = 0; j < 64; j++) out[j] = o[j] * inv;
}
KERNEL nk_fin(Params p, int l, long n) {
  long g = GTID; if (g >= n) return;
  const int i = l >> 1;
  if (l & 1) {
    int ch = g & 15; int m = g >> 4;
    for (int j = 0; j < 64; j++) {
      int col = ch * 64 + j;
      p.O16[(size_t)m * 1024 + col] = (h16)(p.abuf[(size_t)m * 1536 + col] * (float)p.gates16[(size_t)m * 1024 + col]);
    }
  } else {
    int u = g % 12; int m = g / 12;
    if (u < 8) {
      for (int j = 0; j < 64; j++) {
        int col = u * 64 + j;
        p.O16[(size_t)m * 1024 + col] = (h16)(p.abuf[(size_t)m * 1536 + col] * (float)p.gates16[(size_t)m * 1024 + col]);
      }
    } else {
      int h = u - 8; float lam = p.lamv[i]; float lam_init = 0.8f - 0.6f * expf(-0.3f * l);
      const float* a1 = p.abuf + (size_t)m * 1536 + 512 + (h * 2) * 128; const float* a2 = a1 + 128;
      float ss = 0;
      for (int j = 0; j < 128; j++) { float d = a1[j] - lam * a2[j]; ss += d * d; }
      float r = 1.f / sqrtf(ss / 128 + EPSN);
      for (int j = 0; j < 128; j++) {
        float d = (a1[j] - lam * a2[j]) * r * p.diff_subln[i * 128 + j] * (1.f - lam_init);
        int col = 512 + h * 128 + j;
        p.O16[(size_t)m * 1024 + col] = (h16)(d * (float)p.gates16[(size_t)m * 1024 + col]);
      }
    }
  }
}
KERNEL nk_outproj(Params p, int l, long n) {
  long g = GTID; if (g >= n) return;
  int m = g >> 10, col = g & 1023;
  const float* W = ((l & 1) ? p.w_out_odd : p.w_out_even) + (size_t)(l >> 1) * 1024 * 1024 + col;
  const h16* o = p.O16 + (size_t)m * 1024;
  float acc = 0;
  for (int k = 0; k < 1024; k++) acc += (float)o[k] * W[(size_t)k * 1024];
  float gate = p.modv[((size_t)l * NCV + tok_cv(m)) * 3072 + 2048 + col];
  p.Y[(size_t)m * 1024 + col] = xrow(p, l, m)[col] + gate * acc;
}


#endif
#ifndef CPU_EMU
typedef _Float16 h16x8 __attribute__((ext_vector_type(8)));
typedef _Float16 h16x4 __attribute__((ext_vector_type(4)));
typedef float f32x16 __attribute__((ext_vector_type(16)));
typedef float f32x4 __attribute__((ext_vector_type(4)));
#define LAS __attribute__((address_space(3)))
typedef unsigned u32x4 __attribute__((ext_vector_type(4)));
DEVFN size_t pidx(int R, int row, int k) { return ((size_t)(k >> 6) * R + row) * 64 + (k & 63); }
DEVFN size_t vidx(int vrow, int kr) { return ((size_t)(kr >> 6) * 512 + vrow) * 64 + (kr & 63); }
DEVFN float max3f(float a, float b, float c) { float r; asm("v_max3_f32 %0, %1, %2, %3" : "=v"(r) : "v"(a), "v"(b), "v"(c)); return r; }
DEVFN float frsq(float x) { return __builtin_amdgcn_rsqf(x); }
DEVFN float fsilu(float x) { return x * __builtin_amdgcn_rcpf(1.f + __builtin_amdgcn_exp2f(-LOG2E * x)); }
DEVFN int tid_op() { int t = threadIdx.x; asm volatile("" : "+v"(t)); return t; }

DEVFN int even_col(int np) { return np < 416 ? np : (np < 512 ? -1 : np - 96); }

constexpr int G_STAGE = 49152, G_NSTAGE = 3, G_LDS = G_STAGE * G_NSTAGE;
constexpr int G_LDS2 = 131072 + 8 * 3072;
DEVFN int img_off(int r, int c) { return r * 128 + ((c ^ ((r >> 1) & 7)) << 4); }
template <int R>
DEVFN void stage_rows(const h16* g, int ld, char* lds, int tid) {
#pragma unroll
  for (int i = 0; i < R / 64; i++) {
    int r = (tid >> 3) + 64 * i; int c = (tid & 7) ^ ((r >> 1) & 7);
    __builtin_amdgcn_global_load_lds((const unsigned*)(g + (size_t)r * ld + c * 8), (unsigned*)(lds + i * 8192 + tid * 16), 16, 0, 0);
  }
}
#define WAITV(n) asm volatile("s_waitcnt vmcnt(" #n ")" ::: "memory")
#define RAWBAR() do { asm volatile("s_waitcnt lgkmcnt(0)" ::: "memory"); __builtin_amdgcn_s_barrier(); } while (0)
template <bool TR>
DEVFN void gemm_tile(const h16* A, int RA, const h16* Bt, int RB, int K, int m0, int n0, char* lds, f32x16 (&acc)[2][2]) {
  const int TIDX = tid_op();
  const int tid = TIDX, lane = tid & 63, w = tid >> 6, wm = w >> 1, wn = w & 1;
  const int nt = K / 64;
  const h16* Ag = A + (size_t)m0 * 64; const h16* Bg = Bt + (size_t)n0 * 64; const size_t pa = (size_t)RA * 64, pb = (size_t)RB * 64;
#pragma unroll
  for (int a = 0; a < 2; a++)
#pragma unroll
    for (int b = 0; b < 2; b++)
#pragma unroll
      for (int r = 0; r < 16; r++) acc[a][b][r] = 0.f;
  stage_rows<256>(Ag, 64, lds, tid); stage_rows<128>(Bg, 64, lds + 32768, tid);
  if (nt > 1) { stage_rows<256>(Ag + pa, 64, lds + G_STAGE, tid); stage_rows<128>(Bg + pb, 64, lds + G_STAGE + 32768, tid); }
  const int ra = wm * 64 + (lane & 31), rb = wn * 64 + (lane & 31), ch = lane >> 5;
  auto piece = [&](const h16* g, char* s, int i) {
    const int r = (tid >> 3) + 64 * i; const int c = (tid & 7) ^ ((r >> 1) & 7);
    __builtin_amdgcn_global_load_lds((const unsigned*)(g + (size_t)r * 64 + c * 8), (unsigned*)(s + i * 8192 + tid * 16), 16, 0, 0);
  };
  for (int t = 0; t < nt; t++) {
    if (t + 1 < nt) WAITV(6); else WAITV(0);
    RAWBAR();
    const bool pre = t + 2 < nt;
    char* sn = lds + ((t + 2) % 3) * G_STAGE; const h16* An = Ag + (t + 2) * pa; const h16* Bn = Bg + (t + 2) * pb;
    const char* sa = lds + (t % 3) * G_STAGE; const char* sb = sa + 32768;
    h16x8 af[2][2], bf[2][2];
#pragma unroll
    for (int mb = 0; mb < 2; mb++) af[0][mb] = *(const h16x8*)(sa + img_off(ra + mb * 32, ch));
#pragma unroll
    for (int nb = 0; nb < 2; nb++) bf[0][nb] = *(const h16x8*)(sb + img_off(rb + nb * 32, ch));
#pragma unroll
    for (int ks = 0; ks < 4; ks++) {
      const int cur = ks & 1, nxt = cur ^ 1;
      if (ks < 3) {
#pragma unroll
        for (int mb = 0; mb < 2; mb++) af[nxt][mb] = *(const h16x8*)(sa + img_off(ra + mb * 32, 2 * (ks + 1) + ch));
#pragma unroll
        for (int nb = 0; nb < 2; nb++) bf[nxt][nb] = *(const h16x8*)(sb + img_off(rb + nb * 32, 2 * (ks + 1) + ch));
      }
      if (pre) {
        if (ks == 0) { piece(An, sn, 0); piece(An, sn, 1); }
        else if (ks == 1) { piece(An, sn, 2); piece(An, sn, 3); }
        else if (ks == 2) { piece(Bn, sn + 32768, 0); piece(Bn, sn + 32768, 1); }
      }
#pragma unroll
      for (int mb = 0; mb < 2; mb++)
#pragma unroll
        for (int nb = 0; nb < 2; nb++) {
          if (TR) acc[mb][nb] = __builtin_amdgcn_mfma_f32_32x32x16_f16(bf[cur][nb], af[cur][mb], acc[mb][nb], 0, 0, 0);
          else acc[mb][nb] = __builtin_amdgcn_mfma_f32_32x32x16_f16(af[cur][mb], bf[cur][nb], acc[mb][nb], 0, 0, 0);
        }
      __builtin_amdgcn_sched_barrier(0);
    }
  }
  RAWBAR();
}

DEVFN float wsum32(float v) { return v + __shfl_xor(v, 32); }

template <class RsF, class DstF>
DEVFN void epi_head64(const Params& p, const f32x16 (&acc)[2][2], int mbase, RsF rsf, const float* bias, const float* gain, bool rope, float oscale,
                      float* state, int spitch, int scol, int ilayer, DstF dstf) {
  const int TIDX = tid_op();
  const int lane = TIDX & 63, h = lane >> 5;
#pragma unroll
  for (int mb = 0; mb < 2; mb++) {
    const int m = mbase + mb * 32 + (lane & 31);
    const float rs = rsf(m);
    float v[2][16]; float ss = 0;
#pragma unroll
    for (int nb = 0; nb < 2; nb++)
#pragma unroll
      for (int q = 0; q < 4; q++) {
        const int j = nb * 32 + 8 * q + 4 * h;
        f32x4 b = bias ? *(const f32x4*)(bias + j) : (f32x4){0.f, 0.f, 0.f, 0.f};
#pragma unroll
        for (int e = 0; e < 4; e++) { float x = acc[mb][nb][q * 4 + e] * rs + b[e]; v[nb][q * 4 + e] = x; ss += x * x; }
      }
    ss = wsum32(ss);
    const float rr = frsq(ss * (1.f / 64.f) + EPSN);
#pragma unroll
    for (int nb = 0; nb < 2; nb++)
#pragma unroll
      for (int q = 0; q < 4; q++) {
        const int j = nb * 32 + 8 * q + 4 * h;
        f32x4 g = *(const f32x4*)(gain + j);
#pragma unroll
        for (int e = 0; e < 4; e++) v[nb][q * 4 + e] *= rr * g[e];
      }
    const bool smp = m >= MP;
    if (state && !smp) {
      float* sp = state + st_row(m, ilayer) * spitch + scol;
#pragma unroll
      for (int nb = 0; nb < 2; nb++)
#pragma unroll
        for (int q = 0; q < 4; q++) { f32x4 o = {v[nb][q * 4], v[nb][q * 4 + 1], v[nb][q * 4 + 2], v[nb][q * 4 + 3]}; *(f32x4*)(sp + nb * 32 + 8 * q + 4 * h) = o; }
    }
    if (rope && smp) {
      const int t = tok_pos(m);
#pragma unroll
      for (int q = 0; q < 4; q++) {
        f32x4 c = *(const f32x4*)(p.ropeC64 + t * 32 + 8 * q + 4 * h), s = *(const f32x4*)(p.ropeS64 + t * 32 + 8 * q + 4 * h);
#pragma unroll
        for (int e = 0; e < 4; e++) { float x1 = v[0][q * 4 + e], x2 = v[1][q * 4 + e]; v[0][q * 4 + e] = x1 * c[e] - x2 * s[e]; v[1][q * 4 + e] = x2 * c[e] + x1 * s[e]; }
      }
    }
    h16* dst = dstf(m);
#pragma unroll
    for (int nb = 0; nb < 2; nb++)
#pragma unroll
      for (int q = 0; q < 4; q++) {
        h16x4 o;
#pragma unroll
        for (int e = 0; e < 4; e++) o[e] = (h16)(v[nb][q * 4 + e] * oscale);
        *(h16x4*)(dst + nb * 32 + 8 * q + 4 * h) = o;
      }
  }
}
template <class RsF, class DstF>
DEVFN void epi_head32(const Params& p, const f32x16 (&acc)[2][2], int mbase, RsF rsf, const float* bias, const float* gain, bool rope, float oscale,
                      float* state, int ilayer, DstF dstf, float* dual = nullptr) {
  const int TIDX = tid_op();
  const int lane = TIDX & 63, h = lane >> 5;
#pragma unroll
  for (int mb = 0; mb < 2; mb++) {
    const int m = mbase + mb * 32 + (lane & 31);
    const float rs = rsf(m);
    float v[16]; float ss = 0;
#pragma unroll
    for (int q = 0; q < 4; q++) {
      const int j = 8 * q + 4 * h;
      f32x4 b = bias ? *(const f32x4*)(bias + j) : (f32x4){0.f, 0.f, 0.f, 0.f};
#pragma unroll
      for (int e = 0; e < 4; e++) { float x = acc[mb][0][q * 4 + e] * rs + b[e]; v[q * 4 + e] = x; ss += x * x; }
    }
    ss = wsum32(ss);
    const float rr = frsq(ss * (1.f / 32.f) + EPSN);
#pragma unroll
    for (int q = 0; q < 4; q++) {
      f32x4 g = *(const f32x4*)(gain + 8 * q + 4 * h);
#pragma unroll
      for (int e = 0; e < 4; e++) v[q * 4 + e] *= rr * g[e];
    }
    const bool smp = m >= MP;
    if (state && !smp) {
      float* sp = state + st_row(m, ilayer) * 32;
#pragma unroll
      for (int q = 0; q < 4; q++) { f32x4 o = {v[q * 4], v[q * 4 + 1], v[q * 4 + 2], v[q * 4 + 3]}; *(f32x4*)(sp + 8 * q + 4 * h) = o; }
    }
    if (rope && smp) {
      const int t = tok_pos(m);
#pragma unroll
      for (int q = 0; q < 2; q++) {
        f32x4 c = *(const f32x4*)(p.ropeC32 + t * 16 + 8 * q + 4 * h), s = *(const f32x4*)(p.ropeS32 + t * 16 + 8 * q + 4 * h);
#pragma unroll
        for (int e = 0; e < 4; e++) { float x1 = v[q * 4 + e], x2 = v[(q + 2) * 4 + e]; v[q * 4 + e] = x1 * c[e] - x2 * s[e]; v[(q + 2) * 4 + e] = x2 * c[e] + x1 * s[e]; }
      }
    }
    h16* dst = dstf(m);
#pragma unroll
    for (int q = 0; q < 4; q++) {
      h16x4 o;
#pragma unroll
      for (int e = 0; e < 4; e++) o[e] = (h16)(v[q * 4 + e] * oscale);
      *(h16x4*)(dst + 8 * q + 4 * h) = o;
      if (dual) { for (int e = 0; e < 4; e++) dual[(size_t)tok_keyrow(m) * 32 + 8 * q + 4 * h + e] = v[q * 4 + e]; }
    }
  }
}
template <class RsF, class KrF>
DEVFN void epi_vt(const f32x16 (&acc)[2][2], int mbase, RsF rsf, const float* bias  , float* state, int spitch, int scol, int ilayer,
                  h16* vbuf, int vrow0, KrF krf) {
  const int TIDX = tid_op();
  const int lane = TIDX & 63, h = lane >> 5, e0 = lane & 31;
#pragma unroll
  for (int mb = 0; mb < 2; mb++)
#pragma unroll
    for (int q = 0; q < 4; q++) {
      const int mq = mbase + mb * 32 + 8 * q + 4 * h;
      float rs[4];
#pragma unroll
      for (int e = 0; e < 4; e++) rs[e] = rsf(mq + e);
      const int kr = krf(mq);
#pragma unroll
      for (int nb = 0; nb < 2; nb++) {
        const int col = nb * 32 + e0; const float b = bias ? bias[col] : 0.f;
        h16x4 o;
#pragma unroll
        for (int e = 0; e < 4; e++) {
          float x = acc[mb][nb][q * 4 + e] * rs[e] + b; o[e] = (h16)x;
          if (state && mq < MP) state[st_row(mq + e, ilayer) * spitch + scol + col] = x;
        }
        *(h16x4*)(vbuf + vidx(vrow0 + col, kr)) = o;
      }
    }
}

DEVFN void qgemm_tile(const Params& p, int l, int mt, int head, char* lds) {
  const int TIDX = tid_op();
  const int i = l >> 1; const int m0 = mt * 256;
  const int w = TIDX >> 6, wm = w >> 1, wn = w & 1;
  f32x16 acc[2][2];
  gemm_tile<true>(p.qa16, M, (p.wqb16 + (size_t)i * 1024 * 256), 1024, 256, m0, head * 128, lds, acc);
  const float* rq = p.rowss_qa + (size_t)i * M;
  auto rsf = [&](int m) { return frsq(rq[m] * (1.f / 256.f) + EPSN); };
  const float sc = LOG2E / sqrtf(96.f);
  if (wn == 0) epi_head64(p, acc, m0 + wm * 64, rsf, nullptr, p.mla_qn_nope + i * 64, false, sc, nullptr, 0, 0, i, [&](int m) { return p.QA + ((size_t)m * 8 + head) * 96; });
  else epi_head32(p, acc, m0 + wm * 64, rsf, nullptr, p.mla_qn_rope + i * 32, true, sc, nullptr, i, [&](int m) { return p.QA + ((size_t)m * 8 + head) * 96 + 64; });
}
DEVFN void kvgemm_tile(const Params& p, int l, int mt, int ntile, char* lds) {
  const int TIDX = tid_op();
  const int i = l >> 1; const int m0 = mt * 256;
  const int lane = TIDX & 63, w = TIDX >> 6, wm = w >> 1, wn = w & 1, h = lane >> 5;
  f32x16 acc[2][2];
  const float* rck = p.rowss_ckv + (size_t)i * KM;
  auto one = [&](int m) { return frsq(rck[m] * (1.f / 128.f) + EPSN); };
  if (ntile < 4) {
    gemm_tile<true>(p.ckv16, KM, (p.wkvb16 + (size_t)i * 1024 * 128), 1024, 128, m0, ntile * 128, lds, acc);
    const int head = ntile * 2 + wn;
    epi_head64(p, acc, m0 + wm * 64, one, nullptr, p.mla_kn_nope + i * 64, false, 1.f, nullptr, 0, 0, i, [&](int m) { return p.KA + ((size_t)head * KM + m) * 128; });
#pragma unroll
    for (int mb = 0; mb < 2; mb++) {
      const int kr = m0 + wm * 64 + mb * 32 + (lane & 31);
      const h16x8* s = (const h16x8*)(p.kpe16 + (size_t)kr * 32 + h * 16);
      h16x8* d = (h16x8*)(p.KA + ((size_t)head * KM + kr) * 128 + 64 + h * 16);
      d[0] = s[0]; d[1] = s[1];
    }
  } else {
    gemm_tile<false>(p.ckv16, KM, (p.wkvb16 + (size_t)i * 1024 * 128), 1024, 128, m0, ntile * 128, lds, acc);
    const int head = (ntile - 4) * 2 + wn;
    epi_vt(acc, m0 + wm * 64, one, nullptr, nullptr, 0, 0, i, p.VA, head * 64, [](int m) { return m; });
  }
}
DEVFN void outproj_tile(const Params& p, int l, int mt, int ntile, char* lds, bool dry = false) {
  const int TIDX = tid_op();
  const int m0 = mt * 256, n0 = ntile * 128;
  const int lane = TIDX & 63, w = TIDX >> 6, wm = w >> 1, wn = w & 1, h = lane >> 5;
  f32x16 acc[2][2];
  gemm_tile<true>(p.O16, M, (p.wout16 + (size_t)l * D * D), 1024, D, m0, n0, lds, acc);
  const int cv = tok_cv(m0); const int nw0 = n0 + wn * 64;
  const float* gate = p.modv + ((size_t)l * NCV + cv) * 3072 + 2048 + nw0;
  const float* nsc = p.modv + ((size_t)(l + 1) * NCV + cv) * 3072 + 1024 + nw0;
  const float* nnw = p.norm_w + (l + 1) * D + nw0;
#pragma unroll
  for (int mb = 0; mb < 2; mb++) {
    const int m = m0 + wm * 64 + mb * 32 + (lane & 31);
    const float* xr = xrow(p, l, m) + nw0; float* yr = p.Y + (size_t)m * D + nw0;
    float ss = 0;
#pragma unroll
    for (int nb = 0; nb < 2; nb++)
#pragma unroll
      for (int q = 0; q < 4; q++) {
        const int j = nb * 32 + 8 * q + 4 * h;
        f32x4 x = *(const f32x4*)(xr + j), g = *(const f32x4*)(gate + j), o;
#pragma unroll
        for (int e = 0; e < 4; e++) { o[e] = x[e] + g[e] * acc[mb][nb][q * 4 + e]; ss += o[e] * o[e]; }
        if (!dry) *(f32x4*)(yr + j) = o;
        if (l < 3 && !dry) {
          f32x4 s = *(const f32x4*)(nsc + j), nw = *(const f32x4*)(nnw + j); h16x4 oh;
#pragma unroll
          for (int e = 0; e < 4; e++) oh[e] = (h16)(o[e] * nw[e] * (1.f + s[e]));
          *(h16x4*)(p.xs16 + pidx(M, m, nw0 + j)) = oh;
        }
      }
    if (l < 3 && !dry) { ss = wsum32(ss); if (h == 0) atomicAdd(p.rowss_l + (size_t)(l + 1) * M + m, ss); }
  }
}
struct AttnItem {
  const h16 *k0, *k1; int kld;
  const h16 *v0, *v1;
  int kr0, nt0, kr1, nt1;
};
constexpr int A_RING = 3 * 32768;

template <int DQK, int NKI, int NVI, int NDB, bool NAMASK>
DEVFN void attn_core(const AttnItem& it, const h16* qptr, int qpitch, int ksel, int ta, int tb, const float* rpbl, int na_dr0  , int na_c,
                     char* lds, f32x16 (&o)[NDB], float& lsum_out) {
  const int TIDX = tid_op();
  constexpr int NIMG = NKI + NVI; constexpr int STG = NIMG * 8192;
  const int tid = TIDX, lane = tid & 63, h = lane >> 5;
  h16x8 qf[DQK / 16];
#pragma unroll
  for (int ks = 0; ks < DQK / 16; ks++) qf[ks] = *(const h16x8*)(qptr + (size_t)(lane & 31) * qpitch + ks * 16 + 8 * h);
#pragma unroll
  for (int db = 0; db < NDB; db++)
#pragma unroll
    for (int r = 0; r < 16; r++) o[db][r] = 0.f;
  float m_run = 0.f, lsum = 0.f; bool first = true;
  const int nt = it.nt0 + it.nt1;
  auto stage = [&](int t) {
    char* s = lds + (t % 3) * STG; const int kr = t < it.nt0 ? it.kr0 + 64 * t : it.kr1 + 64 * (t - it.nt0);
    stage_rows<64>(it.k0 + (size_t)kr * it.kld, it.kld, s, tid);
    if (NKI == 2) stage_rows<64>(it.k1 + (size_t)kr * it.kld, it.kld, s + 8192, tid);
    stage_rows<64>(it.v0 + (size_t)(kr >> 6) * (512 * 64), 64, s + NKI * 8192, tid);
    if (NVI == 2) stage_rows<64>(it.v1 + (size_t)(kr >> 6) * (512 * 64), 64, s + NKI * 8192 + 8192, tid);
  };
  stage(0); if (nt > 1) stage(1);
  const int l5 = lane & 31;
  const int prow = (l5 & 19) | ((l5 & 4) << 1) | ((l5 & 8) >> 1);
  int na_cs = na_c - 8; na_cs = na_cs < 0 ? 0 : (na_cs > GW - 16 ? GW - 16 : na_cs);
  for (int t = 0; t < nt; t++) {
    if (t + 1 < nt) { if (NIMG == 2) WAITV(2); else if (NIMG == 3) WAITV(3); else WAITV(4); } else WAITV(0);
    RAWBAR();
    if (t + 2 < nt) stage(t + 2);
    const bool active = (t >= it.nt0) || (t >= ta && t < tb);
    if (active) {
      const char* s = lds + (t % 3) * STG;
      const char* sv = s + NKI * 8192;
      h16x8 kf[2][DQK / 16];
#pragma unroll
      for (int kb = 0; kb < 2; kb++)
#pragma unroll
        for (int ks = 0; ks < DQK / 16; ks++) {
          const int img = (DQK == 96) ? (ks >> 2) : ksel;
          kf[kb][ks] = *(const h16x8*)(s + img * 8192 + img_off(32 * kb + prow, 2 * (ks & 3) + h));
        }
      __builtin_amdgcn_sched_barrier(0);
      f32x16 st[2];
#pragma unroll
      for (int kb = 0; kb < 2; kb++) {
#pragma unroll
        for (int r = 0; r < 16; r++) st[kb][r] = -m_run;
#pragma unroll
        for (int ks = 0; ks < DQK / 16; ks++) st[kb] = __builtin_amdgcn_mfma_f32_32x32x16_f16(kf[kb][ks], qf[ks], st[kb], 0, 0, 0);
      }
      __builtin_amdgcn_sched_barrier(0);
      h16x8 vf[2][4];
#pragma unroll
      for (int db = 0; db < 2; db++)
#pragma unroll
        for (int sI = 0; sI < 4; sI++) vf[db][sI] = *(const h16x8*)(sv + img_off(db * 32 + l5, 2 * sI + h));
      __builtin_amdgcn_sched_barrier(0);
      if (NAMASK && t < it.nt0) {
        const int drow = (na_dr0 + t) * 31 + 15 - na_c;
#pragma unroll
        for (int kb = 0; kb < 2; kb++)
#pragma unroll
          for (int r = 0; r < 16; r++) {
            const int kcol = 32 * kb + (r & 7) + 8 * h + 16 * (r >> 3);
            const bool valid = (unsigned)(kcol - na_cs) < 16u;
            const float bv = rpbl[valid ? drow + kcol : 0];
            st[kb][r] = valid ? st[kb][r] + bv : -1e30f;
          }
      }
      float mx;
      {
        float m0 = max3f(st[0][0], st[0][1], st[0][2]), m1 = max3f(st[1][0], st[1][1], st[1][2]);
#pragma unroll
        for (int r = 3; r < 15; r += 2) { m0 = max3f(m0, st[0][r], st[0][r + 1]); m1 = max3f(m1, st[1][r], st[1][r + 1]); }
        mx = max3f(m0, m1, st[0][15]); mx = fmaxf(mx, st[1][15]);
      }
      { auto sw = __builtin_amdgcn_permlane32_swap(__float_as_uint(mx), __float_as_uint(mx), false, false); mx = fmaxf(__uint_as_float(sw[0]), __uint_as_float(sw[1])); }
      if (first || !__all(mx <= 8.f)) {
        const float delta = first ? mx : fmaxf(mx, 0.f);
        const float al = __builtin_amdgcn_exp2f(-delta); m_run += delta; lsum *= al; first = false;
#pragma unroll
        for (int db = 0; db < NDB; db++)
#pragma unroll
          for (int r = 0; r < 16; r++) o[db][r] *= al;
#pragma unroll
        for (int kb = 0; kb < 2; kb++)
#pragma unroll
          for (int r = 0; r < 16; r++) st[kb][r] -= delta;
      }
      float sum = 0.f;
#pragma unroll
      for (int kb = 0; kb < 2; kb++)
#pragma unroll
        for (int r = 0; r < 16; r++) { float pe = __builtin_amdgcn_exp2f(st[kb][r]); st[kb][r] = pe; sum += pe; }
      lsum += sum;
      h16x8 pf[4];
#pragma unroll
      for (int sI = 0; sI < 4; sI++) {
        u32x4 pk;
#pragma unroll
        for (int j = 0; j < 4; j++) pk[j] = __builtin_bit_cast(unsigned, __builtin_amdgcn_cvt_pkrtz(st[sI >> 1][8 * (sI & 1) + 2 * j], st[sI >> 1][8 * (sI & 1) + 2 * j + 1]));
        pf[sI] = __builtin_bit_cast(h16x8, pk);
      }
      __builtin_amdgcn_sched_barrier(0);
      if (NDB == 4) {
        h16x8 vg[2][4];
#pragma unroll
        for (int db = 0; db < 2; db++)
#pragma unroll
          for (int sI = 0; sI < 4; sI++) vg[db][sI] = *(const h16x8*)(sv + 8192 + img_off(db * 32 + l5, 2 * sI + h));
#pragma unroll
        for (int db = 0; db < 2; db++)
#pragma unroll
          for (int sI = 0; sI < 4; sI++) o[db] = __builtin_amdgcn_mfma_f32_32x32x16_f16(vf[db][sI], pf[sI], o[db], 0, 0, 0);
#pragma unroll
        for (int db = 0; db < 2; db++)
#pragma unroll
          for (int sI = 0; sI < 4; sI++) o[NDB == 4 ? 2 + db : db] = __builtin_amdgcn_mfma_f32_32x32x16_f16(vg[db][sI], pf[sI], o[NDB == 4 ? 2 + db : db], 0, 0, 0);
      } else {
#pragma unroll
        for (int db = 0; db < 2; db++)
#pragma unroll
          for (int sI = 0; sI < 4; sI++) o[db] = __builtin_amdgcn_mfma_f32_32x32x16_f16(vf[db][sI], pf[sI], o[db], 0, 0, 0);
      }
      __builtin_amdgcn_sched_barrier(0);
    }
  }
  RAWBAR();
  lsum_out = lsum + __shfl_xor(lsum, 32);
}
template <int NDB>
DEVFN void attn_store_gated(const Params& p, const f32x16 (&o)[NDB], float inv, int m, int col0) {
  const int TIDX = tid_op();
  const int h = (TIDX & 63) >> 5;
#pragma unroll
  for (int db = 0; db < NDB; db++)
#pragma unroll
    for (int q = 0; q < 4; q++) {
      const int c = col0 + 32 * db + 8 * q + 4 * h;
      h16x4 g = *(const h16x4*)(p.gates16 + (size_t)m * 1024 + c), ov;
#pragma unroll
      for (int e = 0; e < 4; e++) ov[e] = (h16)(o[db][q * 4 + e] * inv * (float)g[e]);
      *(h16x4*)(p.O16 + pidx(M, m, c)) = ov;
    }
}
DEVFN void attn_even_item(const Params& p, int l, int item, char* lds) {
  const int TIDX = tid_op();
  const int i = l >> 1; const int lane = TIDX & 63, w = TIDX >> 6, h = lane >> 5;
  const int grp = item >> 7, j = item & 127; const bool smp = grp < 2; const bool isdiff = (grp & 1) == 0;
  AttnItem it{}; it.nt1 = 0; it.kr1 = 0;
  if (isdiff) {
    int b, hh, t0;
    if (smp) { b = j >> 6; hh = (j >> 4) & 3; t0 = (j & 15) * 128; it.kr0 = MP + b * TKS; it.nt0 = TKS / 64; }
    else { b = j >> 3; hh = (j >> 1) & 3; t0 = (j & 1) * 128; it.kr0 = b * SEQ; it.nt0 = SEQ / 64; }
    const int comp = w >> 2;
    const int m0w = (smp ? MP + b * DS : b * SEQ) + t0 + (w & 3) * 32;
    it.k0 = p.KB + (size_t)(2 * hh) * KM * 64; it.k1 = p.KB + (size_t)(2 * hh + 1) * KM * 64; it.kld = 64;
    it.v0 = p.VB + (size_t)(hh * 128) * 64; it.v1 = p.VB + (size_t)(hh * 128 + 64) * 64;
    f32x16 o[4]; float lsum;
    attn_core<64, 2, 2, 4, false>(it, p.QB + ((size_t)m0w * 8 + 2 * hh + comp) * 64, 512, comp, 0, 1 << 30, nullptr, 0, 0, lds, o, lsum);
    const float inv = 1.f / lsum;
    float* a2 = (float*)lds + (size_t)(w & 3) * 32 * 132 + (size_t)(lane & 31) * 132;
    if (comp == 1) {
#pragma unroll
      for (int db = 0; db < 4; db++)
#pragma unroll
        for (int q = 0; q < 4; q++) { f32x4 v = {o[db][q * 4] * inv, o[db][q * 4 + 1] * inv, o[db][q * 4 + 2] * inv, o[db][q * 4 + 3] * inv}; *(f32x4*)(a2 + 32 * db + 8 * q + 4 * h) = v; }
    }
    __syncthreads();
    if (comp == 0) {
      const float lam = p.lamv[i]; const float lam_init = 0.8f - 0.6f * expf(-0.3f * l);
      float ss = 0;
#pragma unroll
      for (int db = 0; db < 4; db++)
#pragma unroll
        for (int q = 0; q < 4; q++) {
          f32x4 v2 = *(const f32x4*)(a2 + 32 * db + 8 * q + 4 * h);
#pragma unroll
          for (int e = 0; e < 4; e++) { float d = o[db][q * 4 + e] * inv - lam * v2[e]; o[db][q * 4 + e] = d; ss += d * d; }
        }
      ss = wsum32(ss);
      const float rr = (1.f - lam_init) * frsq(ss * (1.f / 128.f) + EPSN);
      const int m = m0w + (lane & 31);
#pragma unroll
      for (int db = 0; db < 4; db++)
#pragma unroll
        for (int q = 0; q < 4; q++) {
          const int dv = 32 * db + 8 * q + 4 * h; const int c = 512 + hh * 128 + dv;
          f32x4 sg = *(const f32x4*)(p.diff_subln + i * 128 + dv);
          h16x4 g = *(const h16x4*)(p.gates16 + (size_t)m * 1024 + c), ov;
#pragma unroll
          for (int e = 0; e < 4; e++) ov[e] = (h16)(o[db][q * 4 + e] * rr * sg[e] * (float)g[e]);
          *(h16x4*)(p.O16 + pidx(M, m, c)) = ov;
        }
    }
    __syncthreads();
  } else {
    int b, head, t0;
    if (smp) { b = j >> 6; head = (j >> 3) & 7; t0 = (j & 7) * 256; it.kr0 = MP + b * TKS; it.nt0 = TKS / 64; }
    else { b = j >> 3; head = j & 7; t0 = 0; it.kr0 = b * SEQ; it.nt0 = SEQ / 64; }
    const int m0w = (smp ? MP + b * DS : b * SEQ) + t0 + w * 32;
    it.k0 = p.KA + (size_t)head * KM * 128; it.k1 = it.k0 + 64; it.kld = 128;
    it.v0 = p.VA + (size_t)(head * 64) * 64; it.v1 = it.v0;
    f32x16 o[2]; float lsum;
    attn_core<96, 2, 1, 2, false>(it, p.QA + ((size_t)m0w * 8 + head) * 96, 768, 0, 0, 1 << 30, nullptr, 0, 0, lds, o, lsum);
    attn_store_gated<2>(p, o, 1.f / lsum, m0w + (lane & 31), head * 64);
  }
}
DEVFN void attn_odd_item(const Params& p, int l, int item, char* lds) {
  const int TIDX = tid_op();
  const int i = l >> 1; const int lane = TIDX & 63, w = TIDX >> 6;
  const int grp = item >> 7, j = item & 127; const bool smp = grp < 2; const bool isgqa = (grp & 1) == 0;
  AttnItem it{}; it.nt1 = 0; it.kr1 = 0; it.kld = 64;
  f32x16 o[2]; float lsum;
  if (isgqa) {
    int b, kvh, t0;
    if (smp) { b = j >> 6; kvh = (j >> 5) & 1; t0 = (j & 31) * 64; it.kr0 = MP + b * TKS; it.nt0 = TKS / 64; }
    else { b = j >> 3; kvh = (j >> 2) & 1; t0 = (j & 3) * 64; it.kr0 = b * SEQ; it.nt0 = SEQ / 64; }
    const int head = kvh * 4 + (w >> 1);
    const int m0w = (smp ? MP + b * DS : b * SEQ) + t0 + (w & 1) * 32;
    it.k0 = p.KB + (size_t)kvh * KM * 64; it.k1 = it.k0; it.v0 = p.VB + (size_t)(kvh * 64) * 64; it.v1 = it.v0;
    attn_core<64, 1, 1, 2, false>(it, p.QB + ((size_t)m0w * 8 + head) * 64, 512, 0, 0, 1 << 30, nullptr, 0, 0, lds, o, lsum);
    attn_store_gated<2>(p, o, 1.f / lsum, m0w + (lane & 31), 512 + head * 64);
  } else if (!smp) {
    const int b = j >> 3, head = j & 7; it.kr0 = b * SEQ; it.nt0 = SEQ / 64;
    const int m0w = b * SEQ + w * 32;
    it.k0 = p.KA + (size_t)head * KM * 64; it.k1 = it.k0; it.v0 = p.VA + (size_t)(head * 64) * 64; it.v1 = it.v0;
    attn_core<64, 1, 1, 2, false>(it, p.QA + ((size_t)m0w * 8 + head) * 64, 512, 0, 0, 1 << 30, nullptr, 0, 0, lds, o, lsum);
    attn_store_gated<2>(p, o, 1.f / lsum, m0w + (lane & 31), head * 64);
  } else {
    const int b = j >> 6, head = (j >> 3) & 7, r0 = (j & 7) * 4;
    const int r = r0 + (w >> 1), c0 = (w & 1) * 32;
    auto rsf = [](int rr) { int s = rr - 4; return s < 0 ? 0 : (s > GROWS - 8 ? GROWS - 8 : s); };
    const int rlo = rsf(r0), rhi = rsf(r0 + 3) + 8;
    const int kbase = MP + b * TKS;
    it.kr0 = kbase + rlo * 64; it.nt0 = rhi - rlo; it.kr1 = kbase + DS; it.nt1 = PAST / 64;
    it.k0 = p.KA + (size_t)head * KM * 64; it.k1 = it.k0; it.v0 = p.VA + (size_t)(head * 64) * 64; it.v1 = it.v0;
    float* rpbl = (float*)(lds + A_RING);
    { const float* src = p.na_rpb + ((size_t)i * 8 + head) * 465; for (int k = TIDX; k < 465; k += 512) rpbl[k] = src[k] * LOG2E; }
    const int m0w = MP + b * DS + r * 64 + c0;
    const int ta = rsf(r) - rlo;
    attn_core<64, 1, 1, 2, true>(it, p.QA + ((size_t)m0w * 8 + head) * 64, 512, 0, ta, ta + 8, rpbl, rlo - r + 7, c0 + (lane & 31), lds, o, lsum);
    attn_store_gated<2>(p, o, 1.f / lsum, m0w + (lane & 31), head * 64);
  }
}
constexpr int G8_HTB = 128 * 64 * 2, G8_STAGE = 8 * G8_HTB;
DEVFN int g8_lds_byte(int r, int c) { const int st = (r >> 4) * 2 + (c >> 5), rr = r & 15, cc = c & 31, ob = rr * 64 + cc * 2; return st * 1024 + (ob ^ (((ob >> 9) & 1) << 5)); }
DEVFN void g8_stage_rc(int b, int& R, int& C) { const int st = b / 1024, sb = b % 1024, swz = sb ^ (((sb >> 9) & 1) << 5); R = (st >> 1) * 16 + swz / 64; C = (st & 1) * 32 + (swz % 64) / 2; }
DEVFN int g8_perm32(int rho) { const int n = rho >> 4, i = rho & 15; return 8 * (i >> 2) + 4 * n + (i & 3); }
struct G8Unit { int pm, pn; };
DEVFN bool g8_next(int i, int nM, int nN, int G, int c, G8Unit& u) {
  const int nwg = nM * nN; const long L = (long)i * G + c; if (L >= nwg) return false;
  int wgid = (int)L; { const int q = nwg / 8, r = nwg % 8, xcd = wgid % 8, off = wgid / 8; wgid = (xcd < r ? xcd * (q + 1) : r * (q + 1) + (xcd - r) * q) + off; }
  const int nig = 8 * nN, gid = wgid / nig, fm = gid * 8, gsz = (nM - fm) < 8 ? (nM - fm) : 8;
  u.pm = fm + ((wgid % nig) % gsz); u.pn = (wgid % nig) / gsz; return true;
}
template <class Epi>
DEVFN void gemm8_phase(LAS unsigned char* lds, const h16* A, int RA, const h16* Bt, int RB, int K, int nM, int nN, const Epi& E) {
  const int tid = tid_op(), wid = __builtin_amdgcn_readfirstlane(tid >> 6), lane = tid & 63, wr = wid >> 2, wc = wid & 3, fr = lane & 15, fq = lane >> 4;
  const int nt = K / 64; const int Gg = gridDim.x, cc = blockIdx.x;
  unsigned voffA[2], voffB[2];
#pragma unroll
  for (int i = 0; i < 2; ++i) { int R, C; g8_stage_rc(tid * 16 + i * 8192, R, C); const int Rb = (R & ~31) + g8_perm32(R & 31);
    voffA[i] = (unsigned)(R * 64 + C) * 2u; voffB[i] = (unsigned)(Rb * 64 + C) * 2u; }
  const size_t kstepA = (size_t)RA * 128, kstepB = (size_t)RB * 128;
  const size_t hstep = (size_t)128 * 128;
  const size_t tstep = 2 * hstep;
  const unsigned ldsw = (unsigned)wid * 1024u;
  const int aoff = g8_lds_byte(wr * 64 + fr, fq * 8), boff = g8_lds_byte(wc * 32 + fr, fq * 8);
#define G8_SA(b, h) (((b) * 2 + (h)) * G8_HTB)
#define G8_SB(b, h) ((4 + (b) * 2 + (h)) * G8_HTB)
#define G8_STAGE_(bufoff, gbase, voff) do { _Pragma("unroll") for (int _i = 0; _i < 2; ++_i) \
    __builtin_amdgcn_global_load_lds((const unsigned*)((const char*)(gbase) + (voff)[_i]), (LAS unsigned*)(lds + (bufoff) + ldsw + _i * 8192), 16, 0, 0); } while (0)
#define G8_LDA(dst, b, h) do { _Pragma("unroll") for (int m = 0; m < 4; ++m) _Pragma("unroll") for (int k = 0; k < 2; ++k) dst[m][k] = *(const LAS h16x8*)(lds + G8_SA(b, h) + aoff + m * 2048 + k * 1024); } while (0)
#define G8_LDB(dst, b, h) do { _Pragma("unroll") for (int n = 0; n < 2; ++n) _Pragma("unroll") for (int k = 0; k < 2; ++k) dst[n][k] = *(const LAS h16x8*)(lds + G8_SB(b, h) + boff + n * 2048 + k * 1024); } while (0)
#define G8_MMA(ai, bj, At, Bt_) do { __builtin_amdgcn_s_setprio(1); _Pragma("unroll") for (int m = 0; m < 4; ++m) _Pragma("unroll") for (int n = 0; n < 2; ++n) _Pragma("unroll") for (int k = 0; k < 2; ++k) \
    acc[ai][bj][m][n] = __builtin_amdgcn_mfma_f32_16x16x32_f16(Bt_[n][k], At[m][k], acc[ai][bj][m][n], 0, 0, 0); __builtin_amdgcn_s_setprio(0); } while (0)
#define G8_WAIT_L(n) asm volatile("s_waitcnt lgkmcnt(" #n ")" ::: "memory")
#define G8_BAR __builtin_amdgcn_s_barrier()
#define G8_SCHED __builtin_amdgcn_sched_barrier(0)
  G8Unit cur, nxt; int ui = 0;
  if (!g8_next(0, nM, nN, Gg, cc, cur)) return;
  f32x4 acc[2][2][4][2];
#pragma unroll
  for (int a = 0; a < 2; ++a)
#pragma unroll
    for (int b = 0; b < 2; ++b)
#pragma unroll
      for (int m = 0; m < 4; ++m)
#pragma unroll
        for (int n = 0; n < 2; ++n) acc[a][b][m][n] = (f32x4){0.f, 0.f, 0.f, 0.f};
  h16x8 At[4][2], B0[2][2], B1[2][2];
  const char* cA = (const char*)A + (size_t)cur.pm * tstep; const char* cB = (const char*)Bt + (size_t)cur.pn * tstep;
  G8_STAGE_(G8_SB(0, 0), cB, voffB); G8_STAGE_(G8_SA(0, 0), cA, voffA); G8_STAGE_(G8_SB(0, 1), cB + hstep, voffB); G8_STAGE_(G8_SA(0, 1), cA + hstep, voffA);
  if (wr == 1) G8_BAR;
  WAITV(4); G8_BAR;
  G8_STAGE_(G8_SB(1, 0), cB + kstepB, voffB); G8_STAGE_(G8_SA(1, 0), cA + kstepA, voffA); G8_STAGE_(G8_SB(1, 1), cB + hstep + kstepB, voffB);
  WAITV(6); G8_BAR;
  for (;;) {
    const bool has_next = g8_next(ui + 1, nM, nN, Gg, cc, nxt);
    const char* nA = has_next ? (const char*)A + (size_t)nxt.pm * tstep : cA; const char* nB = has_next ? (const char*)Bt + (size_t)nxt.pn * tstep : cB;
    for (int t = 0; t < nt; t += 2) {
      const bool last = (t == nt - 2);
      const char* a1 = cA + (size_t)(t + 1) * kstepA;
      const char* a2 = last ? nA : cA + (size_t)(t + 2) * kstepA; const char* b2 = last ? nB : cB + (size_t)(t + 2) * kstepB;
      const char* a3 = a2 + kstepA; const char* b3 = b2 + kstepB;
      G8_LDB(B0, 0, 0); G8_SCHED; G8_LDA(At, 0, 0); G8_STAGE_(G8_SA(1, 1), a1 + hstep, voffA);
      G8_WAIT_L(8); G8_BAR; G8_WAIT_L(0); G8_MMA(0, 0, At, B0); G8_BAR; G8_SCHED;
      G8_LDB(B1, 0, 1); G8_STAGE_(G8_SB(0, 0), b2, voffB);
      G8_BAR; G8_WAIT_L(0); G8_MMA(0, 1, At, B1); G8_BAR;
      G8_LDA(At, 0, 1); G8_STAGE_(G8_SA(0, 0), a2, voffA);
      G8_BAR; G8_WAIT_L(0); G8_MMA(1, 0, At, B0); G8_BAR; G8_SCHED;
      G8_STAGE_(G8_SB(0, 1), b2 + hstep, voffB);
      WAITV(6); G8_BAR; G8_MMA(1, 1, At, B1); G8_BAR;
      G8_LDB(B0, 1, 0); G8_SCHED; G8_LDA(At, 1, 0); G8_STAGE_(G8_SA(0, 1), a2 + hstep, voffA);
      G8_WAIT_L(8); G8_BAR; G8_WAIT_L(0); G8_MMA(0, 0, At, B0); G8_BAR; G8_SCHED;
      G8_LDB(B1, 1, 1); G8_STAGE_(G8_SB(1, 0), b3, voffB);
      G8_BAR; G8_WAIT_L(0); G8_MMA(0, 1, At, B1); G8_BAR;
      G8_LDA(At, 1, 1); G8_STAGE_(G8_SA(1, 0), a3, voffA);
      G8_BAR; G8_WAIT_L(0); G8_MMA(1, 0, At, B0); G8_BAR; G8_SCHED;
      G8_STAGE_(G8_SB(1, 1), b3 + hstep, voffB);
      WAITV(6); G8_BAR; G8_MMA(1, 1, At, B1); G8_BAR;
    }
#pragma unroll 1
    for (int e_ = 0; e_ < REP_EPI; e_++)
    E(acc, cur, wr, wc, fr, fq, e_ > 0);
    if (!has_next) break;
#pragma unroll
    for (int a = 0; a < 2; ++a)
#pragma unroll
      for (int b = 0; b < 2; ++b)
#pragma unroll
        for (int m = 0; m < 4; ++m)
#pragma unroll
          for (int n = 0; n < 2; ++n) acc[a][b][m][n] = (f32x4){0.f, 0.f, 0.f, 0.f};
    cur = nxt; cA = nA; cB = nB; ++ui;
  }
  WAITV(0);
  if (wr == 0) G8_BAR;
  G8_BAR;
#undef G8_SA
#undef G8_SB
#undef G8_STAGE_
#undef G8_LDA
#undef G8_LDB
#undef G8_MMA
#undef G8_WAIT_L
#undef G8_BAR
#undef G8_SCHED
}

DEVFN float fq_sum(float v) {
  auto a = __builtin_amdgcn_permlane16_swap(__float_as_uint(v), __float_as_uint(v), false, false); v = __uint_as_float(a[0]) + __uint_as_float(a[1]);
  auto b = __builtin_amdgcn_permlane32_swap(__float_as_uint(v), __float_as_uint(v), false, false); return __uint_as_float(b[0]) + __uint_as_float(b[1]);
}
struct InprojEpi {
  const Params& p; int l; bool dry; LAS unsigned char* scratch;
  DEVFN void operator()(const f32x4 (&acc)[2][2][4][2], const G8Unit& u_, int wr, int wc, int fr_, int fq_, bool dry2) const {
    int fr = fr_, fq = fq_; G8Unit u = u_;
    asm volatile("" : "+v"(fr), "+v"(fq), "+s"(u.pm), "+s"(u.pn));
    const int lane = fr + 16 * fq;
    const int i = l >> 1; const bool odd = l & 1;
    const int G = 4 * u.pn + wc;
    LAS unsigned char* tbase = scratch + (wr * 4 + wc) * 3072;
    const int m0 = u.pm * 256; const bool smp = m0 >= MP;
    enum { T_PAD, T_GATE, T_QHEAD, T_KHEAD, T_VT, T_QA, T_CKV, T_KPE };
    int ty = T_PAD, gcol = 0, head = 0, spitch = 0, scol = 0; bool rope = false; float oscale = 1.f;
    const float* gain = nullptr; float* state = nullptr; h16* qdst = nullptr; h16* kbuf = nullptr; h16* vbuf = nullptr;
    const float QS = LOG2E / 8.f;
    if (!odd) {
      if (G < 4) ty = T_QA;
      else if (G < 6) ty = T_CKV;
      else if (G == 6) { ty = T_KPE; gain = p.mla_kn_rope + i * 32; }
      else if (G == 7) ty = T_PAD;
      else if (G < 16) { ty = T_GATE; gcol = (G - 8) * 64; }
      else if (G < 24) { ty = T_QHEAD; head = G - 16; gain = p.diff_qn + i * 64; rope = true; oscale = QS; qdst = p.QB; }
      else if (G < 32) { ty = T_KHEAD; head = G - 24; gain = p.diff_kn + i * 64; rope = true; state = p.o_dk; spitch = 512; scol = head * 64; kbuf = p.KB; }
      else if (G < 40) { ty = T_VT; head = G - 32; state = p.o_dv; spitch = 512; scol = head * 64; vbuf = p.VB; }
      else { ty = T_GATE; gcol = 512 + (G - 40) * 64; }
    } else {
      if (G < 8) { ty = T_QHEAD; head = G; gain = p.na_qn + i * 64; oscale = QS; qdst = p.QA; }
      else if (G < 16) { ty = T_KHEAD; head = G - 8; gain = p.na_kn + i * 64; state = p.o_nk; spitch = 512; scol = head * 64; kbuf = p.KA; }
      else if (G < 24) { ty = T_VT; head = G - 16; state = p.o_nv; spitch = 512; scol = head * 64; vbuf = p.VA; }
      else if (G < 32) { ty = T_GATE; gcol = (G - 24) * 64; }
      else if (G < 40) { ty = T_QHEAD; head = G - 32; gain = p.gqa_qn + i * 64; rope = true; oscale = QS; qdst = p.QB; }
      else if (G < 42) { ty = T_KHEAD; head = G - 40; gain = p.gqa_kn + i * 64; rope = true; state = p.o_gk; spitch = 128; scol = head * 64; kbuf = p.KB; }
      else if (G < 44) { ty = T_VT; head = G - 42; state = p.o_gv; spitch = 128; scol = head * 64; vbuf = p.VB; }
      else { ty = T_GATE; gcol = 512 + (G - 44) * 64; }
    }
    if (ty == T_PAD) return;
    LAS float* cst = (LAS float*)(tbase + 2048);
    {
      const float* rowss = p.rowss_l + (size_t)l * M + m0 + 64 * wr;
      const float s0 = rowss[lane], s1 = rowss[128 + lane];
      const float bv = p.biasv[((size_t)l * NCV + tok_cv(m0)) * NPO + 256 * u.pn + 32 * wc + 128 * (lane >> 5) + (lane & 31)];
      const bool hasg = gain != nullptr && (ty != T_KPE || lane < 32);
      const float gv = hasg ? gain[lane] : 1.f;
      cst[lane] = frsq(s0 * (1.f / D) + EPSN); cst[64 + lane] = frsq(s1 * (1.f / D) + EPSN);
      cst[128 + lane] = bv; cst[192 + lane] = gv;
    }
    const bool roped = rope && smp;
    float invf[2][4];
    if (roped || (ty == T_KPE && smp)) {
      const float step = ty == T_KPE ? (2.f / 16.f) : (2.f / 32.f);
#pragma unroll
      for (int n = 0; n < 2; n++)
#pragma unroll
        for (int j = 0; j < 4; j++) {
          const int jj = ty == T_KPE ? (8 * (fq & 1) + 4 * n + j) & 7 : (8 * fq + 4 * n + j) & 15;
          invf[n][j] = __builtin_amdgcn_exp2f(-13.287712379549449f * step * (float)jj) * 0.15915494309189535f;
        }
    }
#pragma unroll
    for (int ai = 0; ai < 2; ai++)
#pragma unroll
      for (int m = 0; m < 4; m++) {
        const int r = m0 + 128 * ai + 64 * wr + 16 * m + fr;
        const float rs = cst[ai * 64 + m * 16 + fr];
        float v[2][2][4];
#pragma unroll
        for (int bj = 0; bj < 2; bj++)
#pragma unroll
          for (int n = 0; n < 2; n++) {
            const f32x4 b = *(const LAS f32x4*)(cst + 128 + 32 * bj + 8 * fq + 4 * n);
#pragma unroll
            for (int j = 0; j < 4; j++) v[bj][n][j] = acc[ai][bj][m][n][j] * rs + b[j];
          }
        float c2[2][4], s2[2][4];
        if (roped) {
          const int t = tok_pos(r); const float base = (float)(fq < 2 ? (t >> 6) : (t & 63));
#pragma unroll
          for (int n = 0; n < 2; n++)
#pragma unroll
            for (int j = 0; j < 4; j++) { const float x = base * invf[n][j]; c2[n][j] = __builtin_amdgcn_cosf(x); s2[n][j] = __builtin_amdgcn_sinf(x); }
        }
        if (ty == T_GATE) {
#pragma unroll
          for (int bj = 0; bj < 2; bj++) {
            h16x8 o;
#pragma unroll
            for (int n = 0; n < 2; n++)
#pragma unroll
              for (int j = 0; j < 4; j++) o[n * 4 + j] = (h16)fsilu(v[bj][n][j]);
            *(h16x8*)(p.gates16 + (size_t)r * 1024 + gcol + 32 * bj + 8 * fq) = o;
          }
        } else if (ty == T_QHEAD || ty == T_KHEAD) {
          float ss = 0;
#pragma unroll
          for (int bj = 0; bj < 2; bj++)
#pragma unroll
            for (int n = 0; n < 2; n++)
#pragma unroll
              for (int j = 0; j < 4; j++) ss += v[bj][n][j] * v[bj][n][j];
          ss = fq_sum(ss);
          const float rr = frsq(ss * (1.f / 64.f) + EPSN);
#pragma unroll
          for (int bj = 0; bj < 2; bj++)
#pragma unroll
            for (int n = 0; n < 2; n++) {
              const f32x4 g = *(const LAS f32x4*)(cst + 192 + 32 * bj + 8 * fq + 4 * n);
#pragma unroll
              for (int j = 0; j < 4; j++) v[bj][n][j] *= rr * g[j];
            }
          if (state && !smp) {
            float* sp = state + st_row(r, i) * spitch + scol + 8 * fq;
#pragma unroll
            for (int bj = 0; bj < 2; bj++)
#pragma unroll
              for (int n = 0; n < 2; n++) { f32x4 o = {v[bj][n][0], v[bj][n][1], v[bj][n][2], v[bj][n][3]}; *(f32x4*)(sp + 32 * bj + 4 * n) = o; }
          }
          if (roped) {
#pragma unroll
            for (int n = 0; n < 2; n++)
#pragma unroll
              for (int j = 0; j < 4; j++) { const float x1 = v[0][n][j], x2 = v[1][n][j]; v[0][n][j] = x1 * c2[n][j] - x2 * s2[n][j]; v[1][n][j] = x2 * c2[n][j] + x1 * s2[n][j]; }
          }
          h16* dst = ty == T_QHEAD ? qdst + ((size_t)r * 8 + head) * 64 : kbuf + ((size_t)head * KM + tok_keyrow(r)) * 64;
#pragma unroll
          for (int bj = 0; bj < 2; bj++) {
            h16x8 o;
#pragma unroll
            for (int n = 0; n < 2; n++)
#pragma unroll
              for (int j = 0; j < 4; j++) o[n * 4 + j] = (h16)(v[bj][n][j] * oscale);
            *(h16x8*)(dst + 32 * bj + 8 * fq) = o;
          }
        } else if (ty == T_VT) {
          const int kr = tok_keyrow(r);
          if (!smp) {
            float* sp = state + st_row(r, i) * spitch + scol + 8 * fq;
#pragma unroll
            for (int bj = 0; bj < 2; bj++)
#pragma unroll
              for (int n = 0; n < 2; n++) { f32x4 o = {v[bj][n][0], v[bj][n][1], v[bj][n][2], v[bj][n][3]}; *(f32x4*)(sp + 32 * bj + 4 * n) = o; }
          }
          {
            LAS h16* tb = (LAS h16*)(tbase);
#pragma unroll
            for (int bj = 0; bj < 2; bj++)
#pragma unroll
              for (int n = 0; n < 2; n++)
#pragma unroll
                for (int j = 0; j < 4; j++) tb[(32 * bj + 8 * fq + 4 * n + j) * 16 + fr] = (h16)v[bj][n][j];
            const h16x8 lo = *(const LAS h16x8*)(tb + lane * 16), hi = *(const LAS h16x8*)(tb + lane * 16 + 8);
            h16* dstv = vbuf + vidx(head * 64 + lane, kr - fr);
            *(h16x8*)dstv = lo; *(h16x8*)(dstv + 8) = hi;
          }
        } else if (ty == T_QA) {
          float ss = 0;
#pragma unroll
          for (int bj = 0; bj < 2; bj++) {
            h16x8 o;
#pragma unroll
            for (int n = 0; n < 2; n++)
#pragma unroll
              for (int j = 0; j < 4; j++) { o[n * 4 + j] = (h16)v[bj][n][j]; const float xr = (float)o[n * 4 + j]; ss += xr * xr; }
            *(h16x8*)(p.qa16 + pidx(M, r, 64 * G + 32 * bj + 8 * fq)) = o;
          }
          ss = fq_sum(ss);
          if (fq == 0 && !dry && !dry2) atomicAdd(p.rowss_qa + (size_t)i * M + r, ss);
        } else if (ty == T_CKV) {
          const int kr = tok_keyrow(r);
          float ss = 0;
#pragma unroll
          for (int bj = 0; bj < 2; bj++) {
            h16x8 o;
#pragma unroll
            for (int n = 0; n < 2; n++)
#pragma unroll
              for (int j = 0; j < 4; j++) { o[n * 4 + j] = (h16)v[bj][n][j]; const float xr = (float)o[n * 4 + j]; ss += xr * xr; }
            *(h16x8*)(p.ckv16 + pidx(KM, kr, 64 * (G - 4) + 32 * bj + 8 * fq)) = o;
          }
          ss = fq_sum(ss);
          if (fq == 0 && !dry && !dry2) atomicAdd(p.rowss_ckv + (size_t)i * KM + kr, ss);
        } else {
          float ss = 0;
#pragma unroll
          for (int n = 0; n < 2; n++)
#pragma unroll
            for (int j = 0; j < 4; j++) ss += v[0][n][j] * v[0][n][j];
          ss = fq_sum(ss);
          const float rr = frsq(ss * (1.f / 32.f) + EPSN);
          float w[2][4];
#pragma unroll
          for (int n = 0; n < 2; n++) {
            const f32x4 g = *(const LAS f32x4*)(cst + 192 + 8 * fq + 4 * n);
#pragma unroll
            for (int j = 0; j < 4; j++) w[n][j] = v[0][n][j] * rr * g[j];
          }
          if (!smp) {
            float* sp = p.o_kpe + st_row(r, i) * 32 + 8 * fq;
#pragma unroll
            for (int n = 0; n < 2; n++) { f32x4 o = {w[n][0], w[n][1], w[n][2], w[n][3]}; *(f32x4*)(sp + 4 * n) = o; }
          } else {
            const int t = tok_pos(r); const float base = (float)((fq & 1) == 0 ? (t >> 6) : (t & 63));
#pragma unroll
            for (int n = 0; n < 2; n++)
#pragma unroll
              for (int j = 0; j < 4; j++) {
                const float x = base * invf[n][j]; const float c = __builtin_amdgcn_cosf(x), s = __builtin_amdgcn_sinf(x);
                const float own = w[n][j], oth = __shfl_xor(own, 32);
                w[n][j] = fq < 2 ? own * c - oth * s : own * c + oth * s;
              }
          }
          h16x8 o;
#pragma unroll
          for (int n = 0; n < 2; n++)
#pragma unroll
            for (int j = 0; j < 4; j++) o[n * 4 + j] = (h16)w[n][j];
          *(h16x8*)(p.kpe16 + (size_t)tok_keyrow(r) * 32 + 8 * fq) = o;
        }
      }
  }
};
struct NullEpi {
  DEVFN void operator()(const f32x4 (&acc)[2][2][4][2], const G8Unit&, int, int, int, int, bool) const {
#pragma unroll
    for (int a = 0; a < 2; a++)
#pragma unroll
      for (int b = 0; b < 2; b++)
#pragma unroll
        for (int m = 0; m < 4; m++) asm volatile("" :: "v"(acc[a][b][m][0]), "v"(acc[a][b][m][1]));
  }
};
DEVFN int inproj_pos_col(int np) { const int pn = np >> 8, bj = (np >> 7) & 1, wc = (np >> 5) & 3, g = np & 31; return 64 * (4 * pn + wc) + 32 * bj + g; }

#define XB_TMO      128
#define XB_XCNT(j)  (256  + 64 * (j))
#define XB_XSUB(j)  (1280 + 64 * (j))
#define XB_XGEN(j)  (2304 + 64 * (j))
#define XB_TOP      3328
#define XB_TOPGEN   3392
#define XCD_BAR_WORDS 3456
#define XB_SPIN_CAP (1u << 20)
DEVFN unsigned xb_ld(unsigned* p) { return __hip_atomic_load(p, __ATOMIC_RELAXED, __HIP_MEMORY_SCOPE_AGENT); }
DEVFN unsigned xb_add(unsigned* p, unsigned v) { return __hip_atomic_fetch_add(p, v, __ATOMIC_RELAXED, __HIP_MEMORY_SCOPE_AGENT); }
DEVFN unsigned xb_xcc_id() { return (unsigned)__builtin_amdgcn_s_getreg((3 << 11) | 20) & 0xFu; }
#define XB_SPIN(cond, bar) do { unsigned _sp = 0; while (cond) { __builtin_amdgcn_s_sleep(1); \
    if ((++_sp & 255u) == 0u) { if (xb_ld(&(bar)[XB_TMO])) break; if (_sp > XB_SPIN_CAP) { atomicAdd(&(bar)[XB_TMO], 1u); break; } } } } while (0)
struct XcdBarrier { unsigned* bar; unsigned x; volatile LAS unsigned* st; };
DEVFN XcdBarrier xcd_barrier_post(unsigned* bar, volatile LAS unsigned* st) {
  const int TIDX = tid_op();
  XcdBarrier b; b.bar = bar; b.x = xb_xcc_id(); b.st = st;
  if (TIDX == 0) (void)xb_add(&bar[XB_XCNT(b.x)], 1u);
  return b;
}
DEVFN void xcd_barrier_complete(unsigned* bar, unsigned x, unsigned& nloc, unsigned& nx) {
  const unsigned G = gridDim.x * gridDim.y * gridDim.z;
  unsigned sum, cnt, mine, sp = 0u;
  for (;;) {
    sum = 0u; cnt = 0u; mine = 0u;
#pragma unroll
    for (unsigned j = 0; j < 16; ++j) { const unsigned c = xb_ld(&bar[XB_XCNT(j)]); sum += c; cnt += (c > 0u) ? 1u : 0u; mine = (j == x) ? c : mine; }
    if (sum == G) break;
    __builtin_amdgcn_s_sleep(1);
    if ((++sp & 255u) == 0u) { if (xb_ld(&bar[XB_TMO])) break; if (sp > XB_SPIN_CAP) { atomicAdd(&bar[XB_TMO], 1u); break; } }
  }
  nloc = mine > 0u ? mine : 1u; nx = cnt > 0u ? cnt : 1u;
}
DEVFN void xcd_barrier(const XcdBarrier& b) {
  const int TIDX = tid_op();
  asm volatile("s_waitcnt vmcnt(0)" ::: "memory");
  __syncthreads();
  if (TIDX == 0) {
    unsigned* bar = b.bar;
    __builtin_amdgcn_s_waitcnt(0);
    unsigned nloc = b.st[0], nx = b.st[1];
    if (nloc == 0u) { xcd_barrier_complete(bar, b.x, nloc, nx); b.st[0] = nloc; b.st[1] = nx; }
    const unsigned old = xb_add(&bar[XB_XSUB(b.x)], 1u);
    const unsigned gen = old / nloc;
    if (old + 1u == (gen + 1u) * nloc) {
      __builtin_amdgcn_fence(__ATOMIC_RELEASE, "agent");
      asm volatile("s_waitcnt vmcnt(0)" ::: "memory");
      const unsigned og = xb_add(&bar[XB_TOP], 1u);
      const unsigned tg = og / nx;
      if (og + 1u == (tg + 1u) * nx) xb_add(&bar[XB_TOPGEN], 1u);
      else XB_SPIN(xb_ld(&bar[XB_TOPGEN]) == tg, bar);
      __builtin_amdgcn_fence(__ATOMIC_ACQUIRE, "agent");
      xb_add(&bar[XB_XGEN(b.x)], 1u);
      asm volatile("s_waitcnt vmcnt(0)" ::: "memory");
    } else {
      XB_SPIN(xb_ld(&bar[XB_XGEN(b.x)]) == gen, bar);
      __builtin_amdgcn_fence(__ATOMIC_ACQUIRE, "agent");
      asm volatile("s_waitcnt vmcnt(0)" ::: "memory");
    }
  }
  __syncthreads();
}

DEVFN void cache_ckv_all(const Params& p, int l, int gtid, int gthreads) {
  const int i = l >> 1;
  for (int e = gtid; e < DB * PAST * 20; e += gthreads) {
    const int c8 = e % 20, pos = (e / 20) % PAST, b = e / (20 * PAST);
    const int kr = MP + b * TKS + DS + pos; const size_t crow = ((size_t)(b * 2 + i) * PAST + pos);
    h16x8 o;
    if (c8 < 16) {
      const f32x4 a0 = *(const f32x4*)(p.cache_mla_ckv + crow * 128 + c8 * 8), a1 = *(const f32x4*)(p.cache_mla_ckv + crow * 128 + c8 * 8 + 4);
      const f32x4 g0 = *(const f32x4*)(p.mla_kva_norm + i * 128 + c8 * 8), g1 = *(const f32x4*)(p.mla_kva_norm + i * 128 + c8 * 8 + 4);
#pragma unroll
      for (int j = 0; j < 4; j++) { o[j] = (h16)(a0[j] * __builtin_amdgcn_rcpf(g0[j])); o[4 + j] = (h16)(a1[j] * __builtin_amdgcn_rcpf(g1[j])); }
      *(h16x8*)(p.ckv16 + pidx(KM, kr, c8 * 8)) = o;
      if (c8 == 0) p.rowss_ckv[(size_t)i * KM + kr] = 128.f * (1.f - EPSN);
    } else {
      const f32x4 a0 = *(const f32x4*)(p.cache_mla_kpe + crow * 32 + (c8 - 16) * 8), a1 = *(const f32x4*)(p.cache_mla_kpe + crow * 32 + (c8 - 16) * 8 + 4);
#pragma unroll
      for (int j = 0; j < 4; j++) { o[j] = (h16)a0[j]; o[4 + j] = (h16)a1[j]; }
      *(h16x8*)(p.kpe16 + (size_t)kr * 32 + (c8 - 16) * 8) = o;
    }
  }
}
DEVFN void cache_items(const Params& p, int l, int gtid, int gthreads) {
  const int i = l >> 1;
  if ((l & 1) == 0) {
    const int per = 128 + 32 + 512 + 512;
    for (int e = gtid; e < DB * PAST * per; e += gthreads) {
      const int u = e % per; const int bp = e / per; const int pos = bp % PAST, b = bp / PAST;
      const int kr = MP + b * TKS + DS + pos; const size_t crow = ((size_t)(b * 2 + i) * PAST + pos);
      if (u < 160) { }
      else if (u < 672) { const int c = u - 160; p.KB[((size_t)(c >> 6) * KM + kr) * 64 + (c & 63)] = (h16)p.cache_diff_k[crow * 512 + c]; }
      else { const int c = u - 672; p.VB[vidx(c, kr)] = (h16)p.cache_diff_v[crow * 512 + c]; }
    }
  } else {
    const int per = 512 + 512 + 128 + 128;
    for (int e = gtid; e < DB * PAST * per; e += gthreads) {
      const int u = e % per; const int bp = e / per; const int pos = bp % PAST, b = bp / PAST;
      const int kr = MP + b * TKS + DS + pos; const size_t crow = ((size_t)(b * 2 + i) * PAST + pos);
      if (u < 512) p.KA[((size_t)(u >> 6) * KM + kr) * 64 + (u & 63)] = (h16)p.cache_na_k[crow * 512 + u];
      else if (u < 1024) { const int c = u - 512; p.VA[vidx(c, kr)] = (h16)p.cache_na_v[crow * 512 + c]; }
      else if (u < 1152) { const int c = u - 1024; p.KB[((size_t)(c >> 6) * KM + kr) * 64 + (c & 63)] = (h16)p.cache_gqa_k[crow * 128 + c]; }
      else { const int c = u - 1152; p.VB[vidx(c, kr)] = (h16)p.cache_gqa_v[crow * 128 + c]; }
    }
  }
}

DEVFN void mod_item(const Params& p, int item, char* lds, bool dry = false) {
  const int tid = tid_op();
  const int l = item / 96, rem = item % 96, nchunk = rem / 16, kc = rem % 16;
  float* sil = (float*)lds;
  if (tid < NCV * 64) { const int cv = tid >> 6, k = tid & 63; const float* cvec = cv == 0 ? p.c_ctx : p.c + (size_t)(cv - 1) * D; sil[tid] = siluf(cvec[kc * 64 + k]); }
  __syncthreads();
  const int col = nchunk * 512 + tid;
  const float* w = p.w_mod + ((size_t)l * D + kc * 64) * 3072 + col;
  float acc[NCV];
#pragma unroll
  for (int c = 0; c < NCV; c++) acc[c] = 0.f;
#pragma unroll 16
  for (int k = 0; k < 64; k++) {
    const float wv = w[(size_t)k * 3072];
#pragma unroll
    for (int c = 0; c < NCV; c++) acc[c] += sil[c * 64 + k] * wv;
  }
  const float b = kc == 0 ? p.b_mod[l * 3072 + col] : 0.f;
#pragma unroll
  for (int c = 0; c < NCV; c++) if (!dry) atomicAdd(p.modv + ((size_t)l * NCV + c) * 3072 + col, acc[c] + b);
  __syncthreads();
}
DEVFN void conv_tile(const float* src, h16* dst, int R, int Nsrc, int mode, const float* kscale, bool has_scale, int nb, int kb, char* lds) {
  const int tid = tid_op();
  float (*t)[65] = (float (*)[65])lds;
  {
    const int j = tid & 63; const int np = nb + j; int col;
    if (mode == 0) col = np; else if (mode == 1) col = even_col(np); else if (mode == 4) col = even_col(inproj_pos_col(np)); else if (mode == 5) col = inproj_pos_col(np); else if (mode == 3) { int hh = (np & 511) >> 6; col = hh * 128 + (np >> 9) * 64 + (np & 63); } else { int h = np >> 7, jj = np & 127; col = jj < 96 ? h * 96 + jj : -1; }
    const int colc = col < 0 ? 0 : col; const float msk = col < 0 ? 0.f : 1.f;
    float v[8];
#pragma unroll
    for (int i = 0; i < 8; i++) v[i] = src[(size_t)(kb + (tid >> 6) + 8 * i) * Nsrc + colc];
    if (has_scale) {
#pragma unroll
      for (int i = 0; i < 8; i++) v[i] *= kscale[kb + (tid >> 6) + 8 * i];
    }
#pragma unroll
    for (int i = 0; i < 8; i++) t[(tid >> 6) + 8 * i][j] = v[i] * msk;
  }
  __syncthreads();
  {
    const int kk = tid & 63;
#pragma unroll
    for (int i = 0; i < 8; i++) { const int j = (tid >> 6) + 8 * i; dst[pidx(R, nb + j, kb + kk)] = (h16)t[kk][j]; }
  }
  __syncthreads();
}
constexpr int CV_WIN_E = (NPE / 64) * 16, CV_WIN_O = (NPO / 64) * 16, CV_WOUT = 256, CV_WQB = 64, CV_WKVB = 32;
constexpr int CV_PER_PAIR = CV_WIN_E + CV_WIN_O + 2 * CV_WOUT + CV_WQB + CV_WKVB;
constexpr int CV_TOTAL = 2 * CV_PER_PAIR;
DEVFN void conv_item(const Params& p, int item, char* lds) {
  const int i = item / CV_PER_PAIR; int r = item % CV_PER_PAIR;
  if (r < CV_WIN_E) { conv_tile(p.w_in_even + (size_t)i * D * EVEN_IN, p.win16 + (size_t)(2 * i) * NPO * D, NPO, EVEN_IN, 4, nullptr, false, (r % (NPE / 64)) * 64, (r / (NPE / 64)) * 64, lds); return; }
  r -= CV_WIN_E;
  if (r < CV_WIN_O) { conv_tile(p.w_in_odd + (size_t)i * D * ODD_IN, p.win16 + (size_t)(2 * i + 1) * NPO * D, NPO, ODD_IN, 5, nullptr, false, (r % (NPO / 64)) * 64, (r / (NPO / 64)) * 64, lds); return; }
  r -= CV_WIN_O;
  if (r < CV_WOUT) { conv_tile(p.w_out_even + (size_t)i * D * D, p.wout16 + (size_t)(2 * i) * D * D, 1024, D, 0, nullptr, false, (r % 16) * 64, (r / 16) * 64, lds); return; }
  r -= CV_WOUT;
  if (r < CV_WOUT) { conv_tile(p.w_out_odd + (size_t)i * D * D, p.wout16 + (size_t)(2 * i + 1) * D * D, 1024, D, 0, nullptr, false, (r % 16) * 64, (r / 16) * 64, lds); return; }
  r -= CV_WOUT;
  if (r < CV_WQB) { conv_tile(p.mla_wqb + (size_t)i * 256 * 768, p.wqb16 + (size_t)i * 1024 * 256, 1024, 768, 2, p.mla_qa_norm + i * 256, true, (r % 16) * 64, (r / 16) * 64, lds); return; }
  r -= CV_WQB;
  conv_tile(p.mla_wkvb + (size_t)i * 128 * 1024, p.wkvb16 + (size_t)i * 1024 * 128, 1024, 1024, 3, p.mla_kva_norm + i * 128, true, (r % 16) * 64, (r / 16) * 64, lds);
}
DEVFN void tab_items(const Params& p, int gtid, int gthreads) {
  for (int g = gtid; g < DS * 48; g += gthreads) {
    if (g < 2) {
      const int i = g, l = 2 * i; float s1 = 0, s2 = 0;
      for (int k = 0; k < 64; k++) { s1 += p.diff_lq1[i * 64 + k] * p.diff_lk1[i * 64 + k]; s2 += p.diff_lq2[i * 64 + k] * p.diff_lk2[i * 64 + k]; }
      p.lamv[i] = expf(s1) - expf(s2) + (0.8f - 0.6f * expf(-0.3f * l));
    }
    const int t = g / 48, j = g % 48;
    const float row = (float)(t / GW), col = (float)(t % GW);
    if (j < 32) { const int f = j & 15; const float inv = powf(10000.f, -(float)(2 * f) / 32.f); const float ang = (j < 16 ? row : col) * inv; p.ropeC64[t * 32 + j] = cosf(ang); p.ropeS64[t * 32 + j] = sinf(ang); }
    else { const int jj = j - 32; const int f = jj & 7; const float inv = powf(10000.f, -(float)(2 * f) / 16.f); const float ang = (jj < 8 ? row : col) * inv; p.ropeC32[t * 16 + jj] = cosf(ang); p.ropeS32[t * 16 + jj] = sinf(ang); }
  }
}
DEVFN void bias_row(const Params& p, int l, int np, int lane) {
  const h16* w = p.win16 + (size_t)l * NPO * D;
  float a[NCV];
#pragma unroll
  for (int c = 0; c < NCV; c++) a[c] = 0;
#pragma unroll
  for (int i = 0; i < 2; i++) {
    const int k = (i * 64 + lane) * 8; h16x8 wv = *(const h16x8*)(w + pidx(NPO, np, k));
#pragma unroll
    for (int c = 0; c < NCV; c++) { const float* sh = p.modv + ((size_t)l * NCV + c) * 3072 + k;
#pragma unroll
      for (int e = 0; e < 8; e++) a[c] += sh[e] * (float)wv[e]; }
  }
#pragma unroll
  for (int c = 0; c < NCV; c++) { float v = a[c]; for (int o = 32; o; o >>= 1) v += __shfl_xor(v, o); if (lane == 0) p.biasv[((size_t)l * NCV + c) * NPO + np] = v; }
}
DEVFN void prepx_row(const Params& p, int l, int m, int lane) {
  const float* x = xrow(p, l, m); const float* md = p.modv + ((size_t)l * NCV + tok_cv(m)) * 3072 + 1024; const float* nw = p.norm_w + l * D;
  float ss = 0;
#pragma unroll
  for (int i = 0; i < 4; i++) {
    const int k = (i * 64 + lane) * 4;
    f32x4 v = *(const f32x4*)(x + k); f32x4 s = *(const f32x4*)(md + k); f32x4 w = *(const f32x4*)(nw + k);
    h16x4 o;
#pragma unroll
    for (int e = 0; e < 4; e++) { ss += v[e] * v[e]; o[e] = (h16)(v[e] * w[e] * (1.f + s[e])); }
    *(h16x4*)(p.xs16 + pidx(M, m, k)) = o;
  }
  for (int o = 32; o; o >>= 1) ss += __shfl_xor(ss, o);
  if (lane == 0) p.rowss_l[(size_t)l * M + m] = ss;
}
#define AS4 __attribute__((address_space(4)))
#define PHASE_PARAMS(q) const Params& q = p_unused;
__global__ void __launch_bounds__(512) mega_kernel(Params p_unused) {
  __shared__ __attribute__((aligned(16))) char lds[G_LDS2 + 16];
  if (threadIdx.x == 0) { volatile LAS unsigned* st = (volatile LAS unsigned*)(lds + G_LDS2); st[0] = 0u; st[1] = 0u; st[2] = 0u; st[3] = 0u; }
  __syncthreads();
  XcdBarrier bar;
  { PHASE_PARAMS(p); bar = xcd_barrier_post(p.bar, (volatile LAS unsigned*)(lds + G_LDS2)); }
  const int nb = gridDim.x, bid = blockIdx.x;
  LAS unsigned char* ldsa = (LAS unsigned char*)lds;
  { PHASE_PARAMS(p);
    for (int rep = 0; rep < REP_0A; rep++)
    for (int it = bid; it < 384 + CV_PER_PAIR; it += nb) { if (it < 384) mod_item(p, it, lds, rep > 0); else conv_item(p, it - 384, lds); }
    tab_items(p, bid * 512 + tid_op(), nb * 512); }
  xcd_barrier(bar);
  { PHASE_PARAMS(p);
    const int tid = tid_op(); const int lane = tid & 63, gw = bid * 8 + (tid >> 6), nw = nb * 8;
    for (int rep = 0; rep < REP_0B; rep++)
    for (int r = gw; r < (NPE + NPO) + M; r += nw) {
      if (r < NPE + NPO) bias_row(p, r < NPE ? 0 : 1, r < NPE ? r : r - NPE, lane);
      else prepx_row(p, 0, r - (NPE + NPO), lane);
    }
    cache_ckv_all(p, 0, bid * 512 + tid, nb * 512); }
  xcd_barrier(bar);
#pragma unroll 1
  for (int l = 0; l < 4; l++) {
    { PHASE_PARAMS(p);
#pragma unroll 1
      for (int rep = 1; rep < REP_GK; rep++) { NullEpi ne; gemm8_phase(ldsa, p.xs16, M, p.win16 + (size_t)l * NPO * D, NPO, D, M / 256, ((l & 1) ? NPO : NPE) / 256, ne); }
#pragma unroll 1
      for (int rep = 0; rep < REP_A; rep++) {
        InprojEpi epi{p, l, rep > 0, ldsa + G8_STAGE};
        gemm8_phase(ldsa, p.xs16, M, p.win16 + (size_t)l * NPO * D, NPO, D, M / 256, ((l & 1) ? NPO : NPE) / 256, epi);
      }
      for (int rep = 0; rep < REP_0B; rep++) cache_items(p, l, bid * 512 + tid_op(), nb * 512);
      if (l == 1) cache_ckv_all(p, 2, bid * 512 + tid_op(), nb * 512);
      if ((l & 1) == 0) {
        const int k = nb >= 16 ? bid - (nb - 16) : bid;
        if (k >= 0) {
#pragma unroll 1
          for (int kk = k; kk < 16; kk += (nb >= 16 ? 16 : nb)) kvgemm_tile(p, l, (MP + (kk >> 3) * TKS + DS) / 256, kk & 7, lds);
        }
      }
      if (l < 2) {
        const int nun = (M / 256) * (((l & 1) ? NPO : NPE) / 256); const int fi = nun - nb;
        const bool part = fi > 0 && fi < nb;
        const int nshare = (part && nb - fi > 32) ? nb - fi - 16 : (part ? nb - fi : nb);
        const int start = part ? bid - fi : bid, stride = nshare;
        if (start >= 0 && start < nshare) {
          if (l == 0) {
#pragma unroll 1
            for (int it = CV_PER_PAIR + start; it < CV_TOTAL; it += stride) conv_item(p, it, lds);
          } else {
            const int tid = tid_op(); const int lane = tid & 63;
#pragma unroll 1
            for (int r = start * 8 + (tid >> 6); r < NPE + NPO; r += stride * 8) bias_row(p, r < NPE ? 2 : 3, r < NPE ? r : r - NPE, lane);
          }
        }
      }
    }
    xcd_barrier(bar);
    if ((l & 1) == 0) {
      PHASE_PARAMS(p);
      constexpr int NKVP = KM / 256 - DB;
      const int nq = (M / 256) * 8, nkv = NKVP * 8;
      for (int rep = 0; rep < REP_A2; rep++)
      for (int t = bid; t < nq + nkv; t += nb) {
        if (t < nq) qgemm_tile(p, l, t % 32, t / 32, lds);
        else { const int u = t - nq; int q = u % NKVP; constexpr int CP0 = (MP + DS) / 256; q = q < CP0 ? q : (DB > 1 && q >= CP0 + DS / 256 ? q + 2 : q + 1);
          kvgemm_tile(p, l, q, u / NKVP, lds); }
      }
      { const float* rck = p.rowss_ckv + (size_t)(l >> 1) * KM; const int i = l >> 1;
        for (int e = bid * 512 + tid_op(); e < MP * 128; e += nb * 512) {
          const int m = e >> 7, j = e & 127;
          p.o_ckv[st_row(m, i) * 128 + j] = (float)p.ckv16[pidx(KM, m, j)] * (frsq(rck[m] * (1.f / 128.f) + EPSN)) * p.mla_kva_norm[i * 128 + j];
        } }
      xcd_barrier(bar);
    }
    { PHASE_PARAMS(p);
      for (int rep = 0; rep < REP_B; rep++)
      for (int it = bid; it < 512; it += nb) { if (l & 1) attn_odd_item(p, l, it, lds); else attn_even_item(p, l, it, lds); } }
    xcd_barrier(bar);
    { PHASE_PARAMS(p);
      for (int rep = 0; rep < REP_C; rep++)
      for (int t = bid; t < 32 * 8; t += nb) outproj_tile(p, l, t % 32, t / 32, lds, rep < REP_C - 1); }
    if (l < 3) { for (int rep = 0; rep < REP_BAR; rep++) xcd_barrier(bar); }
  }
}
#endif

static inline size_t al256(size_t x) { return (x + 255) & ~(size_t)255; }

extern "C" void kernel_launch(void* const* d_in, const int* in_sizes, int n_in, void* d_out, int out_size, void* d_ws, size_t ws_size,
                              hipStream_t stream) {
  Params p{};
  const float** ip = (const float**)&p.x_prompt;
  for (int k = 0; k < 39; k++) ip[k] = (const float*)d_in[k];
  float* o = (float*)d_out;
  p.Y = o; o += (size_t)M * 1024;
  p.o_ckv = o; o += (size_t)BATCH * 2 * SEQ * 128;
  p.o_kpe = o; o += (size_t)BATCH * 2 * SEQ * 32;
  p.o_dk = o; o += (size_t)BATCH * 2 * SEQ * 512;
  p.o_dv = o; o += (size_t)BATCH * 2 * SEQ * 512;
  p.o_nk = o; o += (size_t)BATCH * 2 * SEQ * 512;
  p.o_nv = o; o += (size_t)BATCH * 2 * SEQ * 512;
  p.o_gk = o; o += (size_t)BATCH * 2 * SEQ * 128;
  p.o_gv = o; o += (size_t)BATCH * 2 * SEQ * 128;
  char* w = (char*)d_ws; size_t off = 0;
  auto take = [&](size_t bytes) { char* r = w + off; off += al256(bytes); return r; };
  char* zero0 = w + off;
  p.bar = (unsigned*)take(16384);
  p.modv = (float*)take((size_t)4 * NCV * 3072 * 4);
  p.rowss_qa = (float*)take((size_t)2 * M * 4); p.rowss_l = (float*)take((size_t)4 * M * 4); p.rowss_ckv = (float*)take((size_t)2 * KM * 4);
  const size_t zero_bytes = (size_t)((w + off) - zero0);
  p.ropeC64 = (float*)take((size_t)DS * 32 * 4); p.ropeS64 = (float*)take((size_t)DS * 32 * 4);
  p.ropeC32 = (float*)take((size_t)DS * 16 * 4); p.ropeS32 = (float*)take((size_t)DS * 16 * 4);
  p.lamv = (float*)take(256);
  p.rstdx = (float*)take((size_t)M * 4);
  p.QA = (h16*)take((size_t)M * 8 * 96 * 2); p.QB = (h16*)take((size_t)M * 8 * 64 * 2);
  p.KA = (h16*)take((size_t)8 * KM * 128 * 2); p.KB = (h16*)take((size_t)8 * KM * 64 * 2);
  p.VA = (h16*)take((size_t)8 * 64 * KM * 2); p.VB = (h16*)take((size_t)8 * 64 * KM * 2);
  p.gates16 = (h16*)take((size_t)M * 1024 * 2); p.O16 = (h16*)take((size_t)M * 1024 * 2);
  p.ckvbuf = (float*)take((size_t)KM * 128 * 4); p.kpebuf = (float*)take((size_t)KM * 32 * 4);
  p.xs16 = (h16*)take((size_t)M * D * 2); p.qa16 = (h16*)take((size_t)M * 256 * 2); p.ckv16 = (h16*)take((size_t)KM * 128 * 2); p.kpe16 = (h16*)take((size_t)KM * 32 * 2); p.biasv = (float*)take((size_t)4 * NCV * NPO * 4);
  p.win16 = (h16*)take((size_t)4 * NPO * D * 2); p.wout16 = (h16*)take((size_t)4 * D * D * 2);
  p.wqb16 = (h16*)take((size_t)2 * 1024 * 256 * 2); p.wkvb16 = (h16*)take((size_t)2 * 1024 * 128 * 2);
  size_t ub = (size_t)M * 3328 * 2, ab = (size_t)M * 1536 * 4;
  char* big = take(ub > ab ? ub : ab);
  p.ubuf = (h16*)big; p.abuf = (float*)big;
  (void)ws_size; (void)n_in; (void)in_sizes; (void)out_size;

#ifndef CPU_EMU
  {
    (void)hipMemsetAsync(zero0, 0, zero_bytes, stream);
    static int cus = 0;
    if (!cus) { int dev = 0; (void)hipGetDevice(&dev); (void)hipDeviceGetAttribute(&cus, hipDeviceAttributeMultiprocessorCount, dev); }
    void* args[] = {&p};
    (void)hipLaunchCooperativeKernel((void*)mega_kernel, dim3(cus), dim3(512), args, 0, stream);
  }
#else
  (void)zero0; (void)zero_bytes;
  launch1d(nk_mod, (long)4 * NCV * 3072, stream, p, (long)4 * NCV * 3072);
  launch1d(nk_tab, (long)DS * 48, stream, p, (long)DS * 48);
  for (int l = 0; l < 4; l++) {
    const int N = (l & 1) ? ODD_IN : EVEN_IN;
    launch1d(nk_rstd, (long)M, stream, p, l, (long)M);
    launch1d(nk_inproj, (long)M * N, stream, p, l, (long)M * N);
    if ((l & 1) == 0) {
      launch1d(nk_epi_even, (long)M * 50, stream, p, l, 0, (long)M * 50);
      launch1d(nk_cache_even, (long)DB * PAST * 17, stream, p, l, (long)DB * PAST * 17);
      launch1d(nk_kv, (long)KM * 16, stream, p, l, (long)KM * 16);
      launch1d(nk_attn_dense, (long)M * 8, stream, p, 0, 0, M, (long)M * 8);
      launch1d(nk_attn_dense, (long)M * 16, stream, p, 1, 0, M, (long)M * 16);
      launch1d(nk_fin, (long)M * 12, stream, p, l, (long)M * 12);
    } else {
      launch1d(nk_epi_odd, (long)M * 52, stream, p, l, (long)M * 52);
      launch1d(nk_cache_odd, (long)DB * PAST * 20, stream, p, l, (long)DB * PAST * 20);
      launch1d(nk_attn_dense, (long)MP * 8, stream, p, 2, 0, MP, (long)MP * 8);
      launch1d(nk_attn_na, (long)MS * 8, stream, p, l, (long)MS * 8);
      launch1d(nk_attn_dense, (long)M * 8, stream, p, 3, 0, M, (long)M * 8);
      launch1d(nk_fin, (long)M * 16, stream, p, l, (long)M * 16);
    }
    launch1d(nk_outproj, (long)M * 1024, stream, p, l, (long)M * 1024);
  }
#endif
}
```

```cpp
#ifndef CPU_EMU
#include <hip/hip_runtime.h>
#endif
#include <stdint.h>
#include <math.h>

#define FAST_INPROJ 2
#define DUAL_WRITE 0
#define FAST_A2 1
#define FAST_OUTPROJ 1
#define FAST_ATTN 1
#define MEGA 1
#define REP_0A 1
#define REP_A 1
#define REP_A2 1
#define REP_B 1
#define REP_C 1
#define REP_BAR 1
#define REP_GK 1
#define REP_0B 1
#define REP_EPI 1
#ifndef CFG_BATCH
#define CFG_BATCH 16
#endif
#ifndef CFG_DB
#define CFG_DB 2
#endif
#ifndef CFG_DS
#define CFG_DS 2048
#endif
constexpr int D = 1024, BATCH = CFG_BATCH, SEQ = 256, DB = CFG_DB, DS = CFG_DS, PAST = 256;
constexpr int MP = BATCH * SEQ, MS = DB * DS, M = MP + MS;
constexpr int TKS = DS + PAST;
constexpr int KM = MP + DB * TKS;
constexpr int NCV = 1 + DB;
constexpr int GW = 64, GROWS = DS / GW;
constexpr int EVEN_IN = 2976, ODD_IN = 3328;
constexpr int NPE = 3072, NPO = 3328;
constexpr float EPSN = 1e-6f;
constexpr float LOG2E = 1.4426950408889634f;

typedef _Float16 h16;

struct Params {
  const float *x_prompt, *x_sample, *cache_mla_ckv, *cache_mla_kpe, *cache_diff_k, *cache_diff_v, *cache_na_k, *cache_na_v,
      *cache_gqa_k, *cache_gqa_v, *c, *c_ctx, *norm_w, *w_mod, *b_mod, *w_in_even, *w_out_even, *mla_qa_norm, *mla_wqb,
      *mla_kva_norm, *mla_wkvb, *mla_qn_nope, *mla_qn_rope, *mla_kn_nope, *mla_kn_rope, *diff_qn, *diff_kn, *diff_lq1,
      *diff_lk1, *diff_lq2, *diff_lk2, *diff_subln, *w_in_odd, *w_out_odd, *na_qn, *na_kn, *na_rpb, *gqa_qn, *gqa_kn;
  float *Y;
  float *o_ckv, *o_kpe, *o_dk, *o_dv, *o_nk, *o_nv, *o_gk, *o_gv;
  float *modv;
  float *ropeC64, *ropeS64;
  float *ropeC32, *ropeS32;
  float *lamv;
  float *rstdx;
  h16 *ubuf;
  float *abuf;
  float *ckvbuf;
  float *kpebuf;
  h16 *QA, *QB, *KA, *KB, *VA, *VB, *gates16, *O16;
  h16 *xs16;
  float *biasv;
  h16 *win16;
  h16 *wout16;
  h16 *wqb16;
  h16 *wkvb16;
  h16 *qa16;
  float *rowss_qa;
  h16 *ckv16;
  h16 *kpe16;
  float *rowss_l;
  float *rowss_ckv;
  unsigned *bar;
};

#ifdef CPU_EMU
#include <stdio.h>
#include <stdlib.h>
#include <string.h>
typedef void* hipStream_t;
#define KERNEL static void
#define DEVFN static inline
static thread_local long emu_gtid;
#define GTID emu_gtid
template <class... A, class... B>
static void launch1d(void (*f)(A...), long n, hipStream_t, B... a) {
#pragma omp parallel for schedule(dynamic, 64)
  for (long i = 0; i < n; i++) { emu_gtid = i; f(a...); }
}
static inline float exp2f_(float x) { return exp2f(x); }
#else
#define KERNEL __global__ void __launch_bounds__(256)
#define DEVFN __device__ __forceinline__
#define GTID ((long)blockIdx.x * 256 + threadIdx.x)
template <class... A, class... B>
static void launch1d(void (*f)(A...), long n, hipStream_t s, B... a) {
  hipLaunchKernelGGL(f, dim3((unsigned)((n + 255) / 256)), dim3(256), 0, s, a...);
}
DEVFN float exp2f_(float x) { return exp2f(x); }
#endif

DEVFN int tok_cv(int m) { return m < MP ? 0 : 1 + (m - MP) / DS; }
DEVFN int tok_keyrow(int m) { return m < MP ? m : MP + ((m - MP) / DS) * TKS + (m - MP) % DS; }
DEVFN int tok_pos(int m) { return m < MP ? (m % SEQ) : ((m - MP) % DS); }
DEVFN const float* xrow(const Params& p, int l, int m) {
  if (l > 0) return p.Y + (size_t)m * D;
  return m < MP ? p.x_prompt + (size_t)m * D : p.x_sample + (size_t)(m - MP) * D;
}
DEVFN float siluf(float x) { return x / (1.f + expf(-x)); }
DEVFN size_t st_row(int m, int i) { int b = m / SEQ, t = m % SEQ; return ((size_t)(b * 2 + i) * SEQ + t); }

#ifdef CPU_EMU
KERNEL nk_mod(Params p, long n) {
  long g = GTID; if (g >= n) return;
  int col = g % 3072; int cv = (g / 3072) % NCV; int l = g / (3072 * NCV);
  const float* cvec = cv == 0 ? p.c_ctx : p.c + (size_t)(cv - 1) * D;
  const float* w = p.w_mod + (size_t)l * D * 3072 + col;
  float acc = p.b_mod[l * 3072 + col];
  for (int k = 0; k < D; k++) acc += siluf(cvec[k]) * w[(size_t)k * 3072];
  p.modv[((size_t)l * NCV + cv) * 3072 + col] = acc;
}
KERNEL nk_tab(Params p, long n) {
  long g = GTID; if (g >= n) return;
  if (g < 2) {
    int i = g; int l = 2 * i;
    float s1 = 0, s2 = 0;
    for (int k = 0; k < 64; k++) { s1 += p.diff_lq1[i * 64 + k] * p.diff_lk1[i * 64 + k]; s2 += p.diff_lq2[i * 64 + k] * p.diff_lk2[i * 64 + k]; }
    float lam_init = 0.8f - 0.6f * expf(-0.3f * l);
    p.lamv[i] = expf(s1) - expf(s2) + lam_init;
  }
  int t = g / 48, j = g % 48;
  if (t >= DS) return;
  float row = (float)(t / GW), col = (float)(t % GW);
  if (j < 32) {
    int f = j & 15; float inv = powf(10000.f, -(float)(2 * f) / 32.f);
    float ang = (j < 16 ? row : col) * inv;
    p.ropeC64[t * 32 + j] = cosf(ang); p.ropeS64[t * 32 + j] = sinf(ang);
  } else {
    int jj = j - 32; int f = jj & 7; float inv = powf(10000.f, -(float)(2 * f) / 16.f);
    float ang = (jj < 8 ? row : col) * inv;
    p.ropeC32[t * 16 + jj] = cosf(ang); p.ropeS32[t * 16 + jj] = sinf(ang);
  }
}
KERNEL nk_rstd(Params p, int l, long n) {
  long g = GTID; if (g >= n) return;
  const float* x = xrow(p, l, (int)g);
  float s = 0; for (int k = 0; k < D; k++) s += x[k] * x[k];
  p.rstdx[g] = 1.f / sqrtf(s / D + EPSN);
}
KERNEL nk_inproj(Params p, int l, long n) {
  long g = GTID; if (g >= n) return;
  const int N = (l & 1) ? ODD_IN : EVEN_IN;
  int m = g / N, col = g % N;
  const float* W = ((l & 1) ? p.w_in_odd : p.w_in_even) + (size_t)(l >> 1) * D * N + col;
  const float* x = xrow(p, l, m);
  const float* md = p.modv + ((size_t)l * NCV + tok_cv(m)) * 3072;
  const float* nw = p.norm_w + l * D;
  float r = p.rstdx[m], acc = 0;
  for (int k = 0; k < D; k++) { float h = x[k] * r * nw[k] * (1.f + md[1024 + k]) + md[k]; acc += h * W[(size_t)k * N]; }
  p.ubuf[(size_t)m * 3328 + col] = (h16)acc;
}

KERNEL nk_epi_even(Params p, int l, int qa_only, long n) {
  long g = GTID; if (g >= n) return;
  const int i = l >> 1;
  int m = g / 50, u = g % 50;
  if (qa_only && u >= 8) return;
  const h16* ur = qa_only ? p.qa16 + (size_t)m * 256 : p.ubuf + (size_t)m * 3328;
  const bool smp = m >= MP; const int t = tok_pos(m); const int kr = tok_keyrow(m);
  if (u < 8) {
    float ss = 0; for (int k = 0; k < 256; k++) { float v = (float)ur[k]; ss += v * v; }
    float r = 1.f / sqrtf(ss / 256 + EPSN);
    float q[96];
#pragma unroll
    for (int j = 0; j < 96; j++) q[j] = 0;
    const float* W = p.mla_wqb + (size_t)i * 256 * 768 + u * 96;
    for (int k = 0; k < 256; k++) {
      float a = (float)ur[k] * r * p.mla_qa_norm[i * 256 + k];
#pragma unroll
      for (int j = 0; j < 96; j++) q[j] += a * W[(size_t)k * 768 + j];
    }
    float s1 = 0, s2 = 0;
#pragma unroll
    for (int j = 0; j < 64; j++) s1 += q[j] * q[j];
#pragma unroll
    for (int j = 64; j < 96; j++) s2 += q[j] * q[j];
    float r1 = 1.f / sqrtf(s1 / 64 + EPSN), r2 = 1.f / sqrtf(s2 / 32 + EPSN);
#pragma unroll
    for (int j = 0; j < 64; j++) q[j] = q[j] * r1 * p.mla_qn_nope[i * 64 + j];
#pragma unroll
    for (int j = 0; j < 32; j++) q[64 + j] = q[64 + j] * r2 * p.mla_qn_rope[i * 32 + j];
    if (smp) {
#pragma unroll
      for (int j = 0; j < 16; j++) {
        float c = p.ropeC32[t * 16 + j], s = p.ropeS32[t * 16 + j];
        float x1 = q[64 + j], x2 = q[80 + j];
        q[64 + j] = x1 * c - x2 * s; q[80 + j] = x2 * c + x1 * s;
      }
    }
    const float sc = LOG2E / sqrtf(96.f);
    h16* dst = p.QA + ((size_t)m * 8 + u) * 96;
#pragma unroll
    for (int j = 0; j < 96; j++) dst[j] = (h16)(q[j] * sc);
  } else if (u == 8) {
    float ss = 0; for (int k = 0; k < 128; k++) { float v = (float)ur[256 + k]; ss += v * v; }
    float r = 1.f / sqrtf(ss / 128 + EPSN);
    for (int k = 0; k < 128; k++) {
      float v = (float)ur[256 + k] * r * p.mla_kva_norm[i * 128 + k];
      if (!smp) p.o_ckv[st_row(m, i) * 128 + k] = v;
      p.ckvbuf[(size_t)kr * 128 + k] = v;
    }
  } else if (u == 9) {
    float v[32]; float ss = 0;
#pragma unroll
    for (int k = 0; k < 32; k++) { v[k] = (float)ur[384 + k]; ss += v[k] * v[k]; }
    float r = 1.f / sqrtf(ss / 32 + EPSN);
#pragma unroll
    for (int k = 0; k < 32; k++) { v[k] = v[k] * r * p.mla_kn_rope[i * 32 + k]; if (!smp) p.o_kpe[st_row(m, i) * 32 + k] = v[k]; }
    if (smp) {
#pragma unroll
      for (int j = 0; j < 16; j++) {
        float c = p.ropeC32[t * 16 + j], s = p.ropeS32[t * 16 + j];
        float x1 = v[j], x2 = v[16 + j];
        v[j] = x1 * c - x2 * s; v[16 + j] = x2 * c + x1 * s;
      }
    }
#pragma unroll
    for (int k = 0; k < 32; k++) p.kpebuf[(size_t)kr * 32 + k] = v[k];
  } else if (u < 18) {
    int cb = (u - 10) * 64;
    for (int j = 0; j < 64; j++) p.gates16[(size_t)m * 1024 + cb + j] = (h16)siluf((float)ur[416 + cb + j]);
  } else if (u < 34) {
    const bool isq = u < 26; int hc = isq ? u - 18 : u - 26;
    const h16* src = ur + (isq ? 928 : 1440) + hc * 64;
    const float* gn = (isq ? p.diff_qn : p.diff_kn) + i * 64;
    float v[64]; float ss = 0;
#pragma unroll
    for (int k = 0; k < 64; k++) { v[k] = (float)src[k]; ss += v[k] * v[k]; }
    float r = 1.f / sqrtf(ss / 64 + EPSN);
#pragma unroll
    for (int k = 0; k < 64; k++) { v[k] = v[k] * r * gn[k]; if (!isq && !smp) p.o_dk[st_row(m, i) * 512 + hc * 64 + k] = v[k]; }
    if (smp) {
#pragma unroll
      for (int j = 0; j < 32; j++) {
        float c = p.ropeC64[t * 32 + j], s = p.ropeS64[t * 32 + j];
        float x1 = v[j], x2 = v[32 + j];
        v[j] = x1 * c - x2 * s; v[32 + j] = x2 * c + x1 * s;
      }
    }
    if (isq) {
      const float sc = LOG2E / 8.f; h16* dst = p.QB + ((size_t)m * 8 + hc) * 64;
#pragma unroll
      for (int k = 0; k < 64; k++) dst[k] = (h16)(v[k] * sc);
    } else {
      h16* dst = p.KB + ((size_t)hc * KM + kr) * 64;
#pragma unroll
      for (int k = 0; k < 64; k++) dst[k] = (h16)v[k];
    }
  } else if (u < 42) {
    int ch = u - 34; int h = ch >> 1, half = ch & 1;
    for (int j = 0; j < 64; j++) {
      float v = (float)ur[1952 + ch * 64 + j];
      if (!smp) p.o_dv[st_row(m, i) * 512 + ch * 64 + j] = v;
      p.VB[((size_t)h * 128 + half * 64 + j) * KM + kr] = (h16)v;
    }
  } else {
    int cb = (u - 42) * 64;
    for (int j = 0; j < 64; j++) p.gates16[(size_t)m * 1024 + 512 + cb + j] = (h16)siluf((float)ur[2464 + cb + j]);
  }
}
KERNEL nk_cache_even(Params p, int l, long n) {
  long g = GTID; if (g >= n) return;
  const int i = l >> 1;
  int u = g % 17; int pos = (g / 17) % PAST; int b = g / (17 * PAST);
  const int kr = MP + b * TKS + DS + pos;
  const size_t crow = ((size_t)(b * 2 + i) * PAST + pos);
  if (u == 0) {
    for (int k = 0; k < 128; k++) { float v = p.cache_mla_ckv[crow * 128 + k]; p.ckvbuf[(size_t)kr * 128 + k] = v; p.ckv16[(size_t)kr * 128 + k] = (h16)v; }
    for (int k = 0; k < 32; k++) { float v = p.cache_mla_kpe[crow * 32 + k]; p.kpebuf[(size_t)kr * 32 + k] = v; p.kpe16[(size_t)kr * 32 + k] = (h16)v; }
  } else if (u < 9) {
    int hc = u - 1;
    for (int k = 0; k < 64; k++) p.KB[((size_t)hc * KM + kr) * 64 + k] = (h16)p.cache_diff_k[crow * 512 + hc * 64 + k];
  } else {
    int ch = u - 9; int h = ch >> 1, half = ch & 1;
    for (int j = 0; j < 64; j++) p.VB[((size_t)h * 128 + half * 64 + j) * KM + kr] = (h16)p.cache_diff_v[crow * 512 + ch * 64 + j];
  }
}
KERNEL nk_kv(Params p, int l, long n) {
  long g = GTID; if (g >= n) return;
  const int i = l >> 1;
  int part = g & 1; int h = (g >> 1) & 7; int kr = g >> 4;
  const float* cr = p.ckvbuf + (size_t)kr * 128;
  const float* W = p.mla_wkvb + (size_t)i * 128 * 1024 + h * 128 + part * 64;
  float a[64];
#pragma unroll
  for (int j = 0; j < 64; j++) a[j] = 0;
  for (int k = 0; k < 128; k++) {
    float c = (float)(h16)cr[k];
#pragma unroll
    for (int j = 0; j < 64; j++) a[j] += c * W[(size_t)k * 1024 + j];
  }
  if (part == 0) {
    float ss = 0;
#pragma unroll
    for (int j = 0; j < 64; j++) ss += a[j] * a[j];
    float r = 1.f / sqrtf(ss / 64 + EPSN);
    h16* dst = p.KA + ((size_t)h * KM + kr) * 128;
#pragma unroll
    for (int j = 0; j < 64; j++) dst[j] = (h16)(a[j] * r * p.mla_kn_nope[i * 64 + j]);
    for (int j = 0; j < 32; j++) dst[64 + j] = (h16)p.kpebuf[(size_t)kr * 32 + j];
  } else {
#pragma unroll
    for (int j = 0; j < 64; j++) p.VA[((size_t)h * 64 + j) * KM + kr] = (h16)a[j];
  }
}
KERNEL nk_epi_odd(Params p, int l, long n) {
  long g = GTID; if (g >= n) return;
  const int i = l >> 1;
  int m = g / 52, u = g % 52;
  const h16* ur = p.ubuf + (size_t)m * 3328;
  const bool smp = m >= MP; const int t = tok_pos(m); const int kr = tok_keyrow(m);
  if (u < 16 || (u >= 32 && u < 42)) {
    int colbase, head; const float* gn; int kind;
    if (u < 8) { kind = 0; head = u; colbase = head * 64; gn = p.na_qn + i * 64; }
    else if (u < 16) { kind = 1; head = u - 8; colbase = 512 + head * 64; gn = p.na_kn + i * 64; }
    else if (u < 40) { kind = 2; head = u - 32; colbase = 2048 + head * 64; gn = p.gqa_qn + i * 64; }
    else { kind = 3; head = u - 40; colbase = 2560 + head * 64; gn = p.gqa_kn + i * 64; }
    float v[64]; float ss = 0;
#pragma unroll
    for (int k = 0; k < 64; k++) { v[k] = (float)ur[colbase + k]; ss += v[k] * v[k]; }
    float r = 1.f / sqrtf(ss / 64 + EPSN);
#pragma unroll
    for (int k = 0; k < 64; k++) v[k] = v[k] * r * gn[k];
    if (!smp) {
      if (kind == 1) { for (int k = 0; k < 64; k++) p.o_nk[st_row(m, i) * 512 + head * 64 + k] = v[k]; }
      if (kind == 3) { for (int k = 0; k < 64; k++) p.o_gk[st_row(m, i) * 128 + head * 64 + k] = v[k]; }
    }
    if (smp && kind >= 2) {
#pragma unroll
      for (int j = 0; j < 32; j++) {
        float c = p.ropeC64[t * 32 + j], s = p.ropeS64[t * 32 + j];
        float x1 = v[j], x2 = v[32 + j];
        v[j] = x1 * c - x2 * s; v[32 + j] = x2 * c + x1 * s;
      }
    }
    const float sc = LOG2E / 8.f;
    h16* dst;
    if (kind == 0) dst = p.QA + ((size_t)m * 8 + head) * 64;
    else if (kind == 1) dst = p.KA + ((size_t)head * KM + kr) * 64;
    else if (kind == 2) dst = p.QB + ((size_t)m * 8 + head) * 64;
    else dst = p.KB + ((size_t)head * KM + kr) * 64;
    const float mul = (kind == 0 || kind == 2) ? sc : 1.f;
#pragma unroll
    for (int k = 0; k < 64; k++) dst[k] = (h16)(v[k] * mul);
  } else if (u < 24) {
    int head = u - 16;
    for (int j = 0; j < 64; j++) {
      float v = (float)ur[1024 + head * 64 + j];
      if (!smp) p.o_nv[st_row(m, i) * 512 + head * 64 + j] = v;
      p.VA[((size_t)head * 64 + j) * KM + kr] = (h16)v;
    }
  } else if (u < 32) {
    int cb = (u - 24) * 64;
    for (int j = 0; j < 64; j++) p.gates16[(size_t)m * 1024 + cb + j] = (h16)siluf((float)ur[1536 + cb + j]);
  } else if (u < 44) {
    int head = u - 42;
    for (int j = 0; j < 64; j++) {
      float v = (float)ur[2688 + head * 64 + j];
      if (!smp) p.o_gv[st_row(m, i) * 128 + head * 64 + j] = v;
      p.VB[((size_t)head * 64 + j) * KM + kr] = (h16)v;
    }
  } else {
    int cb = (u - 44) * 64;
    for (int j = 0; j < 64; j++) p.gates16[(size_t)m * 1024 + 512 + cb + j] = (h16)siluf((float)ur[2816 + cb + j]);
  }
}
KERNEL nk_cache_odd(Params p, int l, long n) {
  long g = GTID; if (g >= n) return;
  const int i = l >> 1;
  int u = g % 20; int pos = (g / 20) % PAST; int b = g / (20 * PAST);
  const int kr = MP + b * TKS + DS + pos;
  const size_t crow = ((size_t)(b * 2 + i) * PAST + pos);
  if (u < 8) { for (int k = 0; k < 64; k++) p.KA[((size_t)u * KM + kr) * 64 + k] = (h16)p.cache_na_k[crow * 512 + u * 64 + k]; }
  else if (u < 16) { int h = u - 8; for (int j = 0; j < 64; j++) p.VA[((size_t)h * 64 + j) * KM + kr] = (h16)p.cache_na_v[crow * 512 + h * 64 + j]; }
  else if (u < 18) { int h = u - 16; for (int k = 0; k < 64; k++) p.KB[((size_t)h * KM + kr) * 64 + k] = (h16)p.cache_gqa_k[crow * 128 + h * 64 + k]; }
  else { int h = u - 18; for (int j = 0; j < 64; j++) p.VB[((size_t)h * 64 + j) * KM + kr] = (h16)p.cache_gqa_v[crow * 128 + h * 64 + j]; }
}
template <int DQK, int KP>
DEVFN void attn_dense_thread(const h16* q, const h16* K, const h16* VT, int kr0, int nk, float* out) {
  float qf[DQK];
#pragma unroll
  for (int j = 0; j < DQK; j++) qf[j] = (float)q[j];
  float o[64];
#pragma unroll
  for (int j = 0; j < 64; j++) o[j] = 0;
  float mx = -1e30f, sum = 0;
  for (int kk = 0; kk < nk; kk++) {
    const h16* kp = K + (size_t)(kr0 + kk) * KP;
    float s = 0;
#pragma unroll
    for (int j = 0; j < DQK; j++) s += qf[j] * (float)kp[j];
    float mn = fmaxf(mx, s); float al = exp2f_(mx - mn); float pe = exp2f_(s - mn);
    sum = sum * al + pe; mx = mn;
#pragma unroll
    for (int j = 0; j < 64; j++) o[j] = o[j] * al + pe * (float)VT[(size_t)j * KM + kr0 + kk];
  }
  float inv = 1.f / sum;
#pragma unroll
  for (int j = 0; j < 64; j++) out[j] = o[j] * inv;
}
KERNEL nk_attn_dense(Params p, int kind, int mlo, int mhi, long n) {
  long g = GTID; if (g >= n) return;
  const int nch = kind == 1 ? 2 : 1;
  int ch = g % nch; int head = (g / nch) % 8; int m = mlo + g / (nch * 8);
  if (m >= mhi) return;
  int kr0, nk;
  if (m < MP) { kr0 = (m / SEQ) * SEQ; nk = SEQ; } else { kr0 = MP + ((m - MP) / DS) * TKS; nk = TKS; }
  if (kind == 0) {
    attn_dense_thread<96, 128>(p.QA + ((size_t)m * 8 + head) * 96, p.KA + (size_t)head * KM * 128, p.VA + (size_t)head * 64 * KM, kr0, nk,
                          p.abuf + (size_t)m * 1536 + head * 64);
  } else if (kind == 1) {
    attn_dense_thread<64, 64>(p.QB + ((size_t)m * 8 + head) * 64, p.KB + (size_t)head * KM * 64,
                          p.VB + ((size_t)(head >> 1) * 128 + ch * 64) * KM, kr0, nk, p.abuf + (size_t)m * 1536 + 512 + head * 128 + ch * 64);
  } else if (kind == 2) {
    attn_dense_thread<64, 64>(p.QA + ((size_t)m * 8 + head) * 64, p.KA + (size_t)head * KM * 64, p.VA + (size_t)head * 64 * KM, kr0, nk,
                          p.abuf + (size_t)m * 1536 + head * 64);
  } else {
    attn_dense_thread<64, 64>(p.QB + ((size_t)m * 8 + head) * 64, p.KB + (size_t)(head >> 2) * KM * 64, p.VB + (size_t)(head >> 2) * 64 * KM,
                          kr0, nk, p.abuf + (size_t)m * 1536 + 512 + head * 64);
  }
}
KERNEL nk_attn_na(Params p, int l, long n) {
  long g = GTID; if (g >= n) return;
  const int i = l >> 1;
  int head = g & 7; int ms = g >> 3; int m = MP + ms;
  int b = ms / DS, t = ms % DS; int r = t / GW, c = t % GW;
  int rs = r - 4; rs = rs < 0 ? 0 : (rs > GROWS - 8 ? GROWS - 8 : rs);
  int cs = c - 8; cs = cs < 0 ? 0 : (cs > GW - 16 ? GW - 16 : cs);
  const h16* q = p.QA + ((size_t)m * 8 + head) * 64;
  const h16* K = p.KA + (size_t)head * KM * 64; const h16* VT = p.VA + (size_t)head * 64 * KM;
  const int kbase = MP + b * TKS;
  const float* rpb = p.na_rpb + ((size_t)i * 8 + head) * 15 * 31;
  float qf[64], o[64];
#pragma unroll
  for (int j = 0; j < 64; j++) { qf[j] = (float)q[j]; o[j] = 0; }
  float mx = -1e30f, sum = 0;
  for (int kk = 0; kk < 128 + PAST; kk++) {
    int kr; float bias = 0;
    if (kk < 128) { int ri = kk >> 4, cj = kk & 15; kr = kbase + (rs + ri) * GW + cs + cj; bias = rpb[(rs + ri - r + 7) * 31 + (cs + cj - c + 15)] * LOG2E; }
    else kr = kbase + DS + (kk - 128);
    const h16* kp = K + (size_t)kr * 64;
    float s = bias;
#pragma unroll
    for (int j = 0; j < 64; j++) s += qf[j] * (float)kp[j];
    float mn = fmaxf(mx, s); float al = exp2f_(mx - mn); float pe = exp2f_(s - mn);
    sum = sum * al + pe; mx = mn;
#pragma unroll
    for (int j = 0; j < 64; j++) o[j] = o[j] * al + pe * (float)VT[(size_t)j * KM + kr];
  }
  float inv = 1.f / sum; float* out = p.abuf + (size_t)m * 1536 + head * 64;
#pragma unroll
  for (int j = 0; j < 64; j++) out[j] = o[j] * inv;
}
KERNEL nk_fin(Params p, int l, long n) {
  long g = GTID; if (g >= n) return;
  const int i = l >> 1;
  if (l & 1) {
    int ch = g & 15; int m = g >> 4;
    for (int j = 0; j < 64; j++) {
      int col = ch * 64 + j;
      p.O16[(size_t)m * 1024 + col] = (h16)(p.abuf[(size_t)m * 1536 + col] * (float)p.gates16[(size_t)m * 1024 + col]);
    }
  } else {
    int u = g % 12; int m = g / 12;
    if (u < 8) {
      for (int j = 0; j < 64; j++) {
        int col = u * 64 + j;
        p.O16[(size_t)m * 1024 + col] = (h16)(p.abuf[(size_t)m * 1536 + col] * (float)p.gates16[(size_t)m * 1024 + col]);
      }
    } else {
      int h = u - 8; float lam = p.lamv[i]; float lam_init = 0.8f - 0.6f * expf(-0.3f * l);
      const float* a1 = p.abuf + (size_t)m * 1536 + 512 + (h * 2) * 128; const float* a2 = a1 + 128;
      float ss = 0;
      for (int j = 0; j < 128; j++) { float d = a1[j] - lam * a2[j]; ss += d * d; }
      float r = 1.f / sqrtf(ss / 128 + EPSN);
      for (int j = 0; j < 128; j++) {
        float d = (a1[j] - lam * a2[j]) * r * p.diff_subln[i * 128 + j] * (1.f - lam_init);
        int col = 512 + h * 128 + j;
        p.O16[(size_t)m * 1024 + col] = (h16)(d * (float)p.gates16[(size_t)m * 1024 + col]);
      }
    }
  }
}
KERNEL nk_outproj(Params p, int l, long n) {
  long g = GTID; if (g >= n) return;
  int m = g >> 10, col = g & 1023;
  const float* W = ((l & 1) ? p.w_out_odd : p.w_out_even) + (size_t)(l >> 1) * 1024 * 1024 + col;
  const h16* o = p.O16 + (size_t)m * 1024;
  float acc = 0;
  for (int k = 0; k < 1024; k++) acc += (float)o[k] * W[(size_t)k * 1024];
  float gate = p.modv[((size_t)l * NCV + tok_cv(m)) * 3072 + 2048 + col];
  p.Y[(size_t)m * 1024 + col] = xrow(p, l, m)[col] + gate * acc;
}


#endif
#ifndef CPU_EMU
typedef _Float16 h16x8 __attribute__((ext_vector_type(8)));
typedef _Float16 h16x4 __attribute__((ext_vector_type(4)));
typedef float f32x16 __attribute__((ext_vector_type(16)));
typedef float f32x4 __attribute__((ext_vector_type(4)));
#define LAS __attribute__((address_space(3)))
typedef unsigned u32x4 __attribute__((ext_vector_type(4)));
DEVFN size_t pidx(int R, int row, int k) { return ((size_t)(k >> 6) * R + row) * 64 + (k & 63); }
DEVFN size_t vidx(int vrow, int kr) { return ((size_t)(kr >> 6) * 512 + vrow) * 64 + (kr & 63); }
DEVFN float max3f(float a, float b, float c) { float r; asm("v_max3_f32 %0, %1, %2, %3" : "=v"(r) : "v"(a), "v"(b), "v"(c)); return r; }
DEVFN float frsq(float x) { return __builtin_amdgcn_rsqf(x); }
DEVFN float fsilu(float x) { return x * __builtin_amdgcn_rcpf(1.f + __builtin_amdgcn_exp2f(-LOG2E * x)); }
DEVFN int tid_op() { int t = threadIdx.x; asm volatile("" : "+v"(t)); return t; }

DEVFN int even_col(int np) { return np < 416 ? np : (np < 512 ? -1 : np - 96); }

constexpr int G_STAGE = 49152, G_NSTAGE = 3, G_LDS = G_STAGE * G_NSTAGE;
constexpr int G_LDS2 = 131072 + 8 * 3072;
DEVFN int img_off(int r, int c) { return r * 128 + ((c ^ ((r >> 1) & 7)) << 4); }
template <int R>
DEVFN void stage_rows(const h16* g, int ld, char* lds, int tid) {
#pragma unroll
  for (int i = 0; i < R / 64; i++) {
    int r = (tid >> 3) + 64 * i; int c = (tid & 7) ^ ((r >> 1) & 7);
    __builtin_amdgcn_global_load_lds((const unsigned*)(g + (size_t)r * ld + c * 8), (unsigned*)(lds + i * 8192 + tid * 16), 16, 0, 0);
  }
}
#define WAITV(n) asm volatile("s_waitcnt vmcnt(" #n ")" ::: "memory")
#define RAWBAR() do { asm volatile("s_waitcnt lgkmcnt(0)" ::: "memory"); __builtin_amdgcn_s_barrier(); } while (0)
template <bool TR>
DEVFN void gemm_tile(const h16* A, int RA, const h16* Bt, int RB, int K, int m0, int n0, char* lds, f32x16 (&acc)[2][2]) {
  const int TIDX = tid_op();
  const int tid = TIDX, lane = tid & 63, w = tid >> 6, wm = w >> 1, wn = w & 1;
  const int nt = K / 64;
  const h16* Ag = A + (size_t)m0 * 64; const h16* Bg = Bt + (size_t)n0 * 64; const size_t pa = (size_t)RA * 64, pb = (size_t)RB * 64;
#pragma unroll
  for (int a = 0; a < 2; a++)
#pragma unroll
    for (int b = 0; b < 2; b++)
#pragma unroll
      for (int r = 0; r < 16; r++) acc[a][b][r] = 0.f;
  stage_rows<256>(Ag, 64, lds, tid); stage_rows<128>(Bg, 64, lds + 32768, tid);
  if (nt > 1) { stage_rows<256>(Ag + pa, 64, lds + G_STAGE, tid); stage_rows<128>(Bg + pb, 64, lds + G_STAGE + 32768, tid); }
  const int ra = wm * 64 + (lane & 31), rb = wn * 64 + (lane & 31), ch = lane >> 5;
  auto piece = [&](const h16* g, char* s, int i) {
    const int r = (tid >> 3) + 64 * i; const int c = (tid & 7) ^ ((r >> 1) & 7);
    __builtin_amdgcn_global_load_lds((const unsigned*)(g + (size_t)r * 64 + c * 8), (unsigned*)(s + i * 8192 + tid * 16), 16, 0, 0);
  };
  for (int t = 0; t < nt; t++) {
    if (t + 1 < nt) WAITV(6); else WAITV(0);
    RAWBAR();
    const bool pre = t + 2 < nt;
    char* sn = lds + ((t + 2) % 3) * G_STAGE; const h16* An = Ag + (t + 2) * pa; const h16* Bn = Bg + (t + 2) * pb;
    const char* sa = lds + (t % 3) * G_STAGE; const char* sb = sa + 32768;
    h16x8 af[2][2], bf[2][2];
#pragma unroll
    for (int mb = 0; mb < 2; mb++) af[0][mb] = *(const h16x8*)(sa + img_off(ra + mb * 32, ch));
#pragma unroll
    for (int nb = 0; nb < 2; nb++) bf[0][nb] = *(const h16x8*)(sb + img_off(rb + nb * 32, ch));
#pragma unroll
    for (int ks = 0; ks < 4; ks++) {
      const int cur = ks & 1, nxt = cur ^ 1;
      if (ks < 3) {
#pragma unroll
        for (int mb = 0; mb < 2; mb++) af[nxt][mb] = *(const h16x8*)(sa + img_off(ra + mb * 32, 2 * (ks + 1) + ch));
#pragma unroll
        for (int nb = 0; nb < 2; nb++) bf[nxt][nb] = *(const h16x8*)(sb + img_off(rb + nb * 32, 2 * (ks + 1) + ch));
      }
      if (pre) {
        if (ks == 0) { piece(An, sn, 0); piece(An, sn, 1); }
        else if (ks == 1) { piece(An, sn, 2); piece(An, sn, 3); }
        else if (ks == 2) { piece(Bn, sn + 32768, 0); piece(Bn, sn + 32768, 1); }
      }
#pragma unroll
      for (int mb = 0; mb < 2; mb++)
#pragma unroll
        for (int nb = 0; nb < 2; nb++) {
          if (TR) acc[mb][nb] = __builtin_amdgcn_mfma_f32_32x32x16_f16(bf[cur][nb], af[cur][mb], acc[mb][nb], 0, 0, 0);
          else acc[mb][nb] = __builtin_amdgcn_mfma_f32_32x32x16_f16(af[cur][mb], bf[cur][nb], acc[mb][nb], 0, 0, 0);
        }
      __builtin_amdgcn_sched_barrier(0);
    }
  }
  RAWBAR();
}

DEVFN float wsum32(float v) { return v + __shfl_xor(v, 32); }

template <class RsF, class DstF>
DEVFN void epi_head64(const Params& p, const f32x16 (&acc)[2][2], int mbase, RsF rsf, const float* bias, const float* gain, bool rope, float oscale,
                      float* state, int spitch, int scol, int ilayer, DstF dstf) {
  const int TIDX = tid_op();
  const int lane = TIDX & 63, h = lane >> 5;
#pragma unroll
  for (int mb = 0; mb < 2; mb++) {
    const int m = mbase + mb * 32 + (lane & 31);
    const float rs = rsf(m);
    float v[2][16]; float ss = 0;
#pragma unroll
    for (int nb = 0; nb < 2; nb++)
#pragma unroll
      for (int q = 0; q < 4; q++) {
        const int j = nb * 32 + 8 * q + 4 * h;
        f32x4 b = bias ? *(const f32x4*)(bias + j) : (f32x4){0.f, 0.f, 0.f, 0.f};
#pragma unroll
        for (int e = 0; e < 4; e++) { float x = acc[mb][nb][q * 4 + e] * rs + b[e]; v[nb][q * 4 + e] = x; ss += x * x; }
      }
    ss = wsum32(ss);
    const float rr = frsq(ss * (1.f / 64.f) + EPSN);
#pragma unroll
    for (int nb = 0; nb < 2; nb++)
#pragma unroll
      for (int q = 0; q < 4; q++) {
        const int j = nb * 32 + 8 * q + 4 * h;
        f32x4 g = *(const f32x4*)(gain + j);
#pragma unroll
        for (int e = 0; e < 4; e++) v[nb][q * 4 + e] *= rr * g[e];
      }
    const bool smp = m >= MP;
    if (state && !smp) {
      float* sp = state + st_row(m, ilayer) * spitch + scol;
#pragma unroll
      for (int nb = 0; nb < 2; nb++)
#pragma unroll
        for (int q = 0; q < 4; q++) { f32x4 o = {v[nb][q * 4], v[nb][q * 4 + 1], v[nb][q * 4 + 2], v[nb][q * 4 + 3]}; *(f32x4*)(sp + nb * 32 + 8 * q + 4 * h) = o; }
    }
    if (rope && smp) {
      const int t = tok_pos(m);
#pragma unroll
      for (int q = 0; q < 4; q++) {
        f32x4 c = *(const f32x4*)(p.ropeC64 + t * 32 + 8 * q + 4 * h), s = *(const f32x4*)(p.ropeS64 + t * 32 + 8 * q + 4 * h);
#pragma unroll
        for (int e = 0; e < 4; e++) { float x1 = v[0][q * 4 + e], x2 = v[1][q * 4 + e]; v[0][q * 4 + e] = x1 * c[e] - x2 * s[e]; v[1][q * 4 + e] = x2 * c[e] + x1 * s[e]; }
      }
    }
    h16* dst = dstf(m);
#pragma unroll
    for (int nb = 0; nb < 2; nb++)
#pragma unroll
      for (int q = 0; q < 4; q++) {
        h16x4 o;
#pragma unroll
        for (int e = 0; e < 4; e++) o[e] = (h16)(v[nb][q * 4 + e] * oscale);
        *(h16x4*)(dst + nb * 32 + 8 * q + 4 * h) = o;
      }
  }
}
template <class RsF, class DstF>
DEVFN void epi_head32(const Params& p, const f32x16 (&acc)[2][2], int mbase, RsF rsf, const float* bias, const float* gain, bool rope, float oscale,
                      float* state, int ilayer, DstF dstf, float* dual = nullptr) {
  const int TIDX = tid_op();
  const int lane = TIDX & 63, h = lane >> 5;
#pragma unroll
  for (int mb = 0; mb < 2; mb++) {
    const int m = mbase + mb * 32 + (lane & 31);
    const float rs = rsf(m);
    float v[16]; float ss = 0;
#pragma unroll
    for (int q = 0; q < 4; q++) {
      const int j = 8 * q + 4 * h;
      f32x4 b = bias ? *(const f32x4*)(bias + j) : (f32x4){0.f, 0.f, 0.f, 0.f};
#pragma unroll
      for (int e = 0; e < 4; e++) { float x = acc[mb][0][q * 4 + e] * rs + b[e]; v[q * 4 + e] = x; ss += x * x; }
    }
    ss = wsum32(ss);
    const float rr = frsq(ss * (1.f / 32.f) + EPSN);
#pragma unroll
    for (int q = 0; q < 4; q++) {
      f32x4 g = *(const f32x4*)(gain + 8 * q + 4 * h);
#pragma unroll
      for (int e = 0; e < 4; e++) v[q * 4 + e] *= rr * g[e];
    }
    const bool smp = m >= MP;
    if (state && !smp) {
      float* sp = state + st_row(m, ilayer) * 32;
#pragma unroll
      for (int q = 0; q < 4; q++) { f32x4 o = {v[q * 4], v[q * 4 + 1], v[q * 4 + 2], v[q * 4 + 3]}; *(f32x4*)(sp + 8 * q + 4 * h) = o; }
    }
    if (rope && smp) {
      const int t = tok_pos(m);
#pragma unroll
      for (int q = 0; q < 2; q++) {
        f32x4 c = *(const f32x4*)(p.ropeC32 + t * 16 + 8 * q + 4 * h), s = *(const f32x4*)(p.ropeS32 + t * 16 + 8 * q + 4 * h);
#pragma unroll
        for (int e = 0; e < 4; e++) { float x1 = v[q * 4 + e], x2 = v[(q + 2) * 4 + e]; v[q * 4 + e] = x1 * c[e] - x2 * s[e]; v[(q + 2) * 4 + e] = x2 * c[e] + x1 * s[e]; }
      }
    }
    h16* dst = dstf(m);
#pragma unroll
    for (int q = 0; q < 4; q++) {
      h16x4 o;
#pragma unroll
      for (int e = 0; e < 4; e++) o[e] = (h16)(v[q * 4 + e] * oscale);
      *(h16x4*)(dst + 8 * q + 4 * h) = o;
      if (dual) { for (int e = 0; e < 4; e++) dual[(size_t)tok_keyrow(m) * 32 + 8 * q + 4 * h + e] = v[q * 4 + e]; }
    }
  }
}
template <class RsF, class KrF>
DEVFN void epi_vt(const f32x16 (&acc)[2][2], int mbase, RsF rsf, const float* bias  , float* state, int spitch, int scol, int ilayer,
                  h16* vbuf, int vrow0, KrF krf) {
  const int TIDX = tid_op();
  const int lane = TIDX & 63, h = lane >> 5, e0 = lane & 31;
#pragma unroll
  for (int mb = 0; mb < 2; mb++)
#pragma unroll
    for (int q = 0; q < 4; q++) {
      const int mq = mbase + mb * 32 + 8 * q + 4 * h;
      float rs[4];
#pragma unroll
      for (int e = 0; e < 4; e++) rs[e] = rsf(mq + e);
      const int kr = krf(mq);
#pragma unroll
      for (int nb = 0; nb < 2; nb++) {
        const int col = nb * 32 + e0; const float b = bias ? bias[col] : 0.f;
        h16x4 o;
#pragma unroll
        for (int e = 0; e < 4; e++) {
          float x = acc[mb][nb][q * 4 + e] * rs[e] + b; o[e] = (h16)x;
          if (state && mq < MP) state[st_row(mq + e, ilayer) * spitch + scol + col] = x;
        }
        *(h16x4*)(vbuf + vidx(vrow0 + col, kr)) = o;
      }
    }
}

DEVFN void qgemm_tile(const Params& p, int l, int mt, int head, char* lds) {
  const int TIDX = tid_op();
  const int i = l >> 1; const int m0 = mt * 256;
  const int w = TIDX >> 6, wm = w >> 1, wn = w & 1;
  f32x16 acc[2][2];
  gemm_tile<true>(p.qa16, M, (p.wqb16 + (size_t)i * 1024 * 256), 1024, 256, m0, head * 128, lds, acc);
  const float* rq = p.rowss_qa + (size_t)i * M;
  auto rsf = [&](int m) { return frsq(rq[m] * (1.f / 256.f) + EPSN); };
  const float sc = LOG2E / sqrtf(96.f);
  if (wn == 0) epi_head64(p, acc, m0 + wm * 64, rsf, nullptr, p.mla_qn_nope + i * 64, false, sc, nullptr, 0, 0, i, [&](int m) { return p.QA + ((size_t)m * 8 + head) * 96; });
  else epi_head32(p, acc, m0 + wm * 64, rsf, nullptr, p.mla_qn_rope + i * 32, true, sc, nullptr, i, [&](int m) { return p.QA + ((size_t)m * 8 + head) * 96 + 64; });
}
DEVFN void kvgemm_tile(const Params& p, int l, int mt, int ntile, char* lds) {
  const int TIDX = tid_op();
  const int i = l >> 1; const int m0 = mt * 256;
  const int lane = TIDX & 63, w = TIDX >> 6, wm = w >> 1, wn = w & 1, h = lane >> 5;
  f32x16 acc[2][2];
  const float* rck = p.rowss_ckv + (size_t)i * KM;
  auto one = [&](int m) { return frsq(rck[m] * (1.f / 128.f) + EPSN); };
  if (ntile < 4) {
    gemm_tile<true>(p.ckv16, KM, (p.wkvb16 + (size_t)i * 1024 * 128), 1024, 128, m0, ntile * 128, lds, acc);
    const int head = ntile * 2 + wn;
    epi_head64(p, acc, m0 + wm * 64, one, nullptr, p.mla_kn_nope + i * 64, false, 1.f, nullptr, 0, 0, i, [&](int m) { return p.KA + ((size_t)head * KM + m) * 128; });
#pragma unroll
    for (int mb = 0; mb < 2; mb++) {
      const int kr = m0 + wm * 64 + mb * 32 + (lane & 31);
      const h16x8* s = (const h16x8*)(p.kpe16 + (size_t)kr * 32 + h * 16);
      h16x8* d = (h16x8*)(p.KA + ((size_t)head * KM + kr) * 128 + 64 + h * 16);
      d[0] = s[0]; d[1] = s[1];
    }
  } else {
    gemm_tile<false>(p.ckv16, KM, (p.wkvb16 + (size_t)i * 1024 * 128), 1024, 128, m0, ntile * 128, lds, acc);
    const int head = (ntile - 4) * 2 + wn;
    epi_vt(acc, m0 + wm * 64, one, nullptr, nullptr, 0, 0, i, p.VA, head * 64, [](int m) { return m; });
  }
}
DEVFN void outproj_tile(const Params& p, int l, int mt, int ntile, char* lds, bool dry = false) {
  const int TIDX = tid_op();
  const int m0 = mt * 256, n0 = ntile * 128;
  const int lane = TIDX & 63, w = TIDX >> 6, wm = w >> 1, wn = w & 1, h = lane >> 5;
  f32x16 acc[2][2];
  gemm_tile<true>(p.O16, M, (p.wout16 + (size_t)l * D * D), 1024, D, m0, n0, lds, acc);
  const int cv = tok_cv(m0); const int nw0 = n0 + wn * 64;
  const float* gate = p.modv + ((size_t)l * NCV + cv) * 3072 + 2048 + nw0;
  const float* nsc = p.modv + ((size_t)(l + 1) * NCV + cv) * 3072 + 1024 + nw0;
  const float* nnw = p.norm_w + (l + 1) * D + nw0;
#pragma unroll
  for (int mb = 0; mb < 2; mb++) {
    const int m = m0 + wm * 64 + mb * 32 + (lane & 31);
    const float* xr = xrow(p, l, m) + nw0; float* yr = p.Y + (size_t)m * D + nw0;
    float ss = 0;
#pragma unroll
    for (int nb = 0; nb < 2; nb++)
#pragma unroll
      for (int q = 0; q < 4; q++) {
        const int j = nb * 32 + 8 * q + 4 * h;
        f32x4 x = *(const f32x4*)(xr + j), g = *(const f32x4*)(gate + j), o;
#pragma unroll
        for (int e = 0; e < 4; e++) { o[e] = x[e] + g[e] * acc[mb][nb][q * 4 + e]; ss += o[e] * o[e]; }
        if (!dry) *(f32x4*)(yr + j) = o;
        if (l < 3 && !dry) {
          f32x4 s = *(const f32x4*)(nsc + j), nw = *(const f32x4*)(nnw + j); h16x4 oh;
#pragma unroll
          for (int e = 0; e < 4; e++) oh[e] = (h16)(o[e] * nw[e] * (1.f + s[e]));
          *(h16x4*)(p.xs16 + pidx(M, m, nw0 + j)) = oh;
        }
      }
    if (l < 3 && !dry) { ss = wsum32(ss); if (h == 0) atomicAdd(p.rowss_l + (size_t)(l + 1) * M + m, ss); }
  }
}
struct AttnItem {
  const h16 *k0, *k1; int kld;
  const h16 *v0, *v1;
  int kr0, nt0, kr1, nt1;
};
constexpr int A_RING = 3 * 32768;

template <int DQK, int NKI, int NVI, int NDB, bool NAMASK>
DEVFN void attn_core(const AttnItem& it, const h16* qptr, int qpitch, int ksel, int ta, int tb, const float* rpbl, int na_dr0  , int na_c,
                     char* lds, f32x16 (&o)[NDB], float& lsum_out) {
  const int TIDX = tid_op();
  constexpr int NIMG = NKI + NVI; constexpr int STG = NIMG * 8192;
  const int tid = TIDX, lane = tid & 63, h = lane >> 5;
  h16x8 qf[DQK / 16];
#pragma unroll
  for (int ks = 0; ks < DQK / 16; ks++) qf[ks] = *(const h16x8*)(qptr + (size_t)(lane & 31) * qpitch + ks * 16 + 8 * h);
#pragma unroll
  for (int db = 0; db < NDB; db++)
#pragma unroll
    for (int r = 0; r < 16; r++) o[db][r] = 0.f;
  float m_run = 0.f, lsum = 0.f; bool first = true;
  const int nt = it.nt0 + it.nt1;
  auto stage = [&](int t) {
    char* s = lds + (t % 3) * STG; const int kr = t < it.nt0 ? it.kr0 + 64 * t : it.kr1 + 64 * (t - it.nt0);
    stage_rows<64>(it.k0 + (size_t)kr * it.kld, it.kld, s, tid);
    if (NKI == 2) stage_rows<64>(it.k1 + (size_t)kr * it.kld, it.kld, s + 8192, tid);
    stage_rows<64>(it.v0 + (size_t)(kr >> 6) * (512 * 64), 64, s + NKI * 8192, tid);
    if (NVI == 2) stage_rows<64>(it.v1 + (size_t)(kr >> 6) * (512 * 64), 64, s + NKI * 8192 + 8192, tid);
  };
  stage(0); if (nt > 1) stage(1);
  const int l5 = lane & 31;
  const int prow = (l5 & 19) | ((l5 & 4) << 1) | ((l5 & 8) >> 1);
  int na_cs = na_c - 8; na_cs = na_cs < 0 ? 0 : (na_cs > GW - 16 ? GW - 16 : na_cs);
  for (int t = 0; t < nt; t++) {
    if (t + 1 < nt) { if (NIMG == 2) WAITV(2); else if (NIMG == 3) WAITV(3); else WAITV(4); } else WAITV(0);
    RAWBAR();
    if (t + 2 < nt) stage(t + 2);
    const bool active = (t >= it.nt0) || (t >= ta && t < tb);
    if (active) {
      const char* s = lds + (t % 3) * STG;
      const char* sv = s + NKI * 8192;
      h16x8 kf[2][DQK / 16];
#pragma unroll
      for (int kb = 0; kb < 2; kb++)
#pragma unroll
        for (int ks = 0; ks < DQK / 16; ks++) {
          const int img = (DQK == 96) ? (ks >> 2) : ksel;
          kf[kb][ks] = *(const h16x8*)(s + img * 8192 + img_off(32 * kb + prow, 2 * (ks & 3) + h));
        }
      __builtin_amdgcn_sched_barrier(0);
      f32x16 st[2];
#pragma unroll
      for (int kb = 0; kb < 2; kb++) {
#pragma unroll
        for (int r = 0; r < 16; r++) st[kb][r] = -m_run;
#pragma unroll
        for (int ks = 0; ks < DQK / 16; ks++) st[kb] = __builtin_amdgcn_mfma_f32_32x32x16_f16(kf[kb][ks], qf[ks], st[kb], 0, 0, 0);
      }
      __builtin_amdgcn_sched_barrier(0);
      h16x8 vf[2][4];
#pragma unroll
      for (int db = 0; db < 2; db++)
#pragma unroll
        for (int sI = 0; sI < 4; sI++) vf[db][sI] = *(const h16x8*)(sv + img_off(db * 32 + l5, 2 * sI + h));
      __builtin_amdgcn_sched_barrier(0);
      if (NAMASK && t < it.nt0) {
        const int drow = (na_dr0 + t) * 31 + 15 - na_c;
#pragma unroll
        for (int kb = 0; kb < 2; kb++)
#pragma unroll
          for (int r = 0; r < 16; r++) {
            const int kcol = 32 * kb + (r & 7) + 8 * h + 16 * (r >> 3);
            const bool valid = (unsigned)(kcol - na_cs) < 16u;
            const float bv = rpbl[valid ? drow + kcol : 0];
            st[kb][r] = valid ? st[kb][r] + bv : -1e30f;
          }
      }
      float mx;
      {
        float m0 = max3f(st[0][0], st[0][1], st[0][2]), m1 = max3f(st[1][0], st[1][1], st[1][2]);
#pragma unroll
        for (int r = 3; r < 15; r += 2) { m0 = max3f(m0, st[0][r], st[0][r + 1]); m1 = max3f(m1, st[1][r], st[1][r + 1]); }
        mx = max3f(m0, m1, st[0][15]); mx = fmaxf(mx, st[1][15]);
      }
      { auto sw = __builtin_amdgcn_permlane32_swap(__float_as_uint(mx), __float_as_uint(mx), false, false); mx = fmaxf(__uint_as_float(sw[0]), __uint_as_float(sw[1])); }
      if (first || !__all(mx <= 8.f)) {
        const float delta = first ? mx : fmaxf(mx, 0.f);
        const float al = __builtin_amdgcn_exp2f(-delta); m_run += delta; lsum *= al; first = false;
#pragma unroll
        for (int db = 0; db < NDB; db++)
#pragma unroll
          for (int r = 0; r < 16; r++) o[db][r] *= al;
#pragma unroll
        for (int kb = 0; kb < 2; kb++)
#pragma unroll
          for (int r = 0; r < 16; r++) st[kb][r] -= delta;
      }
      float sum = 0.f;
#pragma unroll
      for (int kb = 0; kb < 2; kb++)
#pragma unroll
        for (int r = 0; r < 16; r++) { float pe = __builtin_amdgcn_exp2f(st[kb][r]); st[kb][r] = pe; sum += pe; }
      lsum += sum;
      h16x8 pf[4];
#pragma unroll
      for (int sI = 0; sI < 4; sI++) {
        u32x4 pk;
#pragma unroll
        for (int j = 0; j < 4; j++) pk[j] = __builtin_bit_cast(unsigned, __builtin_amdgcn_cvt_pkrtz(st[sI >> 1][8 * (sI & 1) + 2 * j], st[sI >> 1][8 * (sI & 1) + 2 * j + 1]));
        pf[sI] = __builtin_bit_cast(h16x8, pk);
      }
      __builtin_amdgcn_sched_barrier(0);
      if (NDB == 4) {
        h16x8 vg[2][4];
#pragma unroll
        for (int db = 0; db < 2; db++)
#pragma unroll
          for (int sI = 0; sI < 4; sI++) vg[db][sI] = *(const h16x8*)(sv + 8192 + img_off(db * 32 + l5, 2 * sI + h));
#pragma unroll
        for (int db = 0; db < 2; db++)
#pragma unroll
          for (int sI = 0; sI < 4; sI++) o[db] = __builtin_amdgcn_mfma_f32_32x32x16_f16(vf[db][sI], pf[sI], o[db], 0, 0, 0);
#pragma unroll
        for (int db = 0; db < 2; db++)
#pragma unroll
          for (int sI = 0; sI < 4; sI++) o[NDB == 4 ? 2 + db : db] = __builtin_amdgcn_mfma_f32_32x32x16_f16(vg[db][sI], pf[sI], o[NDB == 4 ? 2 + db : db], 0, 0, 0);
      } else {
#pragma unroll
        for (int db = 0; db < 2; db++)
#pragma unroll
          for (int sI = 0; sI < 4; sI++) o[db] = __builtin_amdgcn_mfma_f32_32x32x16_f16(vf[db][sI], pf[sI], o[db], 0, 0, 0);
      }
      __builtin_amdgcn_sched_barrier(0);
    }
  }
  RAWBAR();
  lsum_out = lsum + __shfl_xor(lsum, 32);
}
template <int NDB>
DEVFN void attn_store_gated(const Params& p, const f32x16 (&o)[NDB], float inv, int m, int col0) {
  const int TIDX = tid_op();
  const int h = (TIDX & 63) >> 5;
#pragma unroll
  for (int db = 0; db < NDB; db++)
#pragma unroll
    for (int q = 0; q < 4; q++) {
      const int c = col0 + 32 * db + 8 * q + 4 * h;
      h16x4 g = *(const h16x4*)(p.gates16 + (size_t)m * 1024 + c), ov;
#pragma unroll
      for (int e = 0; e < 4; e++) ov[e] = (h16)(o[db][q * 4 + e] * inv * (float)g[e]);
      *(h16x4*)(p.O16 + pidx(M, m, c)) = ov;
    }
}
DEVFN void attn_even_item(const Params& p, int l, int item, char* lds) {
  const int TIDX = tid_op();
  const int i = l >> 1; const int lane = TIDX & 63, w = TIDX >> 6, h = lane >> 5;
  const int grp = item >> 7, j0 = item & 127; const bool smp = grp < 2; const bool isdiff = (grp & 1) == 0;
  const int xx = j0 & 7, kk = j0 >> 3;
  const int j = !smp ? j0 : (isdiff ? ((xx << 4) | kk) : (((xx * 2 + (kk >> 3)) << 3) | (kk & 7)));
  AttnItem it{}; it.nt1 = 0; it.kr1 = 0;
  if (isdiff) {
    int b, hh, t0;
    if (smp) { b = j >> 6; hh = (j >> 4) & 3; t0 = (j & 15) * 128; it.kr0 = MP + b * TKS; it.nt0 = TKS / 64; }
    else { b = j >> 3; hh = (j >> 1) & 3; t0 = (j & 1) * 128; it.kr0 = b * SEQ; it.nt0 = SEQ / 64; }
    const int comp = w >> 2;
    const int m0w = (smp ? MP + b * DS : b * SEQ) + t0 + (w & 3) * 32;
    it.k0 = p.KB + (size_t)(2 * hh) * KM * 64; it.k1 = p.KB + (size_t)(2 * hh + 1) * KM * 64; it.kld = 64;
    it.v0 = p.VB + (size_t)(hh * 128) * 64; it.v1 = p.VB + (size_t)(hh * 128 + 64) * 64;
    f32x16 o[4]; float lsum;
    attn_core<64, 2, 2, 4, false>(it, p.QB + ((size_t)m0w * 8 + 2 * hh + comp) * 64, 512, comp, 0, 1 << 30, nullptr, 0, 0, lds, o, lsum);
    const float inv = 1.f / lsum;
    float* a2 = (float*)lds + (size_t)(w & 3) * 32 * 132 + (size_t)(lane & 31) * 132;
    if (comp == 1) {
#pragma unroll
      for (int db = 0; db < 4; db++)
#pragma unroll
        for (int q = 0; q < 4; q++) { f32x4 v = {o[db][q * 4] * inv, o[db][q * 4 + 1] * inv, o[db][q * 4 + 2] * inv, o[db][q * 4 + 3] * inv}; *(f32x4*)(a2 + 32 * db + 8 * q + 4 * h) = v; }
    }
    __syncthreads();
    if (comp == 0) {
      const float lam = p.lamv[i]; const float lam_init = 0.8f - 0.6f * expf(-0.3f * l);
      float ss = 0;
#pragma unroll
      for (int db = 0; db < 4; db++)
#pragma unroll
        for (int q = 0; q < 4; q++) {
          f32x4 v2 = *(const f32x4*)(a2 + 32 * db + 8 * q + 4 * h);
#pragma unroll
          for (int e = 0; e < 4; e++) { float d = o[db][q * 4 + e] * inv - lam * v2[e]; o[db][q * 4 + e] = d; ss += d * d; }
        }
      ss = wsum32(ss);
      const float rr = (1.f - lam_init) * frsq(ss * (1.f / 128.f) + EPSN);
      const int m = m0w + (lane & 31);
#pragma unroll
      for (int db = 0; db < 4; db++)
#pragma unroll
        for (int q = 0; q < 4; q++) {
          const int dv = 32 * db + 8 * q + 4 * h; const int c = 512 + hh * 128 + dv;
          f32x4 sg = *(const f32x4*)(p.diff_subln + i * 128 + dv);
          h16x4 g = *(const h16x4*)(p.gates16 + (size_t)m * 1024 + c), ov;
#pragma unroll
          for (int e = 0; e < 4; e++) ov[e] = (h16)(o[db][q * 4 + e] * rr * sg[e] * (float)g[e]);
          *(h16x4*)(p.O16 + pidx(M, m, c)) = ov;
        }
    }
    __syncthreads();
  } else {
    int b, head, t0;
    if (smp) { b = j >> 6; head = (j >> 3) & 7; t0 = (j & 7) * 256; it.kr0 = MP + b * TKS; it.nt0 = TKS / 64; }
    else { b = j >> 3; head = j & 7; t0 = 0; it.kr0 = b * SEQ; it.nt0 = SEQ / 64; }
    const int m0w = (smp ? MP + b * DS : b * SEQ) + t0 + w * 32;
    it.k0 = p.KA + (size_t)head * KM * 128; it.k1 = it.k0 + 64; it.kld = 128;
    it.v0 = p.VA + (size_t)(head * 64) * 64; it.v1 = it.v0;
    f32x16 o[2]; float lsum;
    attn_core<96, 2, 1, 2, false>(it, p.QA + ((size_t)m0w * 8 + head) * 96, 768, 0, 0, 1 << 30, nullptr, 0, 0, lds, o, lsum);
    attn_store_gated<2>(p, o, 1.f / lsum, m0w + (lane & 31), head * 64);
  }
}
DEVFN void attn_odd_item(const Params& p, int l, int item, char* lds) {
  const int TIDX = tid_op();
  const int i = l >> 1; const int lane = TIDX & 63, w = TIDX >> 6;
  const int grp = item >> 7, j0 = item & 127; const bool smp = grp < 2; const bool isgqa = (grp & 1) == 0;
  const int xx = j0 & 7, kk = j0 >> 3;
  const int j = !smp ? j0 : (isgqa ? (((xx >> 1) << 5) | ((xx & 1) << 4) | kk) : (((xx * 2 + (kk >> 3)) << 3) | (kk & 7)));
  AttnItem it{}; it.nt1 = 0; it.kr1 = 0; it.kld = 64;
  f32x16 o[2]; float lsum;
  if (isgqa) {
    int b, kvh, t0;
    if (smp) { b = j >> 6; kvh = (j >> 5) & 1; t0 = (j & 31) * 64; it.kr0 = MP + b * TKS; it.nt0 = TKS / 64; }
    else { b = j >> 3; kvh = (j >> 2) & 1; t0 = (j & 3) * 64; it.kr0 = b * SEQ; it.nt0 = SEQ / 64; }
    const int head = kvh * 4 + (w >> 1);
    const int m0w = (smp ? MP + b * DS : b * SEQ) + t0 + (w & 1) * 32;
    it.k0 = p.KB + (size_t)kvh * KM * 64; it.k1 = it.k0; it.v0 = p.VB + (size_t)(kvh * 64) * 64; it.v1 = it.v0;
    attn_core<64, 1, 1, 2, false>(it, p.QB + ((size_t)m0w * 8 + head) * 64, 512, 0, 0, 1 << 30, nullptr, 0, 0, lds, o, lsum);
    attn_store_gated<2>(p, o, 1.f / lsum, m0w + (lane & 31), 512 + head * 64);
  } else if (!smp) {
    const int b = j >> 3, head = j & 7; it.kr0 = b * SEQ; it.nt0 = SEQ / 64;
    const int m0w = b * SEQ + w * 32;
    it.k0 = p.KA + (size_t)head * KM * 64; it.k1 = it.k0; it.v0 = p.VA + (size_t)(head * 64) * 64; it.v1 = it.v0;
    attn_core<64, 1, 1, 2, false>(it, p.QA + ((size_t)m0w * 8 + head) * 64, 512, 0, 0, 1 << 30, nullptr, 0, 0, lds, o, lsum);
    attn_store_gated<2>(p, o, 1.f / lsum, m0w + (lane & 31), head * 64);
  } else {
    const int b = j >> 6, head = (j >> 3) & 7, r0 = (j & 7) * 4;
    const int r = r0 + (w >> 1), c0 = (w & 1) * 32;
    auto rsf = [](int rr) { int s = rr - 4; return s < 0 ? 0 : (s > GROWS - 8 ? GROWS - 8 : s); };
    const int rlo = rsf(r0), rhi = rsf(r0 + 3) + 8;
    const int kbase = MP + b * TKS;
    it.kr0 = kbase + rlo * 64; it.nt0 = rhi - rlo; it.kr1 = kbase + DS; it.nt1 = PAST / 64;
    it.k0 = p.KA + (size_t)head * KM * 64; it.k1 = it.k0; it.v0 = p.VA + (size_t)(head * 64) * 64; it.v1 = it.v0;
    float* rpbl = (float*)(lds + A_RING);
    { const float* src = p.na_rpb + ((size_t)i * 8 + head) * 465; for (int k = TIDX; k < 465; k += 512) rpbl[k] = src[k] * LOG2E; }
    const int m0w = MP + b * DS + r * 64 + c0;
    const int ta = rsf(r) - rlo;
    attn_core<64, 1, 1, 2, true>(it, p.QA + ((size_t)m0w * 8 + head) * 64, 512, 0, ta, ta + 8, rpbl, rlo - r + 7, c0 + (lane & 31), lds, o, lsum);
    attn_store_gated<2>(p, o, 1.f / lsum, m0w + (lane & 31), head * 64);
  }
}
constexpr int G8_HTB = 128 * 64 * 2, G8_STAGE = 8 * G8_HTB;
DEVFN int g8_lds_byte(int r, int c) { const int st = (r >> 4) * 2 + (c >> 5), rr = r & 15, cc = c & 31, ob = rr * 64 + cc * 2; return st * 1024 + (ob ^ (((ob >> 9) & 1) << 5)); }
DEVFN void g8_stage_rc(int b, int& R, int& C) { const int st = b / 1024, sb = b % 1024, swz = sb ^ (((sb >> 9) & 1) << 5); R = (st >> 1) * 16 + swz / 64; C = (st & 1) * 32 + (swz % 64) / 2; }
DEVFN int g8_perm32(int rho) { const int n = rho >> 4, i = rho & 15; return 8 * (i >> 2) + 4 * n + (i & 3); }
struct G8Unit { int pm, pn; };
DEVFN bool g8_next(int i, int nM, int nN, int G, int c, G8Unit& u) {
  const int nwg = nM * nN; const long L = (long)i * G + c; if (L >= nwg) return false;
  int wgid = (int)L; { const int q = nwg / 8, r = nwg % 8, xcd = wgid % 8, off = wgid / 8; wgid = (xcd < r ? xcd * (q + 1) : r * (q + 1) + (xcd - r) * q) + off; }
  const int nig = 8 * nN, gid = wgid / nig, fm = gid * 8, gsz = (nM - fm) < 8 ? (nM - fm) : 8;
  u.pm = fm + ((wgid % nig) % gsz); u.pn = (wgid % nig) / gsz; return true;
}
template <class Epi>
DEVFN void gemm8_phase(LAS unsigned char* lds, const h16* A, int RA, const h16* Bt, int RB, int K, int nM, int nN, const Epi& E) {
  const int tid = tid_op(), wid = __builtin_amdgcn_readfirstlane(tid >> 6), lane = tid & 63, wr = wid >> 2, wc = wid & 3, fr = lane & 15, fq = lane >> 4;
  const int nt = K / 64; const int Gg = gridDim.x, cc = blockIdx.x;
  unsigned voffA[2], voffB[2];
#pragma unroll
  for (int i = 0; i < 2; ++i) { int R, C; g8_stage_rc(tid * 16 + i * 8192, R, C); const int Rb = (R & ~31) + g8_perm32(R & 31);
    voffA[i] = (unsigned)(R * 64 + C) * 2u; voffB[i] = (unsigned)(Rb * 64 + C) * 2u; }
  const size_t kstepA = (size_t)RA * 128, kstepB = (size_t)RB * 128;
  const size_t hstep = (size_t)128 * 128;
  const size_t tstep = 2 * hstep;
  const unsigned ldsw = (unsigned)wid * 1024u;
  const int aoff = g8_lds_byte(wr * 64 + fr, fq * 8), boff = g8_lds_byte(wc * 32 + fr, fq * 8);
#define G8_SA(b, h) (((b) * 2 + (h)) * G8_HTB)
#define G8_SB(b, h) ((4 + (b) * 2 + (h)) * G8_HTB)
#define G8_STAGE_(bufoff, gbase, voff) do { _Pragma("unroll") for (int _i = 0; _i < 2; ++_i) \
    __builtin_amdgcn_global_load_lds((const unsigned*)((const char*)(gbase) + (voff)[_i]), (LAS unsigned*)(lds + (bufoff) + ldsw + _i * 8192), 16, 0, 0); } while (0)
#define G8_LDA(dst, b, h) do { _Pragma("unroll") for (int m = 0; m < 4; ++m) _Pragma("unroll") for (int k = 0; k < 2; ++k) dst[m][k] = *(const LAS h16x8*)(lds + G8_SA(b, h) + aoff + m * 2048 + k * 1024); } while (0)
#define G8_LDB(dst, b, h) do { _Pragma("unroll") for (int n = 0; n < 2; ++n) _Pragma("unroll") for (int k = 0; k < 2; ++k) dst[n][k] = *(const LAS h16x8*)(lds + G8_SB(b, h) + boff + n * 2048 + k * 1024); } while (0)
#define G8_MMA(ai, bj, At, Bt_) do { __builtin_amdgcn_s_setprio(1); _Pragma("unroll") for (int m = 0; m < 4; ++m) _Pragma("unroll") for (int n = 0; n < 2; ++n) _Pragma("unroll") for (int k = 0; k < 2; ++k) \
    acc[ai][bj][m][n] = __builtin_amdgcn_mfma_f32_16x16x32_f16(Bt_[n][k], At[m][k], acc[ai][bj][m][n], 0, 0, 0); __builtin_amdgcn_s_setprio(0); } while (0)
#define G8_WAIT_L(n) asm volatile("s_waitcnt lgkmcnt(" #n ")" ::: "memory")
#define G8_BAR __builtin_amdgcn_s_barrier()
#define G8_SCHED __builtin_amdgcn_sched_barrier(0)
  G8Unit cur, nxt; int ui = 0;
  if (!g8_next(0, nM, nN, Gg, cc, cur)) return;
  f32x4 acc[2][2][4][2];
#pragma unroll
  for (int a = 0; a < 2; ++a)
#pragma unroll
    for (int b = 0; b < 2; ++b)
#pragma unroll
      for (int m = 0; m < 4; ++m)
#pragma unroll
        for (int n = 0; n < 2; ++n) acc[a][b][m][n] = (f32x4){0.f, 0.f, 0.f, 0.f};
  h16x8 At[4][2], B0[2][2], B1[2][2];
  const char* cA = (const char*)A + (size_t)cur.pm * tstep; const char* cB = (const char*)Bt + (size_t)cur.pn * tstep;
  G8_STAGE_(G8_SB(0, 0), cB, voffB); G8_STAGE_(G8_SA(0, 0), cA, voffA); G8_STAGE_(G8_SB(0, 1), cB + hstep, voffB); G8_STAGE_(G8_SA(0, 1), cA + hstep, voffA);
  if (wr == 1) G8_BAR;
  WAITV(4); G8_BAR;
  G8_STAGE_(G8_SB(1, 0), cB + kstepB, voffB); G8_STAGE_(G8_SA(1, 0), cA + kstepA, voffA); G8_STAGE_(G8_SB(1, 1), cB + hstep + kstepB, voffB);
  WAITV(6); G8_BAR;
  for (;;) {
    const bool has_next = g8_next(ui + 1, nM, nN, Gg, cc, nxt);
    const char* nA = has_next ? (const char*)A + (size_t)nxt.pm * tstep : cA; const char* nB = has_next ? (const char*)Bt + (size_t)nxt.pn * tstep : cB;
    for (int t = 0; t < nt; t += 2) {
      const bool last = (t == nt - 2);
      const char* a1 = cA + (size_t)(t + 1) * kstepA;
      const char* a2 = last ? nA : cA + (size_t)(t + 2) * kstepA; const char* b2 = last ? nB : cB + (size_t)(t + 2) * kstepB;
      const char* a3 = a2 + kstepA; const char* b3 = b2 + kstepB;
      G8_LDB(B0, 0, 0); G8_SCHED; G8_LDA(At, 0, 0); G8_STAGE_(G8_SA(1, 1), a1 + hstep, voffA);
      G8_WAIT_L(8); G8_BAR; G8_WAIT_L(0); G8_MMA(0, 0, At, B0); G8_BAR; G8_SCHED;
      G8_LDB(B1, 0, 1); G8_STAGE_(G8_SB(0, 0), b2, voffB);
      G8_BAR; G8_WAIT_L(0); G8_MMA(0, 1, At, B1); G8_BAR;
      G8_LDA(At, 0, 1); G8_STAGE_(G8_SA(0, 0), a2, voffA);
      G8_BAR; G8_WAIT_L(0); G8_MMA(1, 0, At, B0); G8_BAR; G8_SCHED;
      G8_STAGE_(G8_SB(0, 1), b2 + hstep, voffB);
      WAITV(6); G8_BAR; G8_MMA(1, 1, At, B1); G8_BAR;
      G8_LDB(B0, 1, 0); G8_SCHED; G8_LDA(At, 1, 0); G8_STAGE_(G8_SA(0, 1), a2 + hstep, voffA);
      G8_WAIT_L(8); G8_BAR; G8_WAIT_L(0); G8_MMA(0, 0, At, B0); G8_BAR; G8_SCHED;
      G8_LDB(B1, 1, 1); G8_STAGE_(G8_SB(1, 0), b3, voffB);
      G8_BAR; G8_WAIT_L(0); G8_MMA(0, 1, At, B1); G8_BAR;
      G8_LDA(At, 1, 1); G8_STAGE_(G8_SA(1, 0), a3, voffA);
      G8_BAR; G8_WAIT_L(0); G8_MMA(1, 0, At, B0); G8_BAR; G8_SCHED;
      G8_STAGE_(G8_SB(1, 1), b3 + hstep, voffB);
      WAITV(6); G8_BAR; G8_MMA(1, 1, At, B1); G8_BAR;
    }
#pragma unroll 1
    for (int e_ = 0; e_ < REP_EPI; e_++)
    E(acc, cur, wr, wc, fr, fq, e_ > 0);
    if (!has_next) break;
#pragma unroll
    for (int a = 0; a < 2; ++a)
#pragma unroll
      for (int b = 0; b < 2; ++b)
#pragma unroll
        for (int m = 0; m < 4; ++m)
#pragma unroll
          for (int n = 0; n < 2; ++n) acc[a][b][m][n] = (f32x4){0.f, 0.f, 0.f, 0.f};
    cur = nxt; cA = nA; cB = nB; ++ui;
  }
  WAITV(0);
  if (wr == 0) G8_BAR;
  G8_BAR;
#undef G8_SA
#undef G8_SB
#undef G8_STAGE_
#undef G8_LDA
#undef G8_LDB
#undef G8_MMA
#undef G8_WAIT_L
#undef G8_BAR
#undef G8_SCHED
}

DEVFN float fq_sum(float v) {
  auto a = __builtin_amdgcn_permlane16_swap(__float_as_uint(v), __float_as_uint(v), false, false); v = __uint_as_float(a[0]) + __uint_as_float(a[1]);
  auto b = __builtin_amdgcn_permlane32_swap(__float_as_uint(v), __float_as_uint(v), false, false); return __uint_as_float(b[0]) + __uint_as_float(b[1]);
}
struct InprojEpi {
  const Params& p; int l; bool dry; LAS unsigned char* scratch;
  DEVFN void operator()(const f32x4 (&acc)[2][2][4][2], const G8Unit& u_, int wr, int wc, int fr_, int fq_, bool dry2) const {
    int fr = fr_, fq = fq_; G8Unit u = u_;
    asm volatile("" : "+v"(fr), "+v"(fq), "+s"(u.pm), "+s"(u.pn));
    const int lane = fr + 16 * fq;
    const int i = l >> 1; const bool odd = l & 1;
    const int G = 4 * u.pn + wc;
    LAS unsigned char* tbase = scratch + (wr * 4 + wc) * 3072;
    const int m0 = u.pm * 256; const bool smp = m0 >= MP;
    enum { T_PAD, T_GATE, T_QHEAD, T_KHEAD, T_VT, T_QA, T_CKV, T_KPE };
    int ty = T_PAD, gcol = 0, head = 0, spitch = 0, scol = 0; bool rope = false; float oscale = 1.f;
    const float* gain = nullptr; float* state = nullptr; h16* qdst = nullptr; h16* kbuf = nullptr; h16* vbuf = nullptr;
    const float QS = LOG2E / 8.f;
    if (!odd) {
      if (G < 4) ty = T_QA;
      else if (G < 6) ty = T_CKV;
      else if (G == 6) { ty = T_KPE; gain = p.mla_kn_rope + i * 32; }
      else if (G == 7) ty = T_PAD;
      else if (G < 16) { ty = T_GATE; gcol = (G - 8) * 64; }
      else if (G < 24) { ty = T_QHEAD; head = G - 16; gain = p.diff_qn + i * 64; rope = true; oscale = QS; qdst = p.QB; }
      else if (G < 32) { ty = T_KHEAD; head = G - 24; gain = p.diff_kn + i * 64; rope = true; state = p.o_dk; spitch = 512; scol = head * 64; kbuf = p.KB; }
      else if (G < 40) { ty = T_VT; head = G - 32; state = p.o_dv; spitch = 512; scol = head * 64; vbuf = p.VB; }
      else { ty = T_GATE; gcol = 512 + (G - 40) * 64; }
    } else {
      if (G < 8) { ty = T_QHEAD; head = G; gain = p.na_qn + i * 64; oscale = QS; qdst = p.QA; }
      else if (G < 16) { ty = T_KHEAD; head = G - 8; gain = p.na_kn + i * 64; state = p.o_nk; spitch = 512; scol = head * 64; kbuf = p.KA; }
      else if (G < 24) { ty = T_VT; head = G - 16; state = p.o_nv; spitch = 512; scol = head * 64; vbuf = p.VA; }
      else if (G < 32) { ty = T_GATE; gcol = (G - 24) * 64; }
      else if (G < 40) { ty = T_QHEAD; head = G - 32; gain = p.gqa_qn + i * 64; rope = true; oscale = QS; qdst = p.QB; }
      else if (G < 42) { ty = T_KHEAD; head = G - 40; gain = p.gqa_kn + i * 64; rope = true; state = p.o_gk; spitch = 128; scol = head * 64; kbuf = p.KB; }
      else if (G < 44) { ty = T_VT; head = G - 42; state = p.o_gv; spitch = 128; scol = head * 64; vbuf = p.VB; }
      else { ty = T_GATE; gcol = 512 + (G - 44) * 64; }
    }
    if (ty == T_PAD) return;
    LAS float* cst = (LAS float*)(tbase + 2048);
    {
      const float* rowss = p.rowss_l + (size_t)l * M + m0 + 64 * wr;
      const float s0 = rowss[lane], s1 = rowss[128 + lane];
      const float bv = p.biasv[((size_t)l * NCV + tok_cv(m0)) * NPO + 256 * u.pn + 32 * wc + 128 * (lane >> 5) + (lane & 31)];
      const bool hasg = gain != nullptr && (ty != T_KPE || lane < 32);
      const float gv = hasg ? gain[lane] : 1.f;
      cst[lane] = frsq(s0 * (1.f / D) + EPSN); cst[64 + lane] = frsq(s1 * (1.f / D) + EPSN);
      cst[128 + lane] = bv; cst[192 + lane] = gv;
    }
    const bool roped = rope && smp;
    float invf[2][4];
    if (roped || (ty == T_KPE && smp)) {
      const float step = ty == T_KPE ? (2.f / 16.f) : (2.f / 32.f);
#pragma unroll
      for (int n = 0; n < 2; n++)
#pragma unroll
        for (int j = 0; j < 4; j++) {
          const int jj = ty == T_KPE ? (8 * (fq & 1) + 4 * n + j) & 7 : (8 * fq + 4 * n + j) & 15;
          invf[n][j] = __builtin_amdgcn_exp2f(-13.287712379549449f * step * (float)jj) * 0.15915494309189535f;
        }
    }
#pragma unroll
    for (int ai = 0; ai < 2; ai++)
#pragma unroll
      for (int m = 0; m < 4; m++) {
        const int r = m0 + 128 * ai + 64 * wr + 16 * m + fr;
        const float rs = cst[ai * 64 + m * 16 + fr];
        float v[2][2][4];
#pragma unroll
        for (int bj = 0; bj < 2; bj++)
#pragma unroll
          for (int n = 0; n < 2; n++) {
            const f32x4 b = *(const LAS f32x4*)(cst + 128 + 32 * bj + 8 * fq + 4 * n);
#pragma unroll
            for (int j = 0; j < 4; j++) v[bj][n][j] = acc[ai][bj][m][n][j] * rs + b[j];
          }
        float c2[2][4], s2[2][4];
        if (roped) {
          const int t = tok_pos(r); const float base = (float)(fq < 2 ? (t >> 6) : (t & 63));
#pragma unroll
          for (int n = 0; n < 2; n++)
#pragma unroll
            for (int j = 0; j < 4; j++) { const float x = base * invf[n][j]; c2[n][j] = __builtin_amdgcn_cosf(x); s2[n][j] = __builtin_amdgcn_sinf(x); }
        }
        if (ty == T_GATE) {
#pragma unroll
          for (int bj = 0; bj < 2; bj++) {
            h16x8 o;
#pragma unroll
            for (int n = 0; n < 2; n++)
#pragma unroll
              for (int j = 0; j < 4; j++) o[n * 4 + j] = (h16)fsilu(v[bj][n][j]);
            *(h16x8*)(p.gates16 + (size_t)r * 1024 + gcol + 32 * bj + 8 * fq) = o;
          }
        } else if (ty == T_QHEAD || ty == T_KHEAD) {
          float ss = 0;
#pragma unroll
          for (int bj = 0; bj < 2; bj++)
#pragma unroll
            for (int n = 0; n < 2; n++)
#pragma unroll
              for (int j = 0; j < 4; j++) ss += v[bj][n][j] * v[bj][n][j];
          ss = fq_sum(ss);
          const float rr = frsq(ss * (1.f / 64.f) + EPSN);
#pragma unroll
          for (int bj = 0; bj < 2; bj++)
#pragma unroll
            for (int n = 0; n < 2; n++) {
              const f32x4 g = *(const LAS f32x4*)(cst + 192 + 32 * bj + 8 * fq + 4 * n);
#pragma unroll
              for (int j = 0; j < 4; j++) v[bj][n][j] *= rr * g[j];
            }
          if (state && !smp) {
            float* sp = state + st_row(r, i) * spitch + scol + 8 * fq;
#pragma unroll
            for (int bj = 0; bj < 2; bj++)
#pragma unroll
              for (int n = 0; n < 2; n++) { f32x4 o = {v[bj][n][0], v[bj][n][1], v[bj][n][2], v[bj][n][3]}; *(f32x4*)(sp + 32 * bj + 4 * n) = o; }
          }
          if (roped) {
#pragma unroll
            for (int n = 0; n < 2; n++)
#pragma unroll
              for (int j = 0; j < 4; j++) { const float x1 = v[0][n][j], x2 = v[1][n][j]; v[0][n][j] = x1 * c2[n][j] - x2 * s2[n][j]; v[1][n][j] = x2 * c2[n][j] + x1 * s2[n][j]; }
          }
          h16* dst = ty == T_QHEAD ? qdst + ((size_t)r * 8 + head) * 64 : kbuf + ((size_t)head * KM + tok_keyrow(r)) * 64;
#pragma unroll
          for (int bj = 0; bj < 2; bj++) {
            h16x8 o;
#pragma unroll
            for (int n = 0; n < 2; n++)
#pragma unroll
              for (int j = 0; j < 4; j++) o[n * 4 + j] = (h16)(v[bj][n][j] * oscale);
            *(h16x8*)(dst + 32 * bj + 8 * fq) = o;
          }
        } else if (ty == T_VT) {
          const int kr = tok_keyrow(r);
          if (!smp) {
            float* sp = state + st_row(r, i) * spitch + scol + 8 * fq;
#pragma unroll
            for (int bj = 0; bj < 2; bj++)
#pragma unroll
              for (int n = 0; n < 2; n++) { f32x4 o = {v[bj][n][0], v[bj][n][1], v[bj][n][2], v[bj][n][3]}; *(f32x4*)(sp + 32 * bj + 4 * n) = o; }
          }
          {
            LAS h16* tb = (LAS h16*)(tbase);
#pragma unroll
            for (int bj = 0; bj < 2; bj++)
#pragma unroll
              for (int n = 0; n < 2; n++)
#pragma unroll
                for (int j = 0; j < 4; j++) tb[(32 * bj + 8 * fq + 4 * n + j) * 16 + fr] = (h16)v[bj][n][j];
            const h16x8 lo = *(const LAS h16x8*)(tb + lane * 16), hi = *(const LAS h16x8*)(tb + lane * 16 + 8);
            h16* dstv = vbuf + vidx(head * 64 + lane, kr - fr);
            *(h16x8*)dstv = lo; *(h16x8*)(dstv + 8) = hi;
          }
        } else if (ty == T_QA) {
          float ss = 0;
#pragma unroll
          for (int bj = 0; bj < 2; bj++) {
            h16x8 o;
#pragma unroll
            for (int n = 0; n < 2; n++)
#pragma unroll
              for (int j = 0; j < 4; j++) { o[n * 4 + j] = (h16)v[bj][n][j]; const float xr = (float)o[n * 4 + j]; ss += xr * xr; }
            *(h16x8*)(p.qa16 + pidx(M, r, 64 * G + 32 * bj + 8 * fq)) = o;
          }
          ss = fq_sum(ss);
          if (fq == 0 && !dry && !dry2) atomicAdd(p.rowss_qa + (size_t)i * M + r, ss);
        } else if (ty == T_CKV) {
          const int kr = tok_keyrow(r);
          float ss = 0;
#pragma unroll
          for (int bj = 0; bj < 2; bj++) {
            h16x8 o;
#pragma unroll
            for (int n = 0; n < 2; n++)
#pragma unroll
              for (int j = 0; j < 4; j++) { o[n * 4 + j] = (h16)v[bj][n][j]; const float xr = (float)o[n * 4 + j]; ss += xr * xr; }
            *(h16x8*)(p.ckv16 + pidx(KM, kr, 64 * (G - 4) + 32 * bj + 8 * fq)) = o;
          }
          ss = fq_sum(ss);
          if (fq == 0 && !dry && !dry2) atomicAdd(p.rowss_ckv + (size_t)i * KM + kr, ss);
        } else {
          float ss = 0;
#pragma unroll
          for (int n = 0; n < 2; n++)
#pragma unroll
            for (int j = 0; j < 4; j++) ss += v[0][n][j] * v[0][n][j];
          ss = fq_sum(ss);
          const float rr = frsq(ss * (1.f / 32.f) + EPSN);
          float w[2][4];
#pragma unroll
          for (int n = 0; n < 2; n++) {
            const f32x4 g = *(const LAS f32x4*)(cst + 192 + 8 * fq + 4 * n);
#pragma unroll
            for (int j = 0; j < 4; j++) w[n][j] = v[0][n][j] * rr * g[j];
          }
          if (!smp) {
            float* sp = p.o_kpe + st_row(r, i) * 32 + 8 * fq;
#pragma unroll
            for (int n = 0; n < 2; n++) { f32x4 o = {w[n][0], w[n][1], w[n][2], w[n][3]}; *(f32x4*)(sp + 4 * n) = o; }
          } else {
            const int t = tok_pos(r); const float base = (float)((fq & 1) == 0 ? (t >> 6) : (t & 63));
#pragma unroll
            for (int n = 0; n < 2; n++)
#pragma unroll
              for (int j = 0; j < 4; j++) {
                const float x = base * invf[n][j]; const float c = __builtin_amdgcn_cosf(x), s = __builtin_amdgcn_sinf(x);
                const float own = w[n][j], oth = __shfl_xor(own, 32);
                w[n][j] = fq < 2 ? own * c - oth * s : own * c + oth * s;
              }
          }
          h16x8 o;
#pragma unroll
          for (int n = 0; n < 2; n++)
#pragma unroll
            for (int j = 0; j < 4; j++) o[n * 4 + j] = (h16)w[n][j];
          *(h16x8*)(p.kpe16 + (size_t)tok_keyrow(r) * 32 + 8 * fq) = o;
        }
      }
  }
};
struct NullEpi {
  DEVFN void operator()(const f32x4 (&acc)[2][2][4][2], const G8Unit&, int, int, int, int, bool) const {
#pragma unroll
    for (int a = 0; a < 2; a++)
#pragma unroll
      for (int b = 0; b < 2; b++)
#pragma unroll
        for (int m = 0; m < 4; m++) asm volatile("" :: "v"(acc[a][b][m][0]), "v"(acc[a][b][m][1]));
  }
};
DEVFN int inproj_pos_col(int np) { const int pn = np >> 8, bj = (np >> 7) & 1, wc = (np >> 5) & 3, g = np & 31; return 64 * (4 * pn + wc) + 32 * bj + g; }

#define XB_TMO      128
#define XB_XCNT(j)  (256  + 64 * (j))
#define XB_XSUB(j)  (1280 + 64 * (j))
#define XB_XGEN(j)  (2304 + 64 * (j))
#define XB_TOP      3328
#define XB_TOPGEN   3392
#define XCD_BAR_WORDS 3456
#define XB_SPIN_CAP (1u << 20)
DEVFN unsigned xb_ld(unsigned* p) { return __hip_atomic_load(p, __ATOMIC_RELAXED, __HIP_MEMORY_SCOPE_AGENT); }
DEVFN unsigned xb_add(unsigned* p, unsigned v) { return __hip_atomic_fetch_add(p, v, __ATOMIC_RELAXED, __HIP_MEMORY_SCOPE_AGENT); }
DEVFN unsigned xb_xcc_id() { return (unsigned)__builtin_amdgcn_s_getreg((3 << 11) | 20) & 0xFu; }
#define XB_SPIN(cond, bar) do { unsigned _sp = 0; while (cond) { __builtin_amdgcn_s_sleep(1); \
    if ((++_sp & 255u) == 0u) { if (xb_ld(&(bar)[XB_TMO])) break; if (_sp > XB_SPIN_CAP) { atomicAdd(&(bar)[XB_TMO], 1u); break; } } } } while (0)
struct XcdBarrier { unsigned* bar; unsigned x; volatile LAS unsigned* st; };
DEVFN XcdBarrier xcd_barrier_post(unsigned* bar, volatile LAS unsigned* st) {
  const int TIDX = tid_op();
  XcdBarrier b; b.bar = bar; b.x = xb_xcc_id(); b.st = st;
  if (TIDX == 0) (void)xb_add(&bar[XB_XCNT(b.x)], 1u);
  return b;
}
DEVFN void xcd_barrier_complete(unsigned* bar, unsigned x, unsigned& nloc, unsigned& nx) {
  const unsigned G = gridDim.x * gridDim.y * gridDim.z;
  unsigned sum, cnt, mine, sp = 0u;
  for (;;) {
    sum = 0u; cnt = 0u; mine = 0u;
#pragma unroll
    for (unsigned j = 0; j < 16; ++j) { const unsigned c = xb_ld(&bar[XB_XCNT(j)]); sum += c; cnt += (c > 0u) ? 1u : 0u; mine = (j == x) ? c : mine; }
    if (sum == G) break;
    __builtin_amdgcn_s_sleep(1);
    if ((++sp & 255u) == 0u) { if (xb_ld(&bar[XB_TMO])) break; if (sp > XB_SPIN_CAP) { atomicAdd(&bar[XB_TMO], 1u); break; } }
  }
  nloc = mine > 0u ? mine : 1u; nx = cnt > 0u ? cnt : 1u;
}
DEVFN void xcd_barrier(const XcdBarrier& b) {
  const int TIDX = tid_op();
  asm volatile("s_waitcnt vmcnt(0)" ::: "memory");
  __syncthreads();
  if (TIDX == 0) {
    unsigned* bar = b.bar;
    __builtin_amdgcn_s_waitcnt(0);
    unsigned nloc = b.st[0], nx = b.st[1];
    if (nloc == 0u) { xcd_barrier_complete(bar, b.x, nloc, nx); b.st[0] = nloc; b.st[1] = nx; }
    const unsigned old = xb_add(&bar[XB_XSUB(b.x)], 1u);
    const unsigned gen = old / nloc;
    if (old + 1u == (gen + 1u) * nloc) {
      __builtin_amdgcn_fence(__ATOMIC_RELEASE, "agent");
      asm volatile("s_waitcnt vmcnt(0)" ::: "memory");
      const unsigned og = xb_add(&bar[XB_TOP], 1u);
      const unsigned tg = og / nx;
      if (og + 1u == (tg + 1u) * nx) xb_add(&bar[XB_TOPGEN], 1u);
      else XB_SPIN(xb_ld(&bar[XB_TOPGEN]) == tg, bar);
      __builtin_amdgcn_fence(__ATOMIC_ACQUIRE, "agent");
      xb_add(&bar[XB_XGEN(b.x)], 1u);
      asm volatile("s_waitcnt vmcnt(0)" ::: "memory");
    } else {
      XB_SPIN(xb_ld(&bar[XB_XGEN(b.x)]) == gen, bar);
      __builtin_amdgcn_fence(__ATOMIC_ACQUIRE, "agent");
      asm volatile("s_waitcnt vmcnt(0)" ::: "memory");
    }
  }
  __syncthreads();
}

DEVFN void cache_ckv_all(const Params& p, int l, int gtid, int gthreads) {
  const int i = l >> 1;
  for (int e = gtid; e < DB * PAST * 20; e += gthreads) {
    const int c8 = e % 20, pos = (e / 20) % PAST, b = e / (20 * PAST);
    const int kr = MP + b * TKS + DS + pos; const size_t crow = ((size_t)(b * 2 + i) * PAST + pos);
    h16x8 o;
    if (c8 < 16) {
      const f32x4 a0 = *(const f32x4*)(p.cache_mla_ckv + crow * 128 + c8 * 8), a1 = *(const f32x4*)(p.cache_mla_ckv + crow * 128 + c8 * 8 + 4);
      const f32x4 g0 = *(const f32x4*)(p.mla_kva_norm + i * 128 + c8 * 8), g1 = *(const f32x4*)(p.mla_kva_norm + i * 128 + c8 * 8 + 4);
#pragma unroll
      for (int j = 0; j < 4; j++) { o[j] = (h16)(a0[j] * __builtin_amdgcn_rcpf(g0[j])); o[4 + j] = (h16)(a1[j] * __builtin_amdgcn_rcpf(g1[j])); }
      *(h16x8*)(p.ckv16 + pidx(KM, kr, c8 * 8)) = o;
      if (c8 == 0) p.rowss_ckv[(size_t)i * KM + kr] = 128.f * (1.f - EPSN);
    } else {
      const f32x4 a0 = *(const f32x4*)(p.cache_mla_kpe + crow * 32 + (c8 - 16) * 8), a1 = *(const f32x4*)(p.cache_mla_kpe + crow * 32 + (c8 - 16) * 8 + 4);
#pragma unroll
      for (int j = 0; j < 4; j++) { o[j] = (h16)a0[j]; o[4 + j] = (h16)a1[j]; }
      *(h16x8*)(p.kpe16 + (size_t)kr * 32 + (c8 - 16) * 8) = o;
    }
  }
}
DEVFN void cache_items(const Params& p, int l, int gtid, int gthreads) {
  const int i = l >> 1;
  if ((l & 1) == 0) {
    const int per = 128 + 32 + 512 + 512;
    for (int e = gtid; e < DB * PAST * per; e += gthreads) {
      const int u = e % per; const int bp = e / per; const int pos = bp % PAST, b = bp / PAST;
      const int kr = MP + b * TKS + DS + pos; const size_t crow = ((size_t)(b * 2 + i) * PAST + pos);
      if (u < 160) { }
      else if (u < 672) { const int c = u - 160; p.KB[((size_t)(c >> 6) * KM + kr) * 64 + (c & 63)] = (h16)p.cache_diff_k[crow * 512 + c]; }
      else { const int c = u - 672; p.VB[vidx(c, kr)] = (h16)p.cache_diff_v[crow * 512 + c]; }
    }
  } else {
    const int per = 512 + 512 + 128 + 128;
    for (int e = gtid; e < DB * PAST * per; e += gthreads) {
      const int u = e % per; const int bp = e / per; const int pos = bp % PAST, b = bp / PAST;
      const int kr = MP + b * TKS + DS + pos; const size_t crow = ((size_t)(b * 2 + i) * PAST + pos);
      if (u < 512) p.KA[((size_t)(u >> 6) * KM + kr) * 64 + (u & 63)] = (h16)p.cache_na_k[crow * 512 + u];
      else if (u < 1024) { const int c = u - 512; p.VA[vidx(c, kr)] = (h16)p.cache_na_v[crow * 512 + c]; }
      else if (u < 1152) { const int c = u - 1024; p.KB[((size_t)(c >> 6) * KM + kr) * 64 + (c & 63)] = (h16)p.cache_gqa_k[crow * 128 + c]; }
      else { const int c = u - 1152; p.VB[vidx(c, kr)] = (h16)p.cache_gqa_v[crow * 128 + c]; }
    }
  }
}

DEVFN void mod_item(const Params& p, int item, char* lds, bool dry = false) {
  const int tid = tid_op();
  const int l = item / 192, rem = item % 192, nchunk = rem / 32, kc = rem % 32;
  float* sil = (float*)lds;
  if (tid < NCV * 32) { const int cv = tid >> 5, k = tid & 31; const float* cvec = cv == 0 ? p.c_ctx : p.c + (size_t)(cv - 1) * D; sil[tid] = siluf(cvec[kc * 32 + k]); }
  const int col = nchunk * 512 + tid;
  const float* w = p.w_mod + ((size_t)l * D + kc * 32) * 3072 + col;
  float wv[32];
#pragma unroll
  for (int k = 0; k < 32; k++) wv[k] = w[(size_t)k * 3072];
  __syncthreads();
  float acc[NCV];
#pragma unroll
  for (int c = 0; c < NCV; c++) acc[c] = 0.f;
#pragma unroll
  for (int k = 0; k < 32; k++) {
#pragma unroll
    for (int c = 0; c < NCV; c++) acc[c] += sil[c * 32 + k] * wv[k];
  }
  const float b = kc == 0 ? p.b_mod[l * 3072 + col] : 0.f;
#pragma unroll
  for (int c = 0; c < NCV; c++) if (!dry) atomicAdd(p.modv + ((size_t)l * NCV + c) * 3072 + col, acc[c] + b);
  __syncthreads();
}
struct ConvDesc { const float* src; h16* dst; const float* kscale; int R, Nsrc, mode, nb, kb; bool has_scale; };
constexpr int CV_WIN_E = (NPE / 64) * 16, CV_WIN_O = (NPO / 64) * 16, CV_WOUT = 256, CV_WQB = 64, CV_WKVB = 32;
constexpr int CV_PER_PAIR = CV_WIN_E + CV_WIN_O + 2 * CV_WOUT + CV_WQB + CV_WKVB;
constexpr int CV_TOTAL = 2 * CV_PER_PAIR;
DEVFN ConvDesc conv_desc(const Params& p, int item) {
  const int i = item / CV_PER_PAIR; int r = item % CV_PER_PAIR;
  ConvDesc d; d.kscale = p.norm_w; d.has_scale = false;
  if (r < CV_WIN_E) { d.src = p.w_in_even + (size_t)i * D * EVEN_IN; d.dst = p.win16 + (size_t)(2 * i) * NPO * D; d.R = NPO; d.Nsrc = EVEN_IN; d.mode = 4; d.nb = (r % (NPE / 64)) * 64; d.kb = (r / (NPE / 64)) * 64; return d; }
  r -= CV_WIN_E;
  if (r < CV_WIN_O) { d.src = p.w_in_odd + (size_t)i * D * ODD_IN; d.dst = p.win16 + (size_t)(2 * i + 1) * NPO * D; d.R = NPO; d.Nsrc = ODD_IN; d.mode = 5; d.nb = (r % (NPO / 64)) * 64; d.kb = (r / (NPO / 64)) * 64; return d; }
  r -= CV_WIN_O;
  if (r < CV_WOUT) { d.src = p.w_out_even + (size_t)i * D * D; d.dst = p.wout16 + (size_t)(2 * i) * D * D; d.R = 1024; d.Nsrc = D; d.mode = 0; d.nb = (r % 16) * 64; d.kb = (r / 16) * 64; return d; }
  r -= CV_WOUT;
  if (r < CV_WOUT) { d.src = p.w_out_odd + (size_t)i * D * D; d.dst = p.wout16 + (size_t)(2 * i + 1) * D * D; d.R = 1024; d.Nsrc = D; d.mode = 0; d.nb = (r % 16) * 64; d.kb = (r / 16) * 64; return d; }
  r -= CV_WOUT;
  if (r < CV_WQB) { d.src = p.mla_wqb + (size_t)i * 256 * 768; d.dst = p.wqb16 + (size_t)i * 1024 * 256; d.R = 1024; d.Nsrc = 768; d.mode = 2; d.kscale = p.mla_qa_norm + i * 256; d.has_scale = true; d.nb = (r % 16) * 64; d.kb = (r / 16) * 64; return d; }
  r -= CV_WQB;
  d.src = p.mla_wkvb + (size_t)i * 128 * 1024; d.dst = p.wkvb16 + (size_t)i * 1024 * 128; d.R = 1024; d.Nsrc = 1024; d.mode = 3; d.kscale = p.mla_kva_norm + i * 128; d.has_scale = true; d.nb = (r % 16) * 64; d.kb = (r / 16) * 64; return d;
}
DEVFN void conv_batch4(const Params& p, int it0, int stride, int limit, char* lds) {
  const int tid = tid_op();
  const int j = tid & 63, k0 = tid >> 6;
  ConvDesc d[4]; float v[4][8]; float msk[4]; bool ok[4];
#pragma unroll
  for (int b = 0; b < 4; b++) {
    const int item = it0 + b * stride; ok[b] = item < limit;
    d[b] = conv_desc(p, ok[b] ? item : it0);
    const int np = d[b].nb + j; int col; const int mode = d[b].mode;
    if (mode == 0) col = np; else if (mode == 4) col = even_col(inproj_pos_col(np)); else if (mode == 5) col = inproj_pos_col(np); else if (mode == 3) { int hh = (np & 511) >> 6; col = hh * 128 + (np >> 9) * 64 + (np & 63); } else { int h = np >> 7, jj = np & 127; col = jj < 96 ? h * 96 + jj : -1; }
    const int colc = col < 0 ? 0 : col; msk[b] = col < 0 ? 0.f : 1.f;
    if (ok[b]) {
#pragma unroll
      for (int i = 0; i < 8; i++) v[b][i] = d[b].src[(size_t)(d[b].kb + k0 + 8 * i) * d[b].Nsrc + colc];
    }
  }
#pragma unroll
  for (int b = 0; b < 4; b++) {
    if (ok[b]) {
      float (*t)[65] = (float (*)[65])(lds + b * 16640);
      if (d[b].has_scale) {
#pragma unroll
        for (int i = 0; i < 8; i++) v[b][i] *= d[b].kscale[d[b].kb + k0 + 8 * i];
      }
#pragma unroll
      for (int i = 0; i < 8; i++) t[k0 + 8 * i][j] = v[b][i] * msk[b];
    }
  }
  __syncthreads();
#pragma unroll
  for (int b = 0; b < 4; b++) {
    if (ok[b]) {
      float (*t)[65] = (float (*)[65])(lds + b * 16640);
#pragma unroll
      for (int i = 0; i < 8; i++) { const int jj = k0 + 8 * i; d[b].dst[pidx(d[b].R, d[b].nb + jj, d[b].kb + j)] = (h16)t[j][jj]; }
    }
  }
  __syncthreads();
}
DEVFN void tab_items(const Params& p, int gtid, int gthreads) {
  for (int g = gtid; g < DS * 48; g += gthreads) {
    if (g < 2) {
      const int i = g, l = 2 * i; float s1 = 0, s2 = 0;
      for (int k = 0; k < 64; k++) { s1 += p.diff_lq1[i * 64 + k] * p.diff_lk1[i * 64 + k]; s2 += p.diff_lq2[i * 64 + k] * p.diff_lk2[i * 64 + k]; }
      p.lamv[i] = expf(s1) - expf(s2) + (0.8f - 0.6f * expf(-0.3f * l));
    }
    const int t = g / 48, j = g % 48;
    const float row = (float)(t / GW), col = (float)(t % GW);
    if (j < 32) { const int f = j & 15; const float inv = powf(10000.f, -(float)(2 * f) / 32.f); const float ang = (j < 16 ? row : col) * inv; p.ropeC64[t * 32 + j] = cosf(ang); p.ropeS64[t * 32 + j] = sinf(ang); }
    else { const int jj = j - 32; const int f = jj & 7; const float inv = powf(10000.f, -(float)(2 * f) / 16.f); const float ang = (jj < 8 ? row : col) * inv; p.ropeC32[t * 16 + jj] = cosf(ang); p.ropeS32[t * 16 + jj] = sinf(ang); }
  }
}
DEVFN void bias_row(const Params& p, int l, int np, int lane) {
  const h16* w = p.win16 + (size_t)l * NPO * D;
  float a[NCV];
#pragma unroll
  for (int c = 0; c < NCV; c++) a[c] = 0;
#pragma unroll
  for (int i = 0; i < 2; i++) {
    const int k = (i * 64 + lane) * 8; h16x8 wv = *(const h16x8*)(w + pidx(NPO, np, k));
#pragma unroll
    for (int c = 0; c < NCV; c++) { const float* sh = p.modv + ((size_t)l * NCV + c) * 3072 + k;
#pragma unroll
      for (int e = 0; e < 8; e++) a[c] += sh[e] * (float)wv[e]; }
  }
#pragma unroll
  for (int c = 0; c < NCV; c++) { float v = a[c]; for (int o = 32; o; o >>= 1) v += __shfl_xor(v, o); if (lane == 0) p.biasv[((size_t)l * NCV + c) * NPO + np] = v; }
}
DEVFN void prepx_row(const Params& p, int l, int m, int lane) {
  const float* x = xrow(p, l, m); const float* md = p.modv + ((size_t)l * NCV + tok_cv(m)) * 3072 + 1024; const float* nw = p.norm_w + l * D;
  float ss = 0;
#pragma unroll
  for (int i = 0; i < 4; i++) {
    const int k = (i * 64 + lane) * 4;
    f32x4 v = *(const f32x4*)(x + k); f32x4 s = *(const f32x4*)(md + k); f32x4 w = *(const f32x4*)(nw + k);
    h16x4 o;
#pragma unroll
    for (int e = 0; e < 4; e++) { ss += v[e] * v[e]; o[e] = (h16)(v[e] * w[e] * (1.f + s[e])); }
    *(h16x4*)(p.xs16 + pidx(M, m, k)) = o;
  }
  for (int o = 32; o; o >>= 1) ss += __shfl_xor(ss, o);
  if (lane == 0) p.rowss_l[(size_t)l * M + m] = ss;
}
#define AS4 __attribute__((address_space(4)))
#define PHASE_PARAMS(q) const Params& q = p_unused;
__global__ void __launch_bounds__(512) mega_kernel(Params p_unused) {
  __shared__ __attribute__((aligned(16))) char lds[G_LDS2 + 16];
  if (threadIdx.x == 0) { volatile LAS unsigned* st = (volatile LAS unsigned*)(lds + G_LDS2); st[0] = 0u; st[1] = 0u; st[2] = 0u; st[3] = 0u; }
  __syncthreads();
  XcdBarrier bar;
  { PHASE_PARAMS(p); bar = xcd_barrier_post(p.bar, (volatile LAS unsigned*)(lds + G_LDS2)); }
  const int nb = gridDim.x, bid = blockIdx.x;
  LAS unsigned char* ldsa = (LAS unsigned char*)lds;
  { PHASE_PARAMS(p);
    for (int rep = 0; rep < REP_0A; rep++)
    {
#pragma unroll 1
      for (int it = bid; it < 768; it += nb) mod_item(p, it, lds, rep > 0);
#pragma unroll 1
      for (int it = bid; it < CV_PER_PAIR; it += 4 * nb) conv_batch4(p, it, nb, CV_PER_PAIR, lds);
    }
    tab_items(p, bid * 512 + tid_op(), nb * 512); }
  xcd_barrier(bar);
  { PHASE_PARAMS(p);
    const int tid = tid_op(); const int lane = tid & 63, gw = bid * 8 + (tid >> 6), nw = nb * 8;
    for (int rep = 0; rep < REP_0B; rep++)
    for (int r = gw; r < (NPE + NPO) + M; r += nw) {
      if (r < NPE + NPO) bias_row(p, r < NPE ? 0 : 1, r < NPE ? r : r - NPE, lane);
      else prepx_row(p, 0, r - (NPE + NPO), lane);
    }
    cache_ckv_all(p, 0, bid * 512 + tid, nb * 512); }
  xcd_barrier(bar);
#pragma unroll 1
  for (int l = 0; l < 4; l++) {
    { PHASE_PARAMS(p);
#pragma unroll 1
      for (int rep = 1; rep < REP_GK; rep++) { NullEpi ne; gemm8_phase(ldsa, p.xs16, M, p.win16 + (size_t)l * NPO * D, NPO, D, M / 256, ((l & 1) ? NPO : NPE) / 256, ne); }
#pragma unroll 1
      for (int rep = 0; rep < REP_A; rep++) {
        InprojEpi epi{p, l, rep > 0, ldsa + G8_STAGE};
        gemm8_phase(ldsa, p.xs16, M, p.win16 + (size_t)l * NPO * D, NPO, D, M / 256, ((l & 1) ? NPO : NPE) / 256, epi);
      }
      for (int rep = 0; rep < REP_0B; rep++) cache_items(p, l, bid * 512 + tid_op(), nb * 512);
      if (l == 1) cache_ckv_all(p, 2, bid * 512 + tid_op(), nb * 512);
      if ((l & 1) == 0) {
        const int k = nb >= 16 ? bid - (nb - 16) : bid;
        if (k >= 0) {
#pragma unroll 1
          for (int kk = k; kk < 16; kk += (nb >= 16 ? 16 : nb)) kvgemm_tile(p, l, (MP + (kk >> 3) * TKS + DS) / 256, kk & 7, lds);
        }
      }
      if (l < 2) {
        const int nun = (M / 256) * (((l & 1) ? NPO : NPE) / 256); const int fi = nun - nb;
        const bool part = fi > 0 && fi < nb;
        const int nshare = (part && nb - fi > 32) ? nb - fi - 16 : (part ? nb - fi : nb);
        const int start = part ? bid - fi : bid, stride = nshare;
        if (start >= 0 && start < nshare) {
          if (l == 0) {
#pragma unroll 1
            for (int it = CV_PER_PAIR + start; it < CV_TOTAL; it += 4 * stride) conv_batch4(p, it, stride, CV_TOTAL, lds);
          } else {
            const int tid = tid_op(); const int lane = tid & 63;
#pragma unroll 1
            for (int r = start * 8 + (tid >> 6); r < NPE + NPO; r += stride * 8) bias_row(p, r < NPE ? 2 : 3, r < NPE ? r : r - NPE, lane);
          }
        }
      }
    }
    xcd_barrier(bar);
    if ((l & 1) == 0) {
      PHASE_PARAMS(p);
      constexpr int NKVP = KM / 256 - DB;
      const int nq = (M / 256) * 8, nkv = NKVP * 8;
      for (int rep = 0; rep < REP_A2; rep++)
      for (int t = bid; t < nq + nkv; t += nb) {
        if (t < nq) qgemm_tile(p, l, t % 32, t / 32, lds);
        else { const int u = t - nq; int q = u % NKVP; constexpr int CP0 = (MP + DS) / 256; q = q < CP0 ? q : (DB > 1 && q >= CP0 + DS / 256 ? q + 2 : q + 1);
          kvgemm_tile(p, l, q, u / NKVP, lds); }
      }
      { const float* rck = p.rowss_ckv + (size_t)(l >> 1) * KM; const int i = l >> 1;
        for (int e = bid * 512 + tid_op(); e < MP * 128; e += nb * 512) {
          const int m = e >> 7, j = e & 127;
          p.o_ckv[st_row(m, i) * 128 + j] = (float)p.ckv16[pidx(KM, m, j)] * (frsq(rck[m] * (1.f / 128.f) + EPSN)) * p.mla_kva_norm[i * 128 + j];
        } }
      xcd_barrier(bar);
    }
    { PHASE_PARAMS(p);
      for (int rep = 0; rep < REP_B; rep++)
      {
        if ((l & 1) == 0) {
#pragma unroll 1
          for (int it = bid; it < 512; it += nb) attn_even_item(p, l, it, lds);
        } else {
          const bool lpt = nb == 256;
          const int n = lpt ? (bid < 128 ? 1 : 3) : (512 - bid + nb - 1) / nb;
#pragma unroll 1
          for (int k = 0; k < n; k++) {
            const int it = !lpt ? bid + k * nb : (k == 0 ? bid : (k == 1 ? 256 + (bid - 128) : 256 + bid));
            attn_odd_item(p, l, it, lds);
          }
        }
      } }
    xcd_barrier(bar);
    { PHASE_PARAMS(p);
      for (int rep = 0; rep < REP_C; rep++)
      for (int t = bid; t < 32 * 8; t += nb) outproj_tile(p, l, t % 32, t / 32, lds, rep < REP_C - 1); }
    if (l < 3) { for (int rep = 0; rep < REP_BAR; rep++) xcd_barrier(bar); }
  }
}
#endif

static inline size_t al256(size_t x) { return (x + 255) & ~(size_t)255; }

extern "C" void kernel_launch(void* const* d_in, const int* in_sizes, int n_in, void* d_out, int out_size, void* d_ws, size_t ws_size,
                              hipStream_t stream) {
  Params p{};
  const float** ip = (const float**)&p.x_prompt;
  for (int k = 0; k < 39; k++) ip[k] = (const float*)d_in[k];
  float* o = (float*)d_out;
  p.Y = o; o += (size_t)M * 1024;
  p.o_ckv = o; o += (size_t)BATCH * 2 * SEQ * 128;
  p.o_kpe = o; o += (size_t)BATCH * 2 * SEQ * 32;
  p.o_dk = o; o += (size_t)BATCH * 2 * SEQ * 512;
  p.o_dv = o; o += (size_t)BATCH * 2 * SEQ * 512;
  p.o_nk = o; o += (size_t)BATCH * 2 * SEQ * 512;
  p.o_nv = o; o += (size_t)BATCH * 2 * SEQ * 512;
  p.o_gk = o; o += (size_t)BATCH * 2 * SEQ * 128;
  p.o_gv = o; o += (size_t)BATCH * 2 * SEQ * 128;
  char* w = (char*)d_ws; size_t off = 0;
  auto take = [&](size_t bytes) { char* r = w + off; off += al256(bytes); return r; };
  char* zero0 = w + off;
  p.bar = (unsigned*)take(16384);
  p.modv = (float*)take((size_t)4 * NCV * 3072 * 4);
  p.rowss_qa = (float*)take((size_t)2 * M * 4); p.rowss_l = (float*)take((size_t)4 * M * 4); p.rowss_ckv = (float*)take((size_t)2 * KM * 4);
  const size_t zero_bytes = (size_t)((w + off) - zero0);
  p.ropeC64 = (float*)take((size_t)DS * 32 * 4); p.ropeS64 = (float*)take((size_t)DS * 32 * 4);
  p.ropeC32 = (float*)take((size_t)DS * 16 * 4); p.ropeS32 = (float*)take((size_t)DS * 16 * 4);
  p.lamv = (float*)take(256);
  p.rstdx = (float*)take((size_t)M * 4);
  p.QA = (h16*)take((size_t)M * 8 * 96 * 2); p.QB = (h16*)take((size_t)M * 8 * 64 * 2);
  p.KA = (h16*)take((size_t)8 * KM * 128 * 2); p.KB = (h16*)take((size_t)8 * KM * 64 * 2);
  p.VA = (h16*)take((size_t)8 * 64 * KM * 2); p.VB = (h16*)take((size_t)8 * 64 * KM * 2);
  p.gates16 = (h16*)take((size_t)M * 1024 * 2); p.O16 = (h16*)take((size_t)M * 1024 * 2);
  p.ckvbuf = (float*)take((size_t)KM * 128 * 4); p.kpebuf = (float*)take((size_t)KM * 32 * 4);
  p.xs16 = (h16*)take((size_t)M * D * 2); p.qa16 = (h16*)take((size_t)M * 256 * 2); p.ckv16 = (h16*)take((size_t)KM * 128 * 2); p.kpe16 = (h16*)take((size_t)KM * 32 * 2); p.biasv = (float*)take((size_t)4 * NCV * NPO * 4);
  p.win16 = (h16*)take((size_t)4 * NPO * D * 2); p.wout16 = (h16*)take((size_t)4 * D * D * 2);
  p.wqb16 = (h16*)take((size_t)2 * 1024 * 256 * 2); p.wkvb16 = (h16*)take((size_t)2 * 1024 * 128 * 2);
  size_t ub = (size_t)M * 3328 * 2, ab = (size_t)M * 1536 * 4;
  char* big = take(ub > ab ? ub : ab);
  p.ubuf = (h16*)big; p.abuf = (float*)big;
  (void)ws_size; (void)n_in; (void)in_sizes; (void)out_size;

#ifndef CPU_EMU
  {
    (void)hipMemsetAsync(zero0, 0, zero_bytes, stream);
    static int cus = 0;
    if (!cus) { int dev = 0; (void)hipGetDevice(&dev); (void)hipDeviceGetAttribute(&cus, hipDeviceAttributeMultiprocessorCount, dev); }
    void* args[] = {&p};
    (void)hipLaunchCooperativeKernel((void*)mega_kernel, dim3(cus), dim3(512), args, 0, stream);
  }
#else
  (void)zero0; (void)zero_bytes;
  launch1d(nk_mod, (long)4 * NCV * 3072, stream, p, (long)4 * NCV * 3072);
  launch1d(nk_tab, (long)DS * 48, stream, p, (long)DS * 48);
  for (int l = 0; l < 4; l++) {
    const int N = (l & 1) ? ODD_IN : EVEN_IN;
    launch1d(nk_rstd, (long)M, stream, p, l, (long)M);
    launch1d(nk_inproj, (long)M * N, stream, p, l, (long)M * N);
    if ((l & 1) == 0) {
      launch1d(nk_epi_even, (long)M * 50, stream, p, l, 0, (long)M * 50);
      launch1d(nk_cache_even, (long)DB * PAST * 17, stream, p, l, (long)DB * PAST * 17);
      launch1d(nk_kv, (long)KM * 16, stream, p, l, (long)KM * 16);
      launch1d(nk_attn_dense, (long)M * 8, stream, p, 0, 0, M, (long)M * 8);
      launch1d(nk_attn_dense, (long)M * 16, stream, p, 1, 0, M, (long)M * 16);
      launch1d(nk_fin, (long)M * 12, stream, p, l, (long)M * 12);
    } else {
      launch1d(nk_epi_odd, (long)M * 52, stream, p, l, (long)M * 52);
      launch1d(nk_cache_odd, (long)DB * PAST * 20, stream, p, l, (long)DB * PAST * 20);
      launch1d(nk_attn_dense, (long)MP * 8, stream, p, 2, 0, MP, (long)MP * 8);
      launch1d(nk_attn_na, (long)MS * 8, stream, p, l, (long)MS * 8);
      launch1d(nk_attn_dense, (long)M * 8, stream, p, 3, 0, M, (long)M * 8);
      launch1d(nk_fin, (long)M * 16, stream, p, l, (long)M * 16);
    }
    launch1d(nk_outproj, (long)M * 1024, stream, p, l, (long)M * 1024);
  }
#endif
}
```

```cpp
#ifndef CPU_EMU
#include <hip/hip_runtime.h>
#endif
#include <stdint.h>
#include <math.h>

#define FAST_INPROJ 2
#define DUAL_WRITE 0
#define FAST_A2 1
#define FAST_OUTPROJ 1
#define FAST_ATTN 1
#define MEGA 1
#define REP_0A 1
#define REP_A 1
#define REP_A2 1
#define REP_B 1
#define REP_C 1
#define REP_BAR 1
#define REP_GK 1
#define REP_0B 1
#define REP_EPI 1
#ifndef CFG_BATCH
#define CFG_BATCH 16
#endif
#ifndef CFG_DB
#define CFG_DB 2
#endif
#ifndef CFG_DS
#define CFG_DS 2048
#endif
constexpr int D = 1024, BATCH = CFG_BATCH, SEQ = 256, DB = CFG_DB, DS = CFG_DS, PAST = 256;
constexpr int MP = BATCH * SEQ, MS = DB * DS, M = MP + MS;
constexpr int TKS = DS + PAST;
constexpr int KM = MP + DB * TKS;
constexpr int NCV = 1 + DB;
constexpr int GW = 64, GROWS = DS / GW;
constexpr int EVEN_IN = 2976, ODD_IN = 3328;
constexpr int NPE = 3072, NPO = 3328;
constexpr float EPSN = 1e-6f;
constexpr float LOG2E = 1.4426950408889634f;

typedef _Float16 h16;

struct Params {
  const float *x_prompt, *x_sample, *cache_mla_ckv, *cache_mla_kpe, *cache_diff_k, *cache_diff_v, *cache_na_k, *cache_na_v,
      *cache_gqa_k, *cache_gqa_v, *c, *c_ctx, *norm_w, *w_mod, *b_mod, *w_in_even, *w_out_even, *mla_qa_norm, *mla_wqb,
      *mla_kva_norm, *mla_wkvb, *mla_qn_nope, *mla_qn_rope, *mla_kn_nope, *mla_kn_rope, *diff_qn, *diff_kn, *diff_lq1,
      *diff_lk1, *diff_lq2, *diff_lk2, *diff_subln, *w_in_odd, *w_out_odd, *na_qn, *na_kn, *na_rpb, *gqa_qn, *gqa_kn;
  float *Y;
  float *o_ckv, *o_kpe, *o_dk, *o_dv, *o_nk, *o_nv, *o_gk, *o_gv;
  float *modv;
  float *ropeC64, *ropeS64;
  float *ropeC32, *ropeS32;
  float *lamv;
  float *rstdx;
  h16 *ubuf;
  float *abuf;
  float *ckvbuf;
  float *kpebuf;
  h16 *QA, *QB, *KA, *KB, *VA, *VB, *gates16, *O16;
  h16 *xs16;
  float *biasv;
  h16 *win16;
  h16 *wout16;
  h16 *wqb16;
  h16 *wkvb16;
  h16 *qa16;
  float *rowss_qa;
  h16 *ckv16;
  h16 *kpe16;
  float *rowss_l;
  float *rowss_ckv;
  unsigned *bar;
  h16 *x16;
};

#ifdef CPU_EMU
#include <stdio.h>
#include <stdlib.h>
#include <string.h>
typedef void* hipStream_t;
#define KERNEL static void
#define DEVFN static inline
static thread_local long emu_gtid;
#define GTID emu_gtid
template <class... A, class... B>
static void launch1d(void (*f)(A...), long n, hipStream_t, B... a) {
#pragma omp parallel for schedule(dynamic, 64)
  for (long i = 0; i < n; i++) { emu_gtid = i; f(a...); }
}
static inline float exp2f_(float x) { return exp2f(x); }
#else
#define KERNEL __global__ void __launch_bounds__(256)
#define DEVFN __device__ __forceinline__
#define GTID ((long)blockIdx.x * 256 + threadIdx.x)
template <class... A, class... B>
static void launch1d(void (*f)(A...), long n, hipStream_t s, B... a) {
  hipLaunchKernelGGL(f, dim3((unsigned)((n + 255) / 256)), dim3(256), 0, s, a...);
}
DEVFN float exp2f_(float x) { return exp2f(x); }
#endif

DEVFN int tok_cv(int m) { return m < MP ? 0 : 1 + (m - MP) / DS; }
DEVFN int tok_keyrow(int m) { return m < MP ? m : MP + ((m - MP) / DS) * TKS + (m - MP) % DS; }
DEVFN int tok_pos(int m) { return m < MP ? (m % SEQ) : ((m - MP) % DS); }
DEVFN const float* xrow(const Params& p, int l, int m) {
  if (l > 0) return p.Y + (size_t)m * D;
  return m < MP ? p.x_prompt + (size_t)m * D : p.x_sample + (size_t)(m - MP) * D;
}
DEVFN float siluf(float x) { return x / (1.f + expf(-x)); }
DEVFN size_t st_row(int m, int i) { int b = m / SEQ, t = m % SEQ; return ((size_t)(b * 2 + i) * SEQ + t); }

#ifdef CPU_EMU
KERNEL nk_mod(Params p, long n) {
  long g = GTID; if (g >= n) return;
  int col = g % 3072; int cv = (g / 3072) % NCV; int l = g / (3072 * NCV);
  const float* cvec = cv == 0 ? p.c_ctx : p.c + (size_t)(cv - 1) * D;
  const float* w = p.w_mod + (size_t)l * D * 3072 + col;
  float acc = p.b_mod[l * 3072 + col];
  for (int k = 0; k < D; k++) acc += siluf(cvec[k]) * w[(size_t)k * 3072];
  p.modv[((size_t)l * NCV + cv) * 3072 + col] = acc;
}
KERNEL nk_tab(Params p, long n) {
  long g = GTID; if (g >= n) return;
  if (g < 2) {
    int i = g; int l = 2 * i;
    float s1 = 0, s2 = 0;
    for (int k = 0; k < 64; k++) { s1 += p.diff_lq1[i * 64 + k] * p.diff_lk1[i * 64 + k]; s2 += p.diff_lq2[i * 64 + k] * p.diff_lk2[i * 64 + k]; }
    float lam_init = 0.8f - 0.6f * expf(-0.3f * l);
    p.lamv[i] = expf(s1) - expf(s2) + lam_init;
  }
  int t = g / 48, j = g % 48;
  if (t >= DS) return;
  float row = (float)(t / GW), col = (float)(t % GW);
  if (j < 32) {
    int f = j & 15; float inv = powf(10000.f, -(float)(2 * f) / 32.f);
    float ang = (j < 16 ? row : col) * inv;
    p.ropeC64[t * 32 + j] = cosf(ang); p.ropeS64[t * 32 + j] = sinf(ang);
  } else {
    int jj = j - 32; int f = jj & 7; float inv = powf(10000.f, -(float)(2 * f) / 16.f);
    float ang = (jj < 8 ? row : col) * inv;
    p.ropeC32[t * 16 + jj] = cosf(ang); p.ropeS32[t * 16 + jj] = sinf(ang);
  }
}
KERNEL nk_rstd(Params p, int l, long n) {
  long g = GTID; if (g >= n) return;
  const float* x = xrow(p, l, (int)g);
  float s = 0; for (int k = 0; k < D; k++) s += x[k] * x[k];
  p.rstdx[g] = 1.f / sqrtf(s / D + EPSN);
}
KERNEL nk_inproj(Params p, int l, long n) {
  long g = GTID; if (g >= n) return;
  const int N = (l & 1) ? ODD_IN : EVEN_IN;
  int m = g / N, col = g % N;
  const float* W = ((l & 1) ? p.w_in_odd : p.w_in_even) + (size_t)(l >> 1) * D * N + col;
  const float* x = xrow(p, l, m);
  const float* md = p.modv + ((size_t)l * NCV + tok_cv(m)) * 3072;
  const float* nw = p.norm_w + l * D;
  float r = p.rstdx[m], acc = 0;
  for (int k = 0; k < D; k++) { float h = x[k] * r * nw[k] * (1.f + md[1024 + k]) + md[k]; acc += h * W[(size_t)k * N]; }
  p.ubuf[(size_t)m * 3328 + col] = (h16)acc;
}

KERNEL nk_epi_even(Params p, int l, int qa_only, long n) {
  long g = GTID; if (g >= n) return;
  const int i = l >> 1;
  int m = g / 50, u = g % 50;
  if (qa_only && u >= 8) return;
  const h16* ur = qa_only ? p.qa16 + (size_t)m * 256 : p.ubuf + (size_t)m * 3328;
  const bool smp = m >= MP; const int t = tok_pos(m); const int kr = tok_keyrow(m);
  if (u < 8) {
    float ss = 0; for (int k = 0; k < 256; k++) { float v = (float)ur[k]; ss += v * v; }
    float r = 1.f / sqrtf(ss / 256 + EPSN);
    float q[96];
#pragma unroll
    for (int j = 0; j < 96; j++) q[j] = 0;
    const float* W = p.mla_wqb + (size_t)i * 256 * 768 + u * 96;
    for (int k = 0; k < 256; k++) {
      float a = (float)ur[k] * r * p.mla_qa_norm[i * 256 + k];
#pragma unroll
      for (int j = 0; j < 96; j++) q[j] += a * W[(size_t)k * 768 + j];
    }
    float s1 = 0, s2 = 0;
#pragma unroll
    for (int j = 0; j < 64; j++) s1 += q[j] * q[j];
#pragma unroll
    for (int j = 64; j < 96; j++) s2 += q[j] * q[j];
    float r1 = 1.f / sqrtf(s1 / 64 + EPSN), r2 = 1.f / sqrtf(s2 / 32 + EPSN);
#pragma unroll
    for (int j = 0; j < 64; j++) q[j] = q[j] * r1 * p.mla_qn_nope[i * 64 + j];
#pragma unroll
    for (int j = 0; j < 32; j++) q[64 + j] = q[64 + j] * r2 * p.mla_qn_rope[i * 32 + j];
    if (smp) {
#pragma unroll
      for (int j = 0; j < 16; j++) {
        float c = p.ropeC32[t * 16 + j], s = p.ropeS32[t * 16 + j];
        float x1 = q[64 + j], x2 = q[80 + j];
        q[64 + j] = x1 * c - x2 * s; q[80 + j] = x2 * c + x1 * s;
      }
    }
    const float sc = LOG2E / sqrtf(96.f);
    h16* dst = p.QA + ((size_t)m * 8 + u) * 96;
#pragma unroll
    for (int j = 0; j < 96; j++) dst[j] = (h16)(q[j] * sc);
  } else if (u == 8) {
    float ss = 0; for (int k = 0; k < 128; k++) { float v = (float)ur[256 + k]; ss += v * v; }
    float r = 1.f / sqrtf(ss / 128 + EPSN);
    for (int k = 0; k < 128; k++) {
      float v = (float)ur[256 + k] * r * p.mla_kva_norm[i * 128 + k];
      if (!smp) p.o_ckv[st_row(m, i) * 128 + k] = v;
      p.ckvbuf[(size_t)kr * 128 + k] = v;
    }
  } else if (u == 9) {
    float v[32]; float ss = 0;
#pragma unroll
    for (int k = 0; k < 32; k++) { v[k] = (float)ur[384 + k]; ss += v[k] * v[k]; }
    float r = 1.f / sqrtf(ss / 32 + EPSN);
#pragma unroll
    for (int k = 0; k < 32; k++) { v[k] = v[k] * r * p.mla_kn_rope[i * 32 + k]; if (!smp) p.o_kpe[st_row(m, i) * 32 + k] = v[k]; }
    if (smp) {
#pragma unroll
      for (int j = 0; j < 16; j++) {
        float c = p.ropeC32[t * 16 + j], s = p.ropeS32[t * 16 + j];
        float x1 = v[j], x2 = v[16 + j];
        v[j] = x1 * c - x2 * s; v[16 + j] = x2 * c + x1 * s;
      }
    }
#pragma unroll
    for (int k = 0; k < 32; k++) p.kpebuf[(size_t)kr * 32 + k] = v[k];
  } else if (u < 18) {
    int cb = (u - 10) * 64;
    for (int j = 0; j < 64; j++) p.gates16[(size_t)m * 1024 + cb + j] = (h16)siluf((float)ur[416 + cb + j]);
  } else if (u < 34) {
    const bool isq = u < 26; int hc = isq ? u - 18 : u - 26;
    const h16* src = ur + (isq ? 928 : 1440) + hc * 64;
    const float* gn = (isq ? p.diff_qn : p.diff_kn) + i * 64;
    float v[64]; float ss = 0;
#pragma unroll
    for (int k = 0; k < 64; k++) { v[k] = (float)src[k]; ss += v[k] * v[k]; }
    float r = 1.f / sqrtf(ss / 64 + EPSN);
#pragma unroll
    for (int k = 0; k < 64; k++) { v[k] = v[k] * r * gn[k]; if (!isq && !smp) p.o_dk[st_row(m, i) * 512 + hc * 64 + k] = v[k]; }
    if (smp) {
#pragma unroll
      for (int j = 0; j < 32; j++) {
        float c = p.ropeC64[t * 32 + j], s = p.ropeS64[t * 32 + j];
        float x1 = v[j], x2 = v[32 + j];
        v[j] = x1 * c - x2 * s; v[32 + j] = x2 * c + x1 * s;
      }
    }
    if (isq) {
      const float sc = LOG2E / 8.f; h16* dst = p.QB + ((size_t)m * 8 + hc) * 64;
#pragma unroll
      for (int k = 0; k < 64; k++) dst[k] = (h16)(v[k] * sc);
    } else {
      h16* dst = p.KB + ((size_t)hc * KM + kr) * 64;
#pragma unroll
      for (int k = 0; k < 64; k++) dst[k] = (h16)v[k];
    }
  } else if (u < 42) {
    int ch = u - 34; int h = ch >> 1, half = ch & 1;
    for (int j = 0; j < 64; j++) {
      float v = (float)ur[1952 + ch * 64 + j];
      if (!smp) p.o_dv[st_row(m, i) * 512 + ch * 64 + j] = v;
      p.VB[((size_t)h * 128 + half * 64 + j) * KM + kr] = (h16)v;
    }
  } else {
    int cb = (u - 42) * 64;
    for (int j = 0; j < 64; j++) p.gates16[(size_t)m * 1024 + 512 + cb + j] = (h16)siluf((float)ur[2464 + cb + j]);
  }
}
KERNEL nk_cache_even(Params p, int l, long n) {
  long g = GTID; if (g >= n) return;
  const int i = l >> 1;
  int u = g % 17; int pos = (g / 17) % PAST; int b = g / (17 * PAST);
  const int kr = MP + b * TKS + DS + pos;
  const size_t crow = ((size_t)(b * 2 + i) * PAST + pos);
  if (u == 0) {
    for (int k = 0; k < 128; k++) { float v = p.cache_mla_ckv[crow * 128 + k]; p.ckvbuf[(size_t)kr * 128 + k] = v; p.ckv16[(size_t)kr * 128 + k] = (h16)v; }
    for (int k = 0; k < 32; k++) { float v = p.cache_mla_kpe[crow * 32 + k]; p.kpebuf[(size_t)kr * 32 + k] = v; p.kpe16[(size_t)kr * 32 + k] = (h16)v; }
  } else if (u < 9) {
    int hc = u - 1;
    for (int k = 0; k < 64; k++) p.KB[((size_t)hc * KM + kr) * 64 + k] = (h16)p.cache_diff_k[crow * 512 + hc * 64 + k];
  } else {
    int ch = u - 9; int h = ch >> 1, half = ch & 1;
    for (int j = 0; j < 64; j++) p.VB[((size_t)h * 128 + half * 64 + j) * KM + kr] = (h16)p.cache_diff_v[crow * 512 + ch * 64 + j];
  }
}
KERNEL nk_kv(Params p, int l, long n) {
  long g = GTID; if (g >= n) return;
  const int i = l >> 1;
  int part = g & 1; int h = (g >> 1) & 7; int kr = g >> 4;
  const float* cr = p.ckvbuf + (size_t)kr * 128;
  const float* W = p.mla_wkvb + (size_t)i * 128 * 1024 + h * 128 + part * 64;
  float a[64];
#pragma unroll
  for (int j = 0; j < 64; j++) a[j] = 0;
  for (int k = 0; k < 128; k++) {
    float c = (float)(h16)cr[k];
#pragma unroll
    for (int j = 0; j < 64; j++) a[j] += c * W[(size_t)k * 1024 + j];
  }
  if (part == 0) {
    float ss = 0;
#pragma unroll
    for (int j = 0; j < 64; j++) ss += a[j] * a[j];
    float r = 1.f / sqrtf(ss / 64 + EPSN);
    h16* dst = p.KA + ((size_t)h * KM + kr) * 128;
#pragma unroll
    for (int j = 0; j < 64; j++) dst[j] = (h16)(a[j] * r * p.mla_kn_nope[i * 64 + j]);
    for (int j = 0; j < 32; j++) dst[64 + j] = (h16)p.kpebuf[(size_t)kr * 32 + j];
  } else {
#pragma unroll
    for (int j = 0; j < 64; j++) p.VA[((size_t)h * 64 + j) * KM + kr] = (h16)a[j];
  }
}
KERNEL nk_epi_odd(Params p, int l, long n) {
  long g = GTID; if (g >= n) return;
  const int i = l >> 1;
  int m = g / 52, u = g % 52;
  const h16* ur = p.ubuf + (size_t)m * 3328;
  const bool smp = m >= MP; const int t = tok_pos(m); const int kr = tok_keyrow(m);
  if (u < 16 || (u >= 32 && u < 42)) {
    int colbase, head; const float* gn; int kind;
    if (u < 8) { kind = 0; head = u; colbase = head * 64; gn = p.na_qn + i * 64; }
    else if (u < 16) { kind = 1; head = u - 8; colbase = 512 + head * 64; gn = p.na_kn + i * 64; }
    else if (u < 40) { kind = 2; head = u - 32; colbase = 2048 + head * 64; gn = p.gqa_qn + i * 64; }
    else { kind = 3; head = u - 40; colbase = 2560 + head * 64; gn = p.gqa_kn + i * 64; }
    float v[64]; float ss = 0;
#pragma unroll
    for (int k = 0; k < 64; k++) { v[k] = (float)ur[colbase + k]; ss += v[k] * v[k]; }
    float r = 1.f / sqrtf(ss / 64 + EPSN);
#pragma unroll
    for (int k = 0; k < 64; k++) v[k] = v[k] * r * gn[k];
    if (!smp) {
      if (kind == 1) { for (int k = 0; k < 64; k++) p.o_nk[st_row(m, i) * 512 + head * 64 + k] = v[k]; }
      if (kind == 3) { for (int k = 0; k < 64; k++) p.o_gk[st_row(m, i) * 128 + head * 64 + k] = v[k]; }
    }
    if (smp && kind >= 2) {
#pragma unroll
      for (int j = 0; j < 32; j++) {
        float c = p.ropeC64[t * 32 + j], s = p.ropeS64[t * 32 + j];
        float x1 = v[j], x2 = v[32 + j];
        v[j] = x1 * c - x2 * s; v[32 + j] = x2 * c + x1 * s;
      }
    }
    const float sc = LOG2E / 8.f;
    h16* dst;
    if (kind == 0) dst = p.QA + ((size_t)m * 8 + head) * 64;
    else if (kind == 1) dst = p.KA + ((size_t)head * KM + kr) * 64;
    else if (kind == 2) dst = p.QB + ((size_t)m * 8 + head) * 64;
    else dst = p.KB + ((size_t)head * KM + kr) * 64;
    const float mul = (kind == 0 || kind == 2) ? sc : 1.f;
#pragma unroll
    for (int k = 0; k < 64; k++) dst[k] = (h16)(v[k] * mul);
  } else if (u < 24) {
    int head = u - 16;
    for (int j = 0; j < 64; j++) {
      float v = (float)ur[1024 + head * 64 + j];
      if (!smp) p.o_nv[st_row(m, i) * 512 + head * 64 + j] = v;
      p.VA[((size_t)head * 64 + j) * KM + kr] = (h16)v;
    }
  } else if (u < 32) {
    int cb = (u - 24) * 64;
    for (int j = 0; j < 64; j++) p.gates16[(size_t)m * 1024 + cb + j] = (h16)siluf((float)ur[1536 + cb + j]);
  } else if (u < 44) {
    int head = u - 42;
    for (int j = 0; j < 64; j++) {
      float v = (float)ur[2688 + head * 64 + j];
      if (!smp) p.o_gv[st_row(m, i) * 128 + head * 64 + j] = v;
      p.VB[((size_t)head * 64 + j) * KM + kr] = (h16)v;
    }
  } else {
    int cb = (u - 44) * 64;
    for (int j = 0; j < 64; j++) p.gates16[(size_t)m * 1024 + 512 + cb + j] = (h16)siluf((float)ur[2816 + cb + j]);
  }
}
KERNEL nk_cache_odd(Params p, int l, long n) {
  long g = GTID; if (g >= n) return;
  const int i = l >> 1;
  int u = g % 20; int pos = (g / 20) % PAST; int b = g / (20 * PAST);
  const int kr = MP + b * TKS + DS + pos;
  const size_t crow = ((size_t)(b * 2 + i) * PAST + pos);
  if (u < 8) { for (int k = 0; k < 64; k++) p.KA[((size_t)u * KM + kr) * 64 + k] = (h16)p.cache_na_k[crow * 512 + u * 64 + k]; }
  else if (u < 16) { int h = u - 8; for (int j = 0; j < 64; j++) p.VA[((size_t)h * 64 + j) * KM + kr] = (h16)p.cache_na_v[crow * 512 + h * 64 + j]; }
  else if (u < 18) { int h = u - 16; for (int k = 0; k < 64; k++) p.KB[((size_t)h * KM + kr) * 64 + k] = (h16)p.cache_gqa_k[crow * 128 + h * 64 + k]; }
  else { int h = u - 18; for (int j = 0; j < 64; j++) p.VB[((size_t)h * 64 + j) * KM + kr] = (h16)p.cache_gqa_v[crow * 128 + h * 64 + j]; }
}
template <int DQK, int KP>
DEVFN void attn_dense_thread(const h16* q, const h16* K, const h16* VT, int kr0, int nk, float* out) {
  float qf[DQK];
#pragma unroll
  for (int j = 0; j < DQK; j++) qf[j] = (float)q[j];
  float o[64];
#pragma unroll
  for (int j = 0; j < 64; j++) o[j] = 0;
  float mx = -1e30f, sum = 0;
  for (int kk = 0; kk < nk; kk++) {
    const h16* kp = K + (size_t)(kr0 + kk) * KP;
    float s = 0;
#pragma unroll
    for (int j = 0; j < DQK; j++) s += qf[j] * (float)kp[j];
    float mn = fmaxf(mx, s); float al = exp2f_(mx - mn); float pe = exp2f_(s - mn);
    sum = sum * al + pe; mx = mn;
#pragma unroll
    for (int j = 0; j < 64; j++) o[j] = o[j] * al + pe * (float)VT[(size_t)j * KM + kr0 + kk];
  }
  float inv = 1.f / sum;
#pragma unroll
  for (int j = 0; j < 64; j++) out[j] = o[j] * inv;
}
KERNEL nk_attn_dense(Params p, int kind, int mlo, int mhi, long n) {
  long g = GTID; if (g >= n) return;
  const int nch = kind == 1 ? 2 : 1;
  int ch = g % nch; int head = (g / nch) % 8; int m = mlo + g / (nch * 8);
  if (m >= mhi) return;
  int kr0, nk;
  if (m < MP) { kr0 = (m / SEQ) * SEQ; nk = SEQ; } else { kr0 = MP + ((m - MP) / DS) * TKS; nk = TKS; }
  if (kind == 0) {
    attn_dense_thread<96, 128>(p.QA + ((size_t)m * 8 + head) * 96, p.KA + (size_t)head * KM * 128, p.VA + (size_t)head * 64 * KM, kr0, nk,
                          p.abuf + (size_t)m * 1536 + head * 64);
  } else if (kind == 1) {
    attn_dense_thread<64, 64>(p.QB + ((size_t)m * 8 + head) * 64, p.KB + (size_t)head * KM * 64,
                          p.VB + ((size_t)(head >> 1) * 128 + ch * 64) * KM, kr0, nk, p.abuf + (size_t)m * 1536 + 512 + head * 128 + ch * 64);
  } else if (kind == 2) {
    attn_dense_thread<64, 64>(p.QA + ((size_t)m * 8 + head) * 64, p.KA + (size_t)head * KM * 64, p.VA + (size_t)head * 64 * KM, kr0, nk,
                          p.abuf + (size_t)m * 1536 + head * 64);
  } else {
    attn_dense_thread<64, 64>(p.QB + ((size_t)m * 8 + head) * 64, p.KB + (size_t)(head >> 2) * KM * 64, p.VB + (size_t)(head >> 2) * 64 * KM,
                          kr0, nk, p.abuf + (size_t)m * 1536 + 512 + head * 64);
  }
}
KERNEL nk_attn_na(Params p, int l, long n) {
  long g = GTID; if (g >= n) return;
  const int i = l >> 1;
  int head = g & 7; int ms = g >> 3; int m = MP + ms;
  int b = ms / DS, t = ms % DS; int r = t / GW, c = t % GW;
  int rs = r - 4; rs = rs < 0 ? 0 : (rs > GROWS - 8 ? GROWS - 8 : rs);
  int cs = c - 8; cs = cs < 0 ? 0 : (cs > GW - 16 ? GW - 16 : cs);
  const h16* q = p.QA + ((size_t)m * 8 + head) * 64;
  const h16* K = p.KA + (size_t)head * KM * 64; const h16* VT = p.VA + (size_t)head * 64 * KM;
  const int kbase = MP + b * TKS;
  const float* rpb = p.na_rpb + ((size_t)i * 8 + head) * 15 * 31;
  float qf[64], o[64];
#pragma unroll
  for (int j = 0; j < 64; j++) { qf[j] = (float)q[j]; o[j] = 0; }
  float mx = -1e30f, sum = 0;
  for (int kk = 0; kk < 128 + PAST; kk++) {
    int kr; float bias = 0;
    if (kk < 128) { int ri = kk >> 4, cj = kk & 15; kr = kbase + (rs + ri) * GW + cs + cj; bias = rpb[(rs + ri - r + 7) * 31 + (cs + cj - c + 15)] * LOG2E; }
    else kr = kbase + DS + (kk - 128);
    const h16* kp = K + (size_t)kr * 64;
    float s = bias;
#pragma unroll
    for (int j = 0; j < 64; j++) s += qf[j] * (float)kp[j];
    float mn = fmaxf(mx, s); float al = exp2f_(mx - mn); float pe = exp2f_(s - mn);
    sum = sum * al + pe; mx = mn;
#pragma unroll
    for (int j = 0; j < 64; j++) o[j] = o[j] * al + pe * (float)VT[(size_t)j * KM + kr];
  }
  float inv = 1.f / sum; float* out = p.abuf + (size_t)m * 1536 + head * 64;
#pragma unroll
  for (int j = 0; j < 64; j++) out[j] = o[j] * inv;
}
KERNEL nk_fin(Params p, int l, long n) {
  long g = GTID; if (g >= n) return;
  const int i = l >> 1;
  if (l & 1) {
    int ch = g & 15; int m = g >> 4;
    for (int j = 0; j < 64; j++) {
      int col = ch * 64 + j;
      p.O16[(size_t)m * 1024 + col] = (h16)(p.abuf[(size_t)m * 1536 + col] * (float)p.gates16[(size_t)m * 1024 + col]);
    }
  } else {
    int u = g % 12; int m = g / 12;
    if (u < 8) {
      for (int j = 0; j < 64; j++) {
        int col = u * 64 + j;
        p.O16[(size_t)m * 1024 + col] = (h16)(p.abuf[(size_t)m * 1536 + col] * (float)p.gates16[(size_t)m * 1024 + col]);
      }
    } else {
      int h = u - 8; float lam = p.lamv[i]; float lam_init = 0.8f - 0.6f * expf(-0.3f * l);
      const float* a1 = p.abuf + (size_t)m * 1536 + 512 + (h * 2) * 128; const float* a2 = a1 + 128;
      float ss = 0;
      for (int j = 0; j < 128; j++) { float d = a1[j] - lam * a2[j]; ss += d * d; }
      float r = 1.f / sqrtf(ss / 128 + EPSN);
      for (int j = 0; j < 128; j++) {
        float d = (a1[j] - lam * a2[j]) * r * p.diff_subln[i * 128 + j] * (1.f - lam_init);
        int col = 512 + h * 128 + j;
        p.O16[(size_t)m * 1024 + col] = (h16)(d * (float)p.gates16[(size_t)m * 1024 + col]);
      }
    }
  }
}
KERNEL nk_outproj(Params p, int l, long n) {
  long g = GTID; if (g >= n) return;
  int m = g >> 10, col = g & 1023;
  const float* W = ((l & 1) ? p.w_out_odd : p.w_out_even) + (size_t)(l >> 1) * 1024 * 1024 + col;
  const h16* o = p.O16 + (size_t)m * 1024;
  float acc = 0;
  for (int k = 0; k < 1024; k++) acc += (float)o[k] * W[(size_t)k * 1024];
  float gate = p.modv[((size_t)l * NCV + tok_cv(m)) * 3072 + 2048 + col];
  p.Y[(size_t)m * 1024 + col] = xrow(p, l, m)[col] + gate * acc;
}


#endif
#ifndef CPU_EMU
typedef _Float16 h16x8 __attribute__((ext_vector_type(8)));
typedef _Float16 h16x4 __attribute__((ext_vector_type(4)));
typedef float f32x16 __attribute__((ext_vector_type(16)));
typedef float f32x4 __attribute__((ext_vector_type(4)));
#define LAS __attribute__((address_space(3)))
typedef unsigned u32x4 __attribute__((ext_vector_type(4)));
DEVFN size_t pidx(int R, int row, int k) { return ((size_t)(k >> 6) * R + row) * 64 + (k & 63); }
DEVFN size_t vidx(int vrow, int kr) { return ((size_t)(kr >> 6) * 512 + vrow) * 64 + (kr & 63); }
DEVFN float max3f(float a, float b, float c) { float r; asm("v_max3_f32 %0, %1, %2, %3" : "=v"(r) : "v"(a), "v"(b), "v"(c)); return r; }
DEVFN float frsq(float x) { return __builtin_amdgcn_rsqf(x); }
DEVFN float fsilu(float x) { return x * __builtin_amdgcn_rcpf(1.f + __builtin_amdgcn_exp2f(-LOG2E * x)); }
DEVFN int tid_op() { int t = threadIdx.x; asm volatile("" : "+v"(t)); return t; }

DEVFN int even_col(int np) { return np < 416 ? np : (np < 512 ? -1 : np - 96); }

constexpr int G_STAGE = 49152, G_NSTAGE = 3, G_LDS = G_STAGE * G_NSTAGE;
constexpr int G_LDS2 = 131072 + 8 * 3072;
DEVFN int img_off(int r, int c) { return r * 128 + ((c ^ ((r >> 1) & 7)) << 4); }
template <int R>
DEVFN void stage_rows(const h16* g, int ld, char* lds, int tid) {
#pragma unroll
  for (int i = 0; i < R / 64; i++) {
    int r = (tid >> 3) + 64 * i; int c = (tid & 7) ^ ((r >> 1) & 7);
    __builtin_amdgcn_global_load_lds((const unsigned*)(g + (size_t)r * ld + c * 8), (unsigned*)(lds + i * 8192 + tid * 16), 16, 0, 0);
  }
}
#define WAITV(n) asm volatile("s_waitcnt vmcnt(" #n ")" ::: "memory")
#define RAWBAR() do { asm volatile("s_waitcnt lgkmcnt(0)" ::: "memory"); __builtin_amdgcn_s_barrier(); } while (0)
template <bool TR>
DEVFN void gemm_tile(const h16* A, int RA, const h16* Bt, int RB, int K, int m0, int n0, char* lds, f32x16 (&acc)[2][2]) {
  const int TIDX = tid_op();
  const int tid = TIDX, lane = tid & 63, w = tid >> 6, wm = w >> 1, wn = w & 1;
  const int nt = K / 64;
  const h16* Ag = A + (size_t)m0 * 64; const h16* Bg = Bt + (size_t)n0 * 64; const size_t pa = (size_t)RA * 64, pb = (size_t)RB * 64;
#pragma unroll
  for (int a = 0; a < 2; a++)
#pragma unroll
    for (int b = 0; b < 2; b++)
#pragma unroll
      for (int r = 0; r < 16; r++) acc[a][b][r] = 0.f;
  stage_rows<256>(Ag, 64, lds, tid); stage_rows<128>(Bg, 64, lds + 32768, tid);
  if (nt > 1) { stage_rows<256>(Ag + pa, 64, lds + G_STAGE, tid); stage_rows<128>(Bg + pb, 64, lds + G_STAGE + 32768, tid); }
  const int ra = wm * 64 + (lane & 31), rb = wn * 64 + (lane & 31), ch = lane >> 5;
  auto piece = [&](const h16* g, char* s, int i) {
    const int r = (tid >> 3) + 64 * i; const int c = (tid & 7) ^ ((r >> 1) & 7);
    __builtin_amdgcn_global_load_lds((const unsigned*)(g + (size_t)r * 64 + c * 8), (unsigned*)(s + i * 8192 + tid * 16), 16, 0, 0);
  };
  for (int t = 0; t < nt; t++) {
    if (t + 1 < nt) WAITV(6); else WAITV(0);
    RAWBAR();
    const bool pre = t + 2 < nt;
    char* sn = lds + ((t + 2) % 3) * G_STAGE; const h16* An = Ag + (t + 2) * pa; const h16* Bn = Bg + (t + 2) * pb;
    const char* sa = lds + (t % 3) * G_STAGE; const char* sb = sa + 32768;
    h16x8 af[2][2], bf[2][2];
#pragma unroll
    for (int mb = 0; mb < 2; mb++) af[0][mb] = *(const h16x8*)(sa + img_off(ra + mb * 32, ch));
#pragma unroll
    for (int nb = 0; nb < 2; nb++) bf[0][nb] = *(const h16x8*)(sb + img_off(rb + nb * 32, ch));
#pragma unroll
    for (int ks = 0; ks < 4; ks++) {
      const int cur = ks & 1, nxt = cur ^ 1;
      if (ks < 3) {
#pragma unroll
        for (int mb = 0; mb < 2; mb++) af[nxt][mb] = *(const h16x8*)(sa + img_off(ra + mb * 32, 2 * (ks + 1) + ch));
#pragma unroll
        for (int nb = 0; nb < 2; nb++) bf[nxt][nb] = *(const h16x8*)(sb + img_off(rb + nb * 32, 2 * (ks + 1) + ch));
      }
      if (pre) {
        if (ks == 0) { piece(An, sn, 0); piece(An, sn, 1); }
        else if (ks == 1) { piece(An, sn, 2); piece(An, sn, 3); }
        else if (ks == 2) { piece(Bn, sn + 32768, 0); piece(Bn, sn + 32768, 1); }
      }
#pragma unroll
      for (int mb = 0; mb < 2; mb++)
#pragma unroll
        for (int nb = 0; nb < 2; nb++) {
          if (TR) acc[mb][nb] = __builtin_amdgcn_mfma_f32_32x32x16_f16(bf[cur][nb], af[cur][mb], acc[mb][nb], 0, 0, 0);
          else acc[mb][nb] = __builtin_amdgcn_mfma_f32_32x32x16_f16(af[cur][mb], bf[cur][nb], acc[mb][nb], 0, 0, 0);
        }
      __builtin_amdgcn_sched_barrier(0);
    }
  }
  RAWBAR();
}

DEVFN float wsum32(float v) { return v + __shfl_xor(v, 32); }

template <class RsF, class DstF>
DEVFN void epi_head64(const Params& p, const f32x16 (&acc)[2][2], int mbase, RsF rsf, const float* bias, const float* gain, bool rope, float oscale,
                      float* state, int spitch, int scol, int ilayer, DstF dstf) {
  const int TIDX = tid_op();
  const int lane = TIDX & 63, h = lane >> 5;
#pragma unroll
  for (int mb = 0; mb < 2; mb++) {
    const int m = mbase + mb * 32 + (lane & 31);
    const float rs = rsf(m);
    float v[2][16]; float ss = 0;
#pragma unroll
    for (int nb = 0; nb < 2; nb++)
#pragma unroll
      for (int q = 0; q < 4; q++) {
        const int j = nb * 32 + 8 * q + 4 * h;
        f32x4 b = bias ? *(const f32x4*)(bias + j) : (f32x4){0.f, 0.f, 0.f, 0.f};
#pragma unroll
        for (int e = 0; e < 4; e++) { float x = acc[mb][nb][q * 4 + e] * rs + b[e]; v[nb][q * 4 + e] = x; ss += x * x; }
      }
    ss = wsum32(ss);
    const float rr = frsq(ss * (1.f / 64.f) + EPSN);
#pragma unroll
    for (int nb = 0; nb < 2; nb++)
#pragma unroll
      for (int q = 0; q < 4; q++) {
        const int j = nb * 32 + 8 * q + 4 * h;
        f32x4 g = *(const f32x4*)(gain + j);
#pragma unroll
        for (int e = 0; e < 4; e++) v[nb][q * 4 + e] *= rr * g[e];
      }
    const bool smp = m >= MP;
    if (state && !smp) {
      float* sp = state + st_row(m, ilayer) * spitch + scol;
#pragma unroll
      for (int nb = 0; nb < 2; nb++)
#pragma unroll
        for (int q = 0; q < 4; q++) { f32x4 o = {v[nb][q * 4], v[nb][q * 4 + 1], v[nb][q * 4 + 2], v[nb][q * 4 + 3]}; *(f32x4*)(sp + nb * 32 + 8 * q + 4 * h) = o; }
    }
    if (rope && smp) {
      const int t = tok_pos(m);
#pragma unroll
      for (int q = 0; q < 4; q++) {
        f32x4 c = *(const f32x4*)(p.ropeC64 + t * 32 + 8 * q + 4 * h), s = *(const f32x4*)(p.ropeS64 + t * 32 + 8 * q + 4 * h);
#pragma unroll
        for (int e = 0; e < 4; e++) { float x1 = v[0][q * 4 + e], x2 = v[1][q * 4 + e]; v[0][q * 4 + e] = x1 * c[e] - x2 * s[e]; v[1][q * 4 + e] = x2 * c[e] + x1 * s[e]; }
      }
    }
    h16* dst = dstf(m);
#pragma unroll
    for (int nb = 0; nb < 2; nb++)
#pragma unroll
      for (int q = 0; q < 4; q++) {
        h16x4 o;
#pragma unroll
        for (int e = 0; e < 4; e++) o[e] = (h16)(v[nb][q * 4 + e] * oscale);
        *(h16x4*)(dst + nb * 32 + 8 * q + 4 * h) = o;
      }
  }
}
template <class RsF, class DstF>
DEVFN void epi_head32(const Params& p, const f32x16 (&acc)[2][2], int mbase, RsF rsf, const float* bias, const float* gain, bool rope, float oscale,
                      float* state, int ilayer, DstF dstf, float* dual = nullptr) {
  const int TIDX = tid_op();
  const int lane = TIDX & 63, h = lane >> 5;
#pragma unroll
  for (int mb = 0; mb < 2; mb++) {
    const int m = mbase + mb * 32 + (lane & 31);
    const float rs = rsf(m);
    float v[16]; float ss = 0;
#pragma unroll
    for (int q = 0; q < 4; q++) {
      const int j = 8 * q + 4 * h;
      f32x4 b = bias ? *(const f32x4*)(bias + j) : (f32x4){0.f, 0.f, 0.f, 0.f};
#pragma unroll
      for (int e = 0; e < 4; e++) { float x = acc[mb][0][q * 4 + e] * rs + b[e]; v[q * 4 + e] = x; ss += x * x; }
    }
    ss = wsum32(ss);
    const float rr = frsq(ss * (1.f / 32.f) + EPSN);
#pragma unroll
    for (int q = 0; q < 4; q++) {
      f32x4 g = *(const f32x4*)(gain + 8 * q + 4 * h);
#pragma unroll
      for (int e = 0; e < 4; e++) v[q * 4 + e] *= rr * g[e];
    }
    const bool smp = m >= MP;
    if (state && !smp) {
      float* sp = state + st_row(m, ilayer) * 32;
#pragma unroll
      for (int q = 0; q < 4; q++) { f32x4 o = {v[q * 4], v[q * 4 + 1], v[q * 4 + 2], v[q * 4 + 3]}; *(f32x4*)(sp + 8 * q + 4 * h) = o; }
    }
    if (rope && smp) {
      const int t = tok_pos(m);
#pragma unroll
      for (int q = 0; q < 2; q++) {
        f32x4 c = *(const f32x4*)(p.ropeC32 + t * 16 + 8 * q + 4 * h), s = *(const f32x4*)(p.ropeS32 + t * 16 + 8 * q + 4 * h);
#pragma unroll
        for (int e = 0; e < 4; e++) { float x1 = v[q * 4 + e], x2 = v[(q + 2) * 4 + e]; v[q * 4 + e] = x1 * c[e] - x2 * s[e]; v[(q + 2) * 4 + e] = x2 * c[e] + x1 * s[e]; }
      }
    }
    h16* dst = dstf(m);
#pragma unroll
    for (int q = 0; q < 4; q++) {
      h16x4 o;
#pragma unroll
      for (int e = 0; e < 4; e++) o[e] = (h16)(v[q * 4 + e] * oscale);
      *(h16x4*)(dst + 8 * q + 4 * h) = o;
      if (dual) { for (int e = 0; e < 4; e++) dual[(size_t)tok_keyrow(m) * 32 + 8 * q + 4 * h + e] = v[q * 4 + e]; }
    }
  }
}
template <class RsF, class KrF>
DEVFN void epi_vt(const f32x16 (&acc)[2][2], int mbase, RsF rsf, const float* bias  , float* state, int spitch, int scol, int ilayer,
                  h16* vbuf, int vrow0, KrF krf) {
  const int TIDX = tid_op();
  const int lane = TIDX & 63, h = lane >> 5, e0 = lane & 31;
#pragma unroll
  for (int mb = 0; mb < 2; mb++)
#pragma unroll
    for (int q = 0; q < 4; q++) {
      const int mq = mbase + mb * 32 + 8 * q + 4 * h;
      float rs[4];
#pragma unroll
      for (int e = 0; e < 4; e++) rs[e] = rsf(mq + e);
      const int kr = krf(mq);
#pragma unroll
      for (int nb = 0; nb < 2; nb++) {
        const int col = nb * 32 + e0; const float b = bias ? bias[col] : 0.f;
        h16x4 o;
#pragma unroll
        for (int e = 0; e < 4; e++) {
          float x = acc[mb][nb][q * 4 + e] * rs[e] + b; o[e] = (h16)x;
          if (state && mq < MP) state[st_row(mq + e, ilayer) * spitch + scol + col] = x;
        }
        *(h16x4*)(vbuf + vidx(vrow0 + col, kr)) = o;
      }
    }
}

DEVFN void qgemm_tile(const Params& p, int l, int mt, int head, char* lds) {
  const int TIDX = tid_op();
  const int i = l >> 1; const int m0 = mt * 256;
  const int w = TIDX >> 6, wm = w >> 1, wn = w & 1;
  f32x16 acc[2][2];
  gemm_tile<true>(p.qa16, M, (p.wqb16 + (size_t)i * 1024 * 256), 1024, 256, m0, head * 128, lds, acc);
  const float* rq = p.rowss_qa + (size_t)i * M;
  auto rsf = [&](int m) { return frsq(rq[m] * (1.f / 256.f) + EPSN); };
  const float sc = LOG2E / sqrtf(96.f);
  if (wn == 0) epi_head64(p, acc, m0 + wm * 64, rsf, nullptr, p.mla_qn_nope + i * 64, false, sc, nullptr, 0, 0, i, [&](int m) { return p.QA + ((size_t)m * 8 + head) * 96; });
  else epi_head32(p, acc, m0 + wm * 64, rsf, nullptr, p.mla_qn_rope + i * 32, true, sc, nullptr, i, [&](int m) { return p.QA + ((size_t)m * 8 + head) * 96 + 64; });
}
DEVFN void kvgemm_tile(const Params& p, int l, int mt, int ntile, char* lds) {
  const int TIDX = tid_op();
  const int i = l >> 1; const int m0 = mt * 256;
  const int lane = TIDX & 63, w = TIDX >> 6, wm = w >> 1, wn = w & 1, h = lane >> 5;
  f32x16 acc[2][2];
  const float* rck = p.rowss_ckv + (size_t)i * KM;
  auto one = [&](int m) { return frsq(rck[m] * (1.f / 128.f) + EPSN); };
  if (ntile < 4) {
    gemm_tile<true>(p.ckv16, KM, (p.wkvb16 + (size_t)i * 1024 * 128), 1024, 128, m0, ntile * 128, lds, acc);
    const int head = ntile * 2 + wn;
    epi_head64(p, acc, m0 + wm * 64, one, nullptr, p.mla_kn_nope + i * 64, false, 1.f, nullptr, 0, 0, i, [&](int m) { return p.KA + ((size_t)head * KM + m) * 128; });
#pragma unroll
    for (int mb = 0; mb < 2; mb++) {
      const int kr = m0 + wm * 64 + mb * 32 + (lane & 31);
      const h16x8* s = (const h16x8*)(p.kpe16 + (size_t)kr * 32 + h * 16);
      h16x8* d = (h16x8*)(p.KA + ((size_t)head * KM + kr) * 128 + 64 + h * 16);
      d[0] = s[0]; d[1] = s[1];
    }
  } else {
    gemm_tile<false>(p.ckv16, KM, (p.wkvb16 + (size_t)i * 1024 * 128), 1024, 128, m0, ntile * 128, lds, acc);
    const int head = (ntile - 4) * 2 + wn;
    epi_vt(acc, m0 + wm * 64, one, nullptr, nullptr, 0, 0, i, p.VA, head * 64, [](int m) { return m; });
  }
}
DEVFN void outproj_tile(const Params& p, int l, int mt, int ntile, char* lds, bool dry = false) {
  const int TIDX = tid_op();
  const int m0 = mt * 256, n0 = ntile * 128;
  const int lane = TIDX & 63, w = TIDX >> 6, wm = w >> 1, wn = w & 1, h = lane >> 5;
  const int cv = tok_cv(m0); const int nw0 = n0 + wn * 64;
  f32x4 xv[2][2][4];
#pragma unroll
  for (int mb = 0; mb < 2; mb++) {
    const int m = m0 + wm * 64 + mb * 32 + (lane & 31);
    if (l == 0) {
      const float* xr = xrow(p, 0, m) + nw0;
#pragma unroll
      for (int nb = 0; nb < 2; nb++)
#pragma unroll
        for (int q = 0; q < 4; q++) xv[mb][nb][q] = *(const f32x4*)(xr + nb * 32 + 8 * q + 4 * h);
    } else {
      const h16* xr = p.x16 + (size_t)m * D + nw0;
#pragma unroll
      for (int nb = 0; nb < 2; nb++)
#pragma unroll
        for (int q = 0; q < 4; q++) { const h16x4 t = *(const h16x4*)(xr + nb * 32 + 8 * q + 4 * h); xv[mb][nb][q] = (f32x4){(float)t[0], (float)t[1], (float)t[2], (float)t[3]}; }
    }
  }
  f32x16 acc[2][2];
  gemm_tile<true>(p.O16, M, (p.wout16 + (size_t)l * D * D), 1024, D, m0, n0, lds, acc);
  const float* gate = p.modv + ((size_t)l * NCV + cv) * 3072 + 2048 + nw0;
  const float* nsc = p.modv + ((size_t)(l + 1) * NCV + cv) * 3072 + 1024 + nw0;
  const float* nnw = p.norm_w + (l + 1) * D + nw0;
#pragma unroll
  for (int mb = 0; mb < 2; mb++) {
    const int m = m0 + wm * 64 + mb * 32 + (lane & 31);
    float* yr = p.Y + (size_t)m * D + nw0;
    float ss = 0;
#pragma unroll
    for (int nb = 0; nb < 2; nb++)
#pragma unroll
      for (int q = 0; q < 4; q++) {
        const int j = nb * 32 + 8 * q + 4 * h;
        f32x4 x = xv[mb][nb][q], g = *(const f32x4*)(gate + j), o;
#pragma unroll
        for (int e = 0; e < 4; e++) { o[e] = x[e] + g[e] * acc[mb][nb][q * 4 + e]; ss += o[e] * o[e]; }
        if (!dry && l == 3) *(f32x4*)(yr + j) = o;
        if (l < 3 && !dry) {
          { h16x4 xh; for (int e = 0; e < 4; e++) xh[e] = (h16)o[e]; *(h16x4*)(p.x16 + (size_t)m * D + nw0 + j) = xh; }
          f32x4 s = *(const f32x4*)(nsc + j), nw = *(const f32x4*)(nnw + j); h16x4 oh;
#pragma unroll
          for (int e = 0; e < 4; e++) oh[e] = (h16)(o[e] * nw[e] * (1.f + s[e]));
          *(h16x4*)(p.xs16 + pidx(M, m, nw0 + j)) = oh;
        }
      }
    if (l < 3 && !dry) { ss = wsum32(ss); if (h == 0) atomicAdd(p.rowss_l + (size_t)(l + 1) * M + m, ss); }
  }
}
struct AttnItem {
  const h16 *k0, *k1; int kld;
  const h16 *v0, *v1;
  int kr0, nt0, kr1, nt1;
};
constexpr int A_RING = 3 * 32768;

template <int DQK, int NKI, int NVI, int NDB, bool NAMASK>
DEVFN void attn_core(const AttnItem& it, const h16* qptr, int qpitch, int ksel, int ta, int tb, const float* rpbl, int na_dr0  , int na_c,
                     char* lds, f32x16 (&o)[NDB], float& lsum_out) {
  const int TIDX = tid_op();
  constexpr int NIMG = NKI + NVI; constexpr int STG = NIMG * 8192;
  const int tid = TIDX, lane = tid & 63, h = lane >> 5;
  h16x8 qf[DQK / 16];
#pragma unroll
  for (int ks = 0; ks < DQK / 16; ks++) qf[ks] = *(const h16x8*)(qptr + (size_t)(lane & 31) * qpitch + ks * 16 + 8 * h);
#pragma unroll
  for (int db = 0; db < NDB; db++)
#pragma unroll
    for (int r = 0; r < 16; r++) o[db][r] = 0.f;
  float m_run = 0.f, lsum = 0.f; bool first = true;
  const int nt = it.nt0 + it.nt1;
  auto stage = [&](int t) {
    char* s = lds + (t % 3) * STG; const int kr = t < it.nt0 ? it.kr0 + 64 * t : it.kr1 + 64 * (t - it.nt0);
    stage_rows<64>(it.k0 + (size_t)kr * it.kld, it.kld, s, tid);
    if (NKI == 2) stage_rows<64>(it.k1 + (size_t)kr * it.kld, it.kld, s + 8192, tid);
    stage_rows<64>(it.v0 + (size_t)(kr >> 6) * (512 * 64), 64, s + NKI * 8192, tid);
    if (NVI == 2) stage_rows<64>(it.v1 + (size_t)(kr >> 6) * (512 * 64), 64, s + NKI * 8192 + 8192, tid);
  };
  stage(0); if (nt > 1) stage(1);
  const int l5 = lane & 31;
  const int prow = (l5 & 19) | ((l5 & 4) << 1) | ((l5 & 8) >> 1);
  int na_cs = na_c - 8; na_cs = na_cs < 0 ? 0 : (na_cs > GW - 16 ? GW - 16 : na_cs);
  for (int t = 0; t < nt; t++) {
    if (t + 1 < nt) { if (NIMG == 2) WAITV(2); else if (NIMG == 3) WAITV(3); else WAITV(4); } else WAITV(0);
    RAWBAR();
    if (t + 2 < nt) stage(t + 2);
    const bool active = (t >= it.nt0) || (t >= ta && t < tb);
    if (active) {
      const char* s = lds + (t % 3) * STG;
      const char* sv = s + NKI * 8192;
      h16x8 kf[2][DQK / 16];
#pragma unroll
      for (int kb = 0; kb < 2; kb++)
#pragma unroll
        for (int ks = 0; ks < DQK / 16; ks++) {
          const int img = (DQK == 96) ? (ks >> 2) : ksel;
          kf[kb][ks] = *(const h16x8*)(s + img * 8192 + img_off(32 * kb + prow, 2 * (ks & 3) + h));
        }
      __builtin_amdgcn_sched_barrier(0);
      f32x16 st[2];
#pragma unroll
      for (int kb = 0; kb < 2; kb++) {
#pragma unroll
        for (int r = 0; r < 16; r++) st[kb][r] = -m_run;
#pragma unroll
        for (int ks = 0; ks < DQK / 16; ks++) st[kb] = __builtin_amdgcn_mfma_f32_32x32x16_f16(kf[kb][ks], qf[ks], st[kb], 0, 0, 0);
      }
      __builtin_amdgcn_sched_barrier(0);
      h16x8 vf[2][4];
#pragma unroll
      for (int db = 0; db < 2; db++)
#pragma unroll
        for (int sI = 0; sI < 4; sI++) vf[db][sI] = *(const h16x8*)(sv + img_off(db * 32 + l5, 2 * sI + h));
      __builtin_amdgcn_sched_barrier(0);
      if (NAMASK && t < it.nt0) {
        const int drow = (na_dr0 + t) * 31 + 15 - na_c;
#pragma unroll
        for (int kb = 0; kb < 2; kb++)
#pragma unroll
          for (int r = 0; r < 16; r++) {
            const int kcol = 32 * kb + (r & 7) + 8 * h + 16 * (r >> 3);
            const bool valid = (unsigned)(kcol - na_cs) < 16u;
            const float bv = rpbl[valid ? drow + kcol : 0];
            st[kb][r] = valid ? st[kb][r] + bv : -1e30f;
          }
      }
      float mx;
      {
        float m0 = max3f(st[0][0], st[0][1], st[0][2]), m1 = max3f(st[1][0], st[1][1], st[1][2]);
#pragma unroll
        for (int r = 3; r < 15; r += 2) { m0 = max3f(m0, st[0][r], st[0][r + 1]); m1 = max3f(m1, st[1][r], st[1][r + 1]); }
        mx = max3f(m0, m1, st[0][15]); mx = fmaxf(mx, st[1][15]);
      }
      { auto sw = __builtin_amdgcn_permlane32_swap(__float_as_uint(mx), __float_as_uint(mx), false, false); mx = fmaxf(__uint_as_float(sw[0]), __uint_as_float(sw[1])); }
      if (first || !__all(mx <= 8.f)) {
        const float delta = first ? mx : fmaxf(mx, 0.f);
        const float al = __builtin_amdgcn_exp2f(-delta); m_run += delta; lsum *= al; first = false;
#pragma unroll
        for (int db = 0; db < NDB; db++)
#pragma unroll
          for (int r = 0; r < 16; r++) o[db][r] *= al;
#pragma unroll
        for (int kb = 0; kb < 2; kb++)
#pragma unroll
          for (int r = 0; r < 16; r++) st[kb][r] -= delta;
      }
      float sum = 0.f;
#pragma unroll
      for (int kb = 0; kb < 2; kb++)
#pragma unroll
        for (int r = 0; r < 16; r++) { float pe = __builtin_amdgcn_exp2f(st[kb][r]); st[kb][r] = pe; sum += pe; }
      lsum += sum;
      h16x8 pf[4];
#pragma unroll
      for (int sI = 0; sI < 4; sI++) {
        u32x4 pk;
#pragma unroll
        for (int j = 0; j < 4; j++) pk[j] = __builtin_bit_cast(unsigned, __builtin_amdgcn_cvt_pkrtz(st[sI >> 1][8 * (sI & 1) + 2 * j], st[sI >> 1][8 * (sI & 1) + 2 * j + 1]));
        pf[sI] = __builtin_bit_cast(h16x8, pk);
      }
      __builtin_amdgcn_sched_barrier(0);
      if (NDB == 4) {
        h16x8 vg[2][4];
#pragma unroll
        for (int db = 0; db < 2; db++)
#pragma unroll
          for (int sI = 0; sI < 4; sI++) vg[db][sI] = *(const h16x8*)(sv + 8192 + img_off(db * 32 + l5, 2 * sI + h));
#pragma unroll
        for (int db = 0; db < 2; db++)
#pragma unroll
          for (int sI = 0; sI < 4; sI++) o[db] = __builtin_amdgcn_mfma_f32_32x32x16_f16(vf[db][sI], pf[sI], o[db], 0, 0, 0);
#pragma unroll
        for (int db = 0; db < 2; db++)
#pragma unroll
          for (int sI = 0; sI < 4; sI++) o[NDB == 4 ? 2 + db : db] = __builtin_amdgcn_mfma_f32_32x32x16_f16(vg[db][sI], pf[sI], o[NDB == 4 ? 2 + db : db], 0, 0, 0);
      } else {
#pragma unroll
        for (int db = 0; db < 2; db++)
#pragma unroll
          for (int sI = 0; sI < 4; sI++) o[db] = __builtin_amdgcn_mfma_f32_32x32x16_f16(vf[db][sI], pf[sI], o[db], 0, 0, 0);
      }
      __builtin_amdgcn_sched_barrier(0);
    }
  }
  RAWBAR();
  lsum_out = lsum + __shfl_xor(lsum, 32);
}
template <int NDB>
DEVFN void attn_store_gated(const Params& p, const f32x16 (&o)[NDB], float inv, int m, int col0) {
  const int TIDX = tid_op();
  const int h = (TIDX & 63) >> 5;
#pragma unroll
  for (int db = 0; db < NDB; db++)
#pragma unroll
    for (int q = 0; q < 4; q++) {
      const int c = col0 + 32 * db + 8 * q + 4 * h;
      h16x4 g = *(const h16x4*)(p.gates16 + (size_t)m * 1024 + c), ov;
#pragma unroll
      for (int e = 0; e < 4; e++) ov[e] = (h16)(o[db][q * 4 + e] * inv * (float)g[e]);
      *(h16x4*)(p.O16 + pidx(M, m, c)) = ov;
    }
}
DEVFN void attn_even_item(const Params& p, int l, int item, char* lds) {
  const int TIDX = tid_op();
  const int i = l >> 1; const int lane = TIDX & 63, w = TIDX >> 6, h = lane >> 5;
  const int grp = item >> 7, j0 = item & 127; const bool smp = grp < 2; const bool isdiff = (grp & 1) == 0;
  const int xx = j0 & 7, kk = j0 >> 3;
  const int j = !smp ? j0 : (isdiff ? ((xx << 4) | kk) : (((xx * 2 + (kk >> 3)) << 3) | (kk & 7)));
  AttnItem it{}; it.nt1 = 0; it.kr1 = 0;
  if (isdiff) {
    int b, hh, t0;
    if (smp) { b = j >> 6; hh = (j >> 4) & 3; t0 = (j & 15) * 128; it.kr0 = MP + b * TKS; it.nt0 = TKS / 64; }
    else { b = j >> 3; hh = (j >> 1) & 3; t0 = (j & 1) * 128; it.kr0 = b * SEQ; it.nt0 = SEQ / 64; }
    const int comp = w >> 2;
    const int m0w = (smp ? MP + b * DS : b * SEQ) + t0 + (w & 3) * 32;
    it.k0 = p.KB + (size_t)(2 * hh) * KM * 64; it.k1 = p.KB + (size_t)(2 * hh + 1) * KM * 64; it.kld = 64;
    it.v0 = p.VB + (size_t)(hh * 128) * 64; it.v1 = p.VB + (size_t)(hh * 128 + 64) * 64;
    f32x16 o[4]; float lsum;
    attn_core<64, 2, 2, 4, false>(it, p.QB + ((size_t)m0w * 8 + 2 * hh + comp) * 64, 512, comp, 0, 1 << 30, nullptr, 0, 0, lds, o, lsum);
    const float inv = 1.f / lsum;
    float* a2 = (float*)lds + (size_t)(w & 3) * 32 * 132 + (size_t)(lane & 31) * 132;
    if (comp == 1) {
#pragma unroll
      for (int db = 0; db < 4; db++)
#pragma unroll
        for (int q = 0; q < 4; q++) { f32x4 v = {o[db][q * 4] * inv, o[db][q * 4 + 1] * inv, o[db][q * 4 + 2] * inv, o[db][q * 4 + 3] * inv}; *(f32x4*)(a2 + 32 * db + 8 * q + 4 * h) = v; }
    }
    __syncthreads();
    if (comp == 0) {
      const float lam = p.lamv[i]; const float lam_init = 0.8f - 0.6f * expf(-0.3f * l);
      float ss = 0;
#pragma unroll
      for (int db = 0; db < 4; db++)
#pragma unroll
        for (int q = 0; q < 4; q++) {
          f32x4 v2 = *(const f32x4*)(a2 + 32 * db + 8 * q + 4 * h);
#pragma unroll
          for (int e = 0; e < 4; e++) { float d = o[db][q * 4 + e] * inv - lam * v2[e]; o[db][q * 4 + e] = d; ss += d * d; }
        }
      ss = wsum32(ss);
      const float rr = (1.f - lam_init) * frsq(ss * (1.f / 128.f) + EPSN);
      const int m = m0w + (lane & 31);
#pragma unroll
      for (int db = 0; db < 4; db++)
#pragma unroll
        for (int q = 0; q < 4; q++) {
          const int dv = 32 * db + 8 * q + 4 * h; const int c = 512 + hh * 128 + dv;
          f32x4 sg = *(const f32x4*)(p.diff_subln + i * 128 + dv);
          h16x4 g = *(const h16x4*)(p.gates16 + (size_t)m * 1024 + c), ov;
#pragma unroll
          for (int e = 0; e < 4; e++) ov[e] = (h16)(o[db][q * 4 + e] * rr * sg[e] * (float)g[e]);
          *(h16x4*)(p.O16 + pidx(M, m, c)) = ov;
        }
    }
    __syncthreads();
  } else {
    int b, head, t0;
    if (smp) { b = j >> 6; head = (j >> 3) & 7; t0 = (j & 7) * 256; it.kr0 = MP + b * TKS; it.nt0 = TKS / 64; }
    else { b = j >> 3; head = j & 7; t0 = 0; it.kr0 = b * SEQ; it.nt0 = SEQ / 64; }
    const int m0w = (smp ? MP + b * DS : b * SEQ) + t0 + w * 32;
    it.k0 = p.KA + (size_t)head * KM * 128; it.k1 = it.k0 + 64; it.kld = 128;
    it.v0 = p.VA + (size_t)(head * 64) * 64; it.v1 = it.v0;
    f32x16 o[2]; float lsum;
    attn_core<96, 2, 1, 2, false>(it, p.QA + ((size_t)m0w * 8 + head) * 96, 768, 0, 0, 1 << 30, nullptr, 0, 0, lds, o, lsum);
    attn_store_gated<2>(p, o, 1.f / lsum, m0w + (lane & 31), head * 64);
  }
}
DEVFN void attn_odd_item(const Params& p, int l, int item, char* lds) {
  const int TIDX = tid_op();
  const int i = l >> 1; const int lane = TIDX & 63, w = TIDX >> 6;
  const int grp = item >> 7, j0 = item & 127; const bool smp = grp < 2; const bool isgqa = (grp & 1) == 0;
  const int xx = j0 & 7, kk = j0 >> 3;
  const int j = !smp ? j0 : (isgqa ? (((xx >> 1) << 5) | ((xx & 1) << 4) | kk) : (((xx * 2 + (kk >> 3)) << 3) | (kk & 7)));
  AttnItem it{}; it.nt1 = 0; it.kr1 = 0; it.kld = 64;
  f32x16 o[2]; float lsum;
  if (isgqa) {
    int b, kvh, t0;
    if (smp) { b = j >> 6; kvh = (j >> 5) & 1; t0 = (j & 31) * 64; it.kr0 = MP + b * TKS; it.nt0 = TKS / 64; }
    else { b = j >> 3; kvh = (j >> 2) & 1; t0 = (j & 3) * 64; it.kr0 = b * SEQ; it.nt0 = SEQ / 64; }
    const int head = kvh * 4 + (w >> 1);
    const int m0w = (smp ? MP + b * DS : b * SEQ) + t0 + (w & 1) * 32;
    it.k0 = p.KB + (size_t)kvh * KM * 64; it.k1 = it.k0; it.v0 = p.VB + (size_t)(kvh * 64) * 64; it.v1 = it.v0;
    attn_core<64, 1, 1, 2, false>(it, p.QB + ((size_t)m0w * 8 + head) * 64, 512, 0, 0, 1 << 30, nullptr, 0, 0, lds, o, lsum);
    attn_store_gated<2>(p, o, 1.f / lsum, m0w + (lane & 31), 512 + head * 64);
  } else if (!smp) {
    const int b = j >> 3, head = j & 7; it.kr0 = b * SEQ; it.nt0 = SEQ / 64;
    const int m0w = b * SEQ + w * 32;
    it.k0 = p.KA + (size_t)head * KM * 64; it.k1 = it.k0; it.v0 = p.VA + (size_t)(head * 64) * 64; it.v1 = it.v0;
    attn_core<64, 1, 1, 2, false>(it, p.QA + ((size_t)m0w * 8 + head) * 64, 512, 0, 0, 1 << 30, nullptr, 0, 0, lds, o, lsum);
    attn_store_gated<2>(p, o, 1.f / lsum, m0w + (lane & 31), head * 64);
  } else {
    const int b = j >> 6, head = (j >> 3) & 7, r0 = (j & 7) * 4;
    const int r = r0 + (w >> 1), c0 = (w & 1) * 32;
    auto rsf = [](int rr) { int s = rr - 4; return s < 0 ? 0 : (s > GROWS - 8 ? GROWS - 8 : s); };
    const int rlo = rsf(r0), rhi = rsf(r0 + 3) + 8;
    const int kbase = MP + b * TKS;
    it.kr0 = kbase + rlo * 64; it.nt0 = rhi - rlo; it.kr1 = kbase + DS; it.nt1 = PAST / 64;
    it.k0 = p.KA + (size_t)head * KM * 64; it.k1 = it.k0; it.v0 = p.VA + (size_t)(head * 64) * 64; it.v1 = it.v0;
    float* rpbl = (float*)(lds + A_RING);
    { const float* src = p.na_rpb + ((size_t)i * 8 + head) * 465; for (int k = TIDX; k < 465; k += 512) rpbl[k] = src[k] * LOG2E; }
    const int m0w = MP + b * DS + r * 64 + c0;
    const int ta = rsf(r) - rlo;
    attn_core<64, 1, 1, 2, true>(it, p.QA + ((size_t)m0w * 8 + head) * 64, 512, 0, ta, ta + 8, rpbl, rlo - r + 7, c0 + (lane & 31), lds, o, lsum);
    attn_store_gated<2>(p, o, 1.f / lsum, m0w + (lane & 31), head * 64);
  }
}
constexpr int G8_HTB = 128 * 64 * 2, G8_STAGE = 8 * G8_HTB;
DEVFN int g8_lds_byte(int r, int c) { const int st = (r >> 4) * 2 + (c >> 5), rr = r & 15, cc = c & 31, ob = rr * 64 + cc * 2; return st * 1024 + (ob ^ (((ob >> 9) & 1) << 5)); }
DEVFN void g8_stage_rc(int b, int& R, int& C) { const int st = b / 1024, sb = b % 1024, swz = sb ^ (((sb >> 9) & 1) << 5); R = (st >> 1) * 16 + swz / 64; C = (st & 1) * 32 + (swz % 64) / 2; }
DEVFN int g8_perm32(int rho) { const int n = rho >> 4, i = rho & 15; return 8 * (i >> 2) + 4 * n + (i & 3); }
struct G8Unit { int pm, pn; };
DEVFN bool g8_next(int i, int nM, int nN, int G, int c, G8Unit& u) {
  const int nwg = nM * nN; const long L = (long)i * G + c; if (L >= nwg) return false;
  int wgid = (int)L; { const int q = nwg / 8, r = nwg % 8, xcd = wgid % 8, off = wgid / 8; wgid = (xcd < r ? xcd * (q + 1) : r * (q + 1) + (xcd - r) * q) + off; }
  const int nig = 8 * nN, gid = wgid / nig, fm = gid * 8, gsz = (nM - fm) < 8 ? (nM - fm) : 8;
  u.pm = fm + ((wgid % nig) % gsz); u.pn = (wgid % nig) / gsz; return true;
}
template <class Epi>
DEVFN void gemm8_phase(LAS unsigned char* lds, const h16* A, int RA, const h16* Bt, int RB, int K, int nM, int nN, const Epi& E) {
  const int tid = tid_op(), wid = __builtin_amdgcn_readfirstlane(tid >> 6), lane = tid & 63, wr = wid >> 2, wc = wid & 3, fr = lane & 15, fq = lane >> 4;
  const int nt = K / 64; const int Gg = gridDim.x, cc = blockIdx.x;
  unsigned voffA[2], voffB[2];
#pragma unroll
  for (int i = 0; i < 2; ++i) { int R, C; g8_stage_rc(tid * 16 + i * 8192, R, C); const int Rb = (R & ~31) + g8_perm32(R & 31);
    voffA[i] = (unsigned)(R * 64 + C) * 2u; voffB[i] = (unsigned)(Rb * 64 + C) * 2u; }
  const size_t kstepA = (size_t)RA * 128, kstepB = (size_t)RB * 128;
  const size_t hstep = (size_t)128 * 128;
  const size_t tstep = 2 * hstep;
  const unsigned ldsw = (unsigned)wid * 1024u;
  const int aoff = g8_lds_byte(wr * 64 + fr, fq * 8), boff = g8_lds_byte(wc * 32 + fr, fq * 8);
#define G8_SA(b, h) (((b) * 2 + (h)) * G8_HTB)
#define G8_SB(b, h) ((4 + (b) * 2 + (h)) * G8_HTB)
#define G8_STAGE_(bufoff, gbase, voff) do { _Pragma("unroll") for (int _i = 0; _i < 2; ++_i) \
    __builtin_amdgcn_global_load_lds((const unsigned*)((const char*)(gbase) + (voff)[_i]), (LAS unsigned*)(lds + (bufoff) + ldsw + _i * 8192), 16, 0, 0); } while (0)
#define G8_LDA(dst, b, h) do { _Pragma("unroll") for (int m = 0; m < 4; ++m) _Pragma("unroll") for (int k = 0; k < 2; ++k) dst[m][k] = *(const LAS h16x8*)(lds + G8_SA(b, h) + aoff + m * 2048 + k * 1024); } while (0)
#define G8_LDB(dst, b, h) do { _Pragma("unroll") for (int n = 0; n < 2; ++n) _Pragma("unroll") for (int k = 0; k < 2; ++k) dst[n][k] = *(const LAS h16x8*)(lds + G8_SB(b, h) + boff + n * 2048 + k * 1024); } while (0)
#define G8_MMA(ai, bj, At, Bt_) do { __builtin_amdgcn_s_setprio(1); _Pragma("unroll") for (int m = 0; m < 4; ++m) _Pragma("unroll") for (int n = 0; n < 2; ++n) _Pragma("unroll") for (int k = 0; k < 2; ++k) \
    acc[ai][bj][m][n] = __builtin_amdgcn_mfma_f32_16x16x32_f16(Bt_[n][k], At[m][k], acc[ai][bj][m][n], 0, 0, 0); __builtin_amdgcn_s_setprio(0); } while (0)
#define G8_WAIT_L(n) asm volatile("s_waitcnt lgkmcnt(" #n ")" ::: "memory")
#define G8_BAR __builtin_amdgcn_s_barrier()
#define G8_SCHED __builtin_amdgcn_sched_barrier(0)
  G8Unit cur, nxt; int ui = 0;
  if (!g8_next(0, nM, nN, Gg, cc, cur)) return;
  f32x4 acc[2][2][4][2];
#pragma unroll
  for (int a = 0; a < 2; ++a)
#pragma unroll
    for (int b = 0; b < 2; ++b)
#pragma unroll
      for (int m = 0; m < 4; ++m)
#pragma unroll
        for (int n = 0; n < 2; ++n) acc[a][b][m][n] = (f32x4){0.f, 0.f, 0.f, 0.f};
  h16x8 At[4][2], B0[2][2], B1[2][2];
  const char* cA = (const char*)A + (size_t)cur.pm * tstep; const char* cB = (const char*)Bt + (size_t)cur.pn * tstep;
  G8_STAGE_(G8_SB(0, 0), cB, voffB); G8_STAGE_(G8_SA(0, 0), cA, voffA); G8_STAGE_(G8_SB(0, 1), cB + hstep, voffB); G8_STAGE_(G8_SA(0, 1), cA + hstep, voffA);
  if (wr == 1) G8_BAR;
  WAITV(4); G8_BAR;
  G8_STAGE_(G8_SB(1, 0), cB + kstepB, voffB); G8_STAGE_(G8_SA(1, 0), cA + kstepA, voffA); G8_STAGE_(G8_SB(1, 1), cB + hstep + kstepB, voffB);
  WAITV(6); G8_BAR;
  for (;;) {
    const bool has_next = g8_next(ui + 1, nM, nN, Gg, cc, nxt);
    const char* nA = has_next ? (const char*)A + (size_t)nxt.pm * tstep : cA; const char* nB = has_next ? (const char*)Bt + (size_t)nxt.pn * tstep : cB;
    for (int t = 0; t < nt; t += 2) {
      const bool last = (t == nt - 2);
      const char* a1 = cA + (size_t)(t + 1) * kstepA;
      const char* a2 = last ? nA : cA + (size_t)(t + 2) * kstepA; const char* b2 = last ? nB : cB + (size_t)(t + 2) * kstepB;
      const char* a3 = a2 + kstepA; const char* b3 = b2 + kstepB;
      G8_LDB(B0, 0, 0); G8_SCHED; G8_LDA(At, 0, 0); G8_STAGE_(G8_SA(1, 1), a1 + hstep, voffA);
      G8_WAIT_L(8); G8_BAR; G8_WAIT_L(0); G8_MMA(0, 0, At, B0); G8_BAR; G8_SCHED;
      G8_LDB(B1, 0, 1); G8_STAGE_(G8_SB(0, 0), b2, voffB);
      G8_BAR; G8_WAIT_L(0); G8_MMA(0, 1, At, B1); G8_BAR;
      G8_LDA(At, 0, 1); G8_STAGE_(G8_SA(0, 0), a2, voffA);
      G8_BAR; G8_WAIT_L(0); G8_MMA(1, 0, At, B0); G8_BAR; G8_SCHED;
      G8_STAGE_(G8_SB(0, 1), b2 + hstep, voffB);
      WAITV(6); G8_BAR; G8_MMA(1, 1, At, B1); G8_BAR;
      G8_LDB(B0, 1, 0); G8_SCHED; G8_LDA(At, 1, 0); G8_STAGE_(G8_SA(0, 1), a2 + hstep, voffA);
      G8_WAIT_L(8); G8_BAR; G8_WAIT_L(0); G8_MMA(0, 0, At, B0); G8_BAR; G8_SCHED;
      G8_LDB(B1, 1, 1); G8_STAGE_(G8_SB(1, 0), b3, voffB);
      G8_BAR; G8_WAIT_L(0); G8_MMA(0, 1, At, B1); G8_BAR;
      G8_LDA(At, 1, 1); G8_STAGE_(G8_SA(1, 0), a3, voffA);
      G8_BAR; G8_WAIT_L(0); G8_MMA(1, 0, At, B0); G8_BAR; G8_SCHED;
      G8_STAGE_(G8_SB(1, 1), b3 + hstep, voffB);
      WAITV(6); G8_BAR; G8_MMA(1, 1, At, B1); G8_BAR;
    }
#pragma unroll 1
    for (int e_ = 0; e_ < REP_EPI; e_++)
    E(acc, cur, wr, wc, fr, fq, e_ > 0);
    if (!has_next) break;
#pragma unroll
    for (int a = 0; a < 2; ++a)
#pragma unroll
      for (int b = 0; b < 2; ++b)
#pragma unroll
        for (int m = 0; m < 4; ++m)
#pragma unroll
          for (int n = 0; n < 2; ++n) acc[a][b][m][n] = (f32x4){0.f, 0.f, 0.f, 0.f};
    cur = nxt; cA = nA; cB = nB; ++ui;
  }
  WAITV(0);
  if (wr == 0) G8_BAR;
  G8_BAR;
#undef G8_SA
#undef G8_SB
#undef G8_STAGE_
#undef G8_LDA
#undef G8_LDB
#undef G8_MMA
#undef G8_WAIT_L
#undef G8_BAR
#undef G8_SCHED
}

DEVFN float fq_sum(float v) {
  auto a = __builtin_amdgcn_permlane16_swap(__float_as_uint(v), __float_as_uint(v), false, false); v = __uint_as_float(a[0]) + __uint_as_float(a[1]);
  auto b = __builtin_amdgcn_permlane32_swap(__float_as_uint(v), __float_as_uint(v), false, false); return __uint_as_float(b[0]) + __uint_as_float(b[1]);
}
struct InprojEpi {
  const Params& p; int l; bool dry; LAS unsigned char* scratch;
  DEVFN void operator()(const f32x4 (&acc)[2][2][4][2], const G8Unit& u_, int wr, int wc, int fr_, int fq_, bool dry2) const {
    int fr = fr_, fq = fq_; G8Unit u = u_;
    asm volatile("" : "+v"(fr), "+v"(fq), "+s"(u.pm), "+s"(u.pn));
    const int lane = fr + 16 * fq;
    const int i = l >> 1; const bool odd = l & 1;
    const int G = 4 * u.pn + wc;
    LAS unsigned char* tbase = scratch + (wr * 4 + wc) * 3072;
    const int m0 = u.pm * 256; const bool smp = m0 >= MP;
    enum { T_PAD, T_GATE, T_QHEAD, T_KHEAD, T_VT, T_QA, T_CKV, T_KPE };
    int ty = T_PAD, gcol = 0, head = 0, spitch = 0, scol = 0; bool rope = false; float oscale = 1.f;
    const float* gain = nullptr; float* state = nullptr; h16* qdst = nullptr; h16* kbuf = nullptr; h16* vbuf = nullptr;
    const float QS = LOG2E / 8.f;
    if (!odd) {
      if (G < 4) ty = T_QA;
      else if (G < 6) ty = T_CKV;
      else if (G == 6) { ty = T_KPE; gain = p.mla_kn_rope + i * 32; }
      else if (G == 7) ty = T_PAD;
      else if (G < 16) { ty = T_GATE; gcol = (G - 8) * 64; }
      else if (G < 24) { ty = T_QHEAD; head = G - 16; gain = p.diff_qn + i * 64; rope = true; oscale = QS; qdst = p.QB; }
      else if (G < 32) { ty = T_KHEAD; head = G - 24; gain = p.diff_kn + i * 64; rope = true; state = p.o_dk; spitch = 512; scol = head * 64; kbuf = p.KB; }
      else if (G < 40) { ty = T_VT; head = G - 32; state = p.o_dv; spitch = 512; scol = head * 64; vbuf = p.VB; }
      else { ty = T_GATE; gcol = 512 + (G - 40) * 64; }
    } else {
      if (G < 8) { ty = T_QHEAD; head = G; gain = p.na_qn + i * 64; oscale = QS; qdst = p.QA; }
      else if (G < 16) { ty = T_KHEAD; head = G - 8; gain = p.na_kn + i * 64; state = p.o_nk; spitch = 512; scol = head * 64; kbuf = p.KA; }
      else if (G < 24) { ty = T_VT; head = G - 16; state = p.o_nv; spitch = 512; scol = head * 64; vbuf = p.VA; }
      else if (G < 32) { ty = T_GATE; gcol = (G - 24) * 64; }
      else if (G < 40) { ty = T_QHEAD; head = G - 32; gain = p.gqa_qn + i * 64; rope = true; oscale = QS; qdst = p.QB; }
      else if (G < 42) { ty = T_KHEAD; head = G - 40; gain = p.gqa_kn + i * 64; rope = true; state = p.o_gk; spitch = 128; scol = head * 64; kbuf = p.KB; }
      else if (G < 44) { ty = T_VT; head = G - 42; state = p.o_gv; spitch = 128; scol = head * 64; vbuf = p.VB; }
      else { ty = T_GATE; gcol = 512 + (G - 44) * 64; }
    }
    if (ty == T_PAD) return;
    LAS float* cst = (LAS float*)(tbase + 2048);
    {
      const float* rowss = p.rowss_l + (size_t)l * M + m0 + 64 * wr;
      const float s0 = rowss[lane], s1 = rowss[128 + lane];
      const float bv = p.biasv[((size_t)l * NCV + tok_cv(m0)) * NPO + 256 * u.pn + 32 * wc + 128 * (lane >> 5) + (lane & 31)];
      const bool hasg = gain != nullptr && (ty != T_KPE || lane < 32);
      const float gv = hasg ? gain[lane] : 1.f;
      cst[lane] = frsq(s0 * (1.f / D) + EPSN); cst[64 + lane] = frsq(s1 * (1.f / D) + EPSN);
      cst[128 + lane] = bv; cst[192 + lane] = gv;
    }
    const bool roped = rope && smp;
    float invf[2][4];
    if (roped || (ty == T_KPE && smp)) {
      const float step = ty == T_KPE ? (2.f / 16.f) : (2.f / 32.f);
#pragma unroll
      for (int n = 0; n < 2; n++)
#pragma unroll
        for (int j = 0; j < 4; j++) {
          const int jj = ty == T_KPE ? (8 * (fq & 1) + 4 * n + j) & 7 : (8 * fq + 4 * n + j) & 15;
          invf[n][j] = __builtin_amdgcn_exp2f(-13.287712379549449f * step * (float)jj) * 0.15915494309189535f;
        }
    }
#pragma unroll
    for (int ai = 0; ai < 2; ai++)
#pragma unroll
      for (int m = 0; m < 4; m++) {
        const int r = m0 + 128 * ai + 64 * wr + 16 * m + fr;
        const float rs = cst[ai * 64 + m * 16 + fr];
        float v[2][2][4];
#pragma unroll
        for (int bj = 0; bj < 2; bj++)
#pragma unroll
          for (int n = 0; n < 2; n++) {
            const f32x4 b = *(const LAS f32x4*)(cst + 128 + 32 * bj + 8 * fq + 4 * n);
#pragma unroll
            for (int j = 0; j < 4; j++) v[bj][n][j] = acc[ai][bj][m][n][j] * rs + b[j];
          }
        float c2[2][4], s2[2][4];
        if (roped) {
          const int t = tok_pos(r); const float base = (float)(fq < 2 ? (t >> 6) : (t & 63));
#pragma unroll
          for (int n = 0; n < 2; n++)
#pragma unroll
            for (int j = 0; j < 4; j++) { const float x = base * invf[n][j]; c2[n][j] = __builtin_amdgcn_cosf(x); s2[n][j] = __builtin_amdgcn_sinf(x); }
        }
        if (ty == T_GATE) {
#pragma unroll
          for (int bj = 0; bj < 2; bj++) {
            h16x8 o;
#pragma unroll
            for (int n = 0; n < 2; n++)
#pragma unroll
              for (int j = 0; j < 4; j++) o[n * 4 + j] = (h16)fsilu(v[bj][n][j]);
            *(h16x8*)(p.gates16 + (size_t)r * 1024 + gcol + 32 * bj + 8 * fq) = o;
          }
        } else if (ty == T_QHEAD || ty == T_KHEAD) {
          float ss = 0;
#pragma unroll
          for (int bj = 0; bj < 2; bj++)
#pragma unroll
            for (int n = 0; n < 2; n++)
#pragma unroll
              for (int j = 0; j < 4; j++) ss += v[bj][n][j] * v[bj][n][j];
          ss = fq_sum(ss);
          const float rr = frsq(ss * (1.f / 64.f) + EPSN);
#pragma unroll
          for (int bj = 0; bj < 2; bj++)
#pragma unroll
            for (int n = 0; n < 2; n++) {
              const f32x4 g = *(const LAS f32x4*)(cst + 192 + 32 * bj + 8 * fq + 4 * n);
#pragma unroll
              for (int j = 0; j < 4; j++) v[bj][n][j] *= rr * g[j];
            }
          if (state && !smp) {
            float* sp = state + st_row(r, i) * spitch + scol + 8 * fq;
#pragma unroll
            for (int bj = 0; bj < 2; bj++)
#pragma unroll
              for (int n = 0; n < 2; n++) { f32x4 o = {v[bj][n][0], v[bj][n][1], v[bj][n][2], v[bj][n][3]}; *(f32x4*)(sp + 32 * bj + 4 * n) = o; }
          }
          if (roped) {
#pragma unroll
            for (int n = 0; n < 2; n++)
#pragma unroll
              for (int j = 0; j < 4; j++) { const float x1 = v[0][n][j], x2 = v[1][n][j]; v[0][n][j] = x1 * c2[n][j] - x2 * s2[n][j]; v[1][n][j] = x2 * c2[n][j] + x1 * s2[n][j]; }
          }
          h16* dst = ty == T_QHEAD ? qdst + ((size_t)r * 8 + head) * 64 : kbuf + ((size_t)head * KM + tok_keyrow(r)) * 64;
#pragma unroll
          for (int bj = 0; bj < 2; bj++) {
            h16x8 o;
#pragma unroll
            for (int n = 0; n < 2; n++)
#pragma unroll
              for (int j = 0; j < 4; j++) o[n * 4 + j] = (h16)(v[bj][n][j] * oscale);
            *(h16x8*)(dst + 32 * bj + 8 * fq) = o;
          }
        } else if (ty == T_VT) {
          const int kr = tok_keyrow(r);
          if (!smp) {
            float* sp = state + st_row(r, i) * spitch + scol + 8 * fq;
#pragma unroll
            for (int bj = 0; bj < 2; bj++)
#pragma unroll
              for (int n = 0; n < 2; n++) { f32x4 o = {v[bj][n][0], v[bj][n][1], v[bj][n][2], v[bj][n][3]}; *(f32x4*)(sp + 32 * bj + 4 * n) = o; }
          }
          {
            LAS h16* tb = (LAS h16*)(tbase);
#pragma unroll
            for (int bj = 0; bj < 2; bj++)
#pragma unroll
              for (int n = 0; n < 2; n++)
#pragma unroll
                for (int j = 0; j < 4; j++) tb[(32 * bj + 8 * fq + 4 * n + j) * 16 + fr] = (h16)v[bj][n][j];
            const h16x8 lo = *(const LAS h16x8*)(tb + lane * 16), hi = *(const LAS h16x8*)(tb + lane * 16 + 8);
            h16* dstv = vbuf + vidx(head * 64 + lane, kr - fr);
            *(h16x8*)dstv = lo; *(h16x8*)(dstv + 8) = hi;
          }
        } else if (ty == T_QA) {
          float ss = 0;
#pragma unroll
          for (int bj = 0; bj < 2; bj++) {
            h16x8 o;
#pragma unroll
            for (int n = 0; n < 2; n++)
#pragma unroll
              for (int j = 0; j < 4; j++) { o[n * 4 + j] = (h16)v[bj][n][j]; const float xr = (float)o[n * 4 + j]; ss += xr * xr; }
            *(h16x8*)(p.qa16 + pidx(M, r, 64 * G + 32 * bj + 8 * fq)) = o;
          }
          ss = fq_sum(ss);
          if (fq == 0 && !dry && !dry2) atomicAdd(p.rowss_qa + (size_t)i * M + r, ss);
        } else if (ty == T_CKV) {
          const int kr = tok_keyrow(r);
          float ss = 0;
#pragma unroll
          for (int bj = 0; bj < 2; bj++) {
            h16x8 o;
#pragma unroll
            for (int n = 0; n < 2; n++)
#pragma unroll
              for (int j = 0; j < 4; j++) { o[n * 4 + j] = (h16)v[bj][n][j]; const float xr = (float)o[n * 4 + j]; ss += xr * xr; }
            *(h16x8*)(p.ckv16 + pidx(KM, kr, 64 * (G - 4) + 32 * bj + 8 * fq)) = o;
          }
          ss = fq_sum(ss);
          if (fq == 0 && !dry && !dry2) atomicAdd(p.rowss_ckv + (size_t)i * KM + kr, ss);
        } else {
          float ss = 0;
#pragma unroll
          for (int n = 0; n < 2; n++)
#pragma unroll
            for (int j = 0; j < 4; j++) ss += v[0][n][j] * v[0][n][j];
          ss = fq_sum(ss);
          const float rr = frsq(ss * (1.f / 32.f) + EPSN);
          float w[2][4];
#pragma unroll
          for (int n = 0; n < 2; n++) {
            const f32x4 g = *(const LAS f32x4*)(cst + 192 + 8 * fq + 4 * n);
#pragma unroll
            for (int j = 0; j < 4; j++) w[n][j] = v[0][n][j] * rr * g[j];
          }
          if (!smp) {
            float* sp = p.o_kpe + st_row(r, i) * 32 + 8 * fq;
#pragma unroll
            for (int n = 0; n < 2; n++) { f32x4 o = {w[n][0], w[n][1], w[n][2], w[n][3]}; *(f32x4*)(sp + 4 * n) = o; }
          } else {
            const int t = tok_pos(r); const float base = (float)((fq & 1) == 0 ? (t >> 6) : (t & 63));
#pragma unroll
            for (int n = 0; n < 2; n++)
#pragma unroll
              for (int j = 0; j < 4; j++) {
                const float x = base * invf[n][j]; const float c = __builtin_amdgcn_cosf(x), s = __builtin_amdgcn_sinf(x);
                const float own = w[n][j], oth = __shfl_xor(own, 32);
                w[n][j] = fq < 2 ? own * c - oth * s : own * c + oth * s;
              }
          }
          h16x8 o;
#pragma unroll
          for (int n = 0; n < 2; n++)
#pragma unroll
            for (int j = 0; j < 4; j++) o[n * 4 + j] = (h16)w[n][j];
          *(h16x8*)(p.kpe16 + (size_t)tok_keyrow(r) * 32 + 8 * fq) = o;
        }
      }
  }
};
struct NullEpi {
  DEVFN void operator()(const f32x4 (&acc)[2][2][4][2], const G8Unit&, int, int, int, int, bool) const {
#pragma unroll
    for (int a = 0; a < 2; a++)
#pragma unroll
      for (int b = 0; b < 2; b++)
#pragma unroll
        for (int m = 0; m < 4; m++) asm volatile("" :: "v"(acc[a][b][m][0]), "v"(acc[a][b][m][1]));
  }
};
DEVFN int inproj_pos_col(int np) { const int pn = np >> 8, bj = (np >> 7) & 1, wc = (np >> 5) & 3, g = np & 31; return 64 * (4 * pn + wc) + 32 * bj + g; }

#define XB_TMO      128
#define XB_XCNT(j)  (256  + 64 * (j))
#define XB_XSUB(j)  (1280 + 64 * (j))
#define XB_XGEN(j)  (2304 + 64 * (j))
#define XB_TOP      3328
#define XB_TOPGEN   3392
#define XCD_BAR_WORDS 3456
#define XB_SPIN_CAP (1u << 20)
DEVFN unsigned xb_ld(unsigned* p) { return __hip_atomic_load(p, __ATOMIC_RELAXED, __HIP_MEMORY_SCOPE_AGENT); }
DEVFN unsigned xb_add(unsigned* p, unsigned v) { return __hip_atomic_fetch_add(p, v, __ATOMIC_RELAXED, __HIP_MEMORY_SCOPE_AGENT); }
DEVFN unsigned xb_xcc_id() { return (unsigned)__builtin_amdgcn_s_getreg((3 << 11) | 20) & 0xFu; }
#define XB_SPIN(cond, bar) do { unsigned _sp = 0; while (cond) { __builtin_amdgcn_s_sleep(1); \
    if ((++_sp & 255u) == 0u) { if (xb_ld(&(bar)[XB_TMO])) break; if (_sp > XB_SPIN_CAP) { atomicAdd(&(bar)[XB_TMO], 1u); break; } } } } while (0)
struct XcdBarrier { unsigned* bar; unsigned x; volatile LAS unsigned* st; };
DEVFN XcdBarrier xcd_barrier_post(unsigned* bar, volatile LAS unsigned* st) {
  const int TIDX = tid_op();
  XcdBarrier b; b.bar = bar; b.x = xb_xcc_id(); b.st = st;
  if (TIDX == 0) (void)xb_add(&bar[XB_XCNT(b.x)], 1u);
  return b;
}
DEVFN void xcd_barrier_complete(unsigned* bar, unsigned x, unsigned& nloc, unsigned& nx) {
  const unsigned G = gridDim.x * gridDim.y * gridDim.z;
  unsigned sum, cnt, mine, sp = 0u;
  for (;;) {
    sum = 0u; cnt = 0u; mine = 0u;
#pragma unroll
    for (unsigned j = 0; j < 16; ++j) { const unsigned c = xb_ld(&bar[XB_XCNT(j)]); sum += c; cnt += (c > 0u) ? 1u : 0u; mine = (j == x) ? c : mine; }
    if (sum == G) break;
    __builtin_amdgcn_s_sleep(1);
    if ((++sp & 255u) == 0u) { if (xb_ld(&bar[XB_TMO])) break; if (sp > XB_SPIN_CAP) { atomicAdd(&bar[XB_TMO], 1u); break; } }
  }
  nloc = mine > 0u ? mine : 1u; nx = cnt > 0u ? cnt : 1u;
}
DEVFN void xcd_barrier(const XcdBarrier& b) {
  const int TIDX = tid_op();
  asm volatile("s_waitcnt vmcnt(0)" ::: "memory");
  __syncthreads();
  if (TIDX == 0) {
    unsigned* bar = b.bar;
    __builtin_amdgcn_s_waitcnt(0);
    unsigned nloc = b.st[0], nx = b.st[1];
    if (nloc == 0u) { xcd_barrier_complete(bar, b.x, nloc, nx); b.st[0] = nloc; b.st[1] = nx; }
    const unsigned old = xb_add(&bar[XB_XSUB(b.x)], 1u);
    const unsigned gen = old / nloc;
    if (old + 1u == (gen + 1u) * nloc) {
      __builtin_amdgcn_fence(__ATOMIC_RELEASE, "agent");
      asm volatile("s_waitcnt vmcnt(0)" ::: "memory");
      const unsigned og = xb_add(&bar[XB_TOP], 1u);
      const unsigned tg = og / nx;
      if (og + 1u == (tg + 1u) * nx) xb_add(&bar[XB_TOPGEN], 1u);
      else XB_SPIN(xb_ld(&bar[XB_TOPGEN]) == tg, bar);
      __builtin_amdgcn_fence(__ATOMIC_ACQUIRE, "agent");
      xb_add(&bar[XB_XGEN(b.x)], 1u);
      asm volatile("s_waitcnt vmcnt(0)" ::: "memory");
    } else {
      XB_SPIN(xb_ld(&bar[XB_XGEN(b.x)]) == gen, bar);
      __builtin_amdgcn_fence(__ATOMIC_ACQUIRE, "agent");
      asm volatile("s_waitcnt vmcnt(0)" ::: "memory");
    }
  }
  __syncthreads();
}

DEVFN void cache_ckv_all(const Params& p, int l, int gtid, int gthreads) {
  const int i = l >> 1;
  for (int e = gtid; e < DB * PAST * 20; e += gthreads) {
    const int c8 = e % 20, pos = (e / 20) % PAST, b = e / (20 * PAST);
    const int kr = MP + b * TKS + DS + pos; const size_t crow = ((size_t)(b * 2 + i) * PAST + pos);
    h16x8 o;
    if (c8 < 16) {
      const f32x4 a0 = *(const f32x4*)(p.cache_mla_ckv + crow * 128 + c8 * 8), a1 = *(const f32x4*)(p.cache_mla_ckv + crow * 128 + c8 * 8 + 4);
      const f32x4 g0 = *(const f32x4*)(p.mla_kva_norm + i * 128 + c8 * 8), g1 = *(const f32x4*)(p.mla_kva_norm + i * 128 + c8 * 8 + 4);
#pragma unroll
      for (int j = 0; j < 4; j++) { o[j] = (h16)(a0[j] * __builtin_amdgcn_rcpf(g0[j])); o[4 + j] = (h16)(a1[j] * __builtin_amdgcn_rcpf(g1[j])); }
      *(h16x8*)(p.ckv16 + pidx(KM, kr, c8 * 8)) = o;
      if (c8 == 0) p.rowss_ckv[(size_t)i * KM + kr] = 128.f * (1.f - EPSN);
    } else {
      const f32x4 a0 = *(const f32x4*)(p.cache_mla_kpe + crow * 32 + (c8 - 16) * 8), a1 = *(const f32x4*)(p.cache_mla_kpe + crow * 32 + (c8 - 16) * 8 + 4);
#pragma unroll
      for (int j = 0; j < 4; j++) { o[j] = (h16)a0[j]; o[4 + j] = (h16)a1[j]; }
      *(h16x8*)(p.kpe16 + (size_t)kr * 32 + (c8 - 16) * 8) = o;
    }
  }
}
DEVFN void cache_items(const Params& p, int l, int gtid, int gthreads) {
  const int i = l >> 1;
  if ((l & 1) == 0) {
    const int per = 128 + 32 + 512 + 512;
    for (int e = gtid; e < DB * PAST * per; e += gthreads) {
      const int u = e % per; const int bp = e / per; const int pos = bp % PAST, b = bp / PAST;
      const int kr = MP + b * TKS + DS + pos; const size_t crow = ((size_t)(b * 2 + i) * PAST + pos);
      if (u < 160) { }
      else if (u < 672) { const int c = u - 160; p.KB[((size_t)(c >> 6) * KM + kr) * 64 + (c & 63)] = (h16)p.cache_diff_k[crow * 512 + c]; }
      else { const int c = u - 672; p.VB[vidx(c, kr)] = (h16)p.cache_diff_v[crow * 512 + c]; }
    }
  } else {
    const int per = 512 + 512 + 128 + 128;
    for (int e = gtid; e < DB * PAST * per; e += gthreads) {
      const int u = e % per; const int bp = e / per; const int pos = bp % PAST, b = bp / PAST;
      const int kr = MP + b * TKS + DS + pos; const size_t crow = ((size_t)(b * 2 + i) * PAST + pos);
      if (u < 512) p.KA[((size_t)(u >> 6) * KM + kr) * 64 + (u & 63)] = (h16)p.cache_na_k[crow * 512 + u];
      else if (u < 1024) { const int c = u - 512; p.VA[vidx(c, kr)] = (h16)p.cache_na_v[crow * 512 + c]; }
      else if (u < 1152) { const int c = u - 1024; p.KB[((size_t)(c >> 6) * KM + kr) * 64 + (c & 63)] = (h16)p.cache_gqa_k[crow * 128 + c]; }
      else { const int c = u - 1152; p.VB[vidx(c, kr)] = (h16)p.cache_gqa_v[crow * 128 + c]; }
    }
  }
}

DEVFN void mod_item(const Params& p, int item, char* lds, bool dry = false) {
  const int tid = tid_op();
  const int l = item / 192, rem = item % 192, nchunk = rem / 32, kc = rem % 32;
  float* sil = (float*)lds;
  if (tid < NCV * 32) { const int cv = tid >> 5, k = tid & 31; const float* cvec = cv == 0 ? p.c_ctx : p.c + (size_t)(cv - 1) * D; sil[tid] = siluf(cvec[kc * 32 + k]); }
  const int col = nchunk * 512 + tid;
  const float* w = p.w_mod + ((size_t)l * D + kc * 32) * 3072 + col;
  float wv[32];
#pragma unroll
  for (int k = 0; k < 32; k++) wv[k] = w[(size_t)k * 3072];
  __syncthreads();
  float acc[NCV];
#pragma unroll
  for (int c = 0; c < NCV; c++) acc[c] = 0.f;
#pragma unroll
  for (int k = 0; k < 32; k++) {
#pragma unroll
    for (int c = 0; c < NCV; c++) acc[c] += sil[c * 32 + k] * wv[k];
  }
  const float b = kc == 0 ? p.b_mod[l * 3072 + col] : 0.f;
#pragma unroll
  for (int c = 0; c < NCV; c++) if (!dry) atomicAdd(p.modv + ((size_t)l * NCV + c) * 3072 + col, acc[c] + b);
  __syncthreads();
}
struct ConvDesc { const float* src; h16* dst; const float* kscale; int R, Nsrc, mode, nb, kb; bool has_scale; };
constexpr int CV_WIN_E = (NPE / 64) * 16, CV_WIN_O = (NPO / 64) * 16, CV_WOUT = 256, CV_WQB = 64, CV_WKVB = 32;
constexpr int CV_PER_PAIR = CV_WIN_E + CV_WIN_O + 2 * CV_WOUT + CV_WQB + CV_WKVB;
constexpr int CV_TOTAL = 2 * CV_PER_PAIR;
DEVFN ConvDesc conv_desc(const Params& p, int item) {
  const int i = item / CV_PER_PAIR; int r = item % CV_PER_PAIR;
  ConvDesc d; d.kscale = p.norm_w; d.has_scale = false;
  if (r < CV_WIN_E) { d.src = p.w_in_even + (size_t)i * D * EVEN_IN; d.dst = p.win16 + (size_t)(2 * i) * NPO * D; d.R = NPO; d.Nsrc = EVEN_IN; d.mode = 4; d.nb = (r % (NPE / 64)) * 64; d.kb = (r / (NPE / 64)) * 64; return d; }
  r -= CV_WIN_E;
  if (r < CV_WIN_O) { d.src = p.w_in_odd + (size_t)i * D * ODD_IN; d.dst = p.win16 + (size_t)(2 * i + 1) * NPO * D; d.R = NPO; d.Nsrc = ODD_IN; d.mode = 5; d.nb = (r % (NPO / 64)) * 64; d.kb = (r / (NPO / 64)) * 64; return d; }
  r -= CV_WIN_O;
  if (r < CV_WOUT) { d.src = p.w_out_even + (size_t)i * D * D; d.dst = p.wout16 + (size_t)(2 * i) * D * D; d.R = 1024; d.Nsrc = D; d.mode = 0; d.nb = (r % 16) * 64; d.kb = (r / 16) * 64; return d; }
  r -= CV_WOUT;
  if (r < CV_WOUT) { d.src = p.w_out_odd + (size_t)i * D * D; d.dst = p.wout16 + (size_t)(2 * i + 1) * D * D; d.R = 1024; d.Nsrc = D; d.mode = 0; d.nb = (r % 16) * 64; d.kb = (r / 16) * 64; return d; }
  r -= CV_WOUT;
  if (r < CV_WQB) { d.src = p.mla_wqb + (size_t)i * 256 * 768; d.dst = p.wqb16 + (size_t)i * 1024 * 256; d.R = 1024; d.Nsrc = 768; d.mode = 2; d.kscale = p.mla_qa_norm + i * 256; d.has_scale = true; d.nb = (r % 16) * 64; d.kb = (r / 16) * 64; return d; }
  r -= CV_WQB;
  d.src = p.mla_wkvb + (size_t)i * 128 * 1024; d.dst = p.wkvb16 + (size_t)i * 1024 * 128; d.R = 1024; d.Nsrc = 1024; d.mode = 3; d.kscale = p.mla_kva_norm + i * 128; d.has_scale = true; d.nb = (r % 16) * 64; d.kb = (r / 16) * 64; return d;
}
DEVFN void conv_batch4(const Params& p, int it0, int stride, int limit, char* lds) {
  const int tid = tid_op();
  const int j = tid & 63, k0 = tid >> 6;
  ConvDesc d[4]; float v[4][8]; float msk[4]; bool ok[4];
#pragma unroll
  for (int b = 0; b < 4; b++) {
    const int item = it0 + b * stride; ok[b] = item < limit;
    d[b] = conv_desc(p, ok[b] ? item : it0);
    const int np = d[b].nb + j; int col; const int mode = d[b].mode;
    if (mode == 0) col = np; else if (mode == 4) col = even_col(inproj_pos_col(np)); else if (mode == 5) col = inproj_pos_col(np); else if (mode == 3) { int hh = (np & 511) >> 6; col = hh * 128 + (np >> 9) * 64 + (np & 63); } else { int h = np >> 7, jj = np & 127; col = jj < 96 ? h * 96 + jj : -1; }
    const int colc = col < 0 ? 0 : col; msk[b] = col < 0 ? 0.f : 1.f;
    if (ok[b]) {
#pragma unroll
      for (int i = 0; i < 8; i++) v[b][i] = d[b].src[(size_t)(d[b].kb + k0 + 8 * i) * d[b].Nsrc + colc];
    }
  }
#pragma unroll
  for (int b = 0; b < 4; b++) {
    if (ok[b]) {
      float (*t)[65] = (float (*)[65])(lds + b * 16640);
      if (d[b].has_scale) {
#pragma unroll
        for (int i = 0; i < 8; i++) v[b][i] *= d[b].kscale[d[b].kb + k0 + 8 * i];
      }
#pragma unroll
      for (int i = 0; i < 8; i++) t[k0 + 8 * i][j] = v[b][i] * msk[b];
    }
  }
  __syncthreads();
#pragma unroll
  for (int b = 0; b < 4; b++) {
    if (ok[b]) {
      float (*t)[65] = (float (*)[65])(lds + b * 16640);
#pragma unroll
      for (int i = 0; i < 8; i++) { const int jj = k0 + 8 * i; d[b].dst[pidx(d[b].R, d[b].nb + jj, d[b].kb + j)] = (h16)t[j][jj]; }
    }
  }
  __syncthreads();
}
DEVFN void tab_items(const Params& p, int gtid, int gthreads) {
  for (int g = gtid; g < DS * 48; g += gthreads) {
    if (g < 2) {
      const int i = g, l = 2 * i; float s1 = 0, s2 = 0;
      for (int k = 0; k < 64; k++) { s1 += p.diff_lq1[i * 64 + k] * p.diff_lk1[i * 64 + k]; s2 += p.diff_lq2[i * 64 + k] * p.diff_lk2[i * 64 + k]; }
      p.lamv[i] = expf(s1) - expf(s2) + (0.8f - 0.6f * expf(-0.3f * l));
    }
    const int t = g / 48, j = g % 48;
    const float row = (float)(t / GW), col = (float)(t % GW);
    if (j < 32) { const int f = j & 15; const float inv = powf(10000.f, -(float)(2 * f) / 32.f); const float ang = (j < 16 ? row : col) * inv; p.ropeC64[t * 32 + j] = cosf(ang); p.ropeS64[t * 32 + j] = sinf(ang); }
    else { const int jj = j - 32; const int f = jj & 7; const float inv = powf(10000.f, -(float)(2 * f) / 16.f); const float ang = (jj < 8 ? row : col) * inv; p.ropeC32[t * 16 + jj] = cosf(ang); p.ropeS32[t * 16 + jj] = sinf(ang); }
  }
}
DEVFN void bias_row(const Params& p, int l, int np, int lane) {
  const h16* w = p.win16 + (size_t)l * NPO * D;
  float a[NCV];
#pragma unroll
  for (int c = 0; c < NCV; c++) a[c] = 0;
#pragma unroll
  for (int i = 0; i < 2; i++) {
    const int k = (i * 64 + lane) * 8; h16x8 wv = *(const h16x8*)(w + pidx(NPO, np, k));
#pragma unroll
    for (int c = 0; c < NCV; c++) { const float* sh = p.modv + ((size_t)l * NCV + c) * 3072 + k;
#pragma unroll
      for (int e = 0; e < 8; e++) a[c] += sh[e] * (float)wv[e]; }
  }
#pragma unroll
  for (int c = 0; c < NCV; c++) { float v = a[c]; for (int o = 32; o; o >>= 1) v += __shfl_xor(v, o); if (lane == 0) p.biasv[((size_t)l * NCV + c) * NPO + np] = v; }
}
DEVFN void prepx_row(const Params& p, int l, int m, int lane) {
  const float* x = xrow(p, l, m); const float* md = p.modv + ((size_t)l * NCV + tok_cv(m)) * 3072 + 1024; const float* nw = p.norm_w + l * D;
  float ss = 0;
#pragma unroll
  for (int i = 0; i < 4; i++) {
    const int k = (i * 64 + lane) * 4;
    f32x4 v = *(const f32x4*)(x + k); f32x4 s = *(const f32x4*)(md + k); f32x4 w = *(const f32x4*)(nw + k);
    h16x4 o;
#pragma unroll
    for (int e = 0; e < 4; e++) { ss += v[e] * v[e]; o[e] = (h16)(v[e] * w[e] * (1.f + s[e])); }
    *(h16x4*)(p.xs16 + pidx(M, m, k)) = o;
  }
  for (int o = 32; o; o >>= 1) ss += __shfl_xor(ss, o);
  if (lane == 0) p.rowss_l[(size_t)l * M + m] = ss;
}
#define AS4 __attribute__((address_space(4)))
#define PHASE_PARAMS(q) const Params& q = p_unused;
__global__ void __launch_bounds__(512) mega_kernel(Params p_unused) {
  __shared__ __attribute__((aligned(16))) char lds[G_LDS2 + 16];
  if (threadIdx.x == 0) { volatile LAS unsigned* st = (volatile LAS unsigned*)(lds + G_LDS2); st[0] = 0u; st[1] = 0u; st[2] = 0u; st[3] = 0u; }
  __syncthreads();
  XcdBarrier bar;
  { PHASE_PARAMS(p); bar = xcd_barrier_post(p.bar, (volatile LAS unsigned*)(lds + G_LDS2)); }
  const int nb = gridDim.x, bid = blockIdx.x;
  LAS unsigned char* ldsa = (LAS unsigned char*)lds;
  { PHASE_PARAMS(p);
    for (int rep = 0; rep < REP_0A; rep++)
    {
#pragma unroll 1
      for (int it = bid; it < 768; it += nb) mod_item(p, it, lds, rep > 0);
#pragma unroll 1
      for (int it = bid; it < CV_PER_PAIR; it += 4 * nb) conv_batch4(p, it, nb, CV_PER_PAIR, lds);
    }
    tab_items(p, bid * 512 + tid_op(), nb * 512); }
  xcd_barrier(bar);
  { PHASE_PARAMS(p);
    const int tid = tid_op(); const int lane = tid & 63, gw = bid * 8 + (tid >> 6), nw = nb * 8;
    for (int rep = 0; rep < REP_0B; rep++)
    for (int r = gw; r < (NPE + NPO) + M; r += nw) {
      if (r < NPE + NPO) bias_row(p, r < NPE ? 0 : 1, r < NPE ? r : r - NPE, lane);
      else prepx_row(p, 0, r - (NPE + NPO), lane);
    }
    cache_ckv_all(p, 0, bid * 512 + tid, nb * 512); }
  xcd_barrier(bar);
#pragma unroll 1
  for (int l = 0; l < 4; l++) {
    { PHASE_PARAMS(p);
#pragma unroll 1
      for (int rep = 1; rep < REP_GK; rep++) { NullEpi ne; gemm8_phase(ldsa, p.xs16, M, p.win16 + (size_t)l * NPO * D, NPO, D, M / 256, ((l & 1) ? NPO : NPE) / 256, ne); }
#pragma unroll 1
      for (int rep = 0; rep < REP_A; rep++) {
        InprojEpi epi{p, l, rep > 0, ldsa + G8_STAGE};
        gemm8_phase(ldsa, p.xs16, M, p.win16 + (size_t)l * NPO * D, NPO, D, M / 256, ((l & 1) ? NPO : NPE) / 256, epi);
      }
      for (int rep = 0; rep < REP_0B; rep++) cache_items(p, l, bid * 512 + tid_op(), nb * 512);
      if (l == 1) cache_ckv_all(p, 2, bid * 512 + tid_op(), nb * 512);
      if ((l & 1) == 0) {
        const int k = nb >= 16 ? bid - (nb - 16) : bid;
        if (k >= 0) {
#pragma unroll 1
          for (int kk = k; kk < 16; kk += (nb >= 16 ? 16 : nb)) kvgemm_tile(p, l, (MP + (kk >> 3) * TKS + DS) / 256, kk & 7, lds);
        }
      }
      if (l < 2) {
        const int nun = (M / 256) * (((l & 1) ? NPO : NPE) / 256); const int fi = nun - nb;
        const bool part = fi > 0 && fi < nb;
        const int nshare = (part && nb - fi > 32) ? nb - fi - 16 : (part ? nb - fi : nb);
        const int start = part ? bid - fi : bid, stride = nshare;
        if (start >= 0 && start < nshare) {
          if (l == 0) {
#pragma unroll 1
            for (int it = CV_PER_PAIR + start; it < CV_TOTAL; it += 4 * stride) conv_batch4(p, it, stride, CV_TOTAL, lds);
          } else {
            const int tid = tid_op(); const int lane = tid & 63;
#pragma unroll 1
            for (int r = start * 8 + (tid >> 6); r < NPE + NPO; r += stride * 8) bias_row(p, r < NPE ? 2 : 3, r < NPE ? r : r - NPE, lane);
          }
        }
      }
    }
    xcd_barrier(bar);
    if ((l & 1) == 0) {
      PHASE_PARAMS(p);
      constexpr int NKVP = KM / 256 - DB;
      const int nq = (M / 256) * 8, nkv = NKVP * 8;
      for (int rep = 0; rep < REP_A2; rep++)
      for (int t = bid; t < nq + nkv; t += nb) {
        if (t < nq) qgemm_tile(p, l, t % 32, t / 32, lds);
        else { const int u = t - nq; int q = u % NKVP; constexpr int CP0 = (MP + DS) / 256; q = q < CP0 ? q : (DB > 1 && q >= CP0 + DS / 256 ? q + 2 : q + 1);
          kvgemm_tile(p, l, q, u / NKVP, lds); }
      }
      { const float* rck = p.rowss_ckv + (size_t)(l >> 1) * KM; const int i = l >> 1;
        for (int e = bid * 512 + tid_op(); e < MP * 128; e += nb * 512) {
          const int m = e >> 7, j = e & 127;
          p.o_ckv[st_row(m, i) * 128 + j] = (float)p.ckv16[pidx(KM, m, j)] * (frsq(rck[m] * (1.f / 128.f) + EPSN)) * p.mla_kva_norm[i * 128 + j];
        } }
      xcd_barrier(bar);
    }
    { PHASE_PARAMS(p);
      for (int rep = 0; rep < REP_B; rep++)
      {
        if ((l & 1) == 0) {
#pragma unroll 1
          for (int it = bid; it < 512; it += nb) attn_even_item(p, l, it, lds);
        } else {
          const bool lpt = nb == 256;
          const int n = lpt ? (bid < 128 ? 1 : 3) : (512 - bid + nb - 1) / nb;
#pragma unroll 1
          for (int k = 0; k < n; k++) {
            const int it = !lpt ? bid + k * nb : (k == 0 ? bid : (k == 1 ? 256 + (bid - 128) : 256 + bid));
            attn_odd_item(p, l, it, lds);
          }
        }
      } }
    xcd_barrier(bar);
    { PHASE_PARAMS(p);
      for (int rep = 0; rep < REP_C; rep++)
      for (int t = bid; t < 32 * 8; t += nb) outproj_tile(p, l, t % 32, t / 32, lds, rep < REP_C - 1); }
    if (l < 3) { for (int rep = 0; rep < REP_BAR; rep++) xcd_barrier(bar); }
  }
}
#endif

static inline size_t al256(size_t x) { return (x + 255) & ~(size_t)255; }

extern "C" void kernel_launch(void* const* d_in, const int* in_sizes, int n_in, void* d_out, int out_size, void* d_ws, size_t ws_size,
                              hipStream_t stream) {
  Params p{};
  const float** ip = (const float**)&p.x_prompt;
  for (int k = 0; k < 39; k++) ip[k] = (const float*)d_in[k];
  float* o = (float*)d_out;
  p.Y = o; o += (size_t)M * 1024;
  p.o_ckv = o; o += (size_t)BATCH * 2 * SEQ * 128;
  p.o_kpe = o; o += (size_t)BATCH * 2 * SEQ * 32;
  p.o_dk = o; o += (size_t)BATCH * 2 * SEQ * 512;
  p.o_dv = o; o += (size_t)BATCH * 2 * SEQ * 512;
  p.o_nk = o; o += (size_t)BATCH * 2 * SEQ * 512;
  p.o_nv = o; o += (size_t)BATCH * 2 * SEQ * 512;
  p.o_gk = o; o += (size_t)BATCH * 2 * SEQ * 128;
  p.o_gv = o; o += (size_t)BATCH * 2 * SEQ * 128;
  char* w = (char*)d_ws; size_t off = 0;
  auto take = [&](size_t bytes) { char* r = w + off; off += al256(bytes); return r; };
  char* zero0 = w + off;
  p.bar = (unsigned*)take(16384);
  p.modv = (float*)take((size_t)4 * NCV * 3072 * 4);
  p.rowss_qa = (float*)take((size_t)2 * M * 4); p.rowss_l = (float*)take((size_t)4 * M * 4); p.rowss_ckv = (float*)take((size_t)2 * KM * 4);
  const size_t zero_bytes = (size_t)((w + off) - zero0);
  p.ropeC64 = (float*)take((size_t)DS * 32 * 4); p.ropeS64 = (float*)take((size_t)DS * 32 * 4);
  p.ropeC32 = (float*)take((size_t)DS * 16 * 4); p.ropeS32 = (float*)take((size_t)DS * 16 * 4);
  p.lamv = (float*)take(256);
  p.rstdx = (float*)take((size_t)M * 4);
  p.QA = (h16*)take((size_t)M * 8 * 96 * 2); p.QB = (h16*)take((size_t)M * 8 * 64 * 2);
  p.KA = (h16*)take((size_t)8 * KM * 128 * 2); p.KB = (h16*)take((size_t)8 * KM * 64 * 2);
  p.VA = (h16*)take((size_t)8 * 64 * KM * 2); p.VB = (h16*)take((size_t)8 * 64 * KM * 2);
  p.gates16 = (h16*)take((size_t)M * 1024 * 2); p.O16 = (h16*)take((size_t)M * 1024 * 2);
  p.ckvbuf = (float*)take((size_t)KM * 128 * 4); p.kpebuf = (float*)take((size_t)KM * 32 * 4);
  p.xs16 = (h16*)take((size_t)M * D * 2); p.x16 = (h16*)take((size_t)M * D * 2); p.qa16 = (h16*)take((size_t)M * 256 * 2); p.ckv16 = (h16*)take((size_t)KM * 128 * 2); p.kpe16 = (h16*)take((size_t)KM * 32 * 2); p.biasv = (float*)take((size_t)4 * NCV * NPO * 4);
  p.win16 = (h16*)take((size_t)4 * NPO * D * 2); p.wout16 = (h16*)take((size_t)4 * D * D * 2);
  p.wqb16 = (h16*)take((size_t)2 * 1024 * 256 * 2); p.wkvb16 = (h16*)take((size_t)2 * 1024 * 128 * 2);
  size_t ub = (size_t)M * 3328 * 2, ab = (size_t)M * 1536 * 4;
  char* big = take(ub > ab ? ub : ab);
  p.ubuf = (h16*)big; p.abuf = (float*)big;
  (void)ws_size; (void)n_in; (void)in_sizes; (void)out_size;

#ifndef CPU_EMU
  {
    (void)hipMemsetAsync(zero0, 0, zero_bytes, stream);
    static int cus = 0;
    if (!cus) { int dev = 0; (void)hipGetDevice(&dev); (void)hipDeviceGetAttribute(&cus, hipDeviceAttributeMultiprocessorCount, dev); }
    void* args[] = {&p};
    (void)hipLaunchCooperativeKernel((void*)mega_kernel, dim3(cus), dim3(512), args, 0, stream);
  }
#else
  (void)zero0; (void)zero_bytes;
  launch1d(nk_mod, (long)4 * NCV * 3072, stream, p, (long)4 * NCV * 3072);
  launch1d(nk_tab, (long)DS * 48, stream, p, (long)DS * 48);
  for (int l = 0; l < 4; l++) {
    const int N = (l & 1) ? ODD_IN : EVEN_IN;
    launch1d(nk_rstd, (long)M, stream, p, l, (long)M);
    launch1d(nk_inproj, (long)M * N, stream, p, l, (long)M * N);
    if ((l & 1) == 0) {
      launch1d(nk_epi_even, (long)M * 50, stream, p, l, 0, (long)M * 50);
      launch1d(nk_cache_even, (long)DB * PAST * 17, stream, p, l, (long)DB * PAST * 17);
      launch1d(nk_kv, (long)KM * 16, stream, p, l, (long)KM * 16);
      launch1d(nk_attn_dense, (long)M * 8, stream, p, 0, 0, M, (long)M * 8);
      launch1d(nk_attn_dense, (long)M * 16, stream, p, 1, 0, M, (long)M * 16);
      launch1d(nk_fin, (long)M * 12, stream, p, l, (long)M * 12);
    } else {
      launch1d(nk_epi_odd, (long)M * 52, stream, p, l, (long)M * 52);
      launch1d(nk_cache_odd, (long)DB * PAST * 20, stream, p, l, (long)DB * PAST * 20);
      launch1d(nk_attn_dense, (long)MP * 8, stream, p, 2, 0, MP, (long)MP * 8);
      launch1d(nk_attn_na, (long)MS * 8, stream, p, l, (long)MS * 8);
      launch1d(nk_attn_dense, (long)M * 8, stream, p, 3, 0, M, (long)M * 8);
      launch1d(nk_fin, (long)M * 16, stream, p, l, (long)M * 16);
    }
    launch1d(nk_outproj, (long)M * 1024, stream, p, l, (long)M * 1024);
  }
#endif
}
```

```cpp
#ifndef CPU_EMU
#include <hip/hip_runtime.h>
#endif
#include <stdint.h>
#include <math.h>

#define FAST_INPROJ 2
#define DUAL_WRITE 0
#define FAST_A2 1
#define FAST_OUTPROJ 1
#define FAST_ATTN 1
#define MEGA 1
#define REP_0A 1
#define REP_A 1
#define REP_A2 1
#define A2_NA0 2
#define A2_NA2 3
#define REP_B 1
#define REP_C 1
#define REP_BAR 1
#define REP_GK 1
#define REP_0B 1
#define REP_EPI 1
#ifndef CFG_BATCH
#define CFG_BATCH 16
#endif
#ifndef CFG_DB
#define CFG_DB 2
#endif
#ifndef CFG_DS
#define CFG_DS 2048
#endif
constexpr int D = 1024, BATCH = CFG_BATCH, SEQ = 256, DB = CFG_DB, DS = CFG_DS, PAST = 256;
constexpr int MP = BATCH * SEQ, MS = DB * DS, M = MP + MS;
constexpr int TKS = DS + PAST;
constexpr int KM = MP + DB * TKS;
constexpr int NCV = 1 + DB;
constexpr int GW = 64, GROWS = DS / GW;
constexpr int EVEN_IN = 2976, ODD_IN = 3328;
constexpr int NPE = 3072, NPO = 3328;
constexpr float EPSN = 1e-6f;
constexpr float LOG2E = 1.4426950408889634f;

typedef _Float16 h16;

struct Params {
  const float *x_prompt, *x_sample, *cache_mla_ckv, *cache_mla_kpe, *cache_diff_k, *cache_diff_v, *cache_na_k, *cache_na_v,
      *cache_gqa_k, *cache_gqa_v, *c, *c_ctx, *norm_w, *w_mod, *b_mod, *w_in_even, *w_out_even, *mla_qa_norm, *mla_wqb,
      *mla_kva_norm, *mla_wkvb, *mla_qn_nope, *mla_qn_rope, *mla_kn_nope, *mla_kn_rope, *diff_qn, *diff_kn, *diff_lq1,
      *diff_lk1, *diff_lq2, *diff_lk2, *diff_subln, *w_in_odd, *w_out_odd, *na_qn, *na_kn, *na_rpb, *gqa_qn, *gqa_kn;
  float *Y;
  float *o_ckv, *o_kpe, *o_dk, *o_dv, *o_nk, *o_nv, *o_gk, *o_gv;
  float *modv;
  float *ropeC64, *ropeS64;
  float *ropeC32, *ropeS32;
  float *lamv;
  float *rstdx;
  h16 *ubuf;
  float *abuf;
  float *ckvbuf;
  float *kpebuf;
  h16 *QA, *QB, *KA, *KB, *VA, *VB, *gates16, *O16;
  h16 *xs16;
  float *biasv;
  h16 *win16;
  h16 *wout16;
  h16 *wqb16;
  h16 *wkvb16;
  h16 *qa16;
  float *rowss_qa;
  h16 *ckv16;
  h16 *kpe16;
  float *rowss_l;
  float *rowss_ckv;
  unsigned *bar;
  h16 *x16;
};

#ifdef CPU_EMU
#include <stdio.h>
#include <stdlib.h>
#include <string.h>
typedef void* hipStream_t;
#define KERNEL static void
#define DEVFN static inline
static thread_local long emu_gtid;
#define GTID emu_gtid
template <class... A, class... B>
static void launch1d(void (*f)(A...), long n, hipStream_t, B... a) {
#pragma omp parallel for schedule(dynamic, 64)
  for (long i = 0; i < n; i++) { emu_gtid = i; f(a...); }
}
static inline float exp2f_(float x) { return exp2f(x); }
#else
#define KERNEL __global__ void __launch_bounds__(256)
#define DEVFN __device__ __forceinline__
#define GTID ((long)blockIdx.x * 256 + threadIdx.x)
template <class... A, class... B>
static void launch1d(void (*f)(A...), long n, hipStream_t s, B... a) {
  hipLaunchKernelGGL(f, dim3((unsigned)((n + 255) / 256)), dim3(256), 0, s, a...);
}
DEVFN float exp2f_(float x) { return exp2f(x); }
#endif

DEVFN int tok_cv(int m) { return m < MP ? 0 : 1 + (m - MP) / DS; }
DEVFN int tok_keyrow(int m) { return m < MP ? m : MP + ((m - MP) / DS) * TKS + (m - MP) % DS; }
DEVFN int tok_pos(int m) { return m < MP ? (m % SEQ) : ((m - MP) % DS); }
DEVFN const float* xrow(const Params& p, int l, int m) {
  if (l > 0) return p.Y + (size_t)m * D;
  return m < MP ? p.x_prompt + (size_t)m * D : p.x_sample + (size_t)(m - MP) * D;
}
DEVFN float siluf(float x) { return x / (1.f + expf(-x)); }
DEVFN size_t st_row(int m, int i) { int b = m / SEQ, t = m % SEQ; return ((size_t)(b * 2 + i) * SEQ + t); }

#ifdef CPU_EMU
KERNEL nk_mod(Params p, long n) {
  long g = GTID; if (g >= n) return;
  int col = g % 3072; int cv = (g / 3072) % NCV; int l = g / (3072 * NCV);
  const float* cvec = cv == 0 ? p.c_ctx : p.c + (size_t)(cv - 1) * D;
  const float* w = p.w_mod + (size_t)l * D * 3072 + col;
  float acc = p.b_mod[l * 3072 + col];
  for (int k = 0; k < D; k++) acc += siluf(cvec[k]) * w[(size_t)k * 3072];
  p.modv[((size_t)l * NCV + cv) * 3072 + col] = acc;
}
KERNEL nk_tab(Params p, long n) {
  long g = GTID; if (g >= n) return;
  if (g < 2) {
    int i = g; int l = 2 * i;
    float s1 = 0, s2 = 0;
    for (int k = 0; k < 64; k++) { s1 += p.diff_lq1[i * 64 + k] * p.diff_lk1[i * 64 + k]; s2 += p.diff_lq2[i * 64 + k] * p.diff_lk2[i * 64 + k]; }
    float lam_init = 0.8f - 0.6f * expf(-0.3f * l);
    p.lamv[i] = expf(s1) - expf(s2) + lam_init;
  }
  int t = g / 48, j = g % 48;
  if (t >= DS) return;
  float row = (float)(t / GW), col = (float)(t % GW);
  if (j < 32) {
    int f = j & 15; float inv = powf(10000.f, -(float)(2 * f) / 32.f);
    float ang = (j < 16 ? row : col) * inv;
    p.ropeC64[t * 32 + j] = cosf(ang); p.ropeS64[t * 32 + j] = sinf(ang);
  } else {
    int jj = j - 32; int f = jj & 7; float inv = powf(10000.f, -(float)(2 * f) / 16.f);
    float ang = (jj < 8 ? row : col) * inv;
    p.ropeC32[t * 16 + jj] = cosf(ang); p.ropeS32[t * 16 + jj] = sinf(ang);
  }
}
KERNEL nk_rstd(Params p, int l, long n) {
  long g = GTID; if (g >= n) return;
  const float* x = xrow(p, l, (int)g);
  float s = 0; for (int k = 0; k < D; k++) s += x[k] * x[k];
  p.rstdx[g] = 1.f / sqrtf(s / D + EPSN);
}
KERNEL nk_inproj(Params p, int l, long n) {
  long g = GTID; if (g >= n) return;
  const int N = (l & 1) ? ODD_IN : EVEN_IN;
  int m = g / N, col = g % N;
  const float* W = ((l & 1) ? p.w_in_odd : p.w_in_even) + (size_t)(l >> 1) * D * N + col;
  const float* x = xrow(p, l, m);
  const float* md = p.modv + ((size_t)l * NCV + tok_cv(m)) * 3072;
  const float* nw = p.norm_w + l * D;
  float r = p.rstdx[m], acc = 0;
  for (int k = 0; k < D; k++) { float h = x[k] * r * nw[k] * (1.f + md[1024 + k]) + md[k]; acc += h * W[(size_t)k * N]; }
  p.ubuf[(size_t)m * 3328 + col] = (h16)acc;
}

KERNEL nk_epi_even(Params p, int l, int qa_only, long n) {
  long g = GTID; if (g >= n) return;
  const int i = l >> 1;
  int m = g / 50, u = g % 50;
  if (qa_only && u >= 8) return;
  const h16* ur = qa_only ? p.qa16 + (size_t)m * 256 : p.ubuf + (size_t)m * 3328;
  const bool smp = m >= MP; const int t = tok_pos(m); const int kr = tok_keyrow(m);
  if (u < 8) {
    float ss = 0; for (int k = 0; k < 256; k++) { float v = (float)ur[k]; ss += v * v; }
    float r = 1.f / sqrtf(ss / 256 + EPSN);
    float q[96];
#pragma unroll
    for (int j = 0; j < 96; j++) q[j] = 0;
    const float* W = p.mla_wqb + (size_t)i * 256 * 768 + u * 96;
    for (int k = 0; k < 256; k++) {
      float a = (float)ur[k] * r * p.mla_qa_norm[i * 256 + k];
#pragma unroll
      for (int j = 0; j < 96; j++) q[j] += a * W[(size_t)k * 768 + j];
    }
    float s1 = 0, s2 = 0;
#pragma unroll
    for (int j = 0; j < 64; j++) s1 += q[j] * q[j];
#pragma unroll
    for (int j = 64; j < 96; j++) s2 += q[j] * q[j];
    float r1 = 1.f / sqrtf(s1 / 64 + EPSN), r2 = 1.f / sqrtf(s2 / 32 + EPSN);
#pragma unroll
    for (int j = 0; j < 64; j++) q[j] = q[j] * r1 * p.mla_qn_nope[i * 64 + j];
#pragma unroll
    for (int j = 0; j < 32; j++) q[64 + j] = q[64 + j] * r2 * p.mla_qn_rope[i * 32 + j];
    if (smp) {
#pragma unroll
      for (int j = 0; j < 16; j++) {
        float c = p.ropeC32[t * 16 + j], s = p.ropeS32[t * 16 + j];
        float x1 = q[64 + j], x2 = q[80 + j];
        q[64 + j] = x1 * c - x2 * s; q[80 + j] = x2 * c + x1 * s;
      }
    }
    const float sc = LOG2E / sqrtf(96.f);
    h16* dst = p.QA + ((size_t)m * 8 + u) * 96;
#pragma unroll
    for (int j = 0; j < 96; j++) dst[j] = (h16)(q[j] * sc);
  } else if (u == 8) {
    float ss = 0; for (int k = 0; k < 128; k++) { float v = (float)ur[256 + k]; ss += v * v; }
    float r = 1.f / sqrtf(ss / 128 + EPSN);
    for (int k = 0; k < 128; k++) {
      float v = (float)ur[256 + k] * r * p.mla_kva_norm[i * 128 + k];
      if (!smp) p.o_ckv[st_row(m, i) * 128 + k] = v;
      p.ckvbuf[(size_t)kr * 128 + k] = v;
    }
  } else if (u == 9) {
    float v[32]; float ss = 0;
#pragma unroll
    for (int k = 0; k < 32; k++) { v[k] = (float)ur[384 + k]; ss += v[k] * v[k]; }
    float r = 1.f / sqrtf(ss / 32 + EPSN);
#pragma unroll
    for (int k = 0; k < 32; k++) { v[k] = v[k] * r * p.mla_kn_rope[i * 32 + k]; if (!smp) p.o_kpe[st_row(m, i) * 32 + k] = v[k]; }
    if (smp) {
#pragma unroll
      for (int j = 0; j < 16; j++) {
        float c = p.ropeC32[t * 16 + j], s = p.ropeS32[t * 16 + j];
        float x1 = v[j], x2 = v[16 + j];
        v[j] = x1 * c - x2 * s; v[16 + j] = x2 * c + x1 * s;
      }
    }
#pragma unroll
    for (int k = 0; k < 32; k++) p.kpebuf[(size_t)kr * 32 + k] = v[k];
  } else if (u < 18) {
    int cb = (u - 10) * 64;
    for (int j = 0; j < 64; j++) p.gates16[(size_t)m * 1024 + cb + j] = (h16)siluf((float)ur[416 + cb + j]);
  } else if (u < 34) {
    const bool isq = u < 26; int hc = isq ? u - 18 : u - 26;
    const h16* src = ur + (isq ? 928 : 1440) + hc * 64;
    const float* gn = (isq ? p.diff_qn : p.diff_kn) + i * 64;
    float v[64]; float ss = 0;
#pragma unroll
    for (int k = 0; k < 64; k++) { v[k] = (float)src[k]; ss += v[k] * v[k]; }
    float r = 1.f / sqrtf(ss / 64 + EPSN);
#pragma unroll
    for (int k = 0; k < 64; k++) { v[k] = v[k] * r * gn[k]; if (!isq && !smp) p.o_dk[st_row(m, i) * 512 + hc * 64 + k] = v[k]; }
    if (smp) {
#pragma unroll
      for (int j = 0; j < 32; j++) {
        float c = p.ropeC64[t * 32 + j], s = p.ropeS64[t * 32 + j];
        float x1 = v[j], x2 = v[32 + j];
        v[j] = x1 * c - x2 * s; v[32 + j] = x2 * c + x1 * s;
      }
    }
    if (isq) {
      const float sc = LOG2E / 8.f; h16* dst = p.QB + ((size_t)m * 8 + hc) * 64;
#pragma unroll
      for (int k = 0; k < 64; k++) dst[k] = (h16)(v[k] * sc);
    } else {
      h16* dst = p.KB + ((size_t)hc * KM + kr) * 64;
#pragma unroll
      for (int k = 0; k < 64; k++) dst[k] = (h16)v[k];
    }
  } else if (u < 42) {
    int ch = u - 34; int h = ch >> 1, half = ch & 1;
    for (int j = 0; j < 64; j++) {
      float v = (float)ur[1952 + ch * 64 + j];
      if (!smp) p.o_dv[st_row(m, i) * 512 + ch * 64 + j] = v;
      p.VB[((size_t)h * 128 + half * 64 + j) * KM + kr] = (h16)v;
    }
  } else {
    int cb = (u - 42) * 64;
    for (int j = 0; j < 64; j++) p.gates16[(size_t)m * 1024 + 512 + cb + j] = (h16)siluf((float)ur[2464 + cb + j]);
  }
}
KERNEL nk_cache_even(Params p, int l, long n) {
  long g = GTID; if (g >= n) return;
  const int i = l >> 1;
  int u = g % 17; int pos = (g / 17) % PAST; int b = g / (17 * PAST);
  const int kr = MP + b * TKS + DS + pos;
  const size_t crow = ((size_t)(b * 2 + i) * PAST + pos);
  if (u == 0) {
    for (int k = 0; k < 128; k++) { float v = p.cache_mla_ckv[crow * 128 + k]; p.ckvbuf[(size_t)kr * 128 + k] = v; p.ckv16[(size_t)kr * 128 + k] = (h16)v; }
    for (int k = 0; k < 32; k++) { float v = p.cache_mla_kpe[crow * 32 + k]; p.kpebuf[(size_t)kr * 32 + k] = v; p.kpe16[(size_t)kr * 32 + k] = (h16)v; }
  } else if (u < 9) {
    int hc = u - 1;
    for (int k = 0; k < 64; k++) p.KB[((size_t)hc * KM + kr) * 64 + k] = (h16)p.cache_diff_k[crow * 512 + hc * 64 + k];
  } else {
    int ch = u - 9; int h = ch >> 1, half = ch & 1;
    for (int j = 0; j < 64; j++) p.VB[((size_t)h * 128 + half * 64 + j) * KM + kr] = (h16)p.cache_diff_v[crow * 512 + ch * 64 + j];
  }
}
KERNEL nk_kv(Params p, int l, long n) {
  long g = GTID; if (g >= n) return;
  const int i = l >> 1;
  int part = g & 1; int h = (g >> 1) & 7; int kr = g >> 4;
  const float* cr = p.ckvbuf + (size_t)kr * 128;
  const float* W = p.mla_wkvb + (size_t)i * 128 * 1024 + h * 128 + part * 64;
  float a[64];
#pragma unroll
  for (int j = 0; j < 64; j++) a[j] = 0;
  for (int k = 0; k < 128; k++) {
    float c = (float)(h16)cr[k];
#pragma unroll
    for (int j = 0; j < 64; j++) a[j] += c * W[(size_t)k * 1024 + j];
  }
  if (part == 0) {
    float ss = 0;
#pragma unroll
    for (int j = 0; j < 64; j++) ss += a[j] * a[j];
    float r = 1.f / sqrtf(ss / 64 + EPSN);
    h16* dst = p.KA + ((size_t)h * KM + kr) * 128;
#pragma unroll
    for (int j = 0; j < 64; j++) dst[j] = (h16)(a[j] * r * p.mla_kn_nope[i * 64 + j]);
    for (int j = 0; j < 32; j++) dst[64 + j] = (h16)p.kpebuf[(size_t)kr * 32 + j];
  } else {
#pragma unroll
    for (int j = 0; j < 64; j++) p.VA[((size_t)h * 64 + j) * KM + kr] = (h16)a[j];
  }
}
KERNEL nk_epi_odd(Params p, int l, long n) {
  long g = GTID; if (g >= n) return;
  const int i = l >> 1;
  int m = g / 52, u = g % 52;
  const h16* ur = p.ubuf + (size_t)m * 3328;
  const bool smp = m >= MP; const int t = tok_pos(m); const int kr = tok_keyrow(m);
  if (u < 16 || (u >= 32 && u < 42)) {
    int colbase, head; const float* gn; int kind;
    if (u < 8) { kind = 0; head = u; colbase = head * 64; gn = p.na_qn + i * 64; }
    else if (u < 16) { kind = 1; head = u - 8; colbase = 512 + head * 64; gn = p.na_kn + i * 64; }
    else if (u < 40) { kind = 2; head = u - 32; colbase = 2048 + head * 64; gn = p.gqa_qn + i * 64; }
    else { kind = 3; head = u - 40; colbase = 2560 + head * 64; gn = p.gqa_kn + i * 64; }
    float v[64]; float ss = 0;
#pragma unroll
    for (int k = 0; k < 64; k++) { v[k] = (float)ur[colbase + k]; ss += v[k] * v[k]; }
    float r = 1.f / sqrtf(ss / 64 + EPSN);
#pragma unroll
    for (int k = 0; k < 64; k++) v[k] = v[k] * r * gn[k];
    if (!smp) {
      if (kind == 1) { for (int k = 0; k < 64; k++) p.o_nk[st_row(m, i) * 512 + head * 64 + k] = v[k]; }
      if (kind == 3) { for (int k = 0; k < 64; k++) p.o_gk[st_row(m, i) * 128 + head * 64 + k] = v[k]; }
    }
    if (smp && kind >= 2) {
#pragma unroll
      for (int j = 0; j < 32; j++) {
        float c = p.ropeC64[t * 32 + j], s = p.ropeS64[t * 32 + j];
        float x1 = v[j], x2 = v[32 + j];
        v[j] = x1 * c - x2 * s; v[32 + j] = x2 * c + x1 * s;
      }
    }
    const float sc = LOG2E / 8.f;
    h16* dst;
    if (kind == 0) dst = p.QA + ((size_t)m * 8 + head) * 64;
    else if (kind == 1) dst = p.KA + ((size_t)head * KM + kr) * 64;
    else if (kind == 2) dst = p.QB + ((size_t)m * 8 + head) * 64;
    else dst = p.KB + ((size_t)head * KM + kr) * 64;
    const float mul = (kind == 0 || kind == 2) ? sc : 1.f;
#pragma unroll
    for (int k = 0; k < 64; k++) dst[k] = (h16)(v[k] * mul);
  } else if (u < 24) {
    int head = u - 16;
    for (int j = 0; j < 64; j++) {
      float v = (float)ur[1024 + head * 64 + j];
      if (!smp) p.o_nv[st_row(m, i) * 512 + head * 64 + j] = v;
      p.VA[((size_t)head * 64 + j) * KM + kr] = (h16)v;
    }
  } else if (u < 32) {
    int cb = (u - 24) * 64;
    for (int j = 0; j < 64; j++) p.gates16[(size_t)m * 1024 + cb + j] = (h16)siluf((float)ur[1536 + cb + j]);
  } else if (u < 44) {
    int head = u - 42;
    for (int j = 0; j < 64; j++) {
      float v = (float)ur[2688 + head * 64 + j];
      if (!smp) p.o_gv[st_row(m, i) * 128 + head * 64 + j] = v;
      p.VB[((size_t)head * 64 + j) * KM + kr] = (h16)v;
    }
  } else {
    int cb = (u - 44) * 64;
    for (int j = 0; j < 64; j++) p.gates16[(size_t)m * 1024 + 512 + cb + j] = (h16)siluf((float)ur[2816 + cb + j]);
  }
}
KERNEL nk_cache_odd(Params p, int l, long n) {
  long g = GTID; if (g >= n) return;
  const int i = l >> 1;
  int u = g % 20; int pos = (g / 20) % PAST; int b = g / (20 * PAST);
  const int kr = MP + b * TKS + DS + pos;
  const size_t crow = ((size_t)(b * 2 + i) * PAST + pos);
  if (u < 8) { for (int k = 0; k < 64; k++) p.KA[((size_t)u * KM + kr) * 64 + k] = (h16)p.cache_na_k[crow * 512 + u * 64 + k]; }
  else if (u < 16) { int h = u - 8; for (int j = 0; j < 64; j++) p.VA[((size_t)h * 64 + j) * KM + kr] = (h16)p.cache_na_v[crow * 512 + h * 64 + j]; }
  else if (u < 18) { int h = u - 16; for (int k = 0; k < 64; k++) p.KB[((size_t)h * KM + kr) * 64 + k] = (h16)p.cache_gqa_k[crow * 128 + h * 64 + k]; }
  else { int h = u - 18; for (int j = 0; j < 64; j++) p.VB[((size_t)h * 64 + j) * KM + kr] = (h16)p.cache_gqa_v[crow * 128 + h * 64 + j]; }
}
template <int DQK, int KP>
DEVFN void attn_dense_thread(const h16* q, const h16* K, const h16* VT, int kr0, int nk, float* out) {
  float qf[DQK];
#pragma unroll
  for (int j = 0; j < DQK; j++) qf[j] = (float)q[j];
  float o[64];
#pragma unroll
  for (int j = 0; j < 64; j++) o[j] = 0;
  float mx = -1e30f, sum = 0;
  for (int kk = 0; kk < nk; kk++) {
    const h16* kp = K + (size_t)(kr0 + kk) * KP;
    float s = 0;
#pragma unroll
    for (int j = 0; j < DQK; j++) s += qf[j] * (float)kp[j];
    float mn = fmaxf(mx, s); float al = exp2f_(mx - mn); float pe = exp2f_(s - mn);
    sum = sum * al + pe; mx = mn;
#pragma unroll
    for (int j = 0; j < 64; j++) o[j] = o[j] * al + pe * (float)VT[(size_t)j * KM + kr0 + kk];
  }
  float inv = 1.f / sum;
#pragma unroll
  for (int j = 0; j < 64; j++) out[j] = o[j] * inv;
}
KERNEL nk_attn_dense(Params p, int kind, int mlo, int mhi, long n) {
  long g = GTID; if (g >= n) return;
  const int nch = kind == 1 ? 2 : 1;
  int ch = g % nch; int head = (g / nch) % 8; int m = mlo + g / (nch * 8);
  if (m >= mhi) return;
  int kr0, nk;
  if (m < MP) { kr0 = (m / SEQ) * SEQ; nk = SEQ; } else { kr0 = MP + ((m - MP) / DS) * TKS; nk = TKS; }
  if (kind == 0) {
    attn_dense_thread<96, 128>(p.QA + ((size_t)m * 8 + head) * 96, p.KA + (size_t)head * KM * 128, p.VA + (size_t)head * 64 * KM, kr0, nk,
                          p.abuf + (size_t)m * 1536 + head * 64);
  } else if (kind == 1) {
    attn_dense_thread<64, 64>(p.QB + ((size_t)m * 8 + head) * 64, p.KB + (size_t)head * KM * 64,
                          p.VB + ((size_t)(head >> 1) * 128 + ch * 64) * KM, kr0, nk, p.abuf + (size_t)m * 1536 + 512 + head * 128 + ch * 64);
  } else if (kind == 2) {
    attn_dense_thread<64, 64>(p.QA + ((size_t)m * 8 + head) * 64, p.KA + (size_t)head * KM * 64, p.VA + (size_t)head * 64 * KM, kr0, nk,
                          p.abuf + (size_t)m * 1536 + head * 64);
  } else {
    attn_dense_thread<64, 64>(p.QB + ((size_t)m * 8 + head) * 64, p.KB + (size_t)(head >> 2) * KM * 64, p.VB + (size_t)(head >> 2) * 64 * KM,
                          kr0, nk, p.abuf + (size_t)m * 1536 + 512 + head * 64);
  }
}
KERNEL nk_attn_na(Params p, int l, long n) {
  long g = GTID; if (g >= n) return;
  const int i = l >> 1;
  int head = g & 7; int ms = g >> 3; int m = MP + ms;
  int b = ms / DS, t = ms % DS; int r = t / GW, c = t % GW;
  int rs = r - 4; rs = rs < 0 ? 0 : (rs > GROWS - 8 ? GROWS - 8 : rs);
  int cs = c - 8; cs = cs < 0 ? 0 : (cs > GW - 16 ? GW - 16 : cs);
  const h16* q = p.QA + ((size_t)m * 8 + head) * 64;
  const h16* K = p.KA + (size_t)head * KM * 64; const h16* VT = p.VA + (size_t)head * 64 * KM;
  const int kbase = MP + b * TKS;
  const float* rpb = p.na_rpb + ((size_t)i * 8 + head) * 15 * 31;
  float qf[64], o[64];
#pragma unroll
  for (int j = 0; j < 64; j++) { qf[j] = (float)q[j]; o[j] = 0; }
  float mx = -1e30f, sum = 0;
  for (int kk = 0; kk < 128 + PAST; kk++) {
    int kr; float bias = 0;
    if (kk < 128) { int ri = kk >> 4, cj = kk & 15; kr = kbase + (rs + ri) * GW + cs + cj; bias = rpb[(rs + ri - r + 7) * 31 + (cs + cj - c + 15)] * LOG2E; }
    else kr = kbase + DS + (kk - 128);
    const h16* kp = K + (size_t)kr * 64;
    float s = bias;
#pragma unroll
    for (int j = 0; j < 64; j++) s += qf[j] * (float)kp[j];
    float mn = fmaxf(mx, s); float al = exp2f_(mx - mn); float pe = exp2f_(s - mn);
    sum = sum * al + pe; mx = mn;
#pragma unroll
    for (int j = 0; j < 64; j++) o[j] = o[j] * al + pe * (float)VT[(size_t)j * KM + kr];
  }
  float inv = 1.f / sum; float* out = p.abuf + (size_t)m * 1536 + head * 64;
#pragma unroll
  for (int j = 0; j < 64; j++) out[j] = o[j] * inv;
}
KERNEL nk_fin(Params p, int l, long n) {
  long g = GTID; if (g >= n) return;
  const int i = l >> 1;
  if (l & 1) {
    int ch = g & 15; int m = g >> 4;
    for (int j = 0; j < 64; j++) {
      int col = ch * 64 + j;
      p.O16[(size_t)m * 1024 + col] = (h16)(p.abuf[(size_t)m * 1536 + col] * (float)p.gates16[(size_t)m * 1024 + col]);
    }
  } else {
    int u = g % 12; int m = g / 12;
    if (u < 8) {
      for (int j = 0; j < 64; j++) {
        int col = u * 64 + j;
        p.O16[(size_t)m * 1024 + col] = (h16)(p.abuf[(size_t)m * 1536 + col] * (float)p.gates16[(size_t)m * 1024 + col]);
      }
    } else {
      int h = u - 8; float lam = p.lamv[i]; float lam_init = 0.8f - 0.6f * expf(-0.3f * l);
      const float* a1 = p.abuf + (size_t)m * 1536 + 512 + (h * 2) * 128; const float* a2 = a1 + 128;
      float ss = 0;
      for (int j = 0; j < 128; j++) { float d = a1[j] - lam * a2[j]; ss += d * d; }
      float r = 1.f / sqrtf(ss / 128 + EPSN);
      for (int j = 0; j < 128; j++) {
        float d = (a1[j] - lam * a2[j]) * r * p.diff_subln[i * 128 + j] * (1.f - lam_init);
        int col = 512 + h * 128 + j;
        p.O16[(size_t)m * 1024 + col] = (h16)(d * (float)p.gates16[(size_t)m * 1024 + col]);
      }
    }
  }
}
KERNEL nk_outproj(Params p, int l, long n) {
  long g = GTID; if (g >= n) return;
  int m = g >> 10, col = g & 1023;
  const float* W = ((l & 1) ? p.w_out_odd : p.w_out_even) + (size_t)(l >> 1) * 1024 * 1024 + col;
  const h16* o = p.O16 + (size_t)m * 1024;
  float acc = 0;
  for (int k = 0; k < 1024; k++) acc += (float)o[k] * W[(size_t)k * 1024];
  float gate = p.modv[((size_t)l * NCV + tok_cv(m)) * 3072 + 2048 + col];
  p.Y[(size_t)m * 1024 + col] = xrow(p, l, m)[col] + gate * acc;
}


#endif
#ifndef CPU_EMU
typedef _Float16 h16x8 __attribute__((ext_vector_type(8)));
typedef _Float16 h16x4 __attribute__((ext_vector_type(4)));
typedef float f32x16 __attribute__((ext_vector_type(16)));
typedef float f32x4 __attribute__((ext_vector_type(4)));
#define LAS __attribute__((address_space(3)))
typedef unsigned u32x4 __attribute__((ext_vector_type(4)));
DEVFN size_t pidx(int R, int row, int k) { return ((size_t)(k >> 6) * R + row) * 64 + (k & 63); }
DEVFN size_t vidx(int vrow, int kr) { return ((size_t)(kr >> 6) * 512 + vrow) * 64 + (kr & 63); }
DEVFN float max3f(float a, float b, float c) { float r; asm("v_max3_f32 %0, %1, %2, %3" : "=v"(r) : "v"(a), "v"(b), "v"(c)); return r; }
DEVFN float frsq(float x) { return __builtin_amdgcn_rsqf(x); }
DEVFN float fsilu(float x) { return x * __builtin_amdgcn_rcpf(1.f + __builtin_amdgcn_exp2f(-LOG2E * x)); }
DEVFN int tid_op() { int t = threadIdx.x; asm volatile("" : "+v"(t)); return t; }

DEVFN int even_col(int np) { return np < 416 ? np : (np < 512 ? -1 : np - 96); }

constexpr int G_STAGE = 49152, G_NSTAGE = 3, G_LDS = G_STAGE * G_NSTAGE;
constexpr int G_LDS2 = 131072 + 8 * 3072;
DEVFN int img_off(int r, int c) { return r * 128 + ((c ^ ((r >> 1) & 7)) << 4); }
template <int R>
DEVFN void stage_rows(const h16* g, int ld, char* lds, int tid) {
#pragma unroll
  for (int i = 0; i < R / 64; i++) {
    int r = (tid >> 3) + 64 * i; int c = (tid & 7) ^ ((r >> 1) & 7);
    __builtin_amdgcn_global_load_lds((const unsigned*)(g + (size_t)r * ld + c * 8), (unsigned*)(lds + i * 8192 + tid * 16), 16, 0, 0);
  }
}
#define WAITV(n) asm volatile("s_waitcnt vmcnt(" #n ")" ::: "memory")
#define RAWBAR() do { asm volatile("s_waitcnt lgkmcnt(0)" ::: "memory"); __builtin_amdgcn_s_barrier(); } while (0)
#define HF_BASE 4096
DEVFN unsigned* hf_flag(const Params& p, int i, int pn, int pm) { return p.bar + HF_BASE + (((i * 2 + pn) * 32 + pm) << 4); }
DEVFN void st16_wt(h16* ptr, h16x8 v) { asm volatile("global_store_dwordx4 %0, %1, off sc0 sc1\n\ts_nop 1" :: "v"(ptr), "v"(v) : "memory"); }
DEVFN void hf_publish(unsigned* flag, int lane) {
  asm volatile("s_waitcnt vmcnt(0)" ::: "memory");
  if (lane == 0) (void)__hip_atomic_fetch_add(flag, 1u, __ATOMIC_RELAXED, __HIP_MEMORY_SCOPE_AGENT);
}
template <class FlagF>
DEVFN void hf_wait_all(int cnt, unsigned need, FlagF flagf) {
  const int t = tid_op();
  if (t < 64) {
    for (int k = t; k < cnt; k += 64) {
      unsigned* flag = flagf(k); unsigned sp = 0;
      while (__hip_atomic_load(flag, __ATOMIC_RELAXED, __HIP_MEMORY_SCOPE_AGENT) < need && ++sp < (1u << 22)) __builtin_amdgcn_s_sleep(2);
    }
    __builtin_amdgcn_fence(__ATOMIC_ACQUIRE, "agent");
    asm volatile("s_waitcnt vmcnt(0)" ::: "memory");
  }
  __syncthreads();
}
#define HF2_BASE 8192
DEVFN unsigned* hf2_flag(const Params& p, int l, int panel) { return p.bar + HF2_BASE + ((l * 32 + panel) << 4); }
DEVFN void hf_publish_n(unsigned* flag, unsigned n, int lane) {
  asm volatile("s_waitcnt vmcnt(0)" ::: "memory");
  if (lane == 0) (void)__hip_atomic_fetch_add(flag, n, __ATOMIC_RELAXED, __HIP_MEMORY_SCOPE_AGENT);
}
DEVFN void store_o16_wt(const Params& p, int m, int cbase, const h16x4 (&ov)[4], int h) {
#pragma unroll
  for (int qp = 0; qp < 2; qp++) {
    union { h16x4 v; unsigned u[2]; } a, b; a.v = ov[2 * qp]; b.v = ov[2 * qp + 1];
    auto s0 = __builtin_amdgcn_permlane32_swap(a.u[0], b.u[0], false, false);
    auto s1 = __builtin_amdgcn_permlane32_swap(a.u[1], b.u[1], false, false);
    union { h16x8 v; unsigned u[4]; } o; o.u[0] = s0[0]; o.u[1] = s1[0]; o.u[2] = s0[1]; o.u[3] = s1[1];
    st16_wt(p.O16 + pidx(M, m, cbase + 8 * (2 * qp + h)), o.v);
  }
}
template <class AddrF>
DEVFN void store_quads16(const h16x4 (&ov)[4], int h, AddrF addr) {
#pragma unroll
  for (int qp = 0; qp < 2; qp++) {
    union { h16x4 v; unsigned u[2]; } a, b; a.v = ov[2 * qp]; b.v = ov[2 * qp + 1];
    auto s0 = __builtin_amdgcn_permlane32_swap(a.u[0], b.u[0], false, false);
    auto s1 = __builtin_amdgcn_permlane32_swap(a.u[1], b.u[1], false, false);
    union { h16x8 v; unsigned u[4]; } o; o.u[0] = s0[0]; o.u[1] = s1[0]; o.u[2] = s0[1]; o.u[3] = s1[1];
    *(h16x8*)addr(8 * (2 * qp + h)) = o.v;
  }
}
template <bool TR>
DEVFN void gemm_tile(const h16* A, int RA, const h16* Bt, int RB, int K, int m0, int n0, char* lds, f32x16 (&acc)[2][2]) {
  const int TIDX = tid_op();
  const int tid = TIDX, lane = tid & 63, w = tid >> 6, wm = w >> 1, wn = w & 1;
  const int nt = K / 64;
  const h16* Ag = A + (size_t)m0 * 64; const h16* Bg = Bt + (size_t)n0 * 64; const size_t pa = (size_t)RA * 64, pb = (size_t)RB * 64;
#pragma unroll
  for (int a = 0; a < 2; a++)
#pragma unroll
    for (int b = 0; b < 2; b++)
#pragma unroll
      for (int r = 0; r < 16; r++) acc[a][b][r] = 0.f;
  stage_rows<256>(Ag, 64, lds, tid); stage_rows<128>(Bg, 64, lds + 32768, tid);
  if (nt > 1) { stage_rows<256>(Ag + pa, 64, lds + G_STAGE, tid); stage_rows<128>(Bg + pb, 64, lds + G_STAGE + 32768, tid); }
  const int ra = wm * 64 + (lane & 31), rb = wn * 64 + (lane & 31), ch = lane >> 5;
  auto piece = [&](const h16* g, char* s, int i) {
    const int r = (tid >> 3) + 64 * i; const int c = (tid & 7) ^ ((r >> 1) & 7);
    __builtin_amdgcn_global_load_lds((const unsigned*)(g + (size_t)r * 64 + c * 8), (unsigned*)(s + i * 8192 + tid * 16), 16, 0, 0);
  };
  for (int t = 0; t < nt; t++) {
    if (t + 1 < nt) WAITV(6); else WAITV(0);
    RAWBAR();
    const bool pre = t + 2 < nt;
    char* sn = lds + ((t + 2) % 3) * G_STAGE; const h16* An = Ag + (t + 2) * pa; const h16* Bn = Bg + (t + 2) * pb;
    const char* sa = lds + (t % 3) * G_STAGE; const char* sb = sa + 32768;
    h16x8 af[2][2], bf[2][2];
#pragma unroll
    for (int mb = 0; mb < 2; mb++) af[0][mb] = *(const h16x8*)(sa + img_off(ra + mb * 32, ch));
#pragma unroll
    for (int nb = 0; nb < 2; nb++) bf[0][nb] = *(const h16x8*)(sb + img_off(rb + nb * 32, ch));
#pragma unroll
    for (int ks = 0; ks < 4; ks++) {
      const int cur = ks & 1, nxt = cur ^ 1;
      if (ks < 3) {
#pragma unroll
        for (int mb = 0; mb < 2; mb++) af[nxt][mb] = *(const h16x8*)(sa + img_off(ra + mb * 32, 2 * (ks + 1) + ch));
#pragma unroll
        for (int nb = 0; nb < 2; nb++) bf[nxt][nb] = *(const h16x8*)(sb + img_off(rb + nb * 32, 2 * (ks + 1) + ch));
      }
      if (pre) {
        if (ks == 0) { piece(An, sn, 0); piece(An, sn, 1); }
        else if (ks == 1) { piece(An, sn, 2); piece(An, sn, 3); }
        else if (ks == 2) { piece(Bn, sn + 32768, 0); piece(Bn, sn + 32768, 1); }
      }
#pragma unroll
      for (int mb = 0; mb < 2; mb++)
#pragma unroll
        for (int nb = 0; nb < 2; nb++) {
          if (TR) acc[mb][nb] = __builtin_amdgcn_mfma_f32_32x32x16_f16(bf[cur][nb], af[cur][mb], acc[mb][nb], 0, 0, 0);
          else acc[mb][nb] = __builtin_amdgcn_mfma_f32_32x32x16_f16(af[cur][mb], bf[cur][nb], acc[mb][nb], 0, 0, 0);
        }
      __builtin_amdgcn_sched_barrier(0);
    }
  }
  RAWBAR();
}

DEVFN float wsum32(float v) { return v + __shfl_xor(v, 32); }

template <class RsF, class DstF>
DEVFN void epi_head64(const Params& p, const f32x16 (&acc)[2][2], int mbase, RsF rsf, const float* bias, const float* gain, bool rope, float oscale,
                      float* state, int spitch, int scol, int ilayer, DstF dstf) {
  const int TIDX = tid_op();
  const int lane = TIDX & 63, h = lane >> 5;
#pragma unroll
  for (int mb = 0; mb < 2; mb++) {
    const int m = mbase + mb * 32 + (lane & 31);
    const float rs = rsf(m);
    float v[2][16]; float ss = 0;
#pragma unroll
    for (int nb = 0; nb < 2; nb++)
#pragma unroll
      for (int q = 0; q < 4; q++) {
        const int j = nb * 32 + 8 * q + 4 * h;
        f32x4 b = bias ? *(const f32x4*)(bias + j) : (f32x4){0.f, 0.f, 0.f, 0.f};
#pragma unroll
        for (int e = 0; e < 4; e++) { float x = acc[mb][nb][q * 4 + e] * rs + b[e]; v[nb][q * 4 + e] = x; ss += x * x; }
      }
    ss = wsum32(ss);
    const float rr = frsq(ss * (1.f / 64.f) + EPSN);
#pragma unroll
    for (int nb = 0; nb < 2; nb++)
#pragma unroll
      for (int q = 0; q < 4; q++) {
        const int j = nb * 32 + 8 * q + 4 * h;
        f32x4 g = *(const f32x4*)(gain + j);
#pragma unroll
        for (int e = 0; e < 4; e++) v[nb][q * 4 + e] *= rr * g[e];
      }
    const bool smp = m >= MP;
    if (state && !smp) {
      float* sp = state + st_row(m, ilayer) * spitch + scol;
#pragma unroll
      for (int nb = 0; nb < 2; nb++)
#pragma unroll
        for (int q = 0; q < 4; q++) { f32x4 o = {v[nb][q * 4], v[nb][q * 4 + 1], v[nb][q * 4 + 2], v[nb][q * 4 + 3]}; *(f32x4*)(sp + nb * 32 + 8 * q + 4 * h) = o; }
    }
    if (rope && smp) {
      const int t = tok_pos(m);
#pragma unroll
      for (int q = 0; q < 4; q++) {
        f32x4 c = *(const f32x4*)(p.ropeC64 + t * 32 + 8 * q + 4 * h), s = *(const f32x4*)(p.ropeS64 + t * 32 + 8 * q + 4 * h);
#pragma unroll
        for (int e = 0; e < 4; e++) { float x1 = v[0][q * 4 + e], x2 = v[1][q * 4 + e]; v[0][q * 4 + e] = x1 * c[e] - x2 * s[e]; v[1][q * 4 + e] = x2 * c[e] + x1 * s[e]; }
      }
    }
    h16* dst = dstf(m);
#pragma unroll
    for (int nb = 0; nb < 2; nb++) {
      h16x4 ov[4];
#pragma unroll
      for (int q = 0; q < 4; q++)
#pragma unroll
        for (int e = 0; e < 4; e++) ov[q][e] = (h16)(v[nb][q * 4 + e] * oscale);
      store_quads16(ov, h, [&](int c) { return dst + nb * 32 + c; });
    }
  }
}
template <class RsF, class DstF>
DEVFN void epi_head32(const Params& p, const f32x16 (&acc)[2][2], int mbase, RsF rsf, const float* bias, const float* gain, bool rope, float oscale,
                      float* state, int ilayer, DstF dstf, float* dual = nullptr) {
  const int TIDX = tid_op();
  const int lane = TIDX & 63, h = lane >> 5;
#pragma unroll
  for (int mb = 0; mb < 2; mb++) {
    const int m = mbase + mb * 32 + (lane & 31);
    const float rs = rsf(m);
    float v[16]; float ss = 0;
#pragma unroll
    for (int q = 0; q < 4; q++) {
      const int j = 8 * q + 4 * h;
      f32x4 b = bias ? *(const f32x4*)(bias + j) : (f32x4){0.f, 0.f, 0.f, 0.f};
#pragma unroll
      for (int e = 0; e < 4; e++) { float x = acc[mb][0][q * 4 + e] * rs + b[e]; v[q * 4 + e] = x; ss += x * x; }
    }
    ss = wsum32(ss);
    const float rr = frsq(ss * (1.f / 32.f) + EPSN);
#pragma unroll
    for (int q = 0; q < 4; q++) {
      f32x4 g = *(const f32x4*)(gain + 8 * q + 4 * h);
#pragma unroll
      for (int e = 0; e < 4; e++) v[q * 4 + e] *= rr * g[e];
    }
    const bool smp = m >= MP;
    if (state && !smp) {
      float* sp = state + st_row(m, ilayer) * 32;
#pragma unroll
      for (int q = 0; q < 4; q++) { f32x4 o = {v[q * 4], v[q * 4 + 1], v[q * 4 + 2], v[q * 4 + 3]}; *(f32x4*)(sp + 8 * q + 4 * h) = o; }
    }
    if (rope && smp) {
      const int t = tok_pos(m);
#pragma unroll
      for (int q = 0; q < 2; q++) {
        f32x4 c = *(const f32x4*)(p.ropeC32 + t * 16 + 8 * q + 4 * h), s = *(const f32x4*)(p.ropeS32 + t * 16 + 8 * q + 4 * h);
#pragma unroll
        for (int e = 0; e < 4; e++) { float x1 = v[q * 4 + e], x2 = v[(q + 2) * 4 + e]; v[q * 4 + e] = x1 * c[e] - x2 * s[e]; v[(q + 2) * 4 + e] = x2 * c[e] + x1 * s[e]; }
      }
    }
    h16* dst = dstf(m);
    h16x4 ov[4];
#pragma unroll
    for (int q = 0; q < 4; q++) {
#pragma unroll
      for (int e = 0; e < 4; e++) ov[q][e] = (h16)(v[q * 4 + e] * oscale);
      if (dual) { for (int e = 0; e < 4; e++) dual[(size_t)tok_keyrow(m) * 32 + 8 * q + 4 * h + e] = v[q * 4 + e]; }
    }
    store_quads16(ov, h, [&](int c) { return dst + c; });
  }
}
template <class RsF, class KrF>
DEVFN void epi_vt(const f32x16 (&acc)[2][2], int mbase, RsF rsf, const float* bias  , float* state, int spitch, int scol, int ilayer,
                  h16* vbuf, int vrow0, KrF krf) {
  const int TIDX = tid_op();
  const int lane = TIDX & 63, h = lane >> 5, e0 = lane & 31;
#pragma unroll
  for (int mb = 0; mb < 2; mb++) {
    float rs[4][4];
#pragma unroll
    for (int q = 0; q < 4; q++)
#pragma unroll
      for (int e = 0; e < 4; e++) rs[q][e] = rsf(mbase + mb * 32 + 8 * q + 4 * h + e);
#pragma unroll
    for (int nb = 0; nb < 2; nb++) {
      const int col = nb * 32 + e0; const float b = bias ? bias[col] : 0.f;
      h16x4 ov[4];
#pragma unroll
      for (int q = 0; q < 4; q++) {
        const int mq = mbase + mb * 32 + 8 * q + 4 * h;
#pragma unroll
        for (int e = 0; e < 4; e++) {
          float x = acc[mb][nb][q * 4 + e] * rs[q][e] + b; ov[q][e] = (h16)x;
          if (state && mq < MP) state[st_row(mq + e, ilayer) * spitch + scol + col] = x;
        }
      }
      store_quads16(ov, h, [&](int c) { return vbuf + vidx(vrow0 + col, krf(mbase + mb * 32 + c)); });
    }
  }
}

DEVFN void qgemm_tile(const Params& p, int l, int mt, int head, char* lds) {
  const int TIDX = tid_op();
  const int i = l >> 1; const int m0 = mt * 256;
  const int w = TIDX >> 6, wm = w >> 1, wn = w & 1;
  f32x16 acc[2][2];
  const float* rq = p.rowss_qa + (size_t)i * M; const int lrow = m0 + wm * 64 + (TIDX & 31);
  const float rq0 = rq[lrow], rq1 = rq[lrow + 32];
  gemm_tile<true>(p.qa16, M, (p.wqb16 + (size_t)i * 1024 * 256), 1024, 256, m0, head * 128, lds, acc);
  auto rsf = [&](int m) { return frsq((m == lrow ? rq0 : rq1) * (1.f / 256.f) + EPSN); };
  const float sc = LOG2E / sqrtf(96.f);
  if (wn == 0) epi_head64(p, acc, m0 + wm * 64, rsf, nullptr, p.mla_qn_nope + i * 64, false, sc, nullptr, 0, 0, i, [&](int m) { return p.QA + ((size_t)m * 8 + head) * 96; });
  else epi_head32(p, acc, m0 + wm * 64, rsf, nullptr, p.mla_qn_rope + i * 32, true, sc, nullptr, i, [&](int m) { return p.QA + ((size_t)m * 8 + head) * 96 + 64; });
}
DEVFN void kvgemm_tile(const Params& p, int l, int mt, int ntile, char* lds) {
  const int TIDX = tid_op();
  const int i = l >> 1; const int m0 = mt * 256;
  const int lane = TIDX & 63, w = TIDX >> 6, wm = w >> 1, wn = w & 1, h = lane >> 5;
  f32x16 acc[2][2];
  const float* rck = p.rowss_ckv + (size_t)i * KM;
  auto one = [&](int m) { return frsq(rck[m] * (1.f / 128.f) + EPSN); };
  if (ntile < 4) {
    const int lrow = m0 + wm * 64 + (lane & 31); const float rk0 = rck[lrow], rk1 = rck[lrow + 32];
    auto onep = [&](int m) { return frsq((m == lrow ? rk0 : rk1) * (1.f / 128.f) + EPSN); };
    gemm_tile<true>(p.ckv16, KM, (p.wkvb16 + (size_t)i * 1024 * 128), 1024, 128, m0, ntile * 128, lds, acc);
    const int head = ntile * 2 + wn;
    epi_head64(p, acc, m0 + wm * 64, onep, nullptr, p.mla_kn_nope + i * 64, false, 1.f, nullptr, 0, 0, i, [&](int m) { return p.KA + ((size_t)head * KM + m) * 128; });
#pragma unroll
    for (int mb = 0; mb < 2; mb++) {
      const int kr = m0 + wm * 64 + mb * 32 + (lane & 31);
      const h16x8* s = (const h16x8*)(p.kpe16 + (size_t)kr * 32 + h * 16);
      h16x8* d = (h16x8*)(p.KA + ((size_t)head * KM + kr) * 128 + 64 + h * 16);
      d[0] = s[0]; d[1] = s[1];
    }
  } else {
    gemm_tile<false>(p.ckv16, KM, (p.wkvb16 + (size_t)i * 1024 * 128), 1024, 128, m0, ntile * 128, lds, acc);
    const int head = (ntile - 4) * 2 + wn;
    epi_vt(acc, m0 + wm * 64, one, nullptr, nullptr, 0, 0, i, p.VA, head * 64, [](int m) { return m; });
  }
}
DEVFN void outproj_tile(const Params& p, int l, int mt, int ntile, char* lds, bool dry = false, unsigned* wait_flag = nullptr) {
  const int TIDX = tid_op();
  const int m0 = mt * 256, n0 = ntile * 128;
  const int lane = TIDX & 63, w = TIDX >> 6, wm = w >> 1, wn = w & 1, h = lane >> 5;
  const int cv = tok_cv(m0); const int nw0 = n0 + wn * 64;
  f32x4 xv[2][2][4]; u32x4 xraw[2][2][2];
#pragma unroll
  for (int mb = 0; mb < 2; mb++) {
    const int m = m0 + wm * 64 + mb * 32 + (lane & 31);
    if (l == 0) {
      const float* xr = xrow(p, 0, m) + nw0;
#pragma unroll
      for (int nb = 0; nb < 2; nb++)
#pragma unroll
        for (int q = 0; q < 4; q++) xv[mb][nb][q] = *(const f32x4*)(xr + nb * 32 + 8 * q + 4 * h);
    } else {
      const h16* xr = p.x16 + (size_t)m * D + nw0;
#pragma unroll
      for (int nb = 0; nb < 2; nb++)
#pragma unroll
        for (int qp = 0; qp < 2; qp++) xraw[mb][nb][qp] = *(const u32x4*)(xr + nb * 32 + 8 * (2 * qp + h));
    }
  }
  float* ecst = (float*)(lds + G_LDS);
  __syncthreads();
  if (TIDX < 128) {
    const float* md = p.modv + ((size_t)l * NCV + cv) * 3072; const int c = n0 + TIDX;
    ecst[TIDX] = md[2048 + c];
    ecst[128 + TIDX] = l < 3 ? p.norm_w[(l + 1) * D + c] * (1.f + p.modv[((size_t)(l + 1) * NCV + cv) * 3072 + 1024 + c]) : 0.f;
  }
  if (wait_flag) hf_wait_all(1, 256u, [&](int) { return wait_flag; });
  if (l > 0) {
#pragma unroll
    for (int mb = 0; mb < 2; mb++)
#pragma unroll
      for (int nb = 0; nb < 2; nb++)
#pragma unroll
        for (int qp = 0; qp < 2; qp++) {
          const u32x4 r = xraw[mb][nb][qp];
          auto s0 = __builtin_amdgcn_permlane32_swap(r[0], r[2], false, false);
          auto s1 = __builtin_amdgcn_permlane32_swap(r[1], r[3], false, false);
          union { unsigned u[2]; h16x4 v; } a, b; a.u[0] = s0[0]; a.u[1] = s1[0]; b.u[0] = s0[1]; b.u[1] = s1[1];
          xv[mb][nb][2 * qp] = (f32x4){(float)a.v[0], (float)a.v[1], (float)a.v[2], (float)a.v[3]};
          xv[mb][nb][2 * qp + 1] = (f32x4){(float)b.v[0], (float)b.v[1], (float)b.v[2], (float)b.v[3]};
        }
  }
  f32x16 acc[2][2];
  gemm_tile<true>(p.O16, M, (p.wout16 + (size_t)l * D * D), 1024, D, m0, n0, lds, acc);
  const float* gate = ecst + wn * 64; const float* nn = ecst + 128 + wn * 64;
#pragma unroll
  for (int mb = 0; mb < 2; mb++) {
    const int m = m0 + wm * 64 + mb * 32 + (lane & 31);
    float* yr = p.Y + (size_t)m * D + nw0;
    float ss = 0;
#pragma unroll
    for (int nb = 0; nb < 2; nb++) {
      h16x4 xh[4], oh[4];
#pragma unroll
      for (int q = 0; q < 4; q++) {
        const int j = nb * 32 + 8 * q + 4 * h;
        f32x4 x = xv[mb][nb][q], g = *(const f32x4*)(gate + j), o;
#pragma unroll
        for (int e = 0; e < 4; e++) { o[e] = x[e] + g[e] * acc[mb][nb][q * 4 + e]; ss += o[e] * o[e]; }
        if (!dry && l == 3) *(f32x4*)(yr + j) = o;
        f32x4 nv = *(const f32x4*)(nn + j);
#pragma unroll
        for (int e = 0; e < 4; e++) { xh[q][e] = (h16)o[e]; oh[q][e] = (h16)(o[e] * nv[e]); }
      }
      if (l < 3 && !dry) {
        store_quads16(xh, h, [&](int c) { return p.x16 + (size_t)m * D + nw0 + nb * 32 + c; });
        store_quads16(oh, h, [&](int c) { return p.xs16 + pidx(M, m, nw0 + nb * 32 + c); });
      }
    }
    if (l < 3 && !dry) { ss = wsum32(ss); if (h == 0) atomicAdd(p.rowss_l + (size_t)(l + 1) * M + m, ss); }
  }
}
struct AttnItem {
  const h16 *k0, *k1; int kld;
  const h16 *v0, *v1;
  int kr0, nt0, kr1, nt1;
};
constexpr int A_RING = 3 * 32768;

template <int DQK, int NKI, int NVI, int NDB, bool NAMASK>
DEVFN void attn_core(const AttnItem& it, const h16* qptr, int qpitch, int ksel, int ta, int tb, const float* rpbl, int na_dr0  , int na_c,
                     char* lds, f32x16 (&o)[NDB], float& lsum_out, const h16* gptr, h16x4 (&gpre)[8]) {
  const int TIDX = tid_op();
  constexpr int NIMG = NKI + NVI; constexpr int STG = NIMG * 8192;
  constexpr int RD = NIMG == 2 ? 6 : 3;
  const int tid = TIDX, lane = tid & 63, h = lane >> 5;
  h16x8 qf[DQK / 16];
#pragma unroll
  for (int ks = 0; ks < DQK / 16; ks++) qf[ks] = *(const h16x8*)(qptr + (size_t)(lane & 31) * qpitch + ks * 16 + 8 * h);
#pragma unroll
  for (int db = 0; db < NDB; db++)
#pragma unroll
    for (int r = 0; r < 16; r++) o[db][r] = 0.f;
  float m_run = 0.f, lsum = 0.f; bool first = true;
  const int nt = it.nt0 + it.nt1;
  auto stage = [&](int t) {
    char* s = lds + (t % RD) * STG; const int kr = t < it.nt0 ? it.kr0 + 64 * t : it.kr1 + 64 * (t - it.nt0);
    stage_rows<64>(it.k0 + (size_t)kr * it.kld, it.kld, s, tid);
    if (NKI == 2) stage_rows<64>(it.k1 + (size_t)kr * it.kld, it.kld, s + 8192, tid);
    stage_rows<64>(it.v0 + (size_t)(kr >> 6) * (512 * 64), 64, s + NKI * 8192, tid);
    if (NVI == 2) stage_rows<64>(it.v1 + (size_t)(kr >> 6) * (512 * 64), 64, s + NKI * 8192 + 8192, tid);
  };
  stage(0); if (nt > 1) stage(1);
  if (RD == 6) { if (nt > 2) stage(2); if (nt > 3) stage(3); }
  const int l5 = lane & 31;
  const int prow = (l5 & 19) | ((l5 & 4) << 1) | ((l5 & 8) >> 1);
  int na_cs = na_c - 8; na_cs = na_cs < 0 ? 0 : (na_cs > GW - 16 ? GW - 16 : na_cs);
  for (int t = 0; t < nt; t++) {
    if (RD == 6) {
      if ((t & 1) == 0) {
        const int rem = nt - 1 - t;
        if (rem >= 3) WAITV(4); else if (rem == 2) WAITV(2); else WAITV(0);
        RAWBAR();
        if (t + 4 < nt) stage(t + 4);
        if (t + 5 < nt) stage(t + 5);
      }
    } else {
    if (t + 1 < nt) { if (NIMG == 3) WAITV(3); else WAITV(4); } else WAITV(0);
    RAWBAR();
    if (t + 2 < nt) stage(t + 2);
    }
    if (NDB == 2 && gptr != nullptr && t == nt - 1) {
#pragma unroll
      for (int gq = 0; gq < 8; gq++) gpre[gq] = *(const h16x4*)(gptr + 32 * (gq >> 2) + 8 * (gq & 3) + 4 * h);
    }
    const bool active = (t >= it.nt0) || (t >= ta && t < tb);
    if (active) {
      const char* s = lds + (t % RD) * STG;
      const char* sv = s + NKI * 8192;
      h16x8 kf[2][DQK / 16];
#pragma unroll
      for (int kb = 0; kb < 2; kb++)
#pragma unroll
        for (int ks = 0; ks < DQK / 16; ks++) {
          const int img = (DQK == 96) ? (ks >> 2) : ksel;
          kf[kb][ks] = *(const h16x8*)(s + img * 8192 + img_off(32 * kb + prow, 2 * (ks & 3) + h));
        }
      __builtin_amdgcn_sched_barrier(0);
      f32x16 st[2];
#pragma unroll
      for (int kb = 0; kb < 2; kb++) {
#pragma unroll
        for (int r = 0; r < 16; r++) st[kb][r] = -m_run;
#pragma unroll
        for (int ks = 0; ks < DQK / 16; ks++) st[kb] = __builtin_amdgcn_mfma_f32_32x32x16_f16(kf[kb][ks], qf[ks], st[kb], 0, 0, 0);
      }
      __builtin_amdgcn_sched_barrier(0);
      h16x8 vf[2][4];
#pragma unroll
      for (int db = 0; db < 2; db++)
#pragma unroll
        for (int sI = 0; sI < 4; sI++) vf[db][sI] = *(const h16x8*)(sv + img_off(db * 32 + l5, 2 * sI + h));
      __builtin_amdgcn_sched_barrier(0);
      if (NAMASK && t < it.nt0) {
        const int drow = (na_dr0 + t) * 31 + 15 - na_c;
#pragma unroll
        for (int kb = 0; kb < 2; kb++)
#pragma unroll
          for (int r = 0; r < 16; r++) {
            const int kcol = 32 * kb + (r & 7) + 8 * h + 16 * (r >> 3);
            const bool valid = (unsigned)(kcol - na_cs) < 16u;
            const float bv = rpbl[valid ? drow + kcol : 0];
            st[kb][r] = valid ? st[kb][r] + bv : -1e30f;
          }
      }
      float mx;
      {
        float m0 = max3f(st[0][0], st[0][1], st[0][2]), m1 = max3f(st[1][0], st[1][1], st[1][2]);
#pragma unroll
        for (int r = 3; r < 15; r += 2) { m0 = max3f(m0, st[0][r], st[0][r + 1]); m1 = max3f(m1, st[1][r], st[1][r + 1]); }
        mx = max3f(m0, m1, st[0][15]); mx = fmaxf(mx, st[1][15]);
      }
      { auto sw = __builtin_amdgcn_permlane32_swap(__float_as_uint(mx), __float_as_uint(mx), false, false); mx = fmaxf(__uint_as_float(sw[0]), __uint_as_float(sw[1])); }
      if (first || !__all(mx <= 8.f)) {
        const float delta = first ? mx : fmaxf(mx, 0.f);
        const float al = __builtin_amdgcn_exp2f(-delta); m_run += delta; lsum *= al; first = false;
#pragma unroll
        for (int db = 0; db < NDB; db++)
#pragma unroll
          for (int r = 0; r < 16; r++) o[db][r] *= al;
#pragma unroll
        for (int kb = 0; kb < 2; kb++)
#pragma unroll
          for (int r = 0; r < 16; r++) st[kb][r] -= delta;
      }
      float sum = 0.f;
#pragma unroll
      for (int kb = 0; kb < 2; kb++)
#pragma unroll
        for (int r = 0; r < 16; r++) { float pe = __builtin_amdgcn_exp2f(st[kb][r]); st[kb][r] = pe; sum += pe; }
      lsum += sum;
      h16x8 pf[4];
#pragma unroll
      for (int sI = 0; sI < 4; sI++) {
        u32x4 pk;
#pragma unroll
        for (int j = 0; j < 4; j++) pk[j] = __builtin_bit_cast(unsigned, __builtin_amdgcn_cvt_pkrtz(st[sI >> 1][8 * (sI & 1) + 2 * j], st[sI >> 1][8 * (sI & 1) + 2 * j + 1]));
        pf[sI] = __builtin_bit_cast(h16x8, pk);
      }
      __builtin_amdgcn_sched_barrier(0);
      if (NDB == 4) {
        h16x8 vg[2][4];
#pragma unroll
        for (int db = 0; db < 2; db++)
#pragma unroll
          for (int sI = 0; sI < 4; sI++) vg[db][sI] = *(const h16x8*)(sv + 8192 + img_off(db * 32 + l5, 2 * sI + h));
#pragma unroll
        for (int db = 0; db < 2; db++)
#pragma unroll
          for (int sI = 0; sI < 4; sI++) o[db] = __builtin_amdgcn_mfma_f32_32x32x16_f16(vf[db][sI], pf[sI], o[db], 0, 0, 0);
#pragma unroll
        for (int db = 0; db < 2; db++)
#pragma unroll
          for (int sI = 0; sI < 4; sI++) o[NDB == 4 ? 2 + db : db] = __builtin_amdgcn_mfma_f32_32x32x16_f16(vg[db][sI], pf[sI], o[NDB == 4 ? 2 + db : db], 0, 0, 0);
      } else {
#pragma unroll
        for (int db = 0; db < 2; db++)
#pragma unroll
          for (int sI = 0; sI < 4; sI++) o[db] = __builtin_amdgcn_mfma_f32_32x32x16_f16(vf[db][sI], pf[sI], o[db], 0, 0, 0);
      }
      __builtin_amdgcn_sched_barrier(0);
    }
  }
  RAWBAR();
  lsum_out = lsum + __shfl_xor(lsum, 32);
}
template <int NDB>
DEVFN void attn_store_gated(const Params& p, const f32x16 (&o)[NDB], float inv, int m, int col0, unsigned* flag, const h16x4* gpre = nullptr) {
  const int TIDX = tid_op();
  const int h = (TIDX & 63) >> 5;
#pragma unroll
  for (int db = 0; db < NDB; db++) {
    h16x4 ov[4];
#pragma unroll
    for (int q = 0; q < 4; q++) {
      const int c = col0 + 32 * db + 8 * q + 4 * h;
      h16x4 g = gpre ? gpre[db * 4 + q] : *(const h16x4*)(p.gates16 + (size_t)m * 1024 + c);
#pragma unroll
      for (int e = 0; e < 4; e++) ov[q][e] = (h16)(o[db][q * 4 + e] * inv * (float)g[e]);
    }
    store_o16_wt(p, m, col0 + 32 * db, ov, h);
  }
  hf_publish_n(flag, NDB, TIDX & 63);
}
DEVFN void attn_even_item(const Params& p, int l, int item, char* lds) {
  const int TIDX = tid_op();
  const int i = l >> 1; const int lane = TIDX & 63, w = TIDX >> 6, h = lane >> 5;
  const int grp = item >> 7, j0 = item & 127; const bool smp = grp < 2; const bool isdiff = (grp & 1) == 0;
  const int xx = j0 & 7, kk = j0 >> 3;
  const int j = !smp ? j0 : (isdiff ? ((xx << 4) | kk) : (((xx * 2 + (kk >> 3)) << 3) | (kk & 7)));
  AttnItem it{}; it.nt1 = 0; it.kr1 = 0;
  if (isdiff) {
    int b, hh, t0;
    if (smp) { b = j >> 6; hh = (j >> 4) & 3; t0 = (j & 15) * 128; it.kr0 = MP + b * TKS; it.nt0 = TKS / 64; }
    else { b = j >> 3; hh = (j >> 1) & 3; t0 = (j & 1) * 128; it.kr0 = b * SEQ; it.nt0 = SEQ / 64; }
    const int comp = w >> 2;
    const int m0w = (smp ? MP + b * DS : b * SEQ) + t0 + (w & 3) * 32;
    it.k0 = p.KB + (size_t)(2 * hh) * KM * 64; it.k1 = p.KB + (size_t)(2 * hh + 1) * KM * 64; it.kld = 64;
    it.v0 = p.VB + (size_t)(hh * 128) * 64; it.v1 = p.VB + (size_t)(hh * 128 + 64) * 64;
    f32x16 o[4]; float lsum;
    h16x4 gdummy[8];
    attn_core<64, 2, 2, 4, false>(it, p.QB + ((size_t)m0w * 8 + 2 * hh + comp) * 64, 512, comp, 0, 1 << 30, nullptr, 0, 0, lds, o, lsum, nullptr, gdummy);
    const float inv = 1.f / lsum;
    float* a2 = (float*)lds + (size_t)(w & 3) * 32 * 132 + (size_t)(lane & 31) * 132;
    if (comp == 1) {
#pragma unroll
      for (int db = 0; db < 4; db++)
#pragma unroll
        for (int q = 0; q < 4; q++) { f32x4 v = {o[db][q * 4] * inv, o[db][q * 4 + 1] * inv, o[db][q * 4 + 2] * inv, o[db][q * 4 + 3] * inv}; *(f32x4*)(a2 + 32 * db + 8 * q + 4 * h) = v; }
    }
    __syncthreads();
    if (comp == 0) {
      const float lam = p.lamv[i]; const float lam_init = 0.8f - 0.6f * expf(-0.3f * l);
      float ss = 0;
#pragma unroll
      for (int db = 0; db < 4; db++)
#pragma unroll
        for (int q = 0; q < 4; q++) {
          f32x4 v2 = *(const f32x4*)(a2 + 32 * db + 8 * q + 4 * h);
#pragma unroll
          for (int e = 0; e < 4; e++) { float d = o[db][q * 4 + e] * inv - lam * v2[e]; o[db][q * 4 + e] = d; ss += d * d; }
        }
      ss = wsum32(ss);
      const float rr = (1.f - lam_init) * frsq(ss * (1.f / 128.f) + EPSN);
      const int m = m0w + (lane & 31);
#pragma unroll
      for (int db = 0; db < 4; db++) {
        h16x4 ov[4];
#pragma unroll
        for (int q = 0; q < 4; q++) {
          const int dv = 32 * db + 8 * q + 4 * h; const int c = 512 + hh * 128 + dv;
          f32x4 sg = *(const f32x4*)(p.diff_subln + i * 128 + dv);
          h16x4 g = *(const h16x4*)(p.gates16 + (size_t)m * 1024 + c);
#pragma unroll
          for (int e = 0; e < 4; e++) ov[q][e] = (h16)(o[db][q * 4 + e] * rr * sg[e] * (float)g[e]);
        }
        store_o16_wt(p, m, 512 + hh * 128 + 32 * db, ov, h);
      }
      hf_publish_n(hf2_flag(p, l, m0w >> 8), 4u, lane);
    }
    __syncthreads();
  } else {
    int b, head, t0;
    if (smp) { b = j >> 6; head = (j >> 3) & 7; t0 = (j & 7) * 256; it.kr0 = MP + b * TKS; it.nt0 = TKS / 64; }
    else { b = j >> 3; head = j & 7; t0 = 0; it.kr0 = b * SEQ; it.nt0 = SEQ / 64; }
    const int m0w = (smp ? MP + b * DS : b * SEQ) + t0 + w * 32;
    it.k0 = p.KA + (size_t)head * KM * 128; it.k1 = it.k0 + 64; it.kld = 128;
    it.v0 = p.VA + (size_t)(head * 64) * 64; it.v1 = it.v0;
    f32x16 o[2]; float lsum;
    h16x4 gpre[8];
    attn_core<96, 2, 1, 2, false>(it, p.QA + ((size_t)m0w * 8 + head) * 96, 768, 0, 0, 1 << 30, nullptr, 0, 0, lds, o, lsum, p.gates16 + (size_t)(m0w + (lane & 31)) * 1024 + head * 64, gpre);
    attn_store_gated<2>(p, o, 1.f / lsum, m0w + (lane & 31), head * 64, hf2_flag(p, l, m0w >> 8), gpre);
  }
}
DEVFN void attn_odd_item(const Params& p, int l, int item, char* lds) {
  const int TIDX = tid_op();
  const int i = l >> 1; const int lane = TIDX & 63, w = TIDX >> 6;
  const int grp = item >> 7, j0 = item & 127; const bool smp = grp < 2; const bool isgqa = (grp & 1) == 0;
  const int xx = j0 & 7, kk = j0 >> 3;
  const int j = !smp ? j0 : (isgqa ? (((xx >> 1) << 5) | ((xx & 1) << 4) | kk) : (((xx * 2 + (kk >> 3)) << 3) | (kk & 7)));
  AttnItem it{}; it.nt1 = 0; it.kr1 = 0; it.kld = 64;
  f32x16 o[2]; float lsum;
  if (isgqa) {
    int b, kvh, t0;
    if (smp) { b = j >> 6; kvh = (j >> 5) & 1; t0 = (j & 31) * 64; it.kr0 = MP + b * TKS; it.nt0 = TKS / 64; }
    else { b = j >> 3; kvh = (j >> 2) & 1; t0 = (j & 3) * 64; it.kr0 = b * SEQ; it.nt0 = SEQ / 64; }
    const int head = kvh * 4 + (w >> 1);
    const int m0w = (smp ? MP + b * DS : b * SEQ) + t0 + (w & 1) * 32;
    it.k0 = p.KB + (size_t)kvh * KM * 64; it.k1 = it.k0; it.v0 = p.VB + (size_t)(kvh * 64) * 64; it.v1 = it.v0;
    h16x4 gpre[8];
    attn_core<64, 1, 1, 2, false>(it, p.QB + ((size_t)m0w * 8 + head) * 64, 512, 0, 0, 1 << 30, nullptr, 0, 0, lds, o, lsum, p.gates16 + (size_t)(m0w + (lane & 31)) * 1024 + 512 + head * 64, gpre);
    attn_store_gated<2>(p, o, 1.f / lsum, m0w + (lane & 31), 512 + head * 64, hf2_flag(p, l, m0w >> 8), gpre);
  } else if (!smp) {
    const int b = j >> 3, head = j & 7; it.kr0 = b * SEQ; it.nt0 = SEQ / 64;
    const int m0w = b * SEQ + w * 32;
    it.k0 = p.KA + (size_t)head * KM * 64; it.k1 = it.k0; it.v0 = p.VA + (size_t)(head * 64) * 64; it.v1 = it.v0;
    h16x4 gpre[8];
    attn_core<64, 1, 1, 2, false>(it, p.QA + ((size_t)m0w * 8 + head) * 64, 512, 0, 0, 1 << 30, nullptr, 0, 0, lds, o, lsum, p.gates16 + (size_t)(m0w + (lane & 31)) * 1024 + head * 64, gpre);
    attn_store_gated<2>(p, o, 1.f / lsum, m0w + (lane & 31), head * 64, hf2_flag(p, l, m0w >> 8), gpre);
  } else {
    const int b = j >> 6, head = (j >> 3) & 7, r0 = (j & 7) * 4;
    const int r = r0 + (w >> 1), c0 = (w & 1) * 32;
    auto rsf = [](int rr) { int s = rr - 4; return s < 0 ? 0 : (s > GROWS - 8 ? GROWS - 8 : s); };
    const int rlo = rsf(r0), rhi = rsf(r0 + 3) + 8;
    const int kbase = MP + b * TKS;
    it.kr0 = kbase + rlo * 64; it.nt0 = rhi - rlo; it.kr1 = kbase + DS; it.nt1 = PAST / 64;
    it.k0 = p.KA + (size_t)head * KM * 64; it.k1 = it.k0; it.v0 = p.VA + (size_t)(head * 64) * 64; it.v1 = it.v0;
    float* rpbl = (float*)(lds + A_RING);
    { const float* src = p.na_rpb + ((size_t)i * 8 + head) * 465; for (int k = TIDX; k < 465; k += 512) rpbl[k] = src[k] * LOG2E; }
    const int m0w = MP + b * DS + r * 64 + c0;
    const int ta = rsf(r) - rlo;
    h16x4 gpre[8];
    attn_core<64, 1, 1, 2, true>(it, p.QA + ((size_t)m0w * 8 + head) * 64, 512, 0, ta, ta + 8, rpbl, rlo - r + 7, c0 + (lane & 31), lds, o, lsum, p.gates16 + (size_t)(m0w + (lane & 31)) * 1024 + head * 64, gpre);
    attn_store_gated<2>(p, o, 1.f / lsum, m0w + (lane & 31), head * 64, hf2_flag(p, l, m0w >> 8), gpre);
  }
}
constexpr int G8_HTB = 128 * 64 * 2, G8_STAGE = 8 * G8_HTB;
DEVFN int g8_lds_byte(int r, int c) { const int st = (r >> 4) * 2 + (c >> 5), rr = r & 15, cc = c & 31, ob = rr * 64 + cc * 2; return st * 1024 + (ob ^ (((ob >> 9) & 1) << 5)); }
DEVFN void g8_stage_rc(int b, int& R, int& C) { const int st = b / 1024, sb = b % 1024, swz = sb ^ (((sb >> 9) & 1) << 5); R = (st >> 1) * 16 + swz / 64; C = (st & 1) * 32 + (swz % 64) / 2; }
DEVFN int g8_perm32(int rho) { const int n = rho >> 4, i = rho & 15; return 8 * (i >> 2) + 4 * n + (i & 3); }
struct G8Unit { int pm, pn; };
DEVFN bool g8_next(int i, int nM, int nN, int G, int c, G8Unit& u) {
  const int nwg = nM * nN; const long L = (long)i * G + c; if (L >= nwg) return false;
  int wgid = (int)L; { const int q = nwg / 8, r = nwg % 8, xcd = wgid % 8, off = wgid / 8; wgid = (xcd < r ? xcd * (q + 1) : r * (q + 1) + (xcd - r) * q) + off; }
  const int nig = 8 * nN, gid = wgid / nig, fm = gid * 8, gsz = (nM - fm) < 8 ? (nM - fm) : 8;
  u.pm = fm + ((wgid % nig) % gsz); u.pn = (wgid % nig) / gsz;
  if (nM == 32) u.pm = 4 * (u.pm & 7) + (u.pm >> 3);
  return true;
}
template <class Epi>
DEVFN void gemm8_phase(LAS unsigned char* lds, const h16* A, int RA, const h16* Bt, int RB, int K, int nM, int nN, const Epi& E) {
  const int tid = tid_op(), wid = __builtin_amdgcn_readfirstlane(tid >> 6), lane = tid & 63, wr = wid >> 2, wc = wid & 3, fr = lane & 15, fq = lane >> 4;
  const int nt = K / 64; const int Gg = gridDim.x, cc = blockIdx.x;
  unsigned voffA[2], voffB[2];
#pragma unroll
  for (int i = 0; i < 2; ++i) { int R, C; g8_stage_rc(tid * 16 + i * 8192, R, C); const int Rb = (R & ~31) + g8_perm32(R & 31);
    voffA[i] = (unsigned)(R * 64 + C) * 2u; voffB[i] = (unsigned)(Rb * 64 + C) * 2u; }
  const size_t kstepA = (size_t)RA * 128, kstepB = (size_t)RB * 128;
  const size_t hstep = (size_t)128 * 128;
  const size_t tstep = 2 * hstep;
  const unsigned ldsw = (unsigned)wid * 1024u;
  const int aoff = g8_lds_byte(wr * 64 + fr, fq * 8), boff = g8_lds_byte(wc * 32 + fr, fq * 8);
#define G8_SA(b, h) (((b) * 2 + (h)) * G8_HTB)
#define G8_SB(b, h) ((4 + (b) * 2 + (h)) * G8_HTB)
#define G8_STAGE_(bufoff, gbase, voff) do { _Pragma("unroll") for (int _i = 0; _i < 2; ++_i) \
    __builtin_amdgcn_global_load_lds((const unsigned*)((const char*)(gbase) + (voff)[_i]), (LAS unsigned*)(lds + (bufoff) + ldsw + _i * 8192), 16, 0, 0); } while (0)
#define G8_LDA(dst, b, h) do { _Pragma("unroll") for (int m = 0; m < 4; ++m) _Pragma("unroll") for (int k = 0; k < 2; ++k) dst[m][k] = *(const LAS h16x8*)(lds + G8_SA(b, h) + aoff + m * 2048 + k * 1024); } while (0)
#define G8_LDB(dst, b, h) do { _Pragma("unroll") for (int n = 0; n < 2; ++n) _Pragma("unroll") for (int k = 0; k < 2; ++k) dst[n][k] = *(const LAS h16x8*)(lds + G8_SB(b, h) + boff + n * 2048 + k * 1024); } while (0)
#define G8_MMA(ai, bj, At, Bt_) do { __builtin_amdgcn_s_setprio(1); _Pragma("unroll") for (int m = 0; m < 4; ++m) _Pragma("unroll") for (int n = 0; n < 2; ++n) _Pragma("unroll") for (int k = 0; k < 2; ++k) \
    acc[ai][bj][m][n] = __builtin_amdgcn_mfma_f32_16x16x32_f16(Bt_[n][k], At[m][k], acc[ai][bj][m][n], 0, 0, 0); __builtin_amdgcn_s_setprio(0); } while (0)
#define G8_WAIT_L(n) asm volatile("s_waitcnt lgkmcnt(" #n ")" ::: "memory")
#define G8_BAR __builtin_amdgcn_s_barrier()
#define G8_SCHED __builtin_amdgcn_sched_barrier(0)
  G8Unit cur, nxt; int ui = 0;
  if (!g8_next(0, nM, nN, Gg, cc, cur)) return;
  f32x4 acc[2][2][4][2];
#pragma unroll
  for (int a = 0; a < 2; ++a)
#pragma unroll
    for (int b = 0; b < 2; ++b)
#pragma unroll
      for (int m = 0; m < 4; ++m)
#pragma unroll
        for (int n = 0; n < 2; ++n) acc[a][b][m][n] = (f32x4){0.f, 0.f, 0.f, 0.f};
  h16x8 At[4][2], B0[2][2], B1[2][2];
  const char* cA = (const char*)A + (size_t)cur.pm * tstep; const char* cB = (const char*)Bt + (size_t)cur.pn * tstep;
  G8_STAGE_(G8_SB(0, 0), cB, voffB); G8_STAGE_(G8_SA(0, 0), cA, voffA); G8_STAGE_(G8_SB(0, 1), cB + hstep, voffB); G8_STAGE_(G8_SA(0, 1), cA + hstep, voffA);
  if (wr == 1) G8_BAR;
  WAITV(4); G8_BAR;
  G8_STAGE_(G8_SB(1, 0), cB + kstepB, voffB); G8_STAGE_(G8_SA(1, 0), cA + kstepA, voffA); G8_STAGE_(G8_SB(1, 1), cB + hstep + kstepB, voffB);
  WAITV(6); G8_BAR;
  for (;;) {
    const bool has_next = g8_next(ui + 1, nM, nN, Gg, cc, nxt);
    const char* nA = has_next ? (const char*)A + (size_t)nxt.pm * tstep : cA; const char* nB = has_next ? (const char*)Bt + (size_t)nxt.pn * tstep : cB;
    for (int t = 0; t < nt; t += 2) {
      const bool last = (t == nt - 2);
      const char* a1 = cA + (size_t)(t + 1) * kstepA;
      const char* a2 = last ? nA : cA + (size_t)(t + 2) * kstepA; const char* b2 = last ? nB : cB + (size_t)(t + 2) * kstepB;
      const char* a3 = a2 + kstepA; const char* b3 = b2 + kstepB;
      G8_LDB(B0, 0, 0); G8_SCHED; G8_LDA(At, 0, 0); G8_STAGE_(G8_SA(1, 1), a1 + hstep, voffA);
      G8_WAIT_L(8); G8_BAR; G8_WAIT_L(0); G8_MMA(0, 0, At, B0); G8_BAR; G8_SCHED;
      G8_LDB(B1, 0, 1); G8_STAGE_(G8_SB(0, 0), b2, voffB);
      G8_BAR; G8_WAIT_L(0); G8_MMA(0, 1, At, B1); G8_BAR;
      G8_LDA(At, 0, 1); G8_STAGE_(G8_SA(0, 0), a2, voffA);
      G8_BAR; G8_WAIT_L(0); G8_MMA(1, 0, At, B0); G8_BAR; G8_SCHED;
      G8_STAGE_(G8_SB(0, 1), b2 + hstep, voffB);
      WAITV(6); G8_BAR; G8_MMA(1, 1, At, B1); G8_BAR;
      G8_LDB(B0, 1, 0); G8_SCHED; G8_LDA(At, 1, 0); G8_STAGE_(G8_SA(0, 1), a2 + hstep, voffA);
      G8_WAIT_L(8); G8_BAR; G8_WAIT_L(0); G8_MMA(0, 0, At, B0); G8_BAR; G8_SCHED;
      G8_LDB(B1, 1, 1); G8_STAGE_(G8_SB(1, 0), b3, voffB);
      G8_BAR; G8_WAIT_L(0); G8_MMA(0, 1, At, B1); G8_BAR;
      G8_LDA(At, 1, 1); G8_STAGE_(G8_SA(1, 0), a3, voffA);
      G8_BAR; G8_WAIT_L(0); G8_MMA(1, 0, At, B0); G8_BAR; G8_SCHED;
      G8_STAGE_(G8_SB(1, 1), b3 + hstep, voffB);
      WAITV(6); G8_BAR; G8_MMA(1, 1, At, B1); G8_BAR;
    }
#pragma unroll 1
    for (int e_ = 0; e_ < REP_EPI; e_++)
    E(acc, cur, wr, wc, fr, fq, e_ > 0);
    if (!has_next) break;
#pragma unroll
    for (int a = 0; a < 2; ++a)
#pragma unroll
      for (int b = 0; b < 2; ++b)
#pragma unroll
        for (int m = 0; m < 4; ++m)
#pragma unroll
          for (int n = 0; n < 2; ++n) acc[a][b][m][n] = (f32x4){0.f, 0.f, 0.f, 0.f};
    cur = nxt; cA = nA; cB = nB; ++ui;
  }
  WAITV(0);
  if (wr == 0) G8_BAR;
  G8_BAR;
#undef G8_SA
#undef G8_SB
#undef G8_STAGE_
#undef G8_LDA
#undef G8_LDB
#undef G8_MMA
#undef G8_WAIT_L
#undef G8_BAR
#undef G8_SCHED
}

DEVFN float fq_sum(float v) {
  auto a = __builtin_amdgcn_permlane16_swap(__float_as_uint(v), __float_as_uint(v), false, false); v = __uint_as_float(a[0]) + __uint_as_float(a[1]);
  auto b = __builtin_amdgcn_permlane32_swap(__float_as_uint(v), __float_as_uint(v), false, false); return __uint_as_float(b[0]) + __uint_as_float(b[1]);
}
struct InprojEpi {
  const Params& p; int l; bool dry; LAS unsigned char* scratch;
  DEVFN void operator()(const f32x4 (&acc)[2][2][4][2], const G8Unit& u_, int wr, int wc, int fr_, int fq_, bool dry2) const {
    int fr = fr_, fq = fq_; G8Unit u = u_;
    asm volatile("" : "+v"(fr), "+v"(fq), "+s"(u.pm), "+s"(u.pn));
    const int lane = fr + 16 * fq;
    const int i = l >> 1; const bool odd = l & 1;
    const int G = 4 * u.pn + wc;
    LAS unsigned char* tbase = scratch + (wr * 4 + wc) * 3072;
    const int m0 = u.pm * 256; const bool smp = m0 >= MP;
    enum { T_PAD, T_GATE, T_QHEAD, T_KHEAD, T_VT, T_QA, T_CKV, T_KPE };
    int ty = T_PAD, gcol = 0, head = 0, spitch = 0, scol = 0; bool rope = false; float oscale = 1.f;
    const float* gain = nullptr; float* state = nullptr; h16* qdst = nullptr; h16* kbuf = nullptr; h16* vbuf = nullptr;
    const float QS = LOG2E / 8.f;
    if (!odd) {
      if (G < 4) ty = T_QA;
      else if (G < 6) ty = T_CKV;
      else if (G == 6) { ty = T_KPE; gain = p.mla_kn_rope + i * 32; }
      else if (G == 7) ty = T_PAD;
      else if (G < 16) { ty = T_GATE; gcol = (G - 8) * 64; }
      else if (G < 24) { ty = T_QHEAD; head = G - 16; gain = p.diff_qn + i * 64; rope = true; oscale = QS; qdst = p.QB; }
      else if (G < 32) { ty = T_KHEAD; head = G - 24; gain = p.diff_kn + i * 64; rope = true; state = p.o_dk; spitch = 512; scol = head * 64; kbuf = p.KB; }
      else if (G < 40) { ty = T_VT; head = G - 32; state = p.o_dv; spitch = 512; scol = head * 64; vbuf = p.VB; }
      else { ty = T_GATE; gcol = 512 + (G - 40) * 64; }
    } else {
      if (G < 8) { ty = T_QHEAD; head = G; gain = p.na_qn + i * 64; oscale = QS; qdst = p.QA; }
      else if (G < 16) { ty = T_KHEAD; head = G - 8; gain = p.na_kn + i * 64; state = p.o_nk; spitch = 512; scol = head * 64; kbuf = p.KA; }
      else if (G < 24) { ty = T_VT; head = G - 16; state = p.o_nv; spitch = 512; scol = head * 64; vbuf = p.VA; }
      else if (G < 32) { ty = T_GATE; gcol = (G - 24) * 64; }
      else if (G < 40) { ty = T_QHEAD; head = G - 32; gain = p.gqa_qn + i * 64; rope = true; oscale = QS; qdst = p.QB; }
      else if (G < 42) { ty = T_KHEAD; head = G - 40; gain = p.gqa_kn + i * 64; rope = true; state = p.o_gk; spitch = 128; scol = head * 64; kbuf = p.KB; }
      else if (G < 44) { ty = T_VT; head = G - 42; state = p.o_gv; spitch = 128; scol = head * 64; vbuf = p.VB; }
      else { ty = T_GATE; gcol = 512 + (G - 44) * 64; }
    }
    const bool pub = !odd && u.pn < 2;
    if (ty == T_PAD) { if (pub) hf_publish(hf_flag(p, i, u.pn, u.pm), lane); return; }
    LAS float* cst = (LAS float*)(tbase + 2048);
    {
      const float* rowss = p.rowss_l + (size_t)l * M + m0 + 64 * wr;
      const float s0 = rowss[lane], s1 = rowss[128 + lane];
      const float bv = p.biasv[((size_t)l * NCV + tok_cv(m0)) * NPO + 256 * u.pn + 32 * wc + 128 * (lane >> 5) + (lane & 31)];
      const bool hasg = gain != nullptr && (ty != T_KPE || lane < 32);
      const float gv = hasg ? gain[lane] : 1.f;
      cst[lane] = frsq(s0 * (1.f / D) + EPSN); cst[64 + lane] = frsq(s1 * (1.f / D) + EPSN);
      cst[128 + lane] = bv; cst[192 + lane] = gv;
    }
    const bool roped = rope && smp;
    float invf[2][4];
    if (roped || (ty == T_KPE && smp)) {
      const float step = ty == T_KPE ? (2.f / 16.f) : (2.f / 32.f);
#pragma unroll
      for (int n = 0; n < 2; n++)
#pragma unroll
        for (int j = 0; j < 4; j++) {
          const int jj = ty == T_KPE ? (8 * (fq & 1) + 4 * n + j) & 7 : (8 * fq + 4 * n + j) & 15;
          invf[n][j] = __builtin_amdgcn_exp2f(-13.287712379549449f * step * (float)jj) * 0.15915494309189535f;
        }
    }
#pragma unroll
    for (int ai = 0; ai < 2; ai++)
#pragma unroll
      for (int m = 0; m < 4; m++) {
        const int r = m0 + 128 * ai + 64 * wr + 16 * m + fr;
        const float rs = cst[ai * 64 + m * 16 + fr];
        float v[2][2][4];
#pragma unroll
        for (int bj = 0; bj < 2; bj++)
#pragma unroll
          for (int n = 0; n < 2; n++) {
            const f32x4 b = *(const LAS f32x4*)(cst + 128 + 32 * bj + 8 * fq + 4 * n);
#pragma unroll
            for (int j = 0; j < 4; j++) v[bj][n][j] = acc[ai][bj][m][n][j] * rs + b[j];
          }
        float c2[2][4], s2[2][4];
        if (roped) {
          const int t = tok_pos(r); const float base = (float)(fq < 2 ? (t >> 6) : (t & 63));
#pragma unroll
          for (int n = 0; n < 2; n++)
#pragma unroll
            for (int j = 0; j < 4; j++) { const float x = base * invf[n][j]; c2[n][j] = __builtin_amdgcn_cosf(x); s2[n][j] = __builtin_amdgcn_sinf(x); }
        }
        if (ty == T_GATE) {
#pragma unroll
          for (int bj = 0; bj < 2; bj++) {
            h16x8 o;
#pragma unroll
            for (int n = 0; n < 2; n++)
#pragma unroll
              for (int j = 0; j < 4; j++) o[n * 4 + j] = (h16)fsilu(v[bj][n][j]);
            *(h16x8*)(p.gates16 + (size_t)r * 1024 + gcol + 32 * bj + 8 * fq) = o;
          }
        } else if (ty == T_QHEAD || ty == T_KHEAD) {
          float ss = 0;
#pragma unroll
          for (int bj = 0; bj < 2; bj++)
#pragma unroll
            for (int n = 0; n < 2; n++)
#pragma unroll
              for (int j = 0; j < 4; j++) ss += v[bj][n][j] * v[bj][n][j];
          ss = fq_sum(ss);
          const float rr = frsq(ss * (1.f / 64.f) + EPSN);
#pragma unroll
          for (int bj = 0; bj < 2; bj++)
#pragma unroll
            for (int n = 0; n < 2; n++) {
              const f32x4 g = *(const LAS f32x4*)(cst + 192 + 32 * bj + 8 * fq + 4 * n);
#pragma unroll
              for (int j = 0; j < 4; j++) v[bj][n][j] *= rr * g[j];
            }
          if (state && !smp) {
            float* sp = state + st_row(r, i) * spitch + scol + 8 * fq;
#pragma unroll
            for (int bj = 0; bj < 2; bj++)
#pragma unroll
              for (int n = 0; n < 2; n++) { f32x4 o = {v[bj][n][0], v[bj][n][1], v[bj][n][2], v[bj][n][3]}; *(f32x4*)(sp + 32 * bj + 4 * n) = o; }
          }
          if (roped) {
#pragma unroll
            for (int n = 0; n < 2; n++)
#pragma unroll
              for (int j = 0; j < 4; j++) { const float x1 = v[0][n][j], x2 = v[1][n][j]; v[0][n][j] = x1 * c2[n][j] - x2 * s2[n][j]; v[1][n][j] = x2 * c2[n][j] + x1 * s2[n][j]; }
          }
          h16* dst = ty == T_QHEAD ? qdst + ((size_t)r * 8 + head) * 64 : kbuf + ((size_t)head * KM + tok_keyrow(r)) * 64;
#pragma unroll
          for (int bj = 0; bj < 2; bj++) {
            h16x8 o;
#pragma unroll
            for (int n = 0; n < 2; n++)
#pragma unroll
              for (int j = 0; j < 4; j++) o[n * 4 + j] = (h16)(v[bj][n][j] * oscale);
            *(h16x8*)(dst + 32 * bj + 8 * fq) = o;
          }
        } else if (ty == T_VT) {
          const int kr = tok_keyrow(r);
          if (!smp) {
            float* sp = state + st_row(r, i) * spitch + scol + 8 * fq;
#pragma unroll
            for (int bj = 0; bj < 2; bj++)
#pragma unroll
              for (int n = 0; n < 2; n++) { f32x4 o = {v[bj][n][0], v[bj][n][1], v[bj][n][2], v[bj][n][3]}; *(f32x4*)(sp + 32 * bj + 4 * n) = o; }
          }
          {
            LAS h16* tb = (LAS h16*)(tbase);
#pragma unroll
            for (int bj = 0; bj < 2; bj++)
#pragma unroll
              for (int n = 0; n < 2; n++)
#pragma unroll
                for (int j = 0; j < 4; j++) tb[(32 * bj + 8 * fq + 4 * n + j) * 16 + fr] = (h16)v[bj][n][j];
            const h16x8 lo = *(const LAS h16x8*)(tb + lane * 16), hi = *(const LAS h16x8*)(tb + lane * 16 + 8);
            h16* dstv = vbuf + vidx(head * 64 + lane, kr - fr);
            *(h16x8*)dstv = lo; *(h16x8*)(dstv + 8) = hi;
          }
        } else if (ty == T_QA) {
          float ss = 0;
#pragma unroll
          for (int bj = 0; bj < 2; bj++) {
            h16x8 o;
#pragma unroll
            for (int n = 0; n < 2; n++)
#pragma unroll
              for (int j = 0; j < 4; j++) { o[n * 4 + j] = (h16)v[bj][n][j]; const float xr = (float)o[n * 4 + j]; ss += xr * xr; }
            st16_wt(p.qa16 + pidx(M, r, 64 * G + 32 * bj + 8 * fq), o);
          }
          ss = fq_sum(ss);
          if (fq == 0 && !dry && !dry2) atomicAdd(p.rowss_qa + (size_t)i * M + r, ss);
        } else if (ty == T_CKV) {
          const int kr = tok_keyrow(r);
          float ss = 0;
#pragma unroll
          for (int bj = 0; bj < 2; bj++) {
            h16x8 o;
#pragma unroll
            for (int n = 0; n < 2; n++)
#pragma unroll
              for (int j = 0; j < 4; j++) { o[n * 4 + j] = (h16)v[bj][n][j]; const float xr = (float)o[n * 4 + j]; ss += xr * xr; }
            st16_wt(p.ckv16 + pidx(KM, kr, 64 * (G - 4) + 32 * bj + 8 * fq), o);
          }
          ss = fq_sum(ss);
          if (fq == 0 && !dry && !dry2) atomicAdd(p.rowss_ckv + (size_t)i * KM + kr, ss);
        } else {
          float ss = 0;
#pragma unroll
          for (int n = 0; n < 2; n++)
#pragma unroll
            for (int j = 0; j < 4; j++) ss += v[0][n][j] * v[0][n][j];
          ss = fq_sum(ss);
          const float rr = frsq(ss * (1.f / 32.f) + EPSN);
          float w[2][4];
#pragma unroll
          for (int n = 0; n < 2; n++) {
            const f32x4 g = *(const LAS f32x4*)(cst + 192 + 8 * fq + 4 * n);
#pragma unroll
            for (int j = 0; j < 4; j++) w[n][j] = v[0][n][j] * rr * g[j];
          }
          if (!smp) {
            float* sp = p.o_kpe + st_row(r, i) * 32 + 8 * fq;
#pragma unroll
            for (int n = 0; n < 2; n++) { f32x4 o = {w[n][0], w[n][1], w[n][2], w[n][3]}; *(f32x4*)(sp + 4 * n) = o; }
          } else {
            const int t = tok_pos(r); const float base = (float)((fq & 1) == 0 ? (t >> 6) : (t & 63));
#pragma unroll
            for (int n = 0; n < 2; n++)
#pragma unroll
              for (int j = 0; j < 4; j++) {
                const float x = base * invf[n][j]; const float c = __builtin_amdgcn_cosf(x), s = __builtin_amdgcn_sinf(x);
                const float own = w[n][j], oth = __shfl_xor(own, 32);
                w[n][j] = fq < 2 ? own * c - oth * s : own * c + oth * s;
              }
          }
          h16x8 o;
#pragma unroll
          for (int n = 0; n < 2; n++)
#pragma unroll
            for (int j = 0; j < 4; j++) o[n * 4 + j] = (h16)w[n][j];
          st16_wt(p.kpe16 + (size_t)tok_keyrow(r) * 32 + 8 * fq, o);
        }
      }
    if (pub) hf_publish(hf_flag(p, i, u.pn, u.pm), lane);
  }
};
struct NullEpi {
  DEVFN void operator()(const f32x4 (&acc)[2][2][4][2], const G8Unit&, int, int, int, int, bool) const {
#pragma unroll
    for (int a = 0; a < 2; a++)
#pragma unroll
      for (int b = 0; b < 2; b++)
#pragma unroll
        for (int m = 0; m < 4; m++) asm volatile("" :: "v"(acc[a][b][m][0]), "v"(acc[a][b][m][1]));
  }
};
DEVFN int inproj_pos_col(int np) { const int pn = np >> 8, bj = (np >> 7) & 1, wc = (np >> 5) & 3, g = np & 31; return 64 * (4 * pn + wc) + 32 * bj + g; }

#define XB_TMO      128
#define XB_XCNT(j)  (256  + 64 * (j))
#define XB_XSUB(j)  (1280 + 64 * (j))
#define XB_XGEN(j)  (2304 + 64 * (j))
#define XB_TOP      3328
#define XB_TOPGEN   3392
#define XCD_BAR_WORDS 3456
#define XB_SPIN_CAP (1u << 20)
DEVFN unsigned xb_ld(unsigned* p) { return __hip_atomic_load(p, __ATOMIC_RELAXED, __HIP_MEMORY_SCOPE_AGENT); }
DEVFN unsigned xb_add(unsigned* p, unsigned v) { return __hip_atomic_fetch_add(p, v, __ATOMIC_RELAXED, __HIP_MEMORY_SCOPE_AGENT); }
DEVFN unsigned xb_xcc_id() { return (unsigned)__builtin_amdgcn_s_getreg((3 << 11) | 20) & 0xFu; }
#define XB_SPIN(cond, bar) do { unsigned _sp = 0; while (cond) { __builtin_amdgcn_s_sleep(1); \
    if ((++_sp & 255u) == 0u) { if (xb_ld(&(bar)[XB_TMO])) break; if (_sp > XB_SPIN_CAP) { atomicAdd(&(bar)[XB_TMO], 1u); break; } } } } while (0)
struct XcdBarrier { unsigned* bar; unsigned x; volatile LAS unsigned* st; };
DEVFN XcdBarrier xcd_barrier_post(unsigned* bar, volatile LAS unsigned* st) {
  const int TIDX = tid_op();
  XcdBarrier b; b.bar = bar; b.x = xb_xcc_id(); b.st = st;
  if (TIDX == 0) (void)xb_add(&bar[XB_XCNT(b.x)], 1u);
  return b;
}
DEVFN void xcd_barrier_complete(unsigned* bar, unsigned x, unsigned& nloc, unsigned& nx) {
  const unsigned G = gridDim.x * gridDim.y * gridDim.z;
  unsigned sum, cnt, mine, sp = 0u;
  for (;;) {
    sum = 0u; cnt = 0u; mine = 0u;
#pragma unroll
    for (unsigned j = 0; j < 16; ++j) { const unsigned c = xb_ld(&bar[XB_XCNT(j)]); sum += c; cnt += (c > 0u) ? 1u : 0u; mine = (j == x) ? c : mine; }
    if (sum == G) break;
    __builtin_amdgcn_s_sleep(1);
    if ((++sp & 255u) == 0u) { if (xb_ld(&bar[XB_TMO])) break; if (sp > XB_SPIN_CAP) { atomicAdd(&bar[XB_TMO], 1u); break; } }
  }
  nloc = mine > 0u ? mine : 1u; nx = cnt > 0u ? cnt : 1u;
}
DEVFN void xcd_barrier(const XcdBarrier& b) {
  const int TIDX = tid_op();
  asm volatile("s_waitcnt vmcnt(0)" ::: "memory");
  __syncthreads();
  if (TIDX == 0) {
    unsigned* bar = b.bar;
    __builtin_amdgcn_s_waitcnt(0);
    unsigned nloc = b.st[0], nx = b.st[1];
    if (nloc == 0u) { xcd_barrier_complete(bar, b.x, nloc, nx); b.st[0] = nloc; b.st[1] = nx; }
    const unsigned old = xb_add(&bar[XB_XSUB(b.x)], 1u);
    const unsigned gen = old / nloc;
    if (old + 1u == (gen + 1u) * nloc) {
      __builtin_amdgcn_fence(__ATOMIC_RELEASE, "agent");
      asm volatile("s_waitcnt vmcnt(0)" ::: "memory");
      const unsigned og = xb_add(&bar[XB_TOP], 1u);
      const unsigned tg = og / nx;
      if (og + 1u == (tg + 1u) * nx) xb_add(&bar[XB_TOPGEN], 1u);
      else XB_SPIN(xb_ld(&bar[XB_TOPGEN]) == tg, bar);
      __builtin_amdgcn_fence(__ATOMIC_ACQUIRE, "agent");
      xb_add(&bar[XB_XGEN(b.x)], 1u);
      asm volatile("s_waitcnt vmcnt(0)" ::: "memory");
    } else {
      XB_SPIN(xb_ld(&bar[XB_XGEN(b.x)]) == gen, bar);
      __builtin_amdgcn_fence(__ATOMIC_ACQUIRE, "agent");
      asm volatile("s_waitcnt vmcnt(0)" ::: "memory");
    }
  }
  __syncthreads();
}

DEVFN void cache_ckv_all(const Params& p, int l, int gtid, int gthreads) {
  const int i = l >> 1;
  for (int e = gtid; e < DB * PAST * 20; e += gthreads) {
    const int c8 = e % 20, pos = (e / 20) % PAST, b = e / (20 * PAST);
    const int kr = MP + b * TKS + DS + pos; const size_t crow = ((size_t)(b * 2 + i) * PAST + pos);
    h16x8 o;
    if (c8 < 16) {
      const f32x4 a0 = *(const f32x4*)(p.cache_mla_ckv + crow * 128 + c8 * 8), a1 = *(const f32x4*)(p.cache_mla_ckv + crow * 128 + c8 * 8 + 4);
      const f32x4 g0 = *(const f32x4*)(p.mla_kva_norm + i * 128 + c8 * 8), g1 = *(const f32x4*)(p.mla_kva_norm + i * 128 + c8 * 8 + 4);
#pragma unroll
      for (int j = 0; j < 4; j++) { o[j] = (h16)(a0[j] * __builtin_amdgcn_rcpf(g0[j])); o[4 + j] = (h16)(a1[j] * __builtin_amdgcn_rcpf(g1[j])); }
      *(h16x8*)(p.ckv16 + pidx(KM, kr, c8 * 8)) = o;
      if (c8 == 0) p.rowss_ckv[(size_t)i * KM + kr] = 128.f * (1.f - EPSN);
    } else {
      const f32x4 a0 = *(const f32x4*)(p.cache_mla_kpe + crow * 32 + (c8 - 16) * 8), a1 = *(const f32x4*)(p.cache_mla_kpe + crow * 32 + (c8 - 16) * 8 + 4);
#pragma unroll
      for (int j = 0; j < 4; j++) { o[j] = (h16)a0[j]; o[4 + j] = (h16)a1[j]; }
      *(h16x8*)(p.kpe16 + (size_t)kr * 32 + (c8 - 16) * 8) = o;
    }
  }
}
DEVFN void cache_items(const Params& p, int l, int gtid, int gthreads) {
  const int i = l >> 1; const bool odd = l & 1;
  const int nkc = odd ? 80 : 64, nvr = odd ? 640 : 512;
  const int NK = DB * PAST * nkc, NV = DB * (PAST / 8) * nvr;
  for (int e = gtid; e < NK + NV; e += gthreads) {
    if (e < NK) {
      const int ch = e % nkc, bp = e / nkc; const int pos = bp % PAST, b = bp / PAST;
      const int kr = MP + b * TKS + DS + pos; const size_t crow = ((size_t)(b * 2 + i) * PAST + pos);
      const float* src; h16* dst;
      if (!odd) { src = p.cache_diff_k + crow * 512 + ch * 8; dst = p.KB + ((size_t)(ch >> 3) * KM + kr) * 64 + (ch & 7) * 8; }
      else if (ch < 64) { src = p.cache_na_k + crow * 512 + ch * 8; dst = p.KA + ((size_t)(ch >> 3) * KM + kr) * 64 + (ch & 7) * 8; }
      else { const int c = ch - 64; src = p.cache_gqa_k + crow * 128 + c * 8; dst = p.KB + ((size_t)(c >> 3) * KM + kr) * 64 + (c & 7) * 8; }
      const f32x4 x0 = *(const f32x4*)src, x1 = *(const f32x4*)(src + 4);
      h16x8 o = {(h16)x0[0], (h16)x0[1], (h16)x0[2], (h16)x0[3], (h16)x1[0], (h16)x1[1], (h16)x1[2], (h16)x1[3]};
      *(h16x8*)dst = o;
    } else {
      const int v = e - NK; const int c = v % nvr, g = v / nvr; const int pos0 = (g % (PAST / 8)) * 8, b = g / (PAST / 8);
      const int kr0 = MP + b * TKS + DS + pos0; const size_t crow0 = ((size_t)(b * 2 + i) * PAST + pos0);
      const float* src; int pitch; h16* dst;
      if (!odd) { src = p.cache_diff_v + crow0 * 512 + c; pitch = 512; dst = p.VB + vidx(c, kr0); }
      else if (c < 512) { src = p.cache_na_v + crow0 * 512 + c; pitch = 512; dst = p.VA + vidx(c, kr0); }
      else { src = p.cache_gqa_v + crow0 * 128 + (c - 512); pitch = 128; dst = p.VB + vidx(c - 512, kr0); }
      float x[8];
#pragma unroll
      for (int k = 0; k < 8; k++) x[k] = src[(size_t)k * pitch];
      h16x8 o;
#pragma unroll
      for (int k = 0; k < 8; k++) o[k] = (h16)x[k];
      *(h16x8*)dst = o;
    }
  }
}

DEVFN void mod_item(const Params& p, int item, char* lds, bool dry = false) {
  const int tid = tid_op();
  const int l = item / 192, rem = item % 192, nchunk = rem / 32, kc = rem % 32;
  float* sil = (float*)lds;
  if (tid < NCV * 32) { const int cv = tid >> 5, k = tid & 31; const float* cvec = cv == 0 ? p.c_ctx : p.c + (size_t)(cv - 1) * D; sil[tid] = siluf(cvec[kc * 32 + k]); }
  const int col = nchunk * 512 + tid;
  const float* w = p.w_mod + ((size_t)l * D + kc * 32) * 3072 + col;
  float wv[32];
#pragma unroll
  for (int k = 0; k < 32; k++) wv[k] = w[(size_t)k * 3072];
  __syncthreads();
  float acc[NCV];
#pragma unroll
  for (int c = 0; c < NCV; c++) acc[c] = 0.f;
#pragma unroll
  for (int k = 0; k < 32; k++) {
#pragma unroll
    for (int c = 0; c < NCV; c++) acc[c] += sil[c * 32 + k] * wv[k];
  }
  const float b = kc == 0 ? p.b_mod[l * 3072 + col] : 0.f;
#pragma unroll
  for (int c = 0; c < NCV; c++) if (!dry) atomicAdd(p.modv + ((size_t)l * NCV + c) * 3072 + col, acc[c] + b);
  __syncthreads();
}
struct ConvDesc { const float* src; h16* dst; const float* kscale; int R, Nsrc, mode, nb, kb; bool has_scale; };
constexpr int CV_WIN_E = (NPE / 64) * 16, CV_WIN_O = (NPO / 64) * 16, CV_WOUT = 256, CV_WQB = 64, CV_WKVB = 32;
constexpr int CV_PER_PAIR = CV_WIN_E + CV_WIN_O + 2 * CV_WOUT + CV_WQB + CV_WKVB;
constexpr int CV_TOTAL = 2 * CV_PER_PAIR;
constexpr int CV_L_EVEN = CV_WIN_E + CV_WOUT + CV_WQB + CV_WKVB;
DEVFN ConvDesc conv_desc(const Params& p, int item) {
  const int i = item / CV_PER_PAIR; int r = item % CV_PER_PAIR;
  ConvDesc d; d.kscale = p.norm_w; d.has_scale = false;
  if (r < CV_WIN_E) { d.src = p.w_in_even + (size_t)i * D * EVEN_IN; d.dst = p.win16 + (size_t)(2 * i) * NPO * D; d.R = NPO; d.Nsrc = EVEN_IN; d.mode = 4; d.nb = (r % (NPE / 64)) * 64; d.kb = (r / (NPE / 64)) * 64; return d; }
  r -= CV_WIN_E;
  if (r < CV_WOUT) { d.src = p.w_out_even + (size_t)i * D * D; d.dst = p.wout16 + (size_t)(2 * i) * D * D; d.R = 1024; d.Nsrc = D; d.mode = 0; d.nb = (r % 16) * 64; d.kb = (r / 16) * 64; return d; }
  r -= CV_WOUT;
  if (r < CV_WQB) { d.src = p.mla_wqb + (size_t)i * 256 * 768; d.dst = p.wqb16 + (size_t)i * 1024 * 256; d.R = 1024; d.Nsrc = 768; d.mode = 2; d.kscale = p.mla_qa_norm + i * 256; d.has_scale = true; d.nb = (r % 16) * 64; d.kb = (r / 16) * 64; return d; }
  r -= CV_WQB;
  if (r < CV_WKVB) { d.src = p.mla_wkvb + (size_t)i * 128 * 1024; d.dst = p.wkvb16 + (size_t)i * 1024 * 128; d.R = 1024; d.Nsrc = 1024; d.mode = 3; d.kscale = p.mla_kva_norm + i * 128; d.has_scale = true; d.nb = (r % 16) * 64; d.kb = (r / 16) * 64; return d; }
  r -= CV_WKVB;
  if (r < CV_WIN_O) { d.src = p.w_in_odd + (size_t)i * D * ODD_IN; d.dst = p.win16 + (size_t)(2 * i + 1) * NPO * D; d.R = NPO; d.Nsrc = ODD_IN; d.mode = 5; d.nb = (r % (NPO / 64)) * 64; d.kb = (r / (NPO / 64)) * 64; return d; }
  r -= CV_WIN_O;
  d.src = p.w_out_odd + (size_t)i * D * D; d.dst = p.wout16 + (size_t)(2 * i + 1) * D * D; d.R = 1024; d.Nsrc = D; d.mode = 0; d.nb = (r % 16) * 64; d.kb = (r / 16) * 64; return d;
}
template <int NB>
DEVFN void conv_batch(const Params& p, int it0, int stride, int limit, char* lds) {
  const int tid = tid_op();
  const int j = tid & 63, k0 = tid >> 6;
  ConvDesc d[NB]; float v[NB][8]; float msk[NB]; bool ok[NB];
#pragma unroll
  for (int b = 0; b < NB; b++) {
    const int item = it0 + b * stride; ok[b] = item < limit;
    d[b] = conv_desc(p, ok[b] ? item : it0);
    const int np = d[b].nb + j; int col; const int mode = d[b].mode;
    if (mode == 0) col = np; else if (mode == 4) col = even_col(inproj_pos_col(np)); else if (mode == 5) col = inproj_pos_col(np); else if (mode == 3) { int hh = (np & 511) >> 6; col = hh * 128 + (np >> 9) * 64 + (np & 63); } else { int h = np >> 7, jj = np & 127; col = jj < 96 ? h * 96 + jj : -1; }
    const int colc = col < 0 ? 0 : col; msk[b] = col < 0 ? 0.f : 1.f;
    if (ok[b]) {
#pragma unroll
      for (int i = 0; i < 8; i++) v[b][i] = d[b].src[(size_t)(d[b].kb + k0 + 8 * i) * d[b].Nsrc + colc];
    }
  }
#pragma unroll
  for (int b = 0; b < NB; b++) {
    if (ok[b]) {
      float (*t)[65] = (float (*)[65])(lds + b * 16640);
      if (d[b].has_scale) {
#pragma unroll
        for (int i = 0; i < 8; i++) v[b][i] *= d[b].kscale[d[b].kb + k0 + 8 * i];
      }
#pragma unroll
      for (int i = 0; i < 8; i++) t[k0 + 8 * i][j] = v[b][i] * msk[b];
    }
  }
  __syncthreads();
#pragma unroll
  for (int b = 0; b < NB; b++) {
    if (ok[b]) {
      float (*t)[65] = (float (*)[65])(lds + b * 16640);
#pragma unroll
      for (int i = 0; i < 8; i++) { const int jj = k0 + 8 * i; d[b].dst[pidx(d[b].R, d[b].nb + jj, d[b].kb + j)] = (h16)t[j][jj]; }
    }
  }
  __syncthreads();
}
DEVFN void conv_batch4(const Params& p, int it0, int stride, int limit, char* lds) { conv_batch<4>(p, it0, stride, limit, lds); }
DEVFN void tab_items(const Params& p, int gtid, int gthreads) {
  for (int g = gtid; g < DS * 48; g += gthreads) {
    if (g < 2) {
      const int i = g, l = 2 * i; float s1 = 0, s2 = 0;
      for (int k = 0; k < 64; k++) { s1 += p.diff_lq1[i * 64 + k] * p.diff_lk1[i * 64 + k]; s2 += p.diff_lq2[i * 64 + k] * p.diff_lk2[i * 64 + k]; }
      p.lamv[i] = expf(s1) - expf(s2) + (0.8f - 0.6f * expf(-0.3f * l));
    }
    const int t = g / 48, j = g % 48;
    const float row = (float)(t / GW), col = (float)(t % GW);
    if (j < 32) { const int f = j & 15; const float inv = powf(10000.f, -(float)(2 * f) / 32.f); const float ang = (j < 16 ? row : col) * inv; p.ropeC64[t * 32 + j] = cosf(ang); p.ropeS64[t * 32 + j] = sinf(ang); }
    else { const int jj = j - 32; const int f = jj & 7; const float inv = powf(10000.f, -(float)(2 * f) / 16.f); const float ang = (jj < 8 ? row : col) * inv; p.ropeC32[t * 16 + jj] = cosf(ang); p.ropeS32[t * 16 + jj] = sinf(ang); }
  }
}
DEVFN void bias_row(const Params& p, int l, int np, int lane) {
  const h16* w = p.win16 + (size_t)l * NPO * D;
  float a[NCV];
#pragma unroll
  for (int c = 0; c < NCV; c++) a[c] = 0;
#pragma unroll
  for (int i = 0; i < 2; i++) {
    const int k = (i * 64 + lane) * 8; h16x8 wv = *(const h16x8*)(w + pidx(NPO, np, k));
#pragma unroll
    for (int c = 0; c < NCV; c++) { const float* sh = p.modv + ((size_t)l * NCV + c) * 3072 + k;
#pragma unroll
      for (int e = 0; e < 8; e++) a[c] += sh[e] * (float)wv[e]; }
  }
#pragma unroll
  for (int c = 0; c < NCV; c++) { float v = a[c]; for (int o = 32; o; o >>= 1) v += __shfl_xor(v, o); if (lane == 0) p.biasv[((size_t)l * NCV + c) * NPO + np] = v; }
}
DEVFN void prepx_row(const Params& p, int l, int m, int lane) {
  const float* x = xrow(p, l, m); const float* md = p.modv + ((size_t)l * NCV + tok_cv(m)) * 3072 + 1024; const float* nw = p.norm_w + l * D;
  float ss = 0;
#pragma unroll
  for (int i = 0; i < 4; i++) {
    const int k = (i * 64 + lane) * 4;
    f32x4 v = *(const f32x4*)(x + k); f32x4 s = *(const f32x4*)(md + k); f32x4 w = *(const f32x4*)(nw + k);
    h16x4 o;
#pragma unroll
    for (int e = 0; e < 4; e++) { ss += v[e] * v[e]; o[e] = (h16)(v[e] * w[e] * (1.f + s[e])); }
    *(h16x4*)(p.xs16 + pidx(M, m, k)) = o;
  }
  for (int o = 32; o; o >>= 1) ss += __shfl_xor(ss, o);
  if (lane == 0) p.rowss_l[(size_t)l * M + m] = ss;
}
#define AS4 __attribute__((address_space(4)))
#define PHASE_PARAMS(q) const Params& q = p_unused;
__global__ void __launch_bounds__(512) mega_kernel(Params p_unused) {
  __shared__ __attribute__((aligned(16))) char lds[G_LDS2 + 16];
  if (threadIdx.x == 0) { volatile LAS unsigned* st = (volatile LAS unsigned*)(lds + G_LDS2); st[0] = 0u; st[1] = 0u; st[2] = 0u; st[3] = 0u; }
  __syncthreads();
  XcdBarrier bar;
  { PHASE_PARAMS(p); bar = xcd_barrier_post(p.bar, (volatile LAS unsigned*)(lds + G_LDS2)); }
  const int nb = gridDim.x, bid = blockIdx.x;
  LAS unsigned char* ldsa = (LAS unsigned char*)lds;
  { PHASE_PARAMS(p);
    for (int rep = 0; rep < REP_0A; rep++)
    {
#pragma unroll 1
      for (int it = bid; it < 768; it += nb) mod_item(p, it, lds, rep > 0);
      {
        const int nit = (CV_PER_PAIR - bid + nb - 1) / nb; int done = 0;
        if (nit >= 5 && (nit & 3) == 1) { conv_batch<5>(p, bid, nb, CV_PER_PAIR, lds); done = 5; }
#pragma unroll 1
        for (; done < nit; done += 4) conv_batch4(p, bid + done * nb, nb, CV_PER_PAIR, lds);
      }
    }
    tab_items(p, bid * 512 + tid_op(), nb * 512); }
  xcd_barrier(bar);
  { PHASE_PARAMS(p);
    const int tid = tid_op(); const int lane = tid & 63, gw = bid * 8 + (tid >> 6), nw = nb * 8;
    for (int rep = 0; rep < REP_0B; rep++)
    for (int r = gw; r < (NPE + NPO) + M; r += nw) {
      if (r < NPE + NPO) bias_row(p, r < NPE ? 0 : 1, r < NPE ? r : r - NPE, lane);
      else prepx_row(p, 0, r - (NPE + NPO), lane);
    }
    cache_ckv_all(p, 0, bid * 512 + tid, nb * 512); }
  xcd_barrier(bar);
#pragma unroll 1
  for (int l = 0; l < 4; l++) {
    { PHASE_PARAMS(p);
#pragma unroll 1
      for (int rep = 1; rep < REP_GK; rep++) { NullEpi ne; gemm8_phase(ldsa, p.xs16, M, p.win16 + (size_t)l * NPO * D, NPO, D, M / 256, ((l & 1) ? NPO : NPE) / 256, ne); }
#pragma unroll 1
      for (int rep = 0; rep < REP_A; rep++) {
        InprojEpi epi{p, l, rep > 0, ldsa + G8_STAGE};
        gemm8_phase(ldsa, p.xs16, M, p.win16 + (size_t)l * NPO * D, NPO, D, M / 256, ((l & 1) ? NPO : NPE) / 256, epi);
      }
      {
        const int nun = (M / 256) * (((l & 1) ? NPO : NPE) / 256); const int fi = nun - nb; const bool part = fi > 0 && fi < nb;
        const int cstart = part ? bid - fi : bid, cn = part ? nb - fi : nb;
        if (cstart >= 0) {
          cache_items(p, l, cstart * 512 + tid_op(), cn * 512);
          if (l == 1) cache_ckv_all(p, 2, cstart * 512 + tid_op(), cn * 512);
        }
      }
      if ((l & 1) == 0) {
        const int k = nb >= 16 ? bid - (nb - 16) : bid;
        if (k >= 0) {
#pragma unroll 1
          for (int kk = k; kk < 16; kk += (nb >= 16 ? 16 : nb)) kvgemm_tile(p, l, (MP + (kk >> 3) * TKS + DS) / 256, kk & 7, lds);
        }
      }
      if (l < 2) {
        const int nun = (M / 256) * (((l & 1) ? NPO : NPE) / 256); const int fi = nun - nb;
        const bool part = fi > 0 && fi < nb;
        const int nshare = part ? ((l == 0 && nb - fi > 32) ? nb - fi - 16 : nb - fi) : nb;
        const int start = part ? bid - fi : bid, stride = nshare;
        if (start >= 0 && start < nshare) {
          const int c0 = CV_PER_PAIR + (l == 0 ? 0 : CV_L_EVEN), c1 = l == 0 ? CV_PER_PAIR + CV_L_EVEN : CV_TOTAL;
#pragma unroll 1
          for (int it = c0 + start; it < c1; it += 4 * stride) conv_batch4(p, it, stride, c1, lds);
          if (l == 1) {
            const int tid = tid_op(); const int lane = tid & 63;
#pragma unroll 1
            for (int r = start * 8 + (tid >> 6); r < NPE; r += stride * 8) bias_row(p, 2, r, lane);
          }
        }
      }
      if (l == 2) {
        const int fi = (M / 256) * (NPE / 256) - nb; const bool part = fi > 0 && fi < nb;
        const int start = part ? bid - fi : bid, cnt = part ? nb - fi : nb;
        if (start >= 0) {
          const int tid = tid_op(); const int lane = tid & 63;
#pragma unroll 1
          for (int r = start * 8 + (tid >> 6); r < NPO; r += cnt * 8) bias_row(p, 3, r, lane);
        }
      }
    }
    if ((l & 1) == 0) {
      PHASE_PARAMS(p);
      constexpr int NKVP = KM / 256 - DB;
      constexpr int NQ = (M / 256) * 8, NT2 = NQ + NKVP * 8;
      const bool merged = nb == 256 && NT2 == 512;
      if (!merged) xcd_barrier(bar);
      const int i = l >> 1;
      int t0, cnt, stride;
      if (merged) { const bool one = bid >= 128; const int nA = l == 0 ? A2_NA0 : A2_NA2, nB = 4 - nA;
        cnt = one ? nA : nB; t0 = one ? (bid - 128) * nA : 128 * nA + bid * nB; stride = 1; }
      else { t0 = bid; cnt = (NT2 - bid + nb - 1) / nb; stride = nb; }
      auto tmap = [&](int k) { const int w = t0 + k * stride; return w < NT2 - NQ ? NQ + w : w - (NT2 - NQ); };
      if (cnt > 0) hf_wait_all(cnt, 8u, [&](int k) { const int t = tmap(k); return t < NQ ? hf_flag(p, i, 0, t % (M / 256)) : hf_flag(p, i, 1, (t - NQ) % NKVP); });
#pragma unroll 1
      for (int k = 0; k < cnt; k++) {
        const int t = tmap(k);
        if (t < NQ) { const int mt = t % (M / 256); qgemm_tile(p, l, mt, t / (M / 256), lds); }
        else {
          const int u = t - NQ; const int tp = u % NKVP, nt = u / NKVP;
          constexpr int CP0 = (MP + DS) / 256;
          const int q = tp < CP0 ? tp : (DB > 1 && tp >= CP0 + DS / 256 ? tp + 2 : tp + 1);
          if (nt == 0 && tp < MP / 256) {
            const float* rck = p.rowss_ckv + (size_t)i * KM; const int tid = tid_op();
            const int jc = (tid & 15) * 8, mr = tp * 256 + (tid >> 4);
            const f32x4 g0 = *(const f32x4*)(p.mla_kva_norm + i * 128 + jc), g1 = *(const f32x4*)(p.mla_kva_norm + i * 128 + jc + 4);
            h16x8 cv[8]; float rs[8];
#pragma unroll
            for (int k = 0; k < 8; k++) { const int m = mr + 32 * k; cv[k] = *(const h16x8*)(p.ckv16 + pidx(KM, m, jc)); rs[k] = rck[m]; }
#pragma unroll
            for (int k = 0; k < 8; k++) {
              const int m = mr + 32 * k; const float r = frsq(rs[k] * (1.f / 128.f) + EPSN);
              float* dst = p.o_ckv + st_row(m, i) * 128 + jc;
              const f32x4 o0 = {(float)cv[k][0] * r * g0[0], (float)cv[k][1] * r * g0[1], (float)cv[k][2] * r * g0[2], (float)cv[k][3] * r * g0[3]};
              const f32x4 o1 = {(float)cv[k][4] * r * g1[0], (float)cv[k][5] * r * g1[1], (float)cv[k][6] * r * g1[2], (float)cv[k][7] * r * g1[3]};
              *(f32x4*)dst = o0; *(f32x4*)(dst + 4) = o1;
            }
          }
          kvgemm_tile(p, l, q, nt, lds);
        }
      }
    }
    xcd_barrier(bar);
    { PHASE_PARAMS(p);
      for (int rep = 0; rep < REP_B; rep++)
      {
        if ((l & 1) == 0) {
#pragma unroll 1
          for (int it = bid; it < 512; it += nb) attn_even_item(p, l, it, lds);
        } else {
          const bool lpt = nb == 256;
          const int n = lpt ? 2 : (512 - bid + nb - 1) / nb;
#pragma unroll 1
          for (int k = 0; k < n; k++) {
            const int it = !lpt ? bid + k * nb : (k == 0 ? bid : (bid < 128 ? 384 + bid : 256 + (bid - 128)));
            attn_odd_item(p, l, it, lds);
          }
        }
      } }
    { PHASE_PARAMS(p);
      for (int rep = 0; rep < REP_C; rep++)
      for (int t = bid; t < 32 * 8; t += nb) {
        const int mt = t % 32;
        outproj_tile(p, l, mt, t / 32, lds, rep < REP_C - 1, hf2_flag(p, l, mt));
      } }
    if (l < 3) { for (int rep = 0; rep < REP_BAR; rep++) xcd_barrier(bar); }
  }
}
#endif

static inline size_t al256(size_t x) { return (x + 255) & ~(size_t)255; }

extern "C" void kernel_launch(void* const* d_in, const int* in_sizes, int n_in, void* d_out, int out_size, void* d_ws, size_t ws_size,
                              hipStream_t stream) {
  Params p{};
  const float** ip = (const float**)&p.x_prompt;
  for (int k = 0; k < 39; k++) ip[k] = (const float*)d_in[k];
  float* o = (float*)d_out;
  p.Y = o; o += (size_t)M * 1024;
  p.o_ckv = o; o += (size_t)BATCH * 2 * SEQ * 128;
  p.o_kpe = o; o += (size_t)BATCH * 2 * SEQ * 32;
  p.o_dk = o; o += (size_t)BATCH * 2 * SEQ * 512;
  p.o_dv = o; o += (size_t)BATCH * 2 * SEQ * 512;
  p.o_nk = o; o += (size_t)BATCH * 2 * SEQ * 512;
  p.o_nv = o; o += (size_t)BATCH * 2 * SEQ * 512;
  p.o_gk = o; o += (size_t)BATCH * 2 * SEQ * 128;
  p.o_gv = o; o += (size_t)BATCH * 2 * SEQ * 128;
  char* w = (char*)d_ws; size_t off = 0;
  auto take = [&](size_t bytes) { char* r = w + off; off += al256(bytes); return r; };
  char* zero0 = w + off;
  p.bar = (unsigned*)take(65536);
  p.modv = (float*)take((size_t)4 * NCV * 3072 * 4);
  p.rowss_qa = (float*)take((size_t)2 * M * 4); p.rowss_l = (float*)take((size_t)4 * M * 4); p.rowss_ckv = (float*)take((size_t)2 * KM * 4);
  const size_t zero_bytes = (size_t)((w + off) - zero0);
  p.ropeC64 = (float*)take((size_t)DS * 32 * 4); p.ropeS64 = (float*)take((size_t)DS * 32 * 4);
  p.ropeC32 = (float*)take((size_t)DS * 16 * 4); p.ropeS32 = (float*)take((size_t)DS * 16 * 4);
  p.lamv = (float*)take(256);
  p.rstdx = (float*)take((size_t)M * 4);
  p.QA = (h16*)take((size_t)M * 8 * 96 * 2); p.QB = (h16*)take((size_t)M * 8 * 64 * 2);
  p.KA = (h16*)take((size_t)8 * KM * 128 * 2); p.KB = (h16*)take((size_t)8 * KM * 64 * 2);
  p.VA = (h16*)take((size_t)8 * 64 * KM * 2); p.VB = (h16*)take((size_t)8 * 64 * KM * 2);
  p.gates16 = (h16*)take((size_t)M * 1024 * 2); p.O16 = (h16*)take((size_t)M * 1024 * 2);
  p.ckvbuf = (float*)take((size_t)KM * 128 * 4); p.kpebuf = (float*)take((size_t)KM * 32 * 4);
  p.xs16 = (h16*)take((size_t)M * D * 2); p.x16 = (h16*)take((size_t)M * D * 2); p.qa16 = (h16*)take((size_t)M * 256 * 2); p.ckv16 = (h16*)take((size_t)KM * 128 * 2); p.kpe16 = (h16*)take((size_t)KM * 32 * 2); p.biasv = (float*)take((size_t)4 * NCV * NPO * 4);
  p.win16 = (h16*)take((size_t)4 * NPO * D * 2); p.wout16 = (h16*)take((size_t)4 * D * D * 2);
  p.wqb16 = (h16*)take((size_t)2 * 1024 * 256 * 2); p.wkvb16 = (h16*)take((size_t)2 * 1024 * 128 * 2);
  size_t ub = (size_t)M * 3328 * 2, ab = (size_t)M * 1536 * 4;
  char* big = take(ub > ab ? ub : ab);
  p.ubuf = (h16*)big; p.abuf = (float*)big;
  (void)ws_size; (void)n_in; (void)in_sizes; (void)out_size;

#ifndef CPU_EMU
  {
    (void)hipMemsetAsync(zero0, 0, zero_bytes, stream);
    static int cus = 0;
    if (!cus) { int dev = 0; (void)hipGetDevice(&dev); (void)hipDeviceGetAttribute(&cus, hipDeviceAttributeMultiprocessorCount, dev); }
    void* args[] = {&p};
    (void)hipLaunchCooperativeKernel((void*)mega_kernel, dim3(cus), dim3(512), args, 0, stream);
  }
#else
  (void)zero0; (void)zero_bytes;
  launch1d(nk_mod, (long)4 * NCV * 3072, stream, p, (long)4 * NCV * 3072);
  launch1d(nk_tab, (long)DS * 48, stream, p, (long)DS * 48);
  for (int l = 0; l < 4; l++) {
    const int N = (l & 1) ? ODD_IN : EVEN_IN;
    launch1d(nk_rstd, (long)M, stream, p, l, (long)M);
    launch1d(nk_inproj, (long)M * N, stream, p, l, (long)M * N);
    if ((l & 1) == 0) {
      launch1d(nk_epi_even, (long)M * 50, stream, p, l, 0, (long)M * 50);
      launch1d(nk_cache_even, (long)DB * PAST * 17, stream, p, l, (long)DB * PAST * 17);
      launch1d(nk_kv, (long)KM * 16, stream, p, l, (long)KM * 16);
      launch1d(nk_attn_dense, (long)M * 8, stream, p, 0, 0, M, (long)M * 8);
      launch1d(nk_attn_dense, (long)M * 16, stream, p, 1, 0, M, (long)M * 16);
      launch1d(nk_fin, (long)M * 12, stream, p, l, (long)M * 12);
    } else {
      launch1d(nk_epi_odd, (long)M * 52, stream, p, l, (long)M * 52);
      launch1d(nk_cache_odd, (long)DB * PAST * 20, stream, p, l, (long)DB * PAST * 20);
      launch1d(nk_attn_dense, (long)MP * 8, stream, p, 2, 0, MP, (long)MP * 8);
      launch1d(nk_attn_na, (long)MS * 8, stream, p, l, (long)MS * 8);
      launch1d(nk_attn_dense, (long)M * 8, stream, p, 3, 0, M, (long)M * 8);
      launch1d(nk_fin, (long)M * 16, stream, p, l, (long)M * 16);
    }
    launch1d(nk_outproj, (long)M * 1024, stream, p, l, (long)M * 1024);
  }
#endif
}
```
